# Optimizing an MI355X kernel written in HIP

```python
import math
import jax, jax.numpy as jnp
from jax import lax
import numpy as np

D_MODEL = 1024
BATCH = 4
SEQ = 4096
DEPTH = 4

CHUNK = 64
N_MIXERS = 3
EPS = 1e-6
N_FOX = (DEPTH + 2) // 3
N_S5 = (DEPTH + 1) // 3
N_POOL = DEPTH // 3
FOX_HEADS = 16
FOX_HEAD_DIM = D_MODEL // FOX_HEADS
Q_BLOCK = 128
FOX_IN = 3 * D_MODEL + FOX_HEADS
FORGET_BIAS_CENTER = 3.0
S5_GROUP = 16
S5_GROUPS = D_MODEL // S5_GROUP
S5_STATE = 64
S5_DT_MIN = 1e-3
S5_DT_MAX = 1e-1
POOL_WINDOWS = (2, 4, 8, 16)
POOL_GROUPS = len(POOL_WINDOWS)
POOL_WIDTH = D_MODEL // POOL_GROUPS
D_FF = -(-8 * D_MODEL // (3 * 256)) * 256

kernel_name = "interleaved_fox_s5_pool_hybrid"

F32 = jnp.float32


def rms_norm(x, g):
    xf = x.astype(F32)
    y = xf * lax.rsqrt(jnp.mean(xf * xf, axis=-1, keepdims=True) + EPS)
    return (y * g.astype(F32)).astype(x.dtype)


def forgetting_attention(h, w_in, b_f, w_out):
    B, S, _ = h.shape
    proj = h @ w_in
    q, k, v, f_logit = jnp.split(proj, [D_MODEL, 2 * D_MODEL, 3 * D_MODEL], axis=-1)

    def heads(t):
        return t.reshape(B, S, FOX_HEADS, FOX_HEAD_DIM).transpose(0, 2, 1, 3).astype(F32)

    q, k, v = heads(q), heads(k), heads(v)
    log_f = jax.nn.log_sigmoid(f_logit.astype(F32) + b_f.astype(F32))
    c = jnp.cumsum(log_f, axis=1).transpose(0, 2, 1)
    n_blk = S // Q_BLOCK
    q_blocks = q.reshape(B, FOX_HEADS, n_blk, Q_BLOCK, FOX_HEAD_DIM).transpose(2, 0, 1, 3, 4)
    c_blocks = c.reshape(B, FOX_HEADS, n_blk, Q_BLOCK).transpose(2, 0, 1, 3)
    starts = jnp.arange(n_blk, dtype=jnp.int32) * Q_BLOCK
    key_pos = jnp.arange(S, dtype=jnp.int32)
    scale = FOX_HEAD_DIM ** -0.5

    def one_block(args):
        q_b, c_b, start = args
        logits = jnp.einsum('bhqd,bhkd->bhqk', q_b, k) * scale
        logits = logits + c_b[..., :, None] - c[..., None, :]
        q_pos = start + jnp.arange(Q_BLOCK, dtype=jnp.int32)
        mask = key_pos[None, :] <= q_pos[:, None]
        p = jax.nn.softmax(jnp.where(mask, logits, -jnp.inf), axis=-1)
        return jnp.einsum('bhqk,bhkd->bhqd', p, v)

    out = lax.map(one_block, (q_blocks, c_blocks, starts))
    out = out.transpose(1, 0, 3, 2, 4).reshape(B, S, D_MODEL).astype(h.dtype)
    return out @ w_out


def s5_layer(h, w_in, a_re, a_im, log_dt, b_re, b_im, c_re, c_im, d, w_glu):
    B, S, _ = h.shape
    u = (h @ w_in).astype(F32)
    u_g = u.reshape(B, S, S5_GROUPS, S5_GROUP).astype(jnp.complex64)
    lam = lax.complex(a_re.astype(F32), a_im.astype(F32))
    dt = jnp.exp(log_dt.astype(F32))[:, None]
    lam_bar = jnp.exp(lam * dt)
    b_mat = lax.complex(b_re.astype(F32), b_im.astype(F32))
    b_bar = ((lam_bar - 1.0) / lam)[..., None] * b_mat
    bu = jnp.einsum('gpc,bsgc->bsgp', b_bar, u_g)
    lam_seq = jnp.broadcast_to(lam_bar, bu.shape)

    def combine(left, right):
        a_l, s_l = left
        a_r, s_r = right
        return a_r * a_l, a_r * s_l + s_r

    _, states = lax.associative_scan(combine, (lam_seq, bu), axis=1)
    c_mat = lax.complex(c_re.astype(F32), c_im.astype(F32))
    y = jnp.einsum('gcp,bsgp->bsgc', c_mat, states).real.reshape(B, S, D_MODEL)
    y = y + d.astype(F32) * u
    g = jax.nn.gelu(y).astype(h.dtype)
    val, gate = jnp.split(g @ w_glu, 2, axis=-1)
    return val * jax.nn.sigmoid(gate)


def multiscale_pool(h, w_grp, b_grp, scale):
    B, S, _ = h.shape
    hf = h.astype(F32).reshape(B, S, POOL_GROUPS, POOL_WIDTH)
    count_base = jnp.arange(1, S + 1, dtype=F32)[None, :, None]
    outs = []
    for gi, w in enumerate(POOL_WINDOWS):
        xg = hf[:, :, gi]
        cs = jnp.cumsum(xg, axis=1)
        lag = jnp.pad(cs[:, :-w], ((0, 0), (w, 0), (0, 0)))
        mean = (cs - lag) / jnp.minimum(count_base, float(w))
        outs.append(jnp.einsum('bsc,cd->bsd', mean - xg, w_grp[gi].astype(F32)))
    y = jnp.concatenate(outs, axis=-1) + b_grp.astype(F32)
    return (y * scale.astype(F32)).astype(h.dtype)


def swiglu(h, w_gate_up, w_down):
    g, u = jnp.split(h @ w_gate_up, 2, axis=-1)
    return (jax.nn.silu(g) * u) @ w_down


def setup_inputs(seed: int = 0) -> dict:
    key = jax.random.key(seed)
    ks = jax.random.split(key, 24)
    D, H, G, P, C = D_MODEL, FOX_HEADS, S5_GROUPS, S5_STATE, S5_GROUP
    nrm = jax.random.normal
    x = nrm(ks[0], (BATCH, SEQ, D), F32)
    mix_norm_g = 1.0 + 0.05 * nrm(ks[1], (DEPTH, D), F32)
    ffn_norm_g = 1.0 + 0.05 * nrm(ks[2], (DEPTH, D), F32)
    final_norm_g = 1.0 + 0.05 * nrm(ks[3], (D,), F32)
    fox_w_in = nrm(ks[4], (N_FOX, D, FOX_IN), F32) * D ** -0.5
    fox_b_f = FORGET_BIAS_CENTER + 0.5 * nrm(ks[5], (N_FOX, H), F32)
    fox_w_out = nrm(ks[6], (N_FOX, D, D), F32) * D ** -0.5
    s5_w_in = nrm(ks[7], (N_S5, D, D), F32) * D ** -0.5
    s5_a_re = -0.5 + 0.01 * nrm(ks[8], (N_S5, G, P), F32)
    s5_a_im = math.pi * jnp.arange(P, dtype=F32)[None, None, :] + 0.01 * nrm(ks[9], (N_S5, G, P), F32)
    s5_log_dt = jax.random.uniform(ks[10], (N_S5, G), F32, math.log(S5_DT_MIN), math.log(S5_DT_MAX))
    s5_b_re = nrm(ks[11], (N_S5, G, P, C), F32) * (2 * C) ** -0.5
    s5_b_im = nrm(ks[12], (N_S5, G, P, C), F32) * (2 * C) ** -0.5
    s5_c_re = nrm(ks[13], (N_S5, G, C, P), F32) * P ** -0.5
    s5_c_im = nrm(ks[14], (N_S5, G, C, P), F32) * P ** -0.5
    s5_d = nrm(ks[15], (N_S5, D), F32)
    s5_w_glu = nrm(ks[16], (N_S5, D, 2 * D), F32) * D ** -0.5
    pool_w = nrm(ks[17], (N_POOL, POOL_GROUPS, POOL_WIDTH, POOL_WIDTH), F32) * POOL_WIDTH ** -0.5
    pool_b = 0.01 * nrm(ks[18], (N_POOL, D), F32)
    pool_scale = 0.5 + 0.05 * nrm(ks[19], (N_POOL, D), F32)
    ffn_w_gate_up = nrm(ks[20], (DEPTH, D, 2 * D_FF), F32) * D ** -0.5
    ffn_w_down = nrm(ks[21], (DEPTH, D_FF, D), F32) * D_FF ** -0.5
    return {"x": x, "mix_norm_g": mix_norm_g, "ffn_norm_g": ffn_norm_g, "final_norm_g": final_norm_g,
            "fox_w_in": fox_w_in, "fox_b_f": fox_b_f, "fox_w_out": fox_w_out,
            "s5_w_in": s5_w_in, "s5_a_re": s5_a_re, "s5_a_im": s5_a_im, "s5_log_dt": s5_log_dt,
            "s5_b_re": s5_b_re, "s5_b_im": s5_b_im, "s5_c_re": s5_c_re, "s5_c_im": s5_c_im,
            "s5_d": s5_d, "s5_w_glu": s5_w_glu,
            "pool_w": pool_w, "pool_b": pool_b, "pool_scale": pool_scale,
            "ffn_w_gate_up": ffn_w_gate_up, "ffn_w_down": ffn_w_down}


def reference(x, mix_norm_g, ffn_norm_g, final_norm_g, fox_w_in, fox_b_f, fox_w_out,
              s5_w_in, s5_a_re, s5_a_im, s5_log_dt, s5_b_re, s5_b_im, s5_c_re, s5_c_im,
              s5_d, s5_w_glu, pool_w, pool_b, pool_scale, ffn_w_gate_up, ffn_w_down):
    for i in range(DEPTH):
        h = rms_norm(x, mix_norm_g[i])
        kind, j = i % N_MIXERS, i // N_MIXERS
        if kind == 0:
            mix = forgetting_attention(h, fox_w_in[j], fox_b_f[j], fox_w_out[j])
        elif kind == 1:
            mix = s5_layer(h, s5_w_in[j], s5_a_re[j], s5_a_im[j], s5_log_dt[j], s5_b_re[j], s5_b_im[j],
                           s5_c_re[j], s5_c_im[j], s5_d[j], s5_w_glu[j])
        else:
            mix = multiscale_pool(h, pool_w[j], pool_b[j], pool_scale[j])
        x = x + mix.astype(x.dtype)
        x = x + swiglu(rms_norm(x, ffn_norm_g[i]), ffn_w_gate_up[i], ffn_w_down[i]).astype(x.dtype)
    return rms_norm(x, final_norm_g)
```

```cpp
#include <hip/hip_runtime.h>
#include <hip/hip_cooperative_groups.h>
#include <cstdio>
#include <cstdint>
#include <cmath>
#define MK_BAR_SETUP() cooperative_groups::grid_group mk_grid = cooperative_groups::this_grid(); bool mk_first = true; \
    XcdBarrier mk_bar = xcd_barrier_post((unsigned*)(args.ws + WS_CTL) + CW_BAR, (volatile LAS unsigned*)(lds + MISC_OFF) + 8)
#define MK_GRID_BAR() do { if (mk_first) { mk_grid.sync(); mk_first = false; } else xcd_barrier(mk_bar); } while (0)
#define MK_ONE_LAUNCH 1
#define MK_NO_NAIVE 1
#define MK_THRL 24
#define MK_UP_DUMMY 0
#define MK_QKV_NOGATES 0
#define MK_DEFER_WEIGHTS 1
#define MK_SKIP_QK 2.0f
#ifndef MK_PREPASS_REPS
#define MK_PREPASS_REPS 1
#endif
#ifndef MK_TOUCH
#define MK_TOUCH 0
#endif
#ifndef MK_WGM
#define MK_WGM 8
#endif
#ifndef MK_ALIGN_UP
#define MK_ALIGN_UP true
#endif
#ifndef MK_S5TAB_REPS
#define MK_S5TAB_REPS 1
#endif
namespace pg8 {
#define PG8_LAS __attribute__((address_space(3)))
typedef unsigned short bf16_t;
typedef short bf16x8 __attribute__((ext_vector_type(8)));
typedef float f32x4 __attribute__((ext_vector_type(4)));
typedef float f32x2 __attribute__((ext_vector_type(2)));
typedef unsigned u32x4 __attribute__((ext_vector_type(4)));
typedef unsigned u32x2 __attribute__((ext_vector_type(2)));
constexpr int BM = 256, BK = 64, HALF = 128, HTB = HALF * BK * 2  , STAGE_BYTES = 8 * HTB, NXCD = 8, WGM = MK_WGM;

__host__ __device__ __forceinline__ int lds_byte(int r, int c) { const int st = (r >> 4) * 2 + (c >> 5), rr = r & 15, cc = c & 31, ob = rr * 64 + cc * 2; return st * 1024 + (ob ^ (((ob >> 9) & 1) << 5)); }
__host__ __device__ __forceinline__ void stage_rc(int b, int& R, int& C) { const int st = b / 1024, sb = b % 1024, swz = sb ^ (((sb >> 9) & 1) << 5); R = (st >> 1) * 16 + swz / 64; C = (st & 1) * 32 + (swz % 64) / 2; }
__host__ __device__ __forceinline__ int perm32(int rho) { const int n = rho >> 4, i = rho & 15; return 8 * (i >> 2) + 4 * n + (i & 3); }

struct Unit { int pm, pn; };
struct Gemm { const bf16_t* A; const bf16_t* Bt; int K; int lda, ldb; int gatherA; int a_pn_off; };

struct StaticOrder {
    int nM, nN, nwg, G, c;
    __host__ __device__ __forceinline__ void init(int nM_, int nN_, int G_, int c_) { nM = nM_; nN = nN_; nwg = nM * nN; G = G_; c = c_; }
    __host__ __device__ __forceinline__ bool next(int i, Unit& u) const {
        const long L = (long)i * G + c; if (L >= nwg) return false;
        int wgid = (int)L; { const int q = nwg / NXCD, r = nwg % NXCD, xcd = wgid % NXCD, off = wgid / NXCD; wgid = (xcd < r ? xcd * (q + 1) : r * (q + 1) + (xcd - r) * q) + off; }
        const int nig = WGM * nN, gid = wgid / nig, fm = gid * WGM, gsz = (nM - fm) < WGM ? (nM - fm) : WGM;
        u.pm = fm + ((wgid % nig) % gsz); u.pn = (wgid % nig) / gsz; return true;
    }
};

__device__ __forceinline__ unsigned cvt_pk_bf16(float lo, float hi) { unsigned r; asm volatile("v_cvt_pk_bf16_f32 %0, %1, %2" : "=v"(r) : "v"(lo), "v"(hi)); return r; }

template <class Epi, class Sched, bool ALIGN_EPI>
__device__ __forceinline__ void gemm_phase(PG8_LAS unsigned char* lds, const int tid, const Gemm g, const Sched& S, const Epi& E) {
    const int wid = __builtin_amdgcn_readfirstlane(tid >> 6), lane = tid & 63, wr = wid >> 2, wc = wid & 3, fr = lane & 15, fq = lane >> 4;
    const int K = g.K, nt = K / BK;
    unsigned voffA[2], voffB[2];
#pragma unroll
    for (int i = 0; i < 2; ++i) { int R, C; stage_rc(tid * 16 + i * 8192, R, C); const int Rb = Epi::PERM ? ((R & ~31) + perm32(R & 31)) : R;
        voffA[i] = g.gatherA ? (unsigned)(R * g.lda + (C >> 4) * g.gatherA + (C & 15)) * 2u : (unsigned)(R * g.lda + C) * 2u; voffB[i] = (unsigned)(Rb * g.ldb + C) * 2u; }
    const size_t kstepA = g.gatherA ? (size_t)g.gatherA * 8 : (size_t)(BK * 2), kstepB = (size_t)(BK * 2);
    const size_t hstepA = (size_t)HALF * g.lda * 2, hstepB = (size_t)HALF * g.ldb * 2;
    const size_t tstepA = 2 * hstepA, tstepB = 2 * hstepB;
    const unsigned ldsw = (unsigned)wid * 1024u;
    const int aoff = lds_byte(wr * 64 + fr, fq * 8), boff = lds_byte(wc * 32 + fr, fq * 8);
#define PG8_SA(b, h) (((b) * 2 + (h)) * HTB)
#define PG8_SB(b, h) ((4 + (b) * 2 + (h)) * HTB)
#define PG8_STAGE(bufoff, gbase, voff) do { _Pragma("unroll") for (int _i = 0; _i < 2; ++_i) \
        __builtin_amdgcn_global_load_lds((const unsigned*)((const char*)(gbase) + (voff)[_i]), (PG8_LAS unsigned*)(lds + (bufoff) + ldsw + _i * 8192), 16, 0, 0); } while (0)
#define PG8_LDA(dst, b, h) do { _Pragma("unroll") for (int m = 0; m < 4; ++m) _Pragma("unroll") for (int k = 0; k < 2; ++k) dst[m][k] = *(const PG8_LAS bf16x8*)(lds + PG8_SA(b, h) + aoff + m * 2048 + k * 1024); } while (0)
#define PG8_LDB(dst, b, h) do { _Pragma("unroll") for (int n = 0; n < 2; ++n) _Pragma("unroll") for (int k = 0; k < 2; ++k) dst[n][k] = *(const PG8_LAS bf16x8*)(lds + PG8_SB(b, h) + boff + n * 2048 + k * 1024); } while (0)
#define PG8_MMA(ai, bj, At, Bt) do { __builtin_amdgcn_s_setprio(1); _Pragma("unroll") for (int m = 0; m < 4; ++m) _Pragma("unroll") for (int n = 0; n < 2; ++n) _Pragma("unroll") for (int k = 0; k < 2; ++k) \
        acc[ai][bj][m][n] = __builtin_amdgcn_mfma_f32_16x16x32_bf16(Bt[n][k], At[m][k], acc[ai][bj][m][n], 0, 0, 0); __builtin_amdgcn_s_setprio(0); } while (0)
#define PG8_WAIT_V(n) asm volatile("s_waitcnt vmcnt(" #n ")" ::: "memory")
#define PG8_WAIT_L(n) asm volatile("s_waitcnt lgkmcnt(" #n ")" ::: "memory")
#define PG8_BAR __builtin_amdgcn_s_barrier()
#define PG8_SCHED __builtin_amdgcn_sched_barrier(0)
    Unit cur, nxt; int ui = 0;
    if (!S.next(0, cur)) return;
    f32x4 acc[2][2][4][2];
#pragma unroll
    for (int a = 0; a < 2; ++a)
#pragma unroll
        for (int b = 0; b < 2; ++b)
#pragma unroll
            for (int m = 0; m < 4; ++m)
#pragma unroll
                for (int n = 0; n < 2; ++n) acc[a][b][m][n] = (f32x4){0.f, 0.f, 0.f, 0.f};
    bf16x8 At[4][2], B0[2][2], B1[2][2];
    const char* cA = (const char*)g.A + (size_t)cur.pm * tstepA + (size_t)cur.pn * g.a_pn_off; const char* cB = (const char*)g.Bt + (size_t)cur.pn * tstepB;
    PG8_STAGE(PG8_SB(0, 0), cB, voffB); PG8_STAGE(PG8_SB(0, 1), cB + hstepB, voffB); PG8_STAGE(PG8_SA(0, 0), cA, voffA); PG8_STAGE(PG8_SA(0, 1), cA + hstepA, voffA);
    if (wr == 1) PG8_BAR;
    PG8_WAIT_V(2); PG8_BAR;
    PG8_STAGE(PG8_SB(1, 0), cB + kstepB, voffB); PG8_STAGE(PG8_SA(1, 0), cA + kstepA, voffA); PG8_STAGE(PG8_SB(1, 1), cB + hstepB + kstepB, voffB);
    PG8_WAIT_V(6); PG8_BAR;
    for (;;) {
        const bool has_next = S.next(ui + 1, nxt);
        const char* nA = has_next ? (const char*)g.A + (size_t)nxt.pm * tstepA + (size_t)nxt.pn * g.a_pn_off : cA; const char* nB = has_next ? (const char*)g.Bt + (size_t)nxt.pn * tstepB : cB;
        for (int t = 0; t < nt; t += 2) {
            const bool last = (t == nt - 2);
            const char* a1 = cA + (size_t)(t + 1) * kstepA;
            const char* a2 = last ? nA : cA + (size_t)(t + 2) * kstepA; const char* b2 = last ? nB : cB + (size_t)(t + 2) * kstepB;
            const char* a3 = a2 + kstepA; const char* b3 = b2 + kstepB;
            PG8_LDB(B0, 0, 0); PG8_LDB(B1, 0, 1); PG8_SCHED; PG8_LDA(At, 0, 0); PG8_STAGE(PG8_SA(1, 1), a1 + hstepA, voffA);
            PG8_WAIT_V(8); PG8_WAIT_L(0); PG8_BAR; PG8_MMA(0, 0, At, B0); PG8_MMA(0, 1, At, B1); PG8_BAR; PG8_SCHED;
            PG8_LDA(At, 0, 1); PG8_STAGE(PG8_SB(0, 0), b2, voffB); PG8_STAGE(PG8_SB(0, 1), b2 + hstepB, voffB); PG8_STAGE(PG8_SA(0, 0), a2, voffA);
            PG8_WAIT_V(8); PG8_WAIT_L(0); PG8_BAR; PG8_MMA(1, 0, At, B0); PG8_MMA(1, 1, At, B1); PG8_BAR; PG8_SCHED;
            PG8_LDB(B0, 1, 0); PG8_LDB(B1, 1, 1); PG8_SCHED; PG8_LDA(At, 1, 0); PG8_STAGE(PG8_SA(0, 1), a2 + hstepA, voffA);
            PG8_WAIT_V(8); PG8_WAIT_L(0); PG8_BAR; PG8_MMA(0, 0, At, B0); PG8_MMA(0, 1, At, B1); PG8_BAR; PG8_SCHED;
            PG8_LDA(At, 1, 1); PG8_STAGE(PG8_SB(1, 0), b3, voffB); PG8_STAGE(PG8_SB(1, 1), b3 + hstepB, voffB); PG8_STAGE(PG8_SA(1, 0), a3, voffA);
            PG8_WAIT_V(8); PG8_WAIT_L(0); PG8_BAR; PG8_MMA(1, 0, At, B0); PG8_MMA(1, 1, At, B1); PG8_BAR; PG8_SCHED;
        }
        if constexpr (ALIGN_EPI) { if (wr == 0) PG8_BAR; }
        if constexpr (!Epi::AFTER_DRAIN) { int ln_; asm volatile("v_mbcnt_lo_u32_b32 %0, -1, 0\n\tv_mbcnt_hi_u32_b32 %0, -1, %0" : "=v"(ln_)); E(acc, cur, wr, wc, ln_ & 15, ln_ >> 4); }
        if (!has_next) break;
#pragma unroll
        for (int a = 0; a < 2; ++a)
#pragma unroll
            for (int b = 0; b < 2; ++b)
#pragma unroll
                for (int m = 0; m < 4; ++m)
#pragma unroll
                    for (int n = 0; n < 2; ++n) acc[a][b][m][n] = (f32x4){0.f, 0.f, 0.f, 0.f};
        cur = nxt; cA = nA; cB = nB; ++ui;
        if constexpr (ALIGN_EPI) { if (wr == 1) PG8_BAR; }
    }
    PG8_WAIT_V(0);
    if constexpr (!ALIGN_EPI) { if (wr == 0) PG8_BAR; }
    PG8_BAR;
    if constexpr (Epi::AFTER_DRAIN) { int ln_; asm volatile("v_mbcnt_lo_u32_b32 %0, -1, 0\n\tv_mbcnt_hi_u32_b32 %0, -1, %0" : "=v"(ln_)); E.fused(acc, cur, wr, wc, ln_ & 15, ln_ >> 4, lds, wid, ln_); }
#undef PG8_SA
#undef PG8_SB
#undef PG8_STAGE
#undef PG8_LDA
#undef PG8_LDB
#undef PG8_MMA
#undef PG8_WAIT_V
#undef PG8_WAIT_L
#undef PG8_BAR
#undef PG8_SCHED
}

__device__ __forceinline__ float shx(float v, int lane, int m) { return __builtin_bit_cast(float, __builtin_amdgcn_ds_bpermute((lane ^ m) << 2, __builtin_bit_cast(int, v))); }
constexpr float RMS_EPS = 1e-6f;
typedef unsigned long long ssq_t;
constexpr float SSQ_SCALE = 1048576.0f;
__device__ __forceinline__ float rstd_row(const ssq_t* ssq, int row) { return __builtin_amdgcn_rsqf((float)ssq[row] * (1.0f / (1024.0f * SSQ_SCALE)) + RMS_EPS); }
#define PG8_GAS __attribute__((address_space(1)))
__device__ __forceinline__ void rstd8(const ssq_t* ssq, int row0, float (&rs)[2][4]) {
    ssq_t sv[2][4];
#pragma unroll
    for (int ai = 0; ai < 2; ++ai)
#pragma unroll
        for (int m = 0; m < 4; ++m) sv[ai][m] = ((const PG8_GAS ssq_t*)ssq)[row0 + ai * HALF + m * 16];
#pragma unroll
    for (int ai = 0; ai < 2; ++ai)
#pragma unroll
        for (int m = 0; m < 4; ++m) rs[ai][m] = __builtin_amdgcn_rsqf((float)sv[ai][m] * (1.0f / (1024.0f * SSQ_SCALE)) + RMS_EPS);
}
__device__ __forceinline__ float fast_sigmoid(float x) { return __builtin_amdgcn_rcpf(1.0f + __builtin_amdgcn_exp2f(-1.4426950408889634f * x)); }

struct EpiQKV {
    static constexpr bool PERM = true, AFTER_DRAIN = false;
    bf16_t* O; size_t split_stride; const ssq_t* ssq; float scale0; float* nrm;
    __device__ __forceinline__ void operator()(const f32x4 (&acc)[2][2][4][2], const Unit& u, int wr, int wc, int fr, int fq) const {
        const int row0 = u.pm * BM + wr * 64 + fr, t = u.pn >> 2; bf16_t* base = O + (size_t)t * split_stride; const float sc = (t == 0) ? scale0 : 1.f;
        const int col0 = (u.pn & 3) * BM + wc * 32 + 8 * fq, ln = fq * 16 + fr;
        float rsv[2][4]; rstd8(ssq, row0, rsv);
#pragma unroll
        for (int ai = 0; ai < 2; ++ai)
#pragma unroll
            for (int m = 0; m < 4; ++m) { const int row = row0 + ai * HALF + m * 16; const float rs = rsv[ai][m] * sc; PG8_GAS bf16_t* rowp = (PG8_GAS bf16_t*)base + (size_t)row * 1024 + col0;
#pragma unroll
                for (int bj = 0; bj < 2; ++bj) { const f32x4 v0 = acc[ai][bj][m][0] * rs, v1 = acc[ai][bj][m][1] * rs;
                    u32x4 w; w.x = cvt_pk_bf16(v0[0], v0[1]); w.y = cvt_pk_bf16(v0[2], v0[3]); w.z = cvt_pk_bf16(v1[0], v1[1]); w.w = cvt_pk_bf16(v1[2], v1[3]);
                    *(PG8_GAS u32x4*)(rowp + bj * HALF) = w;
                    if (t < 2) { float s = ((v0[0] * v0[0] + v0[1] * v0[1]) + (v0[2] * v0[2] + v0[3] * v0[3])) + ((v1[0] * v1[0] + v1[1] * v1[1]) + (v1[2] * v1[2] + v1[3] * v1[3]));
                        s += shx(s, ln, 16); s += shx(s, ln, 32);
                        if (fq == 0) ((PG8_GAS float*)nrm)[(((size_t)t * 16384 + row) * 16 + 4 * (u.pn & 3) + 2 * bj + (wc >> 1)) * 2 + (wc & 1)] = s; } } }
    }
};
struct EpiSwiGLU {
    static constexpr bool PERM = true, AFTER_DRAIN = false;
    bf16_t* Hh; int ldh; const ssq_t* ssq; int dummy;
    __device__ __forceinline__ void operator()(const f32x4 (&acc)[2][2][4][2], const Unit& u, int wr, int wc, int fr, int fq) const {
        const int row0 = u.pm * BM + wr * 64 + fr, col0 = u.pn * HALF + wc * 32 + 8 * fq;
        if (dummy) { if (fr == 0 && fq == 0) *(PG8_GAS float*)((PG8_GAS bf16_t*)Hh + (size_t)row0 * ldh + col0) = acc[0][0][0][0][0] + acc[1][1][3][1][3]; return; }
        float rsv[2][4]; rstd8(ssq, row0, rsv);
#pragma unroll
        for (int ai = 0; ai < 2; ++ai)
#pragma unroll
            for (int m = 0; m < 4; ++m) { const int row = row0 + ai * HALF + m * 16; const float rs = rsv[ai][m];
                float h[8];
#pragma unroll
                for (int n = 0; n < 2; ++n)
#pragma unroll
                    for (int j = 0; j < 4; j += 2) {
                        const f32x2 g2 = {acc[ai][0][m][n][j], acc[ai][0][m][n][j + 1]}, u2 = {acc[ai][1][m][n][j], acc[ai][1][m][n][j + 1]};
                        const f32x2 gs = g2 * rs, us = u2 * rs, ar = gs * (-1.4426950408889634f);
                        f32x2 e; e.x = __builtin_amdgcn_exp2f(ar.x); e.y = __builtin_amdgcn_exp2f(ar.y);
                        const f32x2 dn = e + 1.0f; f32x2 r; r.x = __builtin_amdgcn_rcpf(dn.x); r.y = __builtin_amdgcn_rcpf(dn.y);
                        const f32x2 hv = (gs * r) * us; h[n * 4 + j] = hv.x; h[n * 4 + j + 1] = hv.y; }
                u32x4 w; w.x = cvt_pk_bf16(h[0], h[1]); w.y = cvt_pk_bf16(h[2], h[3]); w.z = cvt_pk_bf16(h[4], h[5]); w.w = cvt_pk_bf16(h[6], h[7]);
                *(PG8_GAS u32x4*)((PG8_GAS bf16_t*)Hh + (size_t)row * ldh + col0) = w; }
    }
};
template <int MODE> struct EpiResid {
    static constexpr bool PERM = false, AFTER_DRAIN = false;
    const float* base; float* X; bf16_t* XB; ssq_t* ssq_out; const float* pb; const float* psc; int dummy;
    __device__ __forceinline__ void operator()(const f32x4 (&acc)[2][2][4][2], const Unit& u, int wr, int wc, int fr, int fq) const {
        if (dummy) { if (acc[0][0][0][0][0] + acc[1][1][3][1][3] == 12345.678f) ((PG8_GAS float*)pb)[0] = 1.f; return; }
        const int row0 = u.pm * BM + wr * 64 + fr;
        const int col0 = (MODE == 1 ? u.pn * HALF : u.pn * BM) + wc * 32 + 4 * fq;
        constexpr int NBJ = (MODE == 1) ? 1 : 2;
        const PG8_GAS float* gb = (const PG8_GAS float*)base + (size_t)row0 * 1024 + col0; PG8_GAS float* gx = (PG8_GAS float*)X + (size_t)row0 * 1024 + col0; PG8_GAS bf16_t* gxb = (PG8_GAS bf16_t*)XB + (size_t)row0 * 1024 + col0;
        float ss[2][4];
#pragma unroll
        for (int ai = 0; ai < 2; ++ai)
#pragma unroll
            for (int m = 0; m < 4; ++m) ss[ai][m] = 0.f;
#pragma unroll
        for (int bj = 0; bj < NBJ; ++bj)
#pragma unroll
            for (int n = 0; n < 2; ++n) { const int co = bj * HALF + n * 16;
                f32x4 bb = {0.f, 0.f, 0.f, 0.f}, sc = {1.f, 1.f, 1.f, 1.f};
                if (MODE == 2) { bb = *(const PG8_GAS f32x4*)((const PG8_GAS float*)pb + col0 + co); sc = *(const PG8_GAS f32x4*)((const PG8_GAS float*)psc + col0 + co); }
                f32x4 bs[2][4];
#pragma unroll
                for (int ai = 0; ai < 2; ++ai)
#pragma unroll
                    for (int m = 0; m < 4; ++m) bs[ai][m] = *(const PG8_GAS f32x4*)(gb + (size_t)(ai * HALF + m * 16) * 1024 + co);
#pragma unroll
                for (int ai = 0; ai < 2; ++ai)
#pragma unroll
                    for (int m = 0; m < 4; ++m) { const size_t off = (size_t)(ai * HALF + m * 16) * 1024 + co; f32x4 d;
                        if (MODE == 0) d = acc[ai][bj][m][n];
                        else if (MODE == 1) { const f32x4 v = acc[ai][0][m][n], gt = acc[ai][1][m][n]; d = (f32x4){v[0] * fast_sigmoid(gt[0]), v[1] * fast_sigmoid(gt[1]), v[2] * fast_sigmoid(gt[2]), v[3] * fast_sigmoid(gt[3])}; }
                        else d = (acc[ai][bj][m][n] + bb) * sc;
                        const f32x4 o = bs[ai][m] + d; *(PG8_GAS f32x4*)(gx + off) = o; ss[ai][m] += (o[0] * o[0] + o[1] * o[1]) + (o[2] * o[2] + o[3] * o[3]);
                        if (XB) { u32x2 w; w.x = cvt_pk_bf16(o[0], o[1]); w.y = cvt_pk_bf16(o[2], o[3]); *(PG8_GAS u32x2*)(gxb + off) = w; } }
                asm volatile("" ::: "memory"); }
        const int ln = fq * 16 + fr;
#pragma unroll
        for (int ai = 0; ai < 2; ++ai)
#pragma unroll
            for (int m = 0; m < 4; ++m) { float s = ss[ai][m]; s += shx(s, ln, 16); s += shx(s, ln, 32);
                if (fq == 0) atomicAdd(ssq_out + row0 + ai * HALF + m * 16, (ssq_t)__builtin_llrintf(s * SSQ_SCALE)); }
    }
};
struct EpiResidFinal {
    static constexpr bool PERM = false, AFTER_DRAIN = true;
    const float* base; float* out; ssq_t* ssq_out; const float* gain; unsigned* cnt;
    __device__ __forceinline__ void fused(f32x4 (&acc)[2][2][4][2], const Unit& u, int wr, int wc, int fr, int fq, PG8_LAS unsigned char* lds, int wid, int lane) const {
        const int row0 = u.pm * BM + wr * 64 + fr, col0 = u.pn * BM + wc * 32 + 4 * fq;
        const PG8_GAS float* gb = (const PG8_GAS float*)base + (size_t)row0 * 1024 + col0;
        float ss[2][4]; float chain_ = 0.f;
#pragma unroll
        for (int ai = 0; ai < 2; ++ai)
#pragma unroll
            for (int m = 0; m < 4; ++m) { int ro_ = (ai * HALF + m * 16) * 1024; asm volatile("" : "+v"(ro_) : "v"(chain_));
                const PG8_GAS float* rp = gb + ro_;
                const f32x4 b0 = *(const PG8_GAS f32x4*)(rp), b1 = *(const PG8_GAS f32x4*)(rp + 16), b2 = *(const PG8_GAS f32x4*)(rp + HALF), b3 = *(const PG8_GAS f32x4*)(rp + HALF + 16);
                const f32x4 o0 = b0 + acc[ai][0][m][0], o1 = b1 + acc[ai][0][m][1], o2 = b2 + acc[ai][1][m][0], o3 = b3 + acc[ai][1][m][1];
                ss[ai][m] = ((o0[0] * o0[0] + o0[1] * o0[1]) + (o0[2] * o0[2] + o0[3] * o0[3])) + ((o1[0] * o1[0] + o1[1] * o1[1]) + (o1[2] * o1[2] + o1[3] * o1[3]))
                          + ((o2[0] * o2[0] + o2[1] * o2[1]) + (o2[2] * o2[2] + o2[3] * o2[3])) + ((o3[0] * o3[0] + o3[1] * o3[1]) + (o3[2] * o3[2] + o3[3] * o3[3]));
                chain_ = ss[ai][m]; }
        const int ln = fq * 16 + fr;
#pragma unroll
        for (int ai = 0; ai < 2; ++ai)
#pragma unroll
            for (int m = 0; m < 4; ++m) { float s = ss[ai][m]; s += shx(s, ln, 16); s += shx(s, ln, 32);
                if (fq == 0) atomicAdd(ssq_out + row0 + ai * HALF + m * 16, (ssq_t)__builtin_llrintf(s * SSQ_SCALE)); }
        asm volatile("s_waitcnt vmcnt(0)" ::: "memory"); __builtin_amdgcn_s_barrier(); asm volatile("" ::: "memory");
        if (wid == 0) {
            unsigned* c = cnt + 64 * u.pm;
            if (lane == 0) __hip_atomic_fetch_add(c, 1u, __ATOMIC_RELAXED, __HIP_MEMORY_SCOPE_AGENT);
            unsigned spins = 0;
            while ((unsigned)__builtin_amdgcn_readfirstlane(__hip_atomic_load(c, __ATOMIC_RELAXED, __HIP_MEMORY_SCOPE_AGENT)) < 4u && ++spins < (1u << 22)) __builtin_amdgcn_s_sleep(2);
        }
        __builtin_amdgcn_s_barrier(); asm volatile("" ::: "memory");
        int l2_; asm volatile("v_mbcnt_lo_u32_b32 %0, -1, 0\n\tv_mbcnt_hi_u32_b32 %0, -1, %0" : "=v"(l2_));
        const int row0b = u.pm * BM + wr * 64 + (l2_ & 15), col0b = u.pn * BM + wc * 32 + 4 * (l2_ >> 4);
        const PG8_GAS float* gb2 = (const PG8_GAS float*)base + (size_t)row0b * 1024 + col0b; PG8_GAS float* go = (PG8_GAS float*)out + (size_t)row0b * 1024 + col0b;
        float rs[2][4];
#pragma unroll
        for (int ai = 0; ai < 2; ++ai)
#pragma unroll
            for (int m = 0; m < 4; ++m) rs[ai][m] = __builtin_amdgcn_rsqf((float)__hip_atomic_load(ssq_out + row0b + ai * HALF + m * 16, __ATOMIC_RELAXED, __HIP_MEMORY_SCOPE_AGENT) * (1.0f / (1024.0f * SSQ_SCALE)) + RMS_EPS);
#pragma unroll
        for (int bj = 0; bj < 2; ++bj)
#pragma unroll
            for (int n = 0; n < 2; ++n) { int co = bj * HALF + n * 16; asm volatile("" : "+v"(co) : "v"(chain_)); const f32x4 gg = *(const PG8_GAS f32x4*)((const PG8_GAS float*)gain + col0b + co); f32x4 bs[2][4];
#pragma unroll
                for (int ai = 0; ai < 2; ++ai)
#pragma unroll
                    for (int m = 0; m < 4; ++m) bs[ai][m] = *(const PG8_GAS f32x4*)(gb2 + (size_t)(ai * HALF + m * 16) * 1024 + co);
#pragma unroll
                for (int ai = 0; ai < 2; ++ai)
#pragma unroll
                    for (int m = 0; m < 4; ++m) { const f32x4 ov = (bs[ai][m] + acc[ai][bj][m][n]) * rs[ai][m] * gg; *(PG8_GAS f32x4*)(go + (size_t)(ai * HALF + m * 16) * 1024 + co) = ov; chain_ = ov[0]; }
                asm volatile("" ::: "memory"); }
    }
};
struct EpiU {
    static constexpr bool PERM = true, AFTER_DRAIN = false;
    bf16_t* UX; const ssq_t* ssq;
    __device__ __forceinline__ void operator()(const f32x4 (&acc)[2][2][4][2], const Unit& u, int wr, int wc, int fr, int fq) const {
        const int row0 = u.pm * BM + wr * 64 + fr, col0 = u.pn * BM + wc * 32 + 8 * fq;
        float rsv[2][4]; rstd8(ssq, row0, rsv);
#pragma unroll
        for (int ai = 0; ai < 2; ++ai)
#pragma unroll
            for (int m = 0; m < 4; ++m) { const int row = row0 + ai * HALF + m * 16; const float rs = rsv[ai][m];
#pragma unroll
                for (int bj = 0; bj < 2; ++bj) { const int col = col0 + bj * HALF; const f32x4 v0 = acc[ai][bj][m][0] * rs, v1 = acc[ai][bj][m][1] * rs;
                    u32x4 w; w.x = cvt_pk_bf16(v0[0], v0[1]); w.y = cvt_pk_bf16(v0[2], v0[3]); w.z = cvt_pk_bf16(v1[0], v1[1]); w.w = cvt_pk_bf16(v1[2], v1[3]);
                    *(PG8_GAS u32x4*)((PG8_GAS bf16_t*)UX + ((size_t)(col >> 4) * 1024 + (row >> 4)) * 384 + (row & 15) * 16 + (col & 15)) = w; } }
    }
};
struct EpiSloc {
    static constexpr bool PERM = false, AFTER_DRAIN = true;
    const float* lamc; bf16_t* UX; PG8_LAS unsigned char* esc;
    __device__ __forceinline__ void fused(f32x4 (&acc)[2][2][4][2], const Unit& u, int wr, int wc, int fr, int fq, PG8_LAS unsigned char* lds, int wid, int lane) const {
        PG8_LAS float* SL = (PG8_LAS float*)lds;
#pragma unroll
        for (int ai = 0; ai < 2; ++ai)
#pragma unroll
            for (int m = 0; m < 4; ++m)
#pragma unroll
                for (int n = 0; n < 2; ++n) *(PG8_LAS f32x4*)(SL + (ai * HALF + wr * 64 + m * 16 + fr) * 128 + wc * 32 + n * 16 + 4 * fq) = acc[ai][0][m][n];
        asm volatile("s_waitcnt lgkmcnt(0)" ::: "memory"); __builtin_amdgcn_s_barrier(); asm volatile("" ::: "memory");
        const int g = u.pn, b = u.pm, seg = wid, p = lane;
        const float lr = lamc[(g * 64 + p) * 2], li = lamc[(g * 64 + p) * 2 + 1];
        float sr = 0.f, si = 0.f;
        for (int c = seg * 32; c < seg * 32 + 32; ++c) { const float xr = SL[c * 128 + p], xi = SL[c * 128 + 64 + p]; const float nr = lr * sr - li * si + xr, ni = lr * si + li * sr + xi; sr = nr; si = ni; }
        PG8_LAS float* E = (PG8_LAS float*)esc;
        E[(seg * 64 + p) * 2] = sr; E[(seg * 64 + p) * 2 + 1] = si;
        asm volatile("s_waitcnt lgkmcnt(0)" ::: "memory"); __builtin_amdgcn_s_barrier(); asm volatile("" ::: "memory");
        float l32r = lr, l32i = li;
#pragma unroll
        for (int q = 0; q < 5; ++q) { const float t = l32r * l32r - l32i * l32i; l32i = 2.f * l32r * l32i; l32r = t; }
        sr = 0.f; si = 0.f;
        for (int j = 0; j < seg; ++j) { const float er = E[(j * 64 + p) * 2], ei = E[(j * 64 + p) * 2 + 1]; const float nr = l32r * sr - l32i * si + er, ni = l32r * si + l32i * sr + ei; sr = nr; si = ni; }
        bf16_t* dst = UX + ((size_t)g * 1024 + b * 256 + seg * 32) * 384 + 256 + p;
        for (int c = seg * 32; c < seg * 32 + 32; ++c) {
            { unsigned ur = __builtin_bit_cast(unsigned, sr), ui = __builtin_bit_cast(unsigned, si); ur = (ur + 0x7fffu + ((ur >> 16) & 1u)) >> 16; ui = (ui + 0x7fffu + ((ui >> 16) & 1u)) >> 16;
              dst[0] = (bf16_t)ur; dst[64] = (bf16_t)ui; }
            const float xr = SL[c * 128 + p], xi = SL[c * 128 + 64 + p]; const float nr = lr * sr - li * si + xr, ni = lr * si + li * sr + xi; sr = nr; si = ni;
            dst += 384; }
        asm volatile("s_waitcnt vmcnt(0) lgkmcnt(0)" ::: "memory"); __builtin_amdgcn_s_barrier(); asm volatile("" ::: "memory");
        if (wid == 0) { __builtin_amdgcn_fence(__ATOMIC_ACQUIRE, "agent"); asm volatile("s_waitcnt vmcnt(0)" ::: "memory"); }
        __builtin_amdgcn_s_barrier(); asm volatile("" ::: "memory");
    }
};
struct EpiY {
    static constexpr bool PERM = true, AFTER_DRAIN = false;
    const bf16_t* UX; const float* dvec; bf16_t* G1;
    __device__ __forceinline__ void operator()(const f32x4 (&acc)[2][2][4][2], const Unit& u, int wr, int wc, int fr, int fq) const {
        const int g = u.pn, b = u.pm, ch0 = g * 16 + 8 * (fq & 1);
        const f32x4 d0 = *(const f32x4*)(dvec + ch0), d1 = *(const f32x4*)(dvec + ch0 + 4);
#pragma unroll
        for (int ai = 0; ai < 2; ++ai) {
            u32x4 uwv[4][2];
#pragma unroll
            for (int m = 0; m < 4; ++m)
#pragma unroll
                for (int bj = 0; bj < 2; ++bj) uwv[m][bj] = *(const PG8_GAS u32x4*)((const PG8_GAS bf16_t*)UX + ((size_t)g * 1024 + b * 256 + (ai * HALF + wr * 64 + m * 16 + fr)) * 384 + (8 * bj + 2 * wc + (fq >> 1)) * 16 + 8 * (fq & 1));
#pragma unroll
            for (int m = 0; m < 4; ++m) { const int R = ai * HALF + wr * 64 + m * 16 + fr;
#pragma unroll
                for (int bj = 0; bj < 2; ++bj) { const int i = 8 * bj + 2 * wc + (fq >> 1);
                    const u32x4 uw = uwv[m][bj];
                    float y[8];
#pragma unroll
                    for (int j = 0; j < 4; ++j) { y[j] = acc[ai][bj][m][0][j] + d0[j] * __builtin_bit_cast(float, (j & 1) ? (uw[j >> 1] & 0xffff0000u) : (uw[j >> 1] << 16));
                                                  y[4 + j] = acc[ai][bj][m][1][j] + d1[j] * __builtin_bit_cast(float, (j & 1) ? (uw[2 + (j >> 1)] & 0xffff0000u) : (uw[2 + (j >> 1)] << 16)); }
#pragma unroll
                    for (int j = 0; j < 8; ++j) { const float z = 0.7978845608028654f * (y[j] + 0.044715f * y[j] * y[j] * y[j]); y[j] = y[j] * fast_sigmoid(2.f * z); }
                    u32x4 w; w.x = cvt_pk_bf16(y[0], y[1]); w.y = cvt_pk_bf16(y[2], y[3]); w.z = cvt_pk_bf16(y[4], y[5]); w.w = cvt_pk_bf16(y[6], y[7]);
                    *(PG8_GAS u32x4*)((PG8_GAS bf16_t*)G1 + ((size_t)g * 16384 + b * 4096 + 16 * R + i) * 16 + 8 * (fq & 1)) = w; } }
            asm volatile("" ::: "memory"); }
    }
};
}
#include <hip/hip_bf16.h>
#include <cmath>
namespace attn_body {
using bf16=__hip_bfloat16;
using bf16x8=__attribute__((ext_vector_type(8)))short;
using s16x4=__attribute__((ext_vector_type(4)))short;
using f32x16=__attribute__((ext_vector_type(16)))float;
using u32x4=__attribute__((ext_vector_type(4)))unsigned;
constexpr int BATCH=4,NHEAD=16,SEQ=4096,D=64,DM=NHEAD*D;
constexpr int NW=8,QBLK=32,QB=QBLK*NW,KVBLK=64,NQB=SEQ/QB;
constexpr int ATTN_PITCH=DM, ATTN_UNIT_ROWS=QB;
__device__ __forceinline__ int crow(int r,int hi){return (r&3)+8*(r>>2)+4*hi;}
#define SBAR() __builtin_amdgcn_sched_barrier(0)
__device__ __forceinline__ void cmask(f32x16&p0,f32x16&p1,int jb,int qrel,int hi){
  const float NEG=-INFINITY; int kb=64*jb+4*hi;
  #pragma unroll
  for(int r=0;r<16;++r){int kv=kb+(r&3)+8*(r>>2); if(kv>qrel)p0[r]=NEG; if(kv+32>qrel)p1[r]=NEG;}
}

constexpr int NSLOT=3, SLOTB=8192;
constexpr int LDS_K=0, LDS_V=NSLOT*SLOTB, LDS_WS=2*NSLOT*SLOTB, LDS_OST=LDS_WS+NW*64*4, LDS_BYTES=LDS_OST+NW*4096;
constexpr float C2=0.125f*1.4426950408889634f;
__device__ __forceinline__ void glds16(const void*gsrc,unsigned lds_dst){unsigned keep;
  asm volatile("s_mov_b32 %0, m0\n\ts_mov_b32 m0, %2\n\ts_nop 0\n\tglobal_load_lds_dwordx4 %1, off\n\ts_mov_b32 m0, %0":"=&s"(keep):"v"(gsrc),"s"(lds_dst):"memory");}
__device__ __forceinline__ float max3f(float a,float b,float c){float r;asm("v_max3_f32 %0, %1, %2, %3":"=v"(r):"v"(a),"v"(b),"v"(c));return r;}
__device__ __forceinline__ float max2f(float a,float b){float r;asm("v_max_f32_e32 %0, %1, %2":"=v"(r):"v"(a),"v"(b));return r;}
__device__ __forceinline__ float fadd_s(float a,float b){float r;asm("v_add_f32_e32 %0, %1, %2":"=v"(r):"v"(a),"v"(b));return r;}
__device__ __forceinline__ float fsub_s(float a,float b){float r;asm("v_sub_f32_e32 %0, %1, %2":"=v"(r):"v"(a),"v"(b));return r;}
typedef float f32x2_t __attribute__((ext_vector_type(2))); typedef __bf16 bf16x2_t __attribute__((ext_vector_type(2)));
__device__ __forceinline__ unsigned cvtpk_s(float lo,float hi){f32x2_t v={lo,hi};bf16x2_t b=__builtin_convertvector(v,bf16x2_t);return __builtin_bit_cast(unsigned,b);}
#define WAIT_BAR(N) asm volatile("s_waitcnt vmcnt(" #N ") lgkmcnt(0)\n\ts_barrier":::"memory")

__device__ __forceinline__ void qkt(f32x16&p0,f32x16&p1,const char*Kslot,const bf16x8*qr,int r32,int hi){
  const char*kb=Kslot+hi*1024+r32*16;
  #pragma unroll
  for(int d0=0;d0<4;++d0){
    const bf16x8 b0=*reinterpret_cast<const bf16x8*>(kb+d0*2048);
    const bf16x8 b1=*reinterpret_cast<const bf16x8*>(kb+d0*2048+512);
    {p0=__builtin_amdgcn_mfma_f32_32x32x16_bf16(b0,qr[d0],p0,0,0,0);p1=__builtin_amdgcn_mfma_f32_32x32x16_bf16(b1,qr[d0],p1,0,0,0);}}
}
typedef __attribute__((address_space(3))) const char* lds_cptr;
typedef short v4i16_t __attribute__((ext_vector_type(4)));
__device__ __forceinline__ void kload8(bf16x8*kf,lds_cptr kp){
  kf[0]=*(const __attribute__((address_space(3))) bf16x8*)(kp);      kf[1]=*(const __attribute__((address_space(3))) bf16x8*)(kp+512);
  kf[2]=*(const __attribute__((address_space(3))) bf16x8*)(kp+2048); kf[3]=*(const __attribute__((address_space(3))) bf16x8*)(kp+2560);
  kf[4]=*(const __attribute__((address_space(3))) bf16x8*)(kp+4096); kf[5]=*(const __attribute__((address_space(3))) bf16x8*)(kp+4608);
  kf[6]=*(const __attribute__((address_space(3))) bf16x8*)(kp+6144); kf[7]=*(const __attribute__((address_space(3))) bf16x8*)(kp+6656);
}
__device__ __forceinline__ void kload2(bf16x8*kf,lds_cptr kp,int j){ kf[2*j]=*(const __attribute__((address_space(3))) bf16x8*)(kp+j*2048); kf[2*j+1]=*(const __attribute__((address_space(3))) bf16x8*)(kp+j*2048+512); }
__device__ __forceinline__ s16x4 vtr(lds_cptr p){ return __builtin_bit_cast(s16x4,__builtin_amdgcn_ds_read_tr16_b64_v4i16((__attribute__((address_space(3))) v4i16_t*)p)); }
__device__ __forceinline__ float rowmax(const f32x16&p0,const f32x16&p1){
  float a=max3f(p0[0],p0[1],p1[0]),b=max3f(p0[2],p0[3],p1[1]);a=max3f(a,p1[2],p1[3]);
  #pragma unroll
  for(int r=4;r<16;r+=4){a=max3f(a,p0[r],p0[r+1]);b=max3f(b,p0[r+2],p0[r+3]);a=max3f(a,p1[r],p1[r+1]);b=max3f(b,p1[r+2],p1[r+3]);}
  const float m=max2f(a,b);
  auto rr=__builtin_amdgcn_permlane32_swap(__float_as_uint(m),__float_as_uint(m),false,false);
  return max2f(__uint_as_float(rr[0]),__uint_as_float(rr[1]));
}
__device__ __forceinline__ void pv(f32x16*o,int vb,bf16x8 pa0,bf16x8 pa1,bf16x8 pa2,bf16x8 pa3){
  #pragma unroll
  for(int d0=0;d0<2;++d0){s16x4 lo[4],hi[4];
    #pragma unroll
    for(int ks=0;ks<4;++ks){
      asm volatile("ds_read_b64_tr_b16 %0,%1 offset:%c2":"=&v"(lo[ks]):"v"(vb),"i"(d0*4096+ks*1024):"memory");
      asm volatile("ds_read_b64_tr_b16 %0,%1 offset:%c2":"=&v"(hi[ks]):"v"(vb),"i"(d0*4096+ks*1024+512):"memory");}
    asm volatile("s_waitcnt lgkmcnt(0)":::"memory");SBAR();
    #define PK(k) (bf16x8){lo[k][0],lo[k][1],lo[k][2],lo[k][3],hi[k][0],hi[k][1],hi[k][2],hi[k][3]}
    o[d0]=__builtin_amdgcn_mfma_f32_32x32x16_bf16(pa0,PK(0),o[d0],0,0,0);
    o[d0]=__builtin_amdgcn_mfma_f32_32x32x16_bf16(pa1,PK(1),o[d0],0,0,0);
    o[d0]=__builtin_amdgcn_mfma_f32_32x32x16_bf16(pa2,PK(2),o[d0],0,0,0);
    o[d0]=__builtin_amdgcn_mfma_f32_32x32x16_bf16(pa3,PK(3),o[d0],0,0,0);
    #undef PK
  }
}

#ifndef ATTN_STORE16
#define ATTN_STORE16(p,v) (*(u32x4*)(p)=(v))
#endif
typedef float f32x4b __attribute__((ext_vector_type(4)));
template<int THRL> __device__ __forceinline__ void attn_unit(int b,int h,int qb,const bf16*Q,const bf16*__restrict__ K,const bf16*__restrict__ V,bf16*O,char*shm,const __attribute__((address_space(3))) float*bl0,const int tid_,const int tskip){
  const __attribute__((address_space(3))) float*bl=bl0+tskip*64;
  const int tid=tid_,lane=tid&63,r32=lane&31,hi=lane>>5; const int wid=__builtin_amdgcn_readfirstlane(tid>>6);
  const long rowbase=(long)b*SEQ; const int q0=qb*QB;
  const bf16*Qw=Q+(rowbase+q0+wid*QBLK)*DM+h*D;
  const bf16*Kh=K+(rowbase+(long)tskip*KVBLK)*DM+h*D,*Vh=V+(rowbase+(long)tskip*KVBLK)*DM+h*D;
  const unsigned lds0=(unsigned)(uintptr_t)shm;
  float*wsf=(float*)(shm+LDS_WS)+wid*64;
  const bf16*ksrc=Kh+(long)lane*DM+wid*8;
  const bf16*vsrc=Vh+(long)(16*(wid&3)+(lane>>2))*DM+(wid>>2)*32+(lane&3)*8;
  const unsigned kdst=lds0+LDS_K+wid*1024, vdst=lds0+LDS_V+wid*1024;
  #define DMA_K(t,slot) glds16(ksrc+(long)(t)*KVBLK*DM,(unsigned)__builtin_amdgcn_readfirstlane(kdst+(slot)))
  #define DMA_V(t,slot) glds16(vsrc+(long)(t)*KVBLK*DM,(unsigned)__builtin_amdgcn_readfirstlane(vdst+(slot)))
  const int vb0=(int)(lds0+LDS_V)+((lane>>4)&1)*32+(lane&3)*8+(4*hi+((lane&15)>>2))*64;
  const char*Kbase=shm+LDS_K; bf16x8 kf[8];
  const lds_cptr shm3=(lds_cptr)shm; const lds_cptr kp0=shm3+LDS_K+hi*1024+r32*16; const lds_cptr vp0=shm3+LDS_V+((lane>>4)&1)*32+(lane&3)*8+(4*hi+((lane&15)>>2))*64;
  const int NT=(q0+QB)/KVBLK-tskip;
  DMA_K(0,0);DMA_V(0,0);DMA_K(1,SLOTB);
  bf16x8 qr[4];
  #pragma unroll
  for(int d0=0;d0<4;++d0)qr[d0]=*reinterpret_cast<const bf16x8*>(&Qw[(long)r32*DM+d0*16+hi*8]);
  float mhat=0.f,l_reg=0.f;f32x16 o[2];o[0]=f32x16{};o[1]=f32x16{};
  const int qrel=wid*QBLK+r32;
  #define CMASK(P0,P1,t) do{int jb_=(t)-(NT-4); if(jb_>=0)cmask(P0,P1,jb_,qrel,hi);}while(0)
  #define BIASLD(P0,P1,t) do{ const __attribute__((address_space(3))) f32x4b*bp_=(const __attribute__((address_space(3))) f32x4b*)(bl+(t)*64+hi*4); \
    _Pragma("unroll") for(int g_=0;g_<4;++g_){ const f32x4b b0_=bp_[2*g_],b1_=bp_[8+2*g_]; \
      P0[4*g_]=b0_[0];P0[4*g_+1]=b0_[1];P0[4*g_+2]=b0_[2];P0[4*g_+3]=b0_[3]; P1[4*g_]=b1_[0];P1[4*g_+1]=b1_[1];P1[4*g_+2]=b1_[2];P1[4*g_+3]=b1_[3]; } }while(0)
  bool resc=false;
  #define START(P0,P1) do{ const float rm=rowmax(P0,P1); resc=false; \
    { const float dl=rm; mhat=fadd_s(mhat,dl); \
      _Pragma("unroll") for(int r=0;r<16;++r){P0[r]=fsub_s(P0[r],dl);P1[r]=fsub_s(P1[r],dl);} } \
    _Pragma("unroll") for(int r=0;r<16;++r)P0[r]=__builtin_amdgcn_exp2f(P0[r]); }while(0)
  #define RESC() do{ if(resc){ asm volatile("s_waitcnt lgkmcnt(0)":::"memory"); \
      _Pragma("unroll") for(int d_=0;d_<2;++d_) _Pragma("unroll") for(int r=0;r<16;++r)o[d_][r]*=wsf[crow(r,hi)]; } }while(0)
  f32x16 pA0,pA1,pB0,pB1;
  int sl_prev=0,sl_cur=0,sl_next=SLOTB;
  #define ROT() do{sl_prev=sl_cur;sl_cur=sl_next;sl_next=(sl_next==(NSLOT-1)*SLOTB)?0:sl_next+SLOTB;}while(0)
  DMA_K(2,2*SLOTB);
  WAIT_BAR(3);
  BIASLD(pA0,pA1,0);qkt(pA0,pA1,Kbase,qr,r32,hi);asm volatile("s_nop 15\n\ts_nop 7":"+v"(pA0),"+v"(pA1));CMASK(pA0,pA1,0);
  START(pA0,pA1);
  _Pragma("unroll") for(int r=0;r<16;++r)pA1[r]=__builtin_amdgcn_exp2f(pA1[r]);
  WAIT_BAR(0);
  DMA_K(3,0);DMA_V(1,SLOTB);
  ROT();
  kload8(kf,kp0+sl_cur);
  WAIT_BAR(2);
  s16x4 vlo[8],vhi[8]; u32x4 pw0,pw1,pw2,pw3;
  #define PKW(P,B) cvtpk_s(P[B],P[B+1])
  #define PAF(k) __builtin_bit_cast(bf16x8,pw##k)
  #define VFR(i) (bf16x8){vlo[i][0],vlo[i][1],vlo[i][2],vlo[i][3],vhi[i][0],vhi[i][1],vhi[i][2],vhi[i][3]}
  #define PIN(x) asm volatile("":"+v"(x))
  #define MX3(a,b,c) __builtin_fmaxf(__builtin_fmaxf((a),(b)),(c))
  #define GAPA(MF,A0,A1,A2,A3,W0,W1,PW) do{ MF; sacc+=A0; sacc+=A1; sacc+=A2; sacc+=A3; PIN(sacc); W0; W1; PIN(PW); SBAR(); }while(0)
  #define EX(v) __builtin_amdgcn_exp2f(v)
  #define GAPB(MF,X,B) do{ MF; X[B]=EX(X[B]-mhat); X[B+1]=EX(X[B+1]-mhat); X[B+2]=EX(X[B+2]-mhat); X[B+3]=EX(X[B+3]-mhat); PIN(X); SBAR(); }while(0)
  #define VRD(i) do{ vlo[i]=vtr(vp_+(((i)>>2)*4096+((i)&3)*1024)); vhi[i]=vtr(vp_+(((i)>>2)*4096+((i)&3)*1024+512)); }while(0)
  #define KRD(G,j) do{ if(G){ kload2(kf,kp0+sl_next,j); SBAR(); } }while(0)
  #define STEP(C0,C1,P0,P1,t,GK,GV,GL) do{ SBAR(); BIASLD(C0,C1,t); SBAR(); \
    const lds_cptr vp_=vp0+sl_prev; \
    VRD(0); SBAR(); float sacc=(P0[0]+P0[1]); \
    GAPA(C0=__builtin_amdgcn_mfma_f32_32x32x16_bf16(kf[0],qr[0],C0,0,0,0), P0[2],P0[3],P0[4],P0[5],     pw0[0]=PKW(P0,0), pw0[1]=PKW(P0,2), pw0); \
    VRD(4); SBAR(); GAPA(C1=__builtin_amdgcn_mfma_f32_32x32x16_bf16(kf[1],qr[0],C1,0,0,0), P0[6],P0[7],P0[8],P0[9],     pw0[2]=PKW(P0,4), pw0[3]=PKW(P0,6), pw0); \
    VRD(1); SBAR(); GAPA(C0=__builtin_amdgcn_mfma_f32_32x32x16_bf16(kf[2],qr[1],C0,0,0,0),   P0[10],P0[11],P0[12],P0[13], pw1[0]=PKW(P0,8), pw1[1]=PKW(P0,10), pw1); \
    VRD(5); SBAR(); GAPA(C1=__builtin_amdgcn_mfma_f32_32x32x16_bf16(kf[3],qr[1],C1,0,0,0),   P0[14],P0[15],P1[0],P1[1],   pw1[2]=PKW(P0,12),pw1[3]=PKW(P0,14), pw1); \
    VRD(2); SBAR(); GAPA(C0=__builtin_amdgcn_mfma_f32_32x32x16_bf16(kf[4],qr[2],C0,0,0,0),   P1[2],P1[3],P1[4],P1[5],     pw2[0]=PKW(P1,0), pw2[1]=PKW(P1,2), pw2); \
    VRD(6); SBAR(); GAPA(C1=__builtin_amdgcn_mfma_f32_32x32x16_bf16(kf[5],qr[2],C1,0,0,0),   P1[6],P1[7],P1[8],P1[9],     pw2[2]=PKW(P1,4), pw2[3]=PKW(P1,6), pw2); \
    VRD(3); SBAR(); GAPA(C0=__builtin_amdgcn_mfma_f32_32x32x16_bf16(kf[6],qr[3],C0,0,0,0),   P1[10],P1[11],P1[12],P1[13], pw3[0]=PKW(P1,8), pw3[1]=PKW(P1,10), pw3); \
    VRD(7); SBAR(); GAPA(C1=__builtin_amdgcn_mfma_f32_32x32x16_bf16(kf[7],qr[3],C1,0,0,0),   P1[14],P1[15],0.f,0.f,       pw3[2]=PKW(P1,12),pw3[3]=PKW(P1,14), pw3); \
    l_reg+=sacc; \
    if(GK){DMA_K((t)+3,sl_cur);} if(GV){DMA_V((t)+1,sl_next);} \
    CMASK(C0,C1,t); \
    { float a=MX3(C0[0],C0[1],C1[0]),b=MX3(C0[2],C0[3],C1[1]); a=MX3(a,C1[2],C1[3]); \
      _Pragma("unroll") for(int r=4;r<16;r+=4){a=MX3(a,C0[r],C0[r+1]);b=MX3(b,C0[r+2],C0[r+3]);a=MX3(a,C1[r],C1[r+1]);b=MX3(b,C1[r+2],C1[r+3]);} \
      float rm=__builtin_fmaxf(a,b); { auto rr=__builtin_amdgcn_permlane32_swap(__float_as_uint(rm),__float_as_uint(rm),false,false); rm=__builtin_fmaxf(__uint_as_float(rr[0]),__uint_as_float(rr[1])); } \
      resc=false; const float dm_=rm-mhat; \
      if(__builtin_expect(__any(dm_>(float)THRL),0)){ const float dl=__builtin_fmaxf(dm_,0.f); mhat+=dl; \
        const float f=__builtin_amdgcn_exp2f(-dl); l_reg*=f; if(hi==0)wsf[r32]=f; resc=true; } } \
    SBAR(); \
    GAPB(o[0]=__builtin_amdgcn_mfma_f32_32x32x16_bf16(PAF(0),VFR(0),o[0],0,0,0), C0,0); \
    GAPB(o[1]=__builtin_amdgcn_mfma_f32_32x32x16_bf16(PAF(0),VFR(4),o[1],0,0,0), C0,4); \
    KRD(GL,0); GAPB(o[0]=__builtin_amdgcn_mfma_f32_32x32x16_bf16(PAF(1),VFR(1),o[0],0,0,0), C0,8); \
    KRD(GL,1); GAPB(o[1]=__builtin_amdgcn_mfma_f32_32x32x16_bf16(PAF(1),VFR(5),o[1],0,0,0), C0,12); \
    KRD(GL,2); GAPB(o[0]=__builtin_amdgcn_mfma_f32_32x32x16_bf16(PAF(2),VFR(2),o[0],0,0,0), C1,0); \
    KRD(GL,3); GAPB(o[1]=__builtin_amdgcn_mfma_f32_32x32x16_bf16(PAF(2),VFR(6),o[1],0,0,0), C1,4); \
    GAPB(o[0]=__builtin_amdgcn_mfma_f32_32x32x16_bf16(PAF(3),VFR(3),o[0],0,0,0), C1,8); \
    GAPB(o[1]=__builtin_amdgcn_mfma_f32_32x32x16_bf16(PAF(3),VFR(7),o[1],0,0,0), C1,12); \
    }while(0)
  int t=1;
  #undef CMASK
  #define CMASK(P0,P1,t) do{}while(0)
  for(;t+5<NT;t+=2){
    STEP(pB0,pB1,pA0,pA1,t,true,true,true);     WAIT_BAR(2); RESC(); ROT();
    STEP(pA0,pA1,pB0,pB1,t+1,true,true,true);   WAIT_BAR(2); RESC(); ROT();
  }
  #undef CMASK
  #define CMASK(P0,P1,t) do{int jb_=(t)-(NT-4); if(jb_>=0)cmask(P0,P1,jb_,qrel,hi);}while(0)
  #define ENDW(tt) do{ if((tt)+3<NT){WAIT_BAR(2);} else if((tt)+2<NT){WAIT_BAR(1);} else {WAIT_BAR(0);} }while(0)
  for(;t+1<NT;t+=2){
    STEP(pB0,pB1,pA0,pA1,t,(t+3<NT),(t+1<NT),(t+1<NT));       ENDW(t);   RESC(); ROT();
    STEP(pA0,pA1,pB0,pB1,t+1,(t+4<NT),(t+2<NT),(t+2<NT));     ENDW(t+1); RESC(); ROT();
  }
  STEP(pB0,pB1,pA0,pA1,NT-1,false,false,false); RESC();
  { float sacc=pB0[0]+pB0[1]; _Pragma("unroll") for(int r=2;r<16;++r)sacc+=pB0[r]; _Pragma("unroll") for(int r=0;r<16;++r)sacc+=pB1[r]; l_reg+=sacc;
    pw0=(u32x4){PKW(pB0,0),PKW(pB0,2),PKW(pB0,4),PKW(pB0,6)};pw1=(u32x4){PKW(pB0,8),PKW(pB0,10),PKW(pB0,12),PKW(pB0,14)};pw2=(u32x4){PKW(pB1,0),PKW(pB1,2),PKW(pB1,4),PKW(pB1,6)};pw3=(u32x4){PKW(pB1,8),PKW(pB1,10),PKW(pB1,12),PKW(pB1,14)};
    SBAR(); pv(o,vb0+sl_cur,PAF(0),PAF(1),PAF(2),PAF(3)); }
  #undef PKW
  #undef PAF
  #undef VFR
  #undef PIN
  #undef MX3
  #undef GAPA
  #undef GAPB
  #undef EX
  #undef VRD
  #undef KRD
  #undef STEP
  #undef ENDW
  {auto rr=__builtin_amdgcn_permlane32_swap(__float_as_uint(l_reg),__float_as_uint(l_reg),false,false);l_reg=__uint_as_float(rr[0])+__uint_as_float(rr[1]);}
  if(hi==0)wsf[32+r32]=l_reg;asm volatile("s_waitcnt lgkmcnt(0)":::"memory");
  float rli[16];
  #pragma unroll
  for(int r=0;r<16;++r)rli[r]=__builtin_amdgcn_rcpf(wsf[32+crow(r,hi)]);
  bf16*Ow=O+(rowbase+q0+wid*QBLK)*DM+h*D;
  { bf16*stg=(bf16*)(shm+LDS_OST)+wid*2048;
    #pragma unroll
    for(int r=0;r<16;++r){const int orow=crow(r,hi);
      #pragma unroll
      for(int d0=0;d0<2;++d0)stg[orow*64+d0*32+r32]=__float2bfloat16(o[d0][r]*rli[r]);}
    asm volatile("s_waitcnt lgkmcnt(0)":::"memory");
    #pragma unroll
    for(int i=0;i<4;++i){const int row=i*8+(lane>>3),ch=lane&7; const u32x4 v=*(const u32x4*)(stg+row*64+ch*8); ATTN_STORE16(Ow+(long)row*DM+ch*8,v);} }
  asm volatile("s_waitcnt lgkmcnt(0)\n\ts_barrier":::"memory");
  #undef DMA_K
  #undef DMA_V
  #undef CMASK
  #undef BIASLD
  #undef START
  #undef RESC
  #undef ROT
}
constexpr int ATTN_LDS_BYTES=LDS_BYTES;
struct AttnTensors { const bf16* Q; const bf16* K; const bf16* V; bf16* O; };
struct AttnUnit { int bh; int qb; };
struct StaticOrder {
  int vcu;
  __device__ __forceinline__ explicit StaticOrder(int grid,int block):vcu((block%8)*(grid/8)+block/8){}
  __device__ __forceinline__ bool next(int i,AttnUnit&u)const{ if(i>=4)return false; const int s=vcu&3; u.bh=vcu>>2; u.qb=(i==0)?s:(i==1)?7-s:(i==2)?8+s:15-s; return true; }
};
template<class Sched,int THRL=8> __device__ __forceinline__ void attn_phase(char*lds,const AttnTensors&T,const Sched&S,const __attribute__((address_space(3))) float*bl,const int tid,const __attribute__((address_space(3))) int*tsk){
  AttnUnit u;
  for(int i=0;S.next(i,u);++i){ attn_unit<THRL>(u.bh/NHEAD,u.bh%NHEAD,u.qb,T.Q,T.K,T.V,T.O,lds,bl,tid,__builtin_amdgcn_readfirstlane(tsk[i])); }
}
#undef SBAR
#undef WAIT_BAR
}
namespace mk {
#define LAS __attribute__((address_space(3)))
#define XB_TMO      128
#define XB_XCNT(j)  (256  + 64 * (j))
#define XB_XSUB(j)  (1280 + 64 * (j))
#define XB_XGEN(j)  (2304 + 64 * (j))
#define XB_TOP      3328
#define XB_TOPGEN   3392
#define XCD_BAR_WORDS 3456
#define XB_SPIN_CAP (1u << 18)

__device__ __forceinline__ unsigned xb_ld(unsigned* p)              { return __hip_atomic_load(p, __ATOMIC_RELAXED, __HIP_MEMORY_SCOPE_AGENT); }
__device__ __forceinline__ unsigned xb_add(unsigned* p, unsigned v) { return __hip_atomic_fetch_add(p, v, __ATOMIC_RELAXED, __HIP_MEMORY_SCOPE_AGENT); }
__device__ __forceinline__ unsigned xb_xcc_id() { return (unsigned)__builtin_amdgcn_s_getreg((3 << 11) | 20) & 0xFu; }
#define XB_SPIN(cond, bar) do { unsigned _sp = 0; while (cond) { __builtin_amdgcn_s_sleep(1); \
    if ((++_sp & 255u) == 0u) { if (xb_ld(&(bar)[XB_TMO])) break; if (_sp > XB_SPIN_CAP) { atomicAdd(&(bar)[XB_TMO], 1u); break; } } } } while (0)

struct XcdBarrier {
    unsigned* bar; unsigned x;
    volatile LAS unsigned* st;
};

__device__ __forceinline__ XcdBarrier xcd_barrier_post(unsigned* bar, volatile LAS unsigned* st) {
    XcdBarrier b; b.bar = bar; b.x = xb_xcc_id(); b.st = st;
    if (threadIdx.x == 0) (void)xb_add(&bar[XB_XCNT(b.x)], 1u);
    return b;
}
__device__ __forceinline__ void xcd_barrier_complete(unsigned* bar, unsigned x, unsigned& nloc, unsigned& nx) {
    const unsigned G = gridDim.x * gridDim.y * gridDim.z;
    unsigned sum, cnt, mine, sp = 0u;
    for (;;) {
        sum = 0u; cnt = 0u; mine = 0u;
#pragma unroll
        for (unsigned j = 0; j < 16; ++j) { const unsigned c = xb_ld(&bar[XB_XCNT(j)]); sum += c; cnt += (c > 0u) ? 1u : 0u; mine = (j == x) ? c : mine; }
        if (sum == G) break;
        __builtin_amdgcn_s_sleep(1);
        if ((++sp & 255u) == 0u) { if (xb_ld(&bar[XB_TMO])) break; if (sp > XB_SPIN_CAP) { atomicAdd(&bar[XB_TMO], 1u); break; } }
    }
    nloc = mine > 0u ? mine : 1u; nx = cnt > 0u ? cnt : 1u;
}

__device__ __forceinline__ void xcd_barrier(const XcdBarrier& b) {
    asm volatile("s_waitcnt vmcnt(0)" ::: "memory");
    __syncthreads();
    if (threadIdx.x == 0) {
        unsigned* bar = b.bar;
        __builtin_amdgcn_s_waitcnt(0);
        unsigned nloc = b.st[0], nx = b.st[1];
        if (nloc == 0u) { xcd_barrier_complete(bar, b.x, nloc, nx); b.st[0] = nloc; b.st[1] = nx; }
        const unsigned old = xb_add(&bar[XB_XSUB(b.x)], 1u);
        const unsigned gen = old / nloc;
        if (old + 1u == (gen + 1u) * nloc) {
            __builtin_amdgcn_fence(__ATOMIC_RELEASE, "agent");
            asm volatile("s_waitcnt vmcnt(0)" ::: "memory");
            const unsigned og = xb_add(&bar[XB_TOP], 1u);
            const unsigned tg = og / nx;
            if (og + 1u == (tg + 1u) * nx) xb_add(&bar[XB_TOPGEN], 1u);
            else XB_SPIN(xb_ld(&bar[XB_TOPGEN]) == tg, bar);
            __builtin_amdgcn_fence(__ATOMIC_ACQUIRE, "agent");
            xb_add(&bar[XB_XGEN(b.x)], 1u);
            asm volatile("s_waitcnt vmcnt(0)" ::: "memory");
        } else {
            XB_SPIN(xb_ld(&bar[XB_XGEN(b.x)]) == gen, bar);
            __builtin_amdgcn_fence(__ATOMIC_ACQUIRE, "agent");
            asm volatile("s_waitcnt vmcnt(0)" ::: "memory");
        }
    }
    __syncthreads();
}

#undef LAS
}
namespace mk {
constexpr int NWAVES = 8;
constexpr int D = 1024, BATCH = 4, SEQ = 4096, M = BATCH * SEQ, DEPTH = 4, NH = 16, HD = 64, FOX_IN = 3 * D + NH, DFF = 2816;
constexpr int SG = 64, SP = 64, SC = 16;
constexpr float RMS_EPS = 1e-6f;
constexpr size_t MiB = 1u << 20;
constexpr size_t WS_CTL = 276 * MiB, CTL_ZERO_BYTES = 3 * MiB;
constexpr size_t WS_SSQ = 277 * MiB;
constexpr size_t WS_WQKV = 2 * MiB;
constexpr size_t WS_WO = 14 * MiB;
constexpr size_t WS_WS5IN = 18 * MiB;
constexpr size_t WS_WGLU = 20 * MiB;
constexpr size_t WS_BTA = 24 * MiB;
constexpr size_t WS_BTB = 32 * MiB;
constexpr size_t WS_WPOOL = 44 * MiB;
constexpr size_t WS_WF = 44 * MiB + 512 * 1024;
constexpr size_t WS_KERN = 45 * MiB;
constexpr size_t WS_LAMC = 46 * MiB;
constexpr size_t WS_LF = 47 * MiB;
constexpr size_t WS_WGU = 48 * MiB;
constexpr size_t WS_WDN = 92 * MiB;
constexpr size_t WS_XB = 114 * MiB;
constexpr size_t WS_ACT = 146 * MiB;
constexpr size_t WS_O = 244 * MiB;
constexpr size_t WS_NRM = 279 * MiB;
constexpr size_t WS_END = 283 * MiB;
constexpr int CW_TMO = 0, CW_BAR = 4096, CW_PANEL = 16384, CW_QUEUE = 24576;

constexpr int RING_OFF = 0, RING_BYTES = 131072;
constexpr int LDSCTL_OFF = RING_BYTES, MISC_OFF = LDSCTL_OFF + 320;
constexpr int LDS_BYTES = 147456;

#define GAS __attribute__((address_space(1)))
#define LAS __attribute__((address_space(3)))
typedef unsigned short bf16;
typedef unsigned v4u __attribute__((ext_vector_type(4)));
typedef float f32x4 __attribute__((ext_vector_type(4)));
typedef float f32x2 __attribute__((ext_vector_type(2)));
typedef short bf16x8 __attribute__((ext_vector_type(8)));
typedef GAS unsigned gu32;
#define RLX_AGENT __ATOMIC_RELAXED, __HIP_MEMORY_SCOPE_AGENT
#define LDS_WAIT() asm volatile("s_waitcnt lgkmcnt(0)" ::: "memory")
#define VM_WAIT() asm volatile("s_waitcnt vmcnt(0)" ::: "memory")
__device__ __forceinline__ unsigned f2bf(float f) { unsigned u = __builtin_bit_cast(unsigned, f); return (u + 0x7fffu + ((u >> 16) & 1u)) >> 16; }
__device__ __forceinline__ unsigned pk2(float lo, float hi) { return f2bf(lo) | (f2bf(hi) << 16); }
__device__ __forceinline__ float bf2f(unsigned short b) { return __builtin_bit_cast(float, (unsigned)b << 16); }
__device__ __forceinline__ float lshx(float v, int lane, int m) { return __builtin_bit_cast(float, __builtin_amdgcn_ds_bpermute((lane ^ m) << 2, __builtin_bit_cast(int, v))); }
__device__ __forceinline__ float wave_sum(float v, int lane) {
#pragma unroll
    for (int o = 1; o < 64; o <<= 1) v += lshx(v, lane, o);
    return v;
}

enum Op { OP_PROLOGUE = 0, OP_QKV, OP_ATTN, OP_WO, OP_UP, OP_DOWN, OP_S5IN, OP_SSM, OP_SSMB, OP_GLU, OP_POOLPREP, OP_POOLGEMM, OP_FINAL, OP_NORMX, OP_S5TAB };
struct PhaseEnt { int op, layer, j, sin, sout; };
#define MK_PROGRAM \
    {OP_PROLOGUE, 0, 0, 0, 0}, \
    {OP_QKV, 0, 0, 0, 0}, {OP_ATTN, 0, 0, 0, 0}, {OP_WO, 0, 0, 0, 1}, {OP_UP, 0, 0, 1, 0}, {OP_DOWN, 0, 0, 0, 2}, \
    {OP_S5IN, 1, 0, 2, 0}, {OP_SSM, 1, 0, 0, 0}, {OP_GLU, 1, 0, 0, 3}, {OP_UP, 1, 0, 3, 0}, {OP_DOWN, 1, 0, 0, 4}, \
    {OP_POOLGEMM, 2, 0, 4, 5}, {OP_UP, 2, 0, 5, 0}, {OP_DOWN, 2, 0, 0, 6}, \
    {OP_QKV, 3, 1, 6, 0}, {OP_ATTN, 3, 1, 0, 0}, {OP_WO, 3, 1, 0, 7}, {OP_UP, 3, 0, 7, 0}, {OP_DOWN, 3, 0, 0, 8}, \
    {OP_FINAL, 0, 0, 8, 0}, \
    {OP_NORMX, 0, 0, 0, 1}, {OP_NORMX, 0, 0, 0, 2}, {OP_NORMX, 0, 0, 0, 3}, {OP_NORMX, 0, 0, 0, 4}, {OP_NORMX, 0, 0, 0, 5}, {OP_NORMX, 0, 0, 0, 6}, {OP_NORMX, 0, 0, 0, 7}, {OP_NORMX, 0, 0, 0, 8}, \
    {OP_S5TAB, 0, 0, 0, 0}
constexpr int N_PROG = 29, PH_FINAL = 19, PH_LAST = 18, PH_NORMX1 = 20, PH_S5TAB = 28;
__constant__ PhaseEnt PROG[N_PROG] = { MK_PROGRAM };

struct Args { const float* in[22]; float* out; unsigned char* ws; int ph_lo, ph_hi; };

__device__ __forceinline__ void wt_item(const float* W, int ldw, int K, const float* gain, bf16* WT, int n0_dst, int n0_src, int k0, LAS float* scr, int lane) {
    const int c4 = lane & 7, r8 = lane >> 3;
    const GAS f32x4* src = (const GAS f32x4*)(W + (size_t)(k0 + r8) * ldw + n0_src + 4 * c4);
    f32x4 v[8];
#pragma unroll
    for (int i = 0; i < 8; ++i) v[i] = src[(size_t)i * 2 * ldw];
    if (gain) {
#pragma unroll
        for (int i = 0; i < 8; ++i) v[i] = v[i] * gain[k0 + r8 + 8 * i]; }
#pragma unroll
    for (int i = 0; i < 8; ++i) { LAS float* d = scr + (r8 + 8 * i) * 33 + 4 * c4; d[0] = v[i].x; d[1] = v[i].y; d[2] = v[i].z; d[3] = v[i].w; }
    LDS_WAIT(); asm volatile("" ::: "memory");
    const int c = lane & 7;
#pragma unroll
    for (int j = 0; j < 4; ++j) { const int n = (lane >> 3) + 8 * j; const LAS float* s = scr + (8 * c) * 33 + n;
        v4u o; o.x = pk2(s[0 * 33], s[1 * 33]); o.y = pk2(s[2 * 33], s[3 * 33]); o.z = pk2(s[4 * 33], s[5 * 33]); o.w = pk2(s[6 * 33], s[7 * 33]);
        *(GAS v4u*)(WT + (size_t)(n0_dst + n) * K + k0 + 8 * c) = o; }
    LDS_WAIT(); asm volatile("" ::: "memory");
}
template <int NR> __device__ __forceinline__ void normx_rows(const float* x0, size_t xstride, bf16* o0, size_t ostride, pg8::ssq_t* ssq0, size_t sstride, int lane) {
    f32x4 v[NR][4]; float s[NR];
#pragma unroll
    for (int r = 0; r < NR; ++r) { const GAS f32x4* xr = (const GAS f32x4*)(x0 + r * xstride) + lane;
#pragma unroll
        for (int j = 0; j < 4; ++j) v[r][j] = xr[64 * j]; }
#pragma unroll
    for (int r = 0; r < NR; ++r) { s[r] = 0.f;
#pragma unroll
        for (int j = 0; j < 4; ++j) s[r] += (v[r][j].x * v[r][j].x + v[r][j].y * v[r][j].y) + (v[r][j].z * v[r][j].z + v[r][j].w * v[r][j].w);
        s[r] = wave_sum(s[r], lane); }
#pragma unroll
    for (int r = 0; r < NR; ++r) { GAS unsigned long long* o8 = (GAS unsigned long long*)(o0 + r * ostride) + lane;
#pragma unroll
        for (int j = 0; j < 4; ++j) o8[64 * j] = (unsigned long long)pk2(v[r][j].x, v[r][j].y) | ((unsigned long long)pk2(v[r][j].z, v[r][j].w) << 32);
        if (lane == 0) ssq0[r * sstride] = (pg8::ssq_t)__builtin_llrintf(s[r] * pg8::SSQ_SCALE); }
}
__device__ __forceinline__ void normx_row(const float* xrow, bf16* orow, pg8::ssq_t* ssq_slot, int lane) { normx_rows<1>(xrow, 0, orow, 0, ssq_slot, 0, lane); }
template <int W> __device__ __forceinline__ void pool_item(const float* X, const pg8::ssq_t* ssq, const f32x4 gg, bf16* PD, int row0, int t0, int c0) {
    f32x4 ring[W]; f32x4 run = {0.f, 0.f, 0.f, 0.f};
    { f32x4 xw[W]; pg8::ssq_t sw[W];
#pragma unroll
      for (int kk = 1; kk < W; ++kk) { xw[kk] = (f32x4){0.f, 0.f, 0.f, 0.f}; sw[kk] = 0;
          if (t0 - W + kk >= 0) { const int r = row0 - W + kk; xw[kk] = *(const GAS f32x4*)(X + (size_t)r * D + c0); sw[kk] = ((const GAS pg8::ssq_t*)ssq)[r]; } }
#pragma unroll
      for (int kk = 1; kk < W; ++kk) {
          const f32x4 hv = xw[kk] * __builtin_amdgcn_rsqf((float)sw[kk] * (1.0f / (1024.0f * pg8::SSQ_SCALE)) + RMS_EPS) * gg;
          ring[kk % W] = hv; run += hv; } }
    f32x4 xc[16]; pg8::ssq_t sc[16];
#pragma unroll
    for (int i = 0; i < 16; ++i) { xc[i] = *(const GAS f32x4*)(X + (size_t)(row0 + i) * D + c0); sc[i] = ((const GAS pg8::ssq_t*)ssq)[row0 + i]; }
#pragma unroll
    for (int i = 0; i < 16; ++i) { const int r = row0 + i, t = t0 + i;
        const f32x4 hv = xc[i] * __builtin_amdgcn_rsqf((float)sc[i] * (1.0f / (1024.0f * pg8::SSQ_SCALE)) + RMS_EPS) * gg;
        run += hv; ring[i % W] = hv;
        const int cnt = (t + 1 < W) ? (t + 1) : W; const f32x4 o = run * (1.0f / (float)cnt) - hv;
        *(GAS unsigned long long*)(PD + (size_t)r * D + c0) = (unsigned long long)pk2(o[0], o[1]) | ((unsigned long long)pk2(o[2], o[3]) << 32);
        run -= ring[(i + 1) % W]; }
}
__device__ __forceinline__ void touch_lines(const void* p, int bytes, int tid) {
    const GAS unsigned* q = (const GAS unsigned*)p + tid * 32; unsigned acc = 0;
    for (int o = 0; o < bytes; o += 512 * 128 * 8) {
#pragma unroll
        for (int i = 0; i < 8; ++i) acc |= q[(size_t)(o / 4) + (size_t)i * 512 * 32];
    }
    asm volatile("" :: "v"(acc));
}
struct WtDesc { const float* W; const float* gain; bf16* WT; int ldw, K, Ndst, kind, off2; };
__device__ __forceinline__ WtDesc wt_desc(const Args& args, int i) {
    unsigned char* ws = args.ws; const float* mix_g = args.in[1]; const float* ffn_g = args.in[2];
    WtDesc d;
    if (i < 2) { d.W = args.in[4] + (size_t)i * D * FOX_IN; d.gain = mix_g + (i ? 3 * D : 0); d.WT = (bf16*)(ws + WS_WQKV) + (size_t)i * 3 * D * D; d.ldw = FOX_IN; d.K = D; d.Ndst = 3 * D; d.kind = 0; d.off2 = 0; }
    else if (i < 4) { d.W = args.in[6] + (size_t)(i - 2) * D * D; d.gain = nullptr; d.WT = (bf16*)(ws + WS_WO) + (size_t)(i - 2) * D * D; d.ldw = D; d.K = D; d.Ndst = D; d.kind = 0; d.off2 = 0; }
    else if (i == 4) { d.W = args.in[7]; d.gain = mix_g + D; d.WT = (bf16*)(ws + WS_WS5IN); d.ldw = D; d.K = D; d.Ndst = D; d.kind = 0; d.off2 = 0; }
    else if (i == 5) { d.W = args.in[16]; d.gain = nullptr; d.WT = (bf16*)(ws + WS_WGLU); d.ldw = 2 * D; d.K = D; d.Ndst = 2 * D; d.kind = 1; d.off2 = D; }
    else if (i < 10) { d.W = args.in[17] + (size_t)(i - 6) * 65536; d.gain = nullptr; d.WT = (bf16*)(ws + WS_WPOOL) + (size_t)(i - 6) * 65536; d.ldw = 256; d.K = 256; d.Ndst = 256; d.kind = 0; d.off2 = 0; }
    else if (i < 14) { d.W = args.in[20] + (size_t)(i - 10) * D * 2 * DFF; d.gain = ffn_g + (i - 10) * D; d.WT = (bf16*)(ws + WS_WGU) + (size_t)(i - 10) * 2 * DFF * D; d.ldw = 2 * DFF; d.K = D; d.Ndst = 2 * DFF; d.kind = 1; d.off2 = DFF; }
    else { d.W = args.in[21] + (size_t)(i - 14) * DFF * D; d.gain = nullptr; d.WT = (bf16*)(ws + WS_WDN) + (size_t)(i - 14) * D * DFF; d.ldw = D; d.K = DFF; d.Ndst = D; d.kind = 0; d.off2 = 0; }
    return d;
}
__device__ __forceinline__ void ph_s5tables(const Args& args, LAS float* scr, LAS float* wsc, int gw, int NGW, int lane) {
    unsigned char* ws = args.ws;
    { const float* a_re = args.in[8]; const float* a_im = args.in[9]; const float* log_dt = args.in[10];
      const float* b_re = args.in[11]; const float* b_im = args.in[12]; const float* c_re = args.in[13]; const float* c_im = args.in[14];
      float* KERN = (float*)(ws + WS_KERN);
      for (int it = (gw + NGW / 2) % NGW; it < SG * 16; it += NGW) {
          const int g = it >> 4, tau = it & 15, p = lane;
          { const GAS f32x4* s0 = (const GAS f32x4*)(c_re + (size_t)g * 1024), *s1 = (const GAS f32x4*)(c_im + (size_t)g * 1024), *s2 = (const GAS f32x4*)(b_re + (size_t)g * 1024), *s3 = (const GAS f32x4*)(b_im + (size_t)g * 1024);
            f32x4 t0[4], t1[4], t2[4], t3[4];
#pragma unroll
            for (int j = 0; j < 4; ++j) { t0[j] = s0[lane + 64 * j]; t1[j] = s1[lane + 64 * j]; t2[j] = s2[lane + 64 * j]; t3[j] = s3[lane + 64 * j]; }
#pragma unroll
            for (int j = 0; j < 4; ++j) { ((LAS f32x4*)scr)[lane + 64 * j] = t0[j]; ((LAS f32x4*)scr)[256 + lane + 64 * j] = t1[j]; ((LAS f32x4*)scr)[512 + lane + 64 * j] = t2[j]; ((LAS f32x4*)scr)[768 + lane + 64 * j] = t3[j]; } }
          const double lr = a_re[g * SP + p], li = a_im[g * SP + p], dt = exp((double)log_dt[g]);
          const double er = exp(lr * dt), lbr = er * cos(li * dt), lbi = er * sin(li * dt);
          const double nr = lbr - 1.0, ni = lbi, den = lr * lr + li * li, fr = (nr * lr + ni * li) / den, fi = (ni * lr - nr * li) / den;
          const double et = exp(lr * dt * tau), ptr_ = et * cos(li * dt * tau), pti = et * sin(li * dt * tau);
          wsc[p] = (float)(ptr_ * fr - pti * fi); wsc[64 + p] = (float)(ptr_ * fi + pti * fr);
          LDS_WAIT(); asm volatile("" ::: "memory");
          const LAS float* Cr = scr, *Ci = scr + 1024, *Br = scr + 2048, *Bi = scr + 3072, *Wr_ = wsc, *Wi_ = wsc + 64;
          float acc[4] = {0.f, 0.f, 0.f, 0.f}; const int ci = lane & 15, cob = lane >> 4;
#pragma unroll 8
          for (int pp = 0; pp < SP; ++pp) {
              const float wr = Wr_[pp], wi = Wi_[pp], br = Br[pp * 16 + ci], bi = Bi[pp * 16 + ci];
#pragma unroll
              for (int q = 0; q < 4; ++q) { const int co = cob + 4 * q; const float cr = Cr[co * 64 + pp], cim = Ci[co * 64 + pp];
                  const float cwr = cr * wr - cim * wi, cwi = cr * wi + cim * wr; acc[q] += cwr * br - cwi * bi; } }
#pragma unroll
          for (int q = 0; q < 4; ++q) KERN[(size_t)it * 256 + lane + 64 * q] = acc[q];
          LDS_WAIT(); asm volatile("" ::: "memory");
      }
      bf16* BTA = (bf16*)(ws + WS_BTA);
      for (int e = gw * 64 + lane; e < SG * 128 * 16; e += NGW * 64) {
          const int g = e >> 11, n = (e >> 4) & 127, j = e & 15, p = n & 63, im = n >> 6;
          const double lr = a_re[g * SP + p], li = a_im[g * SP + p], dt = exp((double)log_dt[g]);
          const double er = exp(lr * dt), lbr = er * cos(li * dt), lbi = er * sin(li * dt);
          const double nr = lbr - 1.0, ni = lbi, den = lr * lr + li * li, fr = (nr * lr + ni * li) / den, fi = (ni * lr - nr * li) / den;
          const double tt = (double)(15 - j), et = exp(lr * dt * tt), ptr_ = et * cos(li * dt * tt), pti = et * sin(li * dt * tt);
          const float Wr = (float)(ptr_ * fr - pti * fi), Wi = (float)(ptr_ * fi + pti * fr);
          unsigned w[8];
#pragma unroll
          for (int c = 0; c < 16; c += 2) { float v[2];
#pragma unroll
              for (int q = 0; q < 2; ++q) { const float br = b_re[(g * SP + p) * SC + c + q], bi = b_im[(g * SP + p) * SC + c + q]; v[q] = im ? (Wr * bi + Wi * br) : (Wr * br - Wi * bi); }
              w[c >> 1] = pk2(v[0], v[1]); }
          v4u* dst = (v4u*)(BTA + ((size_t)g * 256 + n) * 256 + j * 16);
          dst[0] = (v4u){w[0], w[1], w[2], w[3]}; dst[1] = (v4u){w[4], w[5], w[6], w[7]};
      }
      for (int e = gw * 64 + lane; e < SG * 128 * 32; e += NGW * 64) { const int g = e >> 12, r = e & 4095; ((v4u*)(BTA + ((size_t)g * 256 + 128) * 256))[r] = (v4u){0u, 0u, 0u, 0u}; }
      bf16* BTB = (bf16*)(ws + WS_BTB);
      for (int e = gw * 64 + lane; e < SG * 16 * SP; e += NGW * 64) {
          const int g = e >> 10, i = (e >> 6) & 15, p = e & 63;
          const double lr = a_re[g * SP + p], li = a_im[g * SP + p], dt = exp((double)log_dt[g]);
          const double tt = (double)(i + 1), et = exp(lr * dt * tt); const float pr = (float)(et * cos(li * dt * tt)), pi_ = (float)(et * sin(li * dt * tt));
          float crv[16], civ[16];
#pragma unroll
          for (int co = 0; co < 16; ++co) { crv[co] = c_re[(g * SC + co) * SP + p]; civ[co] = c_im[(g * SC + co) * SP + p]; }
#pragma unroll
          for (int co = 0; co < 16; ++co) { const float cr = crv[co], cim = civ[co];
              bf16* row = BTB + ((size_t)g * 256 + i * 16 + co) * 384 + 256;
              row[p] = (bf16)f2bf(cr * pr - cim * pi_); row[64 + p] = (bf16)f2bf(-(cr * pi_ + cim * pr)); }
      }
      float* LAMC = (float*)(ws + WS_LAMC);
      for (int e = gw * 64 + lane; e < SG * SP; e += NGW * 64) {
          const double lr = a_re[e], li = a_im[e], dt = exp((double)log_dt[e >> 6]), et = exp(lr * dt * 16.0);
          LAMC[2 * e] = (float)(et * cos(li * dt * 16.0)); LAMC[2 * e + 1] = (float)(et * sin(li * dt * 16.0)); }
    }
}
__device__ __forceinline__ bool wt_one(const Args& args, LAS float* scr, unsigned mask, int it, int lane) {
    constexpr int NMAT = 18; int base = 0;
    for (int mi = 0; mi < NMAT; ++mi) { if (!((mask >> mi) & 1u)) continue;
        const WtDesc d = wt_desc(args, mi); const int n_it = (d.K / 64) * (d.Ndst / 32);
        if (it < base + n_it) { const int r = it - base, nblk = d.Ndst / 32, kb = r / nblk, nb = r % nblk, n0 = nb * 32; int ns = n0;
            if (d.kind == 1) { const int pn = n0 >> 8, j = n0 & 255; ns = (j < 128) ? (128 * pn + j) : (d.off2 + 128 * pn + (j - 128)); }
            wt_item(d.W, d.ldw, d.K, d.gain, d.WT, n0, ns, kb * 64, scr, lane); return true; }
        base += n_it; }
    return false;
}
__device__ __forceinline__ void ph_weights(const Args& args, LAS float* scr, unsigned mask, int rk, int nw, int lane) {
    constexpr int NMAT = 18;
    int mi = -1, base = 0, n_it = 0; WtDesc d{};
    for (int it = rk; ; it += nw) {
        while (mi < NMAT && it >= base + n_it) { base += n_it; n_it = 0; ++mi; while (mi < NMAT && !((mask >> mi) & 1u)) ++mi; if (mi < NMAT) { d = wt_desc(args, mi); n_it = (d.K / 64) * (d.Ndst / 32); } }
        if (mi >= NMAT) break;
        const int r = it - base, nblk = d.Ndst / 32, kb = r / nblk, nb = r % nblk, n0 = nb * 32; int ns = n0;
        if (d.kind == 1) { const int pn = n0 >> 8, j = n0 & 255; ns = (j < 128) ? (128 * pn + j) : (d.off2 + 128 * pn + (j - 128)); }
        wt_item(d.W, d.ldw, d.K, d.gain, d.WT, n0, ns, kb * 64, scr, lane);
    }
}
__device__ __forceinline__ void ph_wf(const Args& args, int j, int rk, int nw, int lane) {
    for (int e = rk * 64 + lane; e < NH * D; e += nw * 64) { const int h = e >> 10, kk = e & 1023;
        ((bf16*)(args.ws + WS_WF))[j * NH * D + e] = (bf16)f2bf(args.in[4][(size_t)j * D * FOX_IN + (size_t)kk * FOX_IN + 3 * D + h] * args.in[1][(j ? 3 * D : 0) + kk]); }
}
constexpr unsigned WMASK_PRO = (1u << 0);
constexpr unsigned WMASK_ATT = (1u << 2) | (1u << 10);
constexpr int WATT_ITEMS = 16 * 32 + 16 * 176;
constexpr unsigned WMASK_L0 = (1u << 14) | (1u << 4) | (1u << 5) | (1u << 11);
constexpr unsigned WMASK_L1 = (1u << 15) | (1u << 6) | (1u << 7) | (1u << 8) | (1u << 9) | (1u << 12);
constexpr unsigned WMASK_L2 = (1u << 16) | (1u << 1) | (1u << 3) | (1u << 13);
constexpr unsigned WMASK_L3 = (1u << 17);
__device__ __forceinline__ void ph_prologue(const Args& args, LAS unsigned char* lds, int gw, int NGW, int wave, int lane) {
    unsigned char* ws = args.ws;
    LAS float* scr = (LAS float*)(lds + RING_OFF + wave * 16384);
    ph_weights(args, scr, MK_DEFER_WEIGHTS ? WMASK_PRO : 0x3ffffu, gw, NGW, lane);
    ph_wf(args, 0, gw, NGW, lane); if (!MK_DEFER_WEIGHTS) ph_wf(args, 1, gw, NGW, lane);
    for (int rep_ = 0; rep_ < MK_S5TAB_REPS; ++rep_) ph_s5tables(args, scr, (LAS float*)(lds + LDSCTL_OFF + 8192 + wave * 512), gw, NGW, lane);
    pg8::ssq_t* ssq0 = (pg8::ssq_t*)(ws + WS_SSQ);
    for (int m = gw; m < M; m += NGW) normx_row(args.in[0] + (size_t)m * D, (bf16*)(ws + WS_XB) + (size_t)m * D, ssq0 + m, lane);
}

__global__ void __launch_bounds__(NWAVES * 64, 2) mega_k(Args args) {
    extern __shared__ __attribute__((aligned(16))) unsigned char lds_raw[];
    LAS unsigned char* lds = (LAS unsigned char*)lds_raw;
    const int vcu0 = (gridDim.x % 8 == 0) ? (blockIdx.x % 8) * (gridDim.x / 8) + blockIdx.x / 8 : blockIdx.x;
    const int vcu = vcu0, NGW = gridDim.x * NWAVES, wave0 = __builtin_amdgcn_readfirstlane(threadIdx.x >> 6);
    for (int u = threadIdx.x; u < (LDS_BYTES - LDSCTL_OFF) / 4; u += NWAVES * 64) ((LAS unsigned*)(lds + LDSCTL_OFF))[u] = 0u;
    __syncthreads();
    MK_BAR_SETUP();
    int e0 = args.ph_lo;
    if (e0 == PH_S5TAB) { const int tid = threadIdx.x, lane = tid & 63, wave = __builtin_amdgcn_readfirstlane(tid >> 6); ph_s5tables(args, (LAS float*)(lds + RING_OFF + wave * 16384), (LAS float*)(lds + LDSCTL_OFF + 8192 + wave * 512), vcu * NWAVES + wave, NGW, lane); return; }
    if (e0 == 0) {
        const int tid = threadIdx.x, lane = tid & 63, wave = __builtin_amdgcn_readfirstlane(tid >> 6);
        ph_prologue(args, lds, vcu * NWAVES + wave, NGW, wave, lane);
        e0 = 1;
        if (e0 < args.ph_hi) { MK_GRID_BAR(); }
    }
    for (int e = e0; e < args.ph_hi; ++e) {
#define MK_LANE_TID() int lane_; asm volatile("v_mbcnt_lo_u32_b32 %0, -1, 0\n\tv_mbcnt_hi_u32_b32 %0, -1, %0" : "=v"(lane_)); const int lane = lane_, tid = wave * 64 + lane, gw = vcu * NWAVES + wave; (void)tid; (void)gw; (void)lane
        const int wave = wave0;
        int G = gridDim.x, bx = blockIdx.x, vcu = vcu0; asm volatile("" : "+s"(G), "+s"(bx), "+s"(vcu));
        const int NGW = G * NWAVES;
        unsigned char* ws = args.ws; float* X = args.out; asm volatile("" : "+s"(ws), "+s"(X));
        bf16* XB = (bf16*)(ws + WS_XB); pg8::ssq_t* SSQ = (pg8::ssq_t*)(ws + WS_SSQ);
        const int op = PROG[e].op, layer = PROG[e].layer, pj = PROG[e].j, sin = PROG[e].sin, sout = PROG[e].sout;
        (void)pj;
        if (op == OP_NORMX) {
            MK_LANE_TID();
            for (int m = gw; m < M; m += NGW) normx_row(X + (size_t)m * D, XB + (size_t)m * D, SSQ + (size_t)sout * M + m, lane);
        } else if (op == OP_UP) {
            MK_LANE_TID();
            pg8::Gemm g{XB, (const bf16*)(ws + WS_WGU) + (size_t)layer * 2 * DFF * D, D, D, D, 0, 0};
            pg8::StaticOrder S; S.init(M / 256, 2 * DFF / 256, G, bx);
            pg8::EpiSwiGLU E{(bf16*)(ws + WS_ACT), DFF, SSQ + (size_t)sin * M, MK_UP_DUMMY};
            pg8::gemm_phase<pg8::EpiSwiGLU, pg8::StaticOrder, MK_ALIGN_UP>(lds + RING_OFF, tid, g, S, E);
            if (MK_DEFER_WEIGHTS && bx >= 128 && !(MK_UP_DUMMY)) {
                LAS float* scr = (LAS float*)(lds + RING_OFF + wave * 16384); const int rk = (bx - 128) * NWAVES + wave;
                ph_weights(args, scr, layer == 0 ? WMASK_L0 : layer == 1 ? WMASK_L1 : layer == 2 ? WMASK_L2 : WMASK_L3, rk, 128 * NWAVES, lane);
                if (layer == 2) ph_wf(args, 1, rk, 128 * NWAVES, lane); }
        } else if (op == OP_DOWN) {
            MK_LANE_TID();
            pg8::Gemm g{(const bf16*)(ws + WS_ACT), (const bf16*)(ws + WS_WDN) + (size_t)layer * D * DFF, DFF, DFF, DFF, 0, 0};
            pg8::StaticOrder S; S.init(M / 256, D / 256, G, bx);
            if (layer == 3 && !(MK_UP_DUMMY)) {
                pg8::EpiResidFinal E{X, X, SSQ + (size_t)sout * M, args.in[3], (unsigned*)(ws + WS_CTL) + CW_PANEL};
                pg8::gemm_phase<pg8::EpiResidFinal, pg8::StaticOrder, false>(lds + RING_OFF, tid, g, S, E);
            } else {
                pg8::EpiResid<0> E{X, X, XB, SSQ + (size_t)sout * M, args.in[18], nullptr, MK_UP_DUMMY};
                pg8::gemm_phase<pg8::EpiResid<0>, pg8::StaticOrder, true>(lds + RING_OFF, tid, g, S, E); }
        }
        else if (op == OP_QKV) {
            MK_LANE_TID();
            if (MK_TOUCH) touch_lines(XB + (size_t)(8 * (bx & 7) + ((bx >> 3) & 7)) * 256 * D, 256 * D * 2, tid);
            if (!(MK_QKV_NOGATES)) {
              const bf16* WfT = (const bf16*)(ws + WS_WF) + (size_t)pj * NH * D; const pg8::ssq_t* ssq = SSQ + (size_t)sin * M; const float* bfp = args.in[5] + pj * NH; float* LF = (float*)(ws + WS_LF);
#pragma unroll
              for (int i = 0; i < 4; ++i) { const int c = tid + 512 * i; *(LAS v4u*)(lds + (c >> 7) * 2064 + (c & 127) * 16) = ((const GAS v4u*)WfT)[c]; }
              LDS_WAIT(); __syncthreads();
              if (wave < 4) {
                const int r0 = (vcu * 4 + wave) * 16, kq = lane >> 4; const GAS bf16x8* ap = (const GAS bf16x8*)(XB + (size_t)(r0 + (lane & 15)) * D + kq * 8); const LAS unsigned char* bp = lds + (lane & 15) * 2064 + kq * 16;
                bf16x8 afr[32];
#pragma unroll
                for (int ks = 0; ks < 32; ++ks) afr[ks] = ap[ks * 4];
                f32x4 acc = {0.f, 0.f, 0.f, 0.f};
#pragma unroll
                for (int ks = 0; ks < 32; ++ks) acc = __builtin_amdgcn_mfma_f32_16x16x32_bf16(afr[ks], *(const LAS bf16x8*)(bp + ks * 64), acc, 0, 0, 0);
                const int rr = r0 + 4 * kq, hh = lane & 15; const float bb = bfp[hh]; f32x4 o;
#pragma unroll
                for (int i = 0; i < 4; ++i) { const float z = acc[i] * pg8::rstd_row(ssq, rr + i) + bb; o[i] = fminf(z, 0.f) - log1pf(expf(-fabsf(z))); }
                *(GAS f32x4*)(LF + ((size_t)(rr / SEQ) * NH + hh) * SEQ + (rr % SEQ)) = o; }
              LDS_WAIT(); __syncthreads(); }
            pg8::Gemm g{XB, (const bf16*)(ws + WS_WQKV) + (size_t)pj * 3 * D * D, D, D, D, 0, 0};
            pg8::StaticOrder S; S.init(M / 256, 3 * D / 256, G, bx);
            pg8::EpiQKV E{(bf16*)(ws + WS_ACT), (size_t)16 * MiB, SSQ + (size_t)sin * M, attn_body::C2, (float*)(ws + WS_NRM)};
            pg8::gemm_phase<pg8::EpiQKV, pg8::StaticOrder, true>(lds + RING_OFF, tid, g, S, E);
        } else if (op == OP_ATTN) {
            MK_LANE_TID();
            LAS float* bl = (LAS float*)(lds + RING_OFF + attn_body::ATTN_LDS_BYTES);
            { const float* lf = (const float*)(ws + WS_LF) + (size_t)(vcu >> 2) * SEQ + tid * 8; LAS float* wt = (LAS float*)(lds + LDSCTL_OFF + 1024);
              const f32x4 a = *(const f32x4*)lf, b = *(const f32x4*)(lf + 4);
              float p[8]; p[0] = a[0]; p[1] = p[0] + a[1]; p[2] = p[1] + a[2]; p[3] = p[2] + a[3]; p[4] = p[3] + b[0]; p[5] = p[4] + b[1]; p[6] = p[5] + b[2]; p[7] = p[6] + b[3];
              float tot = p[7];
#pragma unroll
              for (int o = 1; o < 64; o <<= 1) { const float u = __builtin_bit_cast(float, __builtin_amdgcn_ds_bpermute((lane - o) << 2, __builtin_bit_cast(int, tot))); if (lane >= o) tot += u; }
              if (lane == 63) wt[wave] = tot;
              LDS_WAIT(); __syncthreads();
              float off = tot - p[7];
              for (int w = 0; w < wave; ++w) off += wt[w];
#pragma unroll
              for (int i = 0; i < 8; ++i) bl[tid * 8 + i] = -(p[i] + off) * 1.4426950408889634f;
              LDS_WAIT(); __syncthreads(); }
            LAS int* tsk = (LAS int*)(lds + LDSCTL_OFF + 12288);
            for (int prep_ = 0; prep_ < MK_PREPASS_REPS; ++prep_) { LAS float* kn = (LAS float*)(lds + LDSCTL_OFF + 12288 + 64); LAS float* qn = kn + 64;
              const int bh = vcu >> 2, sq = vcu & 3; const size_t rb = (size_t)(bh >> 4) * SEQ; const int hc = (bh & 15) * HD + (lane & 7) * 8;
              (void)hc;
              const GAS f32x2* Nk = (const GAS f32x2*)(ws + WS_NRM) + ((size_t)M + rb) * 16 + (bh & 15); const GAS f32x2* Nq = (const GAS f32x2*)(ws + WS_NRM) + rb * 16 + (bh & 15);
              { f32x2 v[8];
#pragma unroll
                for (int i = 0; i < 8; ++i) v[i] = Nk[(size_t)(tid * 8 + i) * 16];
                float mx = 0.f;
#pragma unroll
                for (int i = 0; i < 8; ++i) mx = fmaxf(mx, v[i].x + v[i].y);
                mx = fmaxf(mx, lshx(mx, lane, 1)); mx = fmaxf(mx, lshx(mx, lane, 2)); mx = fmaxf(mx, lshx(mx, lane, 4));
                if ((lane & 7) == 0) kn[tid >> 3] = mx; }
              { f32x2 v[2]; const int i = wave >> 1, qb = (i == 0) ? sq : (i == 1) ? 7 - sq : (i == 2) ? 8 + sq : 15 - sq;
#pragma unroll
                for (int jj = 0; jj < 2; ++jj) v[jj] = Nq[(size_t)(qb * 256 + (wave & 1) * 128 + lane * 2 + jj) * 16];
                float mx = fmaxf(v[0].x + v[0].y, v[1].x + v[1].y);
#pragma unroll
                for (int o = 1; o < 64; o <<= 1) mx = fmaxf(mx, lshx(mx, lane, o));
                if (lane == 0) qn[i * 8 + (wave & 1)] = mx; if (lane == 1) { qn[i * 8 + 2 + (wave & 1) * 3] = 0.f; qn[i * 8 + 3 + (wave & 1) * 3] = 0.f; qn[i * 8 + 4 + (wave & 1) * 3] = 0.f; } }
              LDS_WAIT(); __syncthreads();
              if (wave < 4) { const int i = wave, qb = (i == 0) ? sq : (i == 1) ? 7 - sq : (i == 2) ? 8 + sq : 15 - sq, nt = 4 * qb + 4;
                  float q2 = (lane < 8) ? qn[i * 8 + lane] : 0.f, k2 = (lane < nt) ? kn[lane] : 0.f;
#pragma unroll
                  for (int o = 1; o < 64; o <<= 1) { q2 = fmaxf(q2, lshx(q2, lane, o)); k2 = fmaxf(k2, lshx(k2, lane, o)); }
                  const float lim = MK_SKIP_QK * sqrtf(q2) * sqrtf(k2) * 1.01f + 30.0f, bq = bl[qb * 256];
                  const int ts = 2 * lane;
                  const bool okc = (ts + 2 <= nt - 4) && (bq - bl[64 * (ts + 1) + 63] >= lim);
                  const int cntc = __builtin_popcountll(__ballot(okc));
                  if (lane == 0) tsk[i] = 2 * cntc; }
              LDS_WAIT(); __syncthreads(); }
            const attn_body::AttnTensors AT{(const attn_body::bf16*)(ws + WS_ACT), (const attn_body::bf16*)(ws + WS_ACT + 32 * MiB), (const attn_body::bf16*)(ws + WS_ACT + 64 * MiB), (attn_body::bf16*)(ws + WS_O)};
            const attn_body::StaticOrder S(G, bx);
            attn_body::attn_phase<attn_body::StaticOrder, MK_THRL>((char*)lds_raw + RING_OFF, AT, S, bl, tid, tsk);
            if (MK_DEFER_WEIGHTS && layer == 0) {
                LAS float* scr = (LAS float*)(lds + RING_OFF + wave * 16384); unsigned* q = (unsigned*)(ws + WS_CTL) + CW_QUEUE;
                for (;;) { unsigned b0 = 0; if (lane == 0) b0 = __hip_atomic_fetch_add(q, 4u, __ATOMIC_RELAXED, __HIP_MEMORY_SCOPE_AGENT); b0 = (unsigned)__builtin_amdgcn_readfirstlane((int)b0);
                    if (b0 >= (unsigned)WATT_ITEMS) break;
                    for (int i = 0; i < 4; ++i) if (!wt_one(args, scr, WMASK_ATT, (int)b0 + i, lane)) break; } }
        } else if (op == OP_WO) {
            MK_LANE_TID();
            pg8::Gemm g{(const bf16*)(ws + WS_O), (const bf16*)(ws + WS_WO) + (size_t)pj * D * D, D, D, D, 0, 0};
            pg8::StaticOrder S; S.init(M / 256, D / 256, G, bx);
            pg8::EpiResid<0> E{layer == 0 ? args.in[0] : X, X, XB, SSQ + (size_t)sout * M, nullptr, nullptr, 0};
            pg8::gemm_phase<pg8::EpiResid<0>, pg8::StaticOrder, true>(lds + RING_OFF, tid, g, S, E);
        }
        else if (op == OP_S5IN) {
            MK_LANE_TID();
            { const float* KERN = (const float*)(ws + WS_KERN); bf16* BTB = (bf16*)(ws + WS_BTB);
              for (int e2 = gw * 64 + lane; e2 < SG * 256 * 16; e2 += NGW * 64) { const int g = e2 >> 12, n = (e2 >> 4) & 255, j = e2 & 15, i = n >> 4, co = n & 15;
                  v4u o0 = {0u, 0u, 0u, 0u}, o1 = {0u, 0u, 0u, 0u};
                  if (i >= j) { const f32x4* kp = (const f32x4*)(KERN + (((size_t)g * 16 + (i - j)) * 16 + co) * 16); const f32x4 a = kp[0], b = kp[1], c = kp[2], d = kp[3];
                      o0 = (v4u){pk2(a[0], a[1]), pk2(a[2], a[3]), pk2(b[0], b[1]), pk2(b[2], b[3])}; o1 = (v4u){pk2(c[0], c[1]), pk2(c[2], c[3]), pk2(d[0], d[1]), pk2(d[2], d[3])}; }
                  v4u* dst = (v4u*)(BTB + ((size_t)g * 256 + n) * 384 + j * 16); dst[0] = o0; dst[1] = o1; } }
            pg8::Gemm g{XB, (const bf16*)(ws + WS_WS5IN), D, D, D, 0, 0};
            pg8::StaticOrder S; S.init(M / 256, D / 256, G, bx);
            pg8::EpiU E{(bf16*)(ws + WS_ACT), SSQ + (size_t)sin * M};
            pg8::gemm_phase<pg8::EpiU, pg8::StaticOrder, true>(lds + RING_OFF, tid, g, S, E);
        } else if (op == OP_SSM) {
            MK_LANE_TID();
            pg8::StaticOrder S; S.init(BATCH, SG, G, bx);
            { pg8::Gemm g{(const bf16*)(ws + WS_ACT), (const bf16*)(ws + WS_BTA), 256, 384, 256, 0, 1024 * 384 * 2};
              pg8::EpiSloc E{(const float*)(ws + WS_LAMC), (bf16*)(ws + WS_ACT), lds + LDSCTL_OFF + 2048};
              pg8::gemm_phase<pg8::EpiSloc, pg8::StaticOrder, false>(lds + RING_OFF, tid, g, S, E); }
            { pg8::Gemm g{(const bf16*)(ws + WS_ACT), (const bf16*)(ws + WS_BTB), 384, 384, 384, 0, 1024 * 384 * 2};
              pg8::EpiY E{(const bf16*)(ws + WS_ACT), args.in[15], (bf16*)(ws + WS_ACT + 48 * MiB)};
              pg8::gemm_phase<pg8::EpiY, pg8::StaticOrder, true>(lds + RING_OFF, tid, g, S, E); }
        } else if (op == OP_GLU) {
            MK_LANE_TID();
            pg8::Gemm g{(const bf16*)(ws + WS_ACT + 48 * MiB), (const bf16*)(ws + WS_WGLU), D, 16, D, M * 16, 0};
            pg8::StaticOrder S; S.init(M / 256, 2 * D / 256, G, bx);
            pg8::EpiResid<1> E{X, X, XB, SSQ + (size_t)sout * M, nullptr, nullptr, 0};
            pg8::gemm_phase<pg8::EpiResid<1>, pg8::StaticOrder, true>(lds + RING_OFF, tid, g, S, E);
        }
        else if (op == OP_POOLPREP) {
        } else if (op == OP_POOLGEMM) {
            MK_LANE_TID();
            pg8::StaticOrder S; S.init(M / 256, 4, G, bx);
            { pg8::Unit u0; if (S.next(0, u0)) { const pg8::ssq_t* ssq = SSQ + (size_t)sin * M; const float* gain = args.in[1] + (size_t)layer * D; bf16* PD = (bf16*)(ws + WS_ACT);
                const int gi = u0.pn, c0 = gi * 256 + lane * 4; const f32x4 gg = *(const f32x4*)(gain + c0);
                for (int ci = wave; ci < 16; ci += NWAVES) { const int row0 = u0.pm * 256 + ci * 16, t0 = row0 & (SEQ - 1);
                    if (gi == 0) pool_item<2>(X, ssq, gg, PD, row0, t0, c0); else if (gi == 1) pool_item<4>(X, ssq, gg, PD, row0, t0, c0);
                    else if (gi == 2) pool_item<8>(X, ssq, gg, PD, row0, t0, c0); else pool_item<16>(X, ssq, gg, PD, row0, t0, c0); } }
              asm volatile("s_waitcnt vmcnt(0)" ::: "memory"); __syncthreads();
              if (wave == 0) { __builtin_amdgcn_fence(__ATOMIC_ACQUIRE, "agent"); asm volatile("s_waitcnt vmcnt(0)" ::: "memory"); }
              __syncthreads(); }
            pg8::Gemm g{(const bf16*)(ws + WS_ACT), (const bf16*)(ws + WS_WPOOL), 256, D, 256, 0, 512};
            pg8::EpiResid<2> E{X, X, XB, SSQ + (size_t)sout * M, args.in[18], args.in[19], 0};
            pg8::gemm_phase<pg8::EpiResid<2>, pg8::StaticOrder, true>(lds + RING_OFF, tid, g, S, E);
        } else if (op == OP_FINAL) {
            MK_LANE_TID();
            { const pg8::ssq_t* ssq = SSQ + (size_t)sin * M; const float* gain = args.in[3];
              for (int m = gw; m < M; m += NGW) { const float rs = pg8::rstd_row(ssq, m); f32x4* xr = (f32x4*)(X + (size_t)m * D) + lane; const f32x4* gr = (const f32x4*)gain + lane;
#pragma unroll
                  for (int j = 0; j < 4; ++j) xr[64 * j] = xr[64 * j] * rs * gr[64 * j]; } }
        }
        if (e + 1 < args.ph_hi) { MK_GRID_BAR(); }
    }
}
}
extern "C" void kernel_launch(void* const* d_in, const int* in_sizes, int n_in, void* d_out, int out_size, void* d_ws, size_t ws_size, hipStream_t stream) {
    static int grid = 0;
    if (grid == 0) {
        int dev = 0, cus = 0, per_cu = 0;
        if (hipGetDevice(&dev) != hipSuccess || hipDeviceGetAttribute(&cus, hipDeviceAttributeMultiprocessorCount, dev) != hipSuccess) { grid = -1; return; }
        if (hipFuncSetAttribute((const void*)mk::mega_k, hipFuncAttributeMaxDynamicSharedMemorySize, mk::LDS_BYTES) != hipSuccess) { grid = -1; return; }
        if (hipOccupancyMaxActiveBlocksPerMultiprocessor(&per_cu, (const void*)mk::mega_k, mk::NWAVES * 64, mk::LDS_BYTES) != hipSuccess || per_cu < 1) { fprintf(stderr, "kernel_launch: occupancy query says %d blocks per CU\n", per_cu); grid = -1; (void)hipGetLastError(); return; }
        (void)hipGetLastError();
        grid = cus;
        if (n_in != 22 || ws_size < mk::WS_END || cus != 256 || in_sizes[0] != mk::M * mk::D || out_size != mk::M * mk::D) { fprintf(stderr, "kernel_launch: unexpected n_in %d / ws_size %zu / CUs %d\n", n_in, ws_size, cus); grid = -1; }
    }
    if (grid < 0) return;
    (void)hipMemsetAsync((char*)d_ws + mk::WS_CTL, 0, mk::CTL_ZERO_BYTES, stream);
    mk::Args a{};
    for (int i = 0; i < 22; ++i) a.in[i] = (const float*)d_in[i];
    a.out = (float*)d_out; a.ws = (unsigned char*)d_ws;
#if MK_ONE_LAUNCH
    a.ph_lo = 0; a.ph_hi = mk::PH_LAST + 1;
    void* kargs[] = {&a};
    const hipError_t e = hipLaunchCooperativeKernel((const void*)mk::mega_k, dim3(grid), dim3(mk::NWAVES * 64), kargs, mk::LDS_BYTES, stream);
    if (e != hipSuccess) fprintf(stderr, "kernel_launch: cooperative launch failed: %s\n", hipGetErrorString(e));
#else
    for (int ph = 0; ph <= mk::PH_LAST; ++ph) { a.ph_lo = ph; a.ph_hi = ph + 1; hipLaunchKernelGGL(mk::mega_k, dim3(grid), dim3(mk::NWAVES * 64), mk::LDS_BYTES, stream, a);
    }
#endif
}
```

```cpp
#include <hip/hip_runtime.h>
#include <hip/hip_cooperative_groups.h>
#include <cstdio>
#include <cstdint>
#include <cmath>
#define MK_BAR_SETUP() cooperative_groups::grid_group mk_grid = cooperative_groups::this_grid(); bool mk_first = true; \
    XcdBarrier mk_bar = xcd_barrier_post((unsigned*)(args.ws + WS_CTL) + CW_BAR, (volatile LAS unsigned*)(lds + MISC_OFF) + 8)
#define MK_GRID_BAR() do { if (mk_first) { mk_grid.sync(); mk_first = false; } else xcd_barrier(mk_bar); } while (0)
#define MK_ONE_LAUNCH 1
#define MK_NO_NAIVE 1
#define MK_THRL 24
#define MK_UP_DUMMY 0
#define MK_QKV_NOGATES 0
#define MK_DEFER_WEIGHTS 1
#define MK_SKIP_QK 2.0f
#ifndef MK_PREPASS_REPS
#define MK_PREPASS_REPS 1
#endif
#ifndef MK_TOUCH
#define MK_TOUCH 0
#endif
#ifndef MK_WGM
#define MK_WGM 8
#endif
#ifndef MK_ALIGN_UP
#define MK_ALIGN_UP true
#endif
#ifndef MK_S5TAB_REPS
#define MK_S5TAB_REPS 1
#endif
#ifndef MK_G1_NATURAL
#define MK_G1_NATURAL 0
#endif
namespace pg8 {
#define PG8_LAS __attribute__((address_space(3)))
typedef unsigned short bf16_t;
typedef short bf16x8 __attribute__((ext_vector_type(8)));
typedef float f32x4 __attribute__((ext_vector_type(4)));
typedef float f32x2 __attribute__((ext_vector_type(2)));
typedef unsigned u32x4 __attribute__((ext_vector_type(4)));
typedef unsigned u32x2 __attribute__((ext_vector_type(2)));
constexpr int BM = 256, BK = 64, HALF = 128, HTB = HALF * BK * 2  , STAGE_BYTES = 8 * HTB, NXCD = 8, WGM = MK_WGM;

__host__ __device__ __forceinline__ int lds_byte(int r, int c) { const int st = (r >> 4) * 2 + (c >> 5), rr = r & 15, cc = c & 31, ob = rr * 64 + cc * 2; return st * 1024 + (ob ^ (((ob >> 9) & 1) << 5)); }
__host__ __device__ __forceinline__ void stage_rc(int b, int& R, int& C) { const int st = b / 1024, sb = b % 1024, swz = sb ^ (((sb >> 9) & 1) << 5); R = (st >> 1) * 16 + swz / 64; C = (st & 1) * 32 + (swz % 64) / 2; }
__host__ __device__ __forceinline__ int perm32(int rho) { const int n = rho >> 4, i = rho & 15; return 8 * (i >> 2) + 4 * n + (i & 3); }

struct Unit { int pm, pn; };
struct Gemm { const bf16_t* A; const bf16_t* Bt; int K; int lda, ldb; int gatherA; int a_pn_off; };

struct StaticOrder {
    int nM, nN, nwg, G, c;
    __host__ __device__ __forceinline__ void init(int nM_, int nN_, int G_, int c_) { nM = nM_; nN = nN_; nwg = nM * nN; G = G_; c = c_; }
    __host__ __device__ __forceinline__ bool next(int i, Unit& u) const {
        const long L = (long)i * G + c; if (L >= nwg) return false;
        int wgid = (int)L; { const int q = nwg / NXCD, r = nwg % NXCD, xcd = wgid % NXCD, off = wgid / NXCD; wgid = (xcd < r ? xcd * (q + 1) : r * (q + 1) + (xcd - r) * q) + off; }
        const int nig = WGM * nN, gid = wgid / nig, fm = gid * WGM, gsz = (nM - fm) < WGM ? (nM - fm) : WGM;
        u.pm = fm + ((wgid % nig) % gsz); u.pn = (wgid % nig) / gsz; return true;
    }
};

__device__ __forceinline__ unsigned cvt_pk_bf16(float lo, float hi) { unsigned r; asm volatile("v_cvt_pk_bf16_f32 %0, %1, %2" : "=v"(r) : "v"(lo), "v"(hi)); return r; }

template <class Epi, class Sched, bool ALIGN_EPI>
__device__ __forceinline__ void gemm_phase(PG8_LAS unsigned char* lds, const int tid, const Gemm g, const Sched& S, const Epi& E) {
    const int wid = __builtin_amdgcn_readfirstlane(tid >> 6), lane = tid & 63, wr = wid >> 2, wc = wid & 3, fr = lane & 15, fq = lane >> 4;
    const int K = g.K, nt = K / BK;
    unsigned voffA[2], voffB[2];
#pragma unroll
    for (int i = 0; i < 2; ++i) { int R, C; stage_rc(tid * 16 + i * 8192, R, C); const int Rb = Epi::PERM ? ((R & ~31) + perm32(R & 31)) : R;
        voffA[i] = g.gatherA ? (unsigned)(R * g.lda + (C >> 4) * g.gatherA + (C & 15)) * 2u : (unsigned)(R * g.lda + C) * 2u; voffB[i] = (unsigned)(Rb * g.ldb + C) * 2u; }
    const size_t kstepA = g.gatherA ? (size_t)g.gatherA * 8 : (size_t)(BK * 2), kstepB = (size_t)(BK * 2);
    const size_t hstepA = (size_t)HALF * g.lda * 2, hstepB = (size_t)HALF * g.ldb * 2;
    const size_t tstepA = 2 * hstepA, tstepB = 2 * hstepB;
    const unsigned ldsw = (unsigned)wid * 1024u;
    const int aoff = lds_byte(wr * 64 + fr, fq * 8), boff = lds_byte(wc * 32 + fr, fq * 8);
#define PG8_SA(b, h) (((b) * 2 + (h)) * HTB)
#define PG8_SB(b, h) ((4 + (b) * 2 + (h)) * HTB)
#define PG8_STAGE(bufoff, gbase, voff) do { _Pragma("unroll") for (int _i = 0; _i < 2; ++_i) \
        __builtin_amdgcn_global_load_lds((const unsigned*)((const char*)(gbase) + (voff)[_i]), (PG8_LAS unsigned*)(lds + (bufoff) + ldsw + _i * 8192), 16, 0, 0); } while (0)
#define PG8_LDA(dst, b, h) do { _Pragma("unroll") for (int m = 0; m < 4; ++m) _Pragma("unroll") for (int k = 0; k < 2; ++k) dst[m][k] = *(const PG8_LAS bf16x8*)(lds + PG8_SA(b, h) + aoff + m * 2048 + k * 1024); } while (0)
#define PG8_LDB(dst, b, h) do { _Pragma("unroll") for (int n = 0; n < 2; ++n) _Pragma("unroll") for (int k = 0; k < 2; ++k) dst[n][k] = *(const PG8_LAS bf16x8*)(lds + PG8_SB(b, h) + boff + n * 2048 + k * 1024); } while (0)
#define PG8_MMA(ai, bj, At, Bt) do { __builtin_amdgcn_s_setprio(1); _Pragma("unroll") for (int m = 0; m < 4; ++m) _Pragma("unroll") for (int n = 0; n < 2; ++n) _Pragma("unroll") for (int k = 0; k < 2; ++k) \
        acc[ai][bj][m][n] = __builtin_amdgcn_mfma_f32_16x16x32_bf16(Bt[n][k], At[m][k], acc[ai][bj][m][n], 0, 0, 0); __builtin_amdgcn_s_setprio(0); } while (0)
#define PG8_WAIT_V(n) asm volatile("s_waitcnt vmcnt(" #n ")" ::: "memory")
#define PG8_WAIT_L(n) asm volatile("s_waitcnt lgkmcnt(" #n ")" ::: "memory")
#define PG8_BAR __builtin_amdgcn_s_barrier()
#define PG8_SCHED __builtin_amdgcn_sched_barrier(0)
    Unit cur, nxt; int ui = 0;
    if (!S.next(0, cur)) return;
    f32x4 acc[2][2][4][2];
#pragma unroll
    for (int a = 0; a < 2; ++a)
#pragma unroll
        for (int b = 0; b < 2; ++b)
#pragma unroll
            for (int m = 0; m < 4; ++m)
#pragma unroll
                for (int n = 0; n < 2; ++n) acc[a][b][m][n] = (f32x4){0.f, 0.f, 0.f, 0.f};
    bf16x8 At[4][2], B0[2][2], B1[2][2];
    const char* cA = (const char*)g.A + (size_t)cur.pm * tstepA + (size_t)cur.pn * g.a_pn_off; const char* cB = (const char*)g.Bt + (size_t)cur.pn * tstepB;
    PG8_STAGE(PG8_SB(0, 0), cB, voffB); PG8_STAGE(PG8_SB(0, 1), cB + hstepB, voffB); PG8_STAGE(PG8_SA(0, 0), cA, voffA); PG8_STAGE(PG8_SA(0, 1), cA + hstepA, voffA);
    if (wr == 1) PG8_BAR;
    PG8_WAIT_V(2); PG8_BAR;
    PG8_STAGE(PG8_SB(1, 0), cB + kstepB, voffB); PG8_STAGE(PG8_SA(1, 0), cA + kstepA, voffA); PG8_STAGE(PG8_SB(1, 1), cB + hstepB + kstepB, voffB);
    PG8_WAIT_V(6); PG8_BAR;
    for (;;) {
        const bool has_next = S.next(ui + 1, nxt);
        const char* nA = has_next ? (const char*)g.A + (size_t)nxt.pm * tstepA + (size_t)nxt.pn * g.a_pn_off : cA; const char* nB = has_next ? (const char*)g.Bt + (size_t)nxt.pn * tstepB : cB;
        for (int t = 0; t < nt; t += 2) {
            const bool last = (t == nt - 2);
            const char* a1 = cA + (size_t)(t + 1) * kstepA;
            const char* a2 = last ? nA : cA + (size_t)(t + 2) * kstepA; const char* b2 = last ? nB : cB + (size_t)(t + 2) * kstepB;
            const char* a3 = a2 + kstepA; const char* b3 = b2 + kstepB;
            PG8_LDB(B0, 0, 0); PG8_LDB(B1, 0, 1); PG8_SCHED; PG8_LDA(At, 0, 0); PG8_STAGE(PG8_SA(1, 1), a1 + hstepA, voffA);
            PG8_WAIT_V(8); PG8_WAIT_L(0); PG8_BAR; PG8_MMA(0, 0, At, B0); PG8_MMA(0, 1, At, B1); PG8_BAR; PG8_SCHED;
            PG8_LDA(At, 0, 1); PG8_STAGE(PG8_SB(0, 0), b2, voffB); PG8_STAGE(PG8_SB(0, 1), b2 + hstepB, voffB); PG8_STAGE(PG8_SA(0, 0), a2, voffA);
            PG8_WAIT_V(8); PG8_WAIT_L(0); PG8_BAR; PG8_MMA(1, 0, At, B0); PG8_MMA(1, 1, At, B1); PG8_BAR; PG8_SCHED;
            PG8_LDB(B0, 1, 0); PG8_LDB(B1, 1, 1); PG8_SCHED; PG8_LDA(At, 1, 0); PG8_STAGE(PG8_SA(0, 1), a2 + hstepA, voffA);
            PG8_WAIT_V(8); PG8_WAIT_L(0); PG8_BAR; PG8_MMA(0, 0, At, B0); PG8_MMA(0, 1, At, B1); PG8_BAR; PG8_SCHED;
            PG8_LDA(At, 1, 1); PG8_STAGE(PG8_SB(1, 0), b3, voffB); PG8_STAGE(PG8_SB(1, 1), b3 + hstepB, voffB); PG8_STAGE(PG8_SA(1, 0), a3, voffA);
            PG8_WAIT_V(8); PG8_WAIT_L(0); PG8_BAR; PG8_MMA(1, 0, At, B0); PG8_MMA(1, 1, At, B1); PG8_BAR; PG8_SCHED;
        }
        if constexpr (ALIGN_EPI) { if (wr == 0) PG8_BAR; }
        if constexpr (!Epi::AFTER_DRAIN) { int ln_; asm volatile("v_mbcnt_lo_u32_b32 %0, -1, 0\n\tv_mbcnt_hi_u32_b32 %0, -1, %0" : "=v"(ln_)); E(acc, cur, wr, wc, ln_ & 15, ln_ >> 4); }
        if (!has_next) break;
#pragma unroll
        for (int a = 0; a < 2; ++a)
#pragma unroll
            for (int b = 0; b < 2; ++b)
#pragma unroll
                for (int m = 0; m < 4; ++m)
#pragma unroll
                    for (int n = 0; n < 2; ++n) acc[a][b][m][n] = (f32x4){0.f, 0.f, 0.f, 0.f};
        cur = nxt; cA = nA; cB = nB; ++ui;
        if constexpr (ALIGN_EPI) { if (wr == 1) PG8_BAR; }
    }
    PG8_WAIT_V(0);
    if constexpr (!ALIGN_EPI) { if (wr == 0) PG8_BAR; }
    PG8_BAR;
    if constexpr (Epi::AFTER_DRAIN) { int ln_; asm volatile("v_mbcnt_lo_u32_b32 %0, -1, 0\n\tv_mbcnt_hi_u32_b32 %0, -1, %0" : "=v"(ln_)); E.fused(acc, cur, wr, wc, ln_ & 15, ln_ >> 4, lds, wid, ln_); }
#undef PG8_SA
#undef PG8_SB
#undef PG8_STAGE
#undef PG8_LDA
#undef PG8_LDB
#undef PG8_MMA
#undef PG8_WAIT_V
#undef PG8_WAIT_L
#undef PG8_BAR
#undef PG8_SCHED
}

__device__ __forceinline__ float shx(float v, int lane, int m) { return __builtin_bit_cast(float, __builtin_amdgcn_ds_bpermute((lane ^ m) << 2, __builtin_bit_cast(int, v))); }
constexpr float RMS_EPS = 1e-6f;
typedef unsigned long long ssq_t;
constexpr float SSQ_SCALE = 1048576.0f;
__device__ __forceinline__ float rstd_row(const ssq_t* ssq, int row) { return __builtin_amdgcn_rsqf((float)ssq[row] * (1.0f / (1024.0f * SSQ_SCALE)) + RMS_EPS); }
#define PG8_GAS __attribute__((address_space(1)))
__device__ __forceinline__ void rstd8(const ssq_t* ssq, int row0, float (&rs)[2][4]) {
    ssq_t sv[2][4];
#pragma unroll
    for (int ai = 0; ai < 2; ++ai)
#pragma unroll
        for (int m = 0; m < 4; ++m) sv[ai][m] = ((const PG8_GAS ssq_t*)ssq)[row0 + ai * HALF + m * 16];
#pragma unroll
    for (int ai = 0; ai < 2; ++ai)
#pragma unroll
        for (int m = 0; m < 4; ++m) rs[ai][m] = __builtin_amdgcn_rsqf((float)sv[ai][m] * (1.0f / (1024.0f * SSQ_SCALE)) + RMS_EPS);
}
__device__ __forceinline__ float fast_sigmoid(float x) { return __builtin_amdgcn_rcpf(1.0f + __builtin_amdgcn_exp2f(-1.4426950408889634f * x)); }

struct EpiQKV {
    static constexpr bool PERM = true, AFTER_DRAIN = false;
    bf16_t* O; size_t split_stride; const ssq_t* ssq; float scale0; float* nrm;
    __device__ __forceinline__ void operator()(const f32x4 (&acc)[2][2][4][2], const Unit& u, int wr, int wc, int fr, int fq) const {
        const int row0 = u.pm * BM + wr * 64 + fr, t = u.pn >> 2; bf16_t* base = O + (size_t)t * split_stride; const float sc = (t == 0) ? scale0 : 1.f;
        const int col0 = (u.pn & 3) * BM + wc * 32 + 8 * fq, ln = fq * 16 + fr;
        float rsv[2][4]; rstd8(ssq, row0, rsv);
#pragma unroll
        for (int ai = 0; ai < 2; ++ai)
#pragma unroll
            for (int m = 0; m < 4; ++m) { const int row = row0 + ai * HALF + m * 16; const float rs = rsv[ai][m] * sc; PG8_GAS bf16_t* rowp = (PG8_GAS bf16_t*)base + (size_t)row * 1024 + col0;
#pragma unroll
                for (int bj = 0; bj < 2; ++bj) { const f32x4 v0 = acc[ai][bj][m][0] * rs, v1 = acc[ai][bj][m][1] * rs;
                    u32x4 w; w.x = cvt_pk_bf16(v0[0], v0[1]); w.y = cvt_pk_bf16(v0[2], v0[3]); w.z = cvt_pk_bf16(v1[0], v1[1]); w.w = cvt_pk_bf16(v1[2], v1[3]);
                    *(PG8_GAS u32x4*)(rowp + bj * HALF) = w;
                    if (t < 2) { float s = ((v0[0] * v0[0] + v0[1] * v0[1]) + (v0[2] * v0[2] + v0[3] * v0[3])) + ((v1[0] * v1[0] + v1[1] * v1[1]) + (v1[2] * v1[2] + v1[3] * v1[3]));
                        s += shx(s, ln, 16); s += shx(s, ln, 32);
                        if (fq == 0) ((PG8_GAS float*)nrm)[(((size_t)(t * 4 + (u.pn & 3)) * 16384 + row) * 4 + 2 * bj + (wc >> 1)) * 2 + (wc & 1)] = s; } } }
    }
};
struct EpiSwiGLU {
    static constexpr bool PERM = true, AFTER_DRAIN = false;
    bf16_t* Hh; int ldh; const ssq_t* ssq; int dummy;
    __device__ __forceinline__ void operator()(const f32x4 (&acc)[2][2][4][2], const Unit& u, int wr, int wc, int fr, int fq) const {
        const int row0 = u.pm * BM + wr * 64 + fr, col0 = u.pn * HALF + wc * 32 + 8 * fq;
        if (dummy) { if (fr == 0 && fq == 0) *(PG8_GAS float*)((PG8_GAS bf16_t*)Hh + (size_t)row0 * ldh + col0) = acc[0][0][0][0][0] + acc[1][1][3][1][3]; return; }
        float rsv[2][4]; rstd8(ssq, row0, rsv);
#pragma unroll
        for (int ai = 0; ai < 2; ++ai)
#pragma unroll
            for (int m = 0; m < 4; ++m) { const int row = row0 + ai * HALF + m * 16; const float rs = rsv[ai][m];
                float h[8];
#pragma unroll
                for (int n = 0; n < 2; ++n)
#pragma unroll
                    for (int j = 0; j < 4; j += 2) {
                        const f32x2 g2 = {acc[ai][0][m][n][j], acc[ai][0][m][n][j + 1]}, u2 = {acc[ai][1][m][n][j], acc[ai][1][m][n][j + 1]};
                        const f32x2 gs = g2 * rs, us = u2 * rs, ar = gs * (-1.4426950408889634f);
                        f32x2 e; e.x = __builtin_amdgcn_exp2f(ar.x); e.y = __builtin_amdgcn_exp2f(ar.y);
                        const f32x2 dn = e + 1.0f; f32x2 r; r.x = __builtin_amdgcn_rcpf(dn.x); r.y = __builtin_amdgcn_rcpf(dn.y);
                        const f32x2 hv = (gs * r) * us; h[n * 4 + j] = hv.x; h[n * 4 + j + 1] = hv.y; }
                u32x4 w; w.x = cvt_pk_bf16(h[0], h[1]); w.y = cvt_pk_bf16(h[2], h[3]); w.z = cvt_pk_bf16(h[4], h[5]); w.w = cvt_pk_bf16(h[6], h[7]);
                *(PG8_GAS u32x4*)((PG8_GAS bf16_t*)Hh + (size_t)row * ldh + col0) = w; }
    }
};
template <int MODE> struct EpiResid {
    static constexpr bool PERM = false, AFTER_DRAIN = false;
    const float* base; float* X; bf16_t* XB; ssq_t* ssq_out; const float* pb; const float* psc; int dummy;
    __device__ __forceinline__ void operator()(const f32x4 (&acc)[2][2][4][2], const Unit& u, int wr, int wc, int fr, int fq) const {
        if (dummy) { if (acc[0][0][0][0][0] + acc[1][1][3][1][3] == 12345.678f) ((PG8_GAS float*)pb)[0] = 1.f; return; }
        const int row0 = u.pm * BM + wr * 64 + fr;
        const int col0 = (MODE == 1 ? u.pn * HALF : u.pn * BM) + wc * 32 + 4 * fq;
        constexpr int NBJ = (MODE == 1) ? 1 : 2;
        const PG8_GAS float* gb = (const PG8_GAS float*)base + (size_t)row0 * 1024 + col0; PG8_GAS float* gx = (PG8_GAS float*)X + (size_t)row0 * 1024 + col0; PG8_GAS bf16_t* gxb = (PG8_GAS bf16_t*)XB + (size_t)row0 * 1024 + col0;
        float ss[2][4];
#pragma unroll
        for (int ai = 0; ai < 2; ++ai)
#pragma unroll
            for (int m = 0; m < 4; ++m) ss[ai][m] = 0.f;
#pragma unroll
        for (int bj = 0; bj < NBJ; ++bj)
#pragma unroll
            for (int n = 0; n < 2; ++n) { const int co = bj * HALF + n * 16;
                f32x4 bb = {0.f, 0.f, 0.f, 0.f}, sc = {1.f, 1.f, 1.f, 1.f};
                if (MODE == 2) { bb = *(const PG8_GAS f32x4*)((const PG8_GAS float*)pb + col0 + co); sc = *(const PG8_GAS f32x4*)((const PG8_GAS float*)psc + col0 + co); }
                f32x4 bs[2][4];
#pragma unroll
                for (int ai = 0; ai < 2; ++ai)
#pragma unroll
                    for (int m = 0; m < 4; ++m) bs[ai][m] = *(const PG8_GAS f32x4*)(gb + (size_t)(ai * HALF + m * 16) * 1024 + co);
#pragma unroll
                for (int ai = 0; ai < 2; ++ai)
#pragma unroll
                    for (int m = 0; m < 4; ++m) { const size_t off = (size_t)(ai * HALF + m * 16) * 1024 + co; f32x4 d;
                        if (MODE == 0) d = acc[ai][bj][m][n];
                        else if (MODE == 1) { const f32x4 v = acc[ai][0][m][n], gt = acc[ai][1][m][n]; d = (f32x4){v[0] * fast_sigmoid(gt[0]), v[1] * fast_sigmoid(gt[1]), v[2] * fast_sigmoid(gt[2]), v[3] * fast_sigmoid(gt[3])}; }
                        else d = (acc[ai][bj][m][n] + bb) * sc;
                        const f32x4 o = bs[ai][m] + d; *(PG8_GAS f32x4*)(gx + off) = o; ss[ai][m] += (o[0] * o[0] + o[1] * o[1]) + (o[2] * o[2] + o[3] * o[3]);
                        if (XB) { u32x2 w; w.x = cvt_pk_bf16(o[0], o[1]); w.y = cvt_pk_bf16(o[2], o[3]); *(PG8_GAS u32x2*)(gxb + off) = w; } }
                asm volatile("" ::: "memory"); }
        const int ln = fq * 16 + fr;
#pragma unroll
        for (int ai = 0; ai < 2; ++ai)
#pragma unroll
            for (int m = 0; m < 4; ++m) { float s = ss[ai][m]; s += shx(s, ln, 16); s += shx(s, ln, 32);
                if (fq == 0) atomicAdd(ssq_out + row0 + ai * HALF + m * 16, (ssq_t)__builtin_llrintf(s * SSQ_SCALE)); }
    }
};
struct EpiResidFinal {
    static constexpr bool PERM = false, AFTER_DRAIN = true;
    const float* base; float* out; ssq_t* ssq_out; const float* gain; unsigned* cnt;
    __device__ __forceinline__ void fused(f32x4 (&acc)[2][2][4][2], const Unit& u, int wr, int wc, int fr, int fq, PG8_LAS unsigned char* lds, int wid, int lane) const {
        const int row0 = u.pm * BM + wr * 64 + fr, col0 = u.pn * BM + wc * 32 + 4 * fq;
        const PG8_GAS float* gb = (const PG8_GAS float*)base + (size_t)row0 * 1024 + col0;
        float ss[2][4]; float chain_ = 0.f;
#pragma unroll
        for (int ai = 0; ai < 2; ++ai)
#pragma unroll
            for (int m = 0; m < 4; ++m) { int ro_ = (ai * HALF + m * 16) * 1024; asm volatile("" : "+v"(ro_) : "v"(chain_));
                const PG8_GAS float* rp = gb + ro_;
                const f32x4 b0 = *(const PG8_GAS f32x4*)(rp), b1 = *(const PG8_GAS f32x4*)(rp + 16), b2 = *(const PG8_GAS f32x4*)(rp + HALF), b3 = *(const PG8_GAS f32x4*)(rp + HALF + 16);
                const f32x4 o0 = b0 + acc[ai][0][m][0], o1 = b1 + acc[ai][0][m][1], o2 = b2 + acc[ai][1][m][0], o3 = b3 + acc[ai][1][m][1];
                ss[ai][m] = ((o0[0] * o0[0] + o0[1] * o0[1]) + (o0[2] * o0[2] + o0[3] * o0[3])) + ((o1[0] * o1[0] + o1[1] * o1[1]) + (o1[2] * o1[2] + o1[3] * o1[3]))
                          + ((o2[0] * o2[0] + o2[1] * o2[1]) + (o2[2] * o2[2] + o2[3] * o2[3])) + ((o3[0] * o3[0] + o3[1] * o3[1]) + (o3[2] * o3[2] + o3[3] * o3[3]));
                chain_ = ss[ai][m]; }
        const int ln = fq * 16 + fr;
#pragma unroll
        for (int ai = 0; ai < 2; ++ai)
#pragma unroll
            for (int m = 0; m < 4; ++m) { float s = ss[ai][m]; s += shx(s, ln, 16); s += shx(s, ln, 32);
                if (fq == 0) atomicAdd(ssq_out + row0 + ai * HALF + m * 16, (ssq_t)__builtin_llrintf(s * SSQ_SCALE)); }
        asm volatile("s_waitcnt vmcnt(0)" ::: "memory"); __builtin_amdgcn_s_barrier(); asm volatile("" ::: "memory");
        if (wid == 0) {
            unsigned* c = cnt + 64 * u.pm;
            if (lane == 0) __hip_atomic_fetch_add(c, 1u, __ATOMIC_RELAXED, __HIP_MEMORY_SCOPE_AGENT);
            unsigned spins = 0;
            while ((unsigned)__builtin_amdgcn_readfirstlane(__hip_atomic_load(c, __ATOMIC_RELAXED, __HIP_MEMORY_SCOPE_AGENT)) < 4u && ++spins < (1u << 22)) __builtin_amdgcn_s_sleep(2);
        }
        __builtin_amdgcn_s_barrier(); asm volatile("" ::: "memory");
        int l2_; asm volatile("v_mbcnt_lo_u32_b32 %0, -1, 0\n\tv_mbcnt_hi_u32_b32 %0, -1, %0" : "=v"(l2_));
        const int row0b = u.pm * BM + wr * 64 + (l2_ & 15), col0b = u.pn * BM + wc * 32 + 4 * (l2_ >> 4);
        const PG8_GAS float* gb2 = (const PG8_GAS float*)base + (size_t)row0b * 1024 + col0b; PG8_GAS float* go = (PG8_GAS float*)out + (size_t)row0b * 1024 + col0b;
        float rs[2][4];
#pragma unroll
        for (int ai = 0; ai < 2; ++ai)
#pragma unroll
            for (int m = 0; m < 4; ++m) rs[ai][m] = __builtin_amdgcn_rsqf((float)__hip_atomic_load(ssq_out + row0b + ai * HALF + m * 16, __ATOMIC_RELAXED, __HIP_MEMORY_SCOPE_AGENT) * (1.0f / (1024.0f * SSQ_SCALE)) + RMS_EPS);
#pragma unroll
        for (int bj = 0; bj < 2; ++bj)
#pragma unroll
            for (int n = 0; n < 2; ++n) { int co = bj * HALF + n * 16; asm volatile("" : "+v"(co) : "v"(chain_)); const f32x4 gg = *(const PG8_GAS f32x4*)((const PG8_GAS float*)gain + col0b + co); f32x4 bs[2][4];
#pragma unroll
                for (int ai = 0; ai < 2; ++ai)
#pragma unroll
                    for (int m = 0; m < 4; ++m) bs[ai][m] = *(const PG8_GAS f32x4*)(gb2 + (size_t)(ai * HALF + m * 16) * 1024 + co);
#pragma unroll
                for (int ai = 0; ai < 2; ++ai)
#pragma unroll
                    for (int m = 0; m < 4; ++m) { const f32x4 ov = (bs[ai][m] + acc[ai][bj][m][n]) * rs[ai][m] * gg; *(PG8_GAS f32x4*)(go + (size_t)(ai * HALF + m * 16) * 1024 + co) = ov; chain_ = ov[0]; }
                asm volatile("" ::: "memory"); }
    }
};
struct EpiU {
    static constexpr bool PERM = true, AFTER_DRAIN = false;
    bf16_t* UX; const ssq_t* ssq;
    __device__ __forceinline__ void operator()(const f32x4 (&acc)[2][2][4][2], const Unit& u, int wr, int wc, int fr, int fq) const {
        const int row0 = u.pm * BM + wr * 64 + fr, col0 = u.pn * BM + wc * 32 + 8 * fq;
        float rsv[2][4]; rstd8(ssq, row0, rsv);
#pragma unroll
        for (int ai = 0; ai < 2; ++ai)
#pragma unroll
            for (int m = 0; m < 4; ++m) { const int row = row0 + ai * HALF + m * 16; const float rs = rsv[ai][m];
#pragma unroll
                for (int bj = 0; bj < 2; ++bj) { const int col = col0 + bj * HALF; const f32x4 v0 = acc[ai][bj][m][0] * rs, v1 = acc[ai][bj][m][1] * rs;
                    u32x4 w; w.x = cvt_pk_bf16(v0[0], v0[1]); w.y = cvt_pk_bf16(v0[2], v0[3]); w.z = cvt_pk_bf16(v1[0], v1[1]); w.w = cvt_pk_bf16(v1[2], v1[3]);
                    *(PG8_GAS u32x4*)((PG8_GAS bf16_t*)UX + ((size_t)(col >> 4) * 1024 + (row >> 4)) * 384 + (row & 15) * 16 + (col & 15)) = w; } }
    }
};
struct EpiSloc {
    static constexpr bool PERM = false, AFTER_DRAIN = true;
    const float* lamc; bf16_t* UX; PG8_LAS unsigned char* esc;
    __device__ __forceinline__ void fused(f32x4 (&acc)[2][2][4][2], const Unit& u, int wr, int wc, int fr, int fq, PG8_LAS unsigned char* lds, int wid, int lane) const {
        PG8_LAS float* SL = (PG8_LAS float*)lds;
#pragma unroll
        for (int ai = 0; ai < 2; ++ai)
#pragma unroll
            for (int m = 0; m < 4; ++m)
#pragma unroll
                for (int n = 0; n < 2; ++n) *(PG8_LAS f32x4*)(SL + (ai * HALF + wr * 64 + m * 16 + fr) * 128 + wc * 32 + n * 16 + 4 * fq) = acc[ai][0][m][n];
        asm volatile("s_waitcnt lgkmcnt(0)" ::: "memory"); __builtin_amdgcn_s_barrier(); asm volatile("" ::: "memory");
        const int g = u.pn, b = u.pm, seg = wid, p = lane;
        const float lr = lamc[(g * 64 + p) * 2], li = lamc[(g * 64 + p) * 2 + 1];
        float sr = 0.f, si = 0.f;
        for (int c = seg * 32; c < seg * 32 + 32; ++c) { const float xr = SL[c * 128 + p], xi = SL[c * 128 + 64 + p]; const float nr = lr * sr - li * si + xr, ni = lr * si + li * sr + xi; sr = nr; si = ni; }
        PG8_LAS float* E = (PG8_LAS float*)esc;
        E[(seg * 64 + p) * 2] = sr; E[(seg * 64 + p) * 2 + 1] = si;
        asm volatile("s_waitcnt lgkmcnt(0)" ::: "memory"); __builtin_amdgcn_s_barrier(); asm volatile("" ::: "memory");
        float l32r = lr, l32i = li;
#pragma unroll
        for (int q = 0; q < 5; ++q) { const float t = l32r * l32r - l32i * l32i; l32i = 2.f * l32r * l32i; l32r = t; }
        sr = 0.f; si = 0.f;
        for (int j = 0; j < seg; ++j) { const float er = E[(j * 64 + p) * 2], ei = E[(j * 64 + p) * 2 + 1]; const float nr = l32r * sr - l32i * si + er, ni = l32r * si + l32i * sr + ei; sr = nr; si = ni; }
        bf16_t* dst = UX + ((size_t)g * 1024 + b * 256 + seg * 32) * 384 + 256 + p;
        for (int c = seg * 32; c < seg * 32 + 32; ++c) {
            { unsigned ur = __builtin_bit_cast(unsigned, sr), ui = __builtin_bit_cast(unsigned, si); ur = (ur + 0x7fffu + ((ur >> 16) & 1u)) >> 16; ui = (ui + 0x7fffu + ((ui >> 16) & 1u)) >> 16;
              dst[0] = (bf16_t)ur; dst[64] = (bf16_t)ui; }
            const float xr = SL[c * 128 + p], xi = SL[c * 128 + 64 + p]; const float nr = lr * sr - li * si + xr, ni = lr * si + li * sr + xi; sr = nr; si = ni;
            dst += 384; }
        asm volatile("s_waitcnt vmcnt(0) lgkmcnt(0)" ::: "memory"); __builtin_amdgcn_s_barrier(); asm volatile("" ::: "memory");
        if (wid == 0) { __builtin_amdgcn_fence(__ATOMIC_ACQUIRE, "agent"); asm volatile("s_waitcnt vmcnt(0)" ::: "memory"); }
        __builtin_amdgcn_s_barrier(); asm volatile("" ::: "memory");
    }
};
struct EpiY {
    static constexpr bool PERM = true, AFTER_DRAIN = false;
    const bf16_t* UX; const float* dvec; bf16_t* G1;
    __device__ __forceinline__ void operator()(const f32x4 (&acc)[2][2][4][2], const Unit& u, int wr, int wc, int fr, int fq) const {
        const int g = u.pn, b = u.pm, ch0 = g * 16 + 8 * (fq & 1);
        const f32x4 d0 = *(const f32x4*)(dvec + ch0), d1 = *(const f32x4*)(dvec + ch0 + 4);
#pragma unroll
        for (int ai = 0; ai < 2; ++ai) {
            u32x4 uwv[4][2];
#pragma unroll
            for (int m = 0; m < 4; ++m)
#pragma unroll
                for (int bj = 0; bj < 2; ++bj) uwv[m][bj] = *(const PG8_GAS u32x4*)((const PG8_GAS bf16_t*)UX + ((size_t)g * 1024 + b * 256 + (ai * HALF + wr * 64 + m * 16 + fr)) * 384 + (8 * bj + 2 * wc + (fq >> 1)) * 16 + 8 * (fq & 1));
#pragma unroll
            for (int m = 0; m < 4; ++m) { const int R = ai * HALF + wr * 64 + m * 16 + fr;
#pragma unroll
                for (int bj = 0; bj < 2; ++bj) { const int i = 8 * bj + 2 * wc + (fq >> 1);
                    const u32x4 uw = uwv[m][bj];
                    float y[8];
#pragma unroll
                    for (int j = 0; j < 4; ++j) { y[j] = acc[ai][bj][m][0][j] + d0[j] * __builtin_bit_cast(float, (j & 1) ? (uw[j >> 1] & 0xffff0000u) : (uw[j >> 1] << 16));
                                                  y[4 + j] = acc[ai][bj][m][1][j] + d1[j] * __builtin_bit_cast(float, (j & 1) ? (uw[2 + (j >> 1)] & 0xffff0000u) : (uw[2 + (j >> 1)] << 16)); }
#pragma unroll
                    for (int j = 0; j < 8; ++j) { const float z = 0.7978845608028654f * (y[j] + 0.044715f * y[j] * y[j] * y[j]); y[j] = y[j] * fast_sigmoid(2.f * z); }
                    u32x4 w; w.x = cvt_pk_bf16(y[0], y[1]); w.y = cvt_pk_bf16(y[2], y[3]); w.z = cvt_pk_bf16(y[4], y[5]); w.w = cvt_pk_bf16(y[6], y[7]);
                    *(PG8_GAS u32x4*)((PG8_GAS bf16_t*)G1 + (MK_G1_NATURAL ? ((size_t)(b * 4096 + 16 * R + i) * 1024 + g * 16 + 8 * (fq & 1)) : (((size_t)g * 16384 + b * 4096 + 16 * R + i) * 16 + 8 * (fq & 1)))) = w; } }
            asm volatile("" ::: "memory"); }
    }
};
}
#include <hip/hip_bf16.h>
#include <cmath>
namespace attn_body {
using bf16=__hip_bfloat16;
using bf16x8=__attribute__((ext_vector_type(8)))short;
using s16x4=__attribute__((ext_vector_type(4)))short;
using f32x16=__attribute__((ext_vector_type(16)))float;
using u32x4=__attribute__((ext_vector_type(4)))unsigned;
constexpr int BATCH=4,NHEAD=16,SEQ=4096,D=64,DM=NHEAD*D;
constexpr int NW=8,QBLK=32,QB=QBLK*NW,KVBLK=64,NQB=SEQ/QB;
constexpr int ATTN_PITCH=DM, ATTN_UNIT_ROWS=QB;
__device__ __forceinline__ int crow(int r,int hi){return (r&3)+8*(r>>2)+4*hi;}
#define SBAR() __builtin_amdgcn_sched_barrier(0)
__device__ __forceinline__ void cmask(f32x16&p0,f32x16&p1,int jb,int qrel,int hi){
  const float NEG=-INFINITY; int kb=64*jb+4*hi;
  #pragma unroll
  for(int r=0;r<16;++r){int kv=kb+(r&3)+8*(r>>2); if(kv>qrel)p0[r]=NEG; if(kv+32>qrel)p1[r]=NEG;}
}

constexpr int NSLOT=3, SLOTB=8192;
constexpr int LDS_K=0, LDS_V=NSLOT*SLOTB, LDS_WS=2*NSLOT*SLOTB, LDS_OST=LDS_WS+NW*64*4, LDS_BYTES=LDS_OST+NW*4096;
constexpr float C2=0.125f*1.4426950408889634f;
__device__ __forceinline__ void glds16(const void*gsrc,unsigned lds_dst){unsigned keep;
  asm volatile("s_mov_b32 %0, m0\n\ts_mov_b32 m0, %2\n\ts_nop 0\n\tglobal_load_lds_dwordx4 %1, off\n\ts_mov_b32 m0, %0":"=&s"(keep):"v"(gsrc),"s"(lds_dst):"memory");}
__device__ __forceinline__ float max3f(float a,float b,float c){float r;asm("v_max3_f32 %0, %1, %2, %3":"=v"(r):"v"(a),"v"(b),"v"(c));return r;}
__device__ __forceinline__ float max2f(float a,float b){float r;asm("v_max_f32_e32 %0, %1, %2":"=v"(r):"v"(a),"v"(b));return r;}
__device__ __forceinline__ float fadd_s(float a,float b){float r;asm("v_add_f32_e32 %0, %1, %2":"=v"(r):"v"(a),"v"(b));return r;}
__device__ __forceinline__ float fsub_s(float a,float b){float r;asm("v_sub_f32_e32 %0, %1, %2":"=v"(r):"v"(a),"v"(b));return r;}
typedef float f32x2_t __attribute__((ext_vector_type(2))); typedef __bf16 bf16x2_t __attribute__((ext_vector_type(2)));
__device__ __forceinline__ unsigned cvtpk_s(float lo,float hi){f32x2_t v={lo,hi};bf16x2_t b=__builtin_convertvector(v,bf16x2_t);return __builtin_bit_cast(unsigned,b);}
#define WAIT_BAR(N) asm volatile("s_waitcnt vmcnt(" #N ") lgkmcnt(0)\n\ts_barrier":::"memory")

__device__ __forceinline__ void qkt(f32x16&p0,f32x16&p1,const char*Kslot,const bf16x8*qr,int r32,int hi){
  const char*kb=Kslot+hi*1024+r32*16;
  #pragma unroll
  for(int d0=0;d0<4;++d0){
    const bf16x8 b0=*reinterpret_cast<const bf16x8*>(kb+d0*2048);
    const bf16x8 b1=*reinterpret_cast<const bf16x8*>(kb+d0*2048+512);
    {p0=__builtin_amdgcn_mfma_f32_32x32x16_bf16(b0,qr[d0],p0,0,0,0);p1=__builtin_amdgcn_mfma_f32_32x32x16_bf16(b1,qr[d0],p1,0,0,0);}}
}
typedef __attribute__((address_space(3))) const char* lds_cptr;
typedef short v4i16_t __attribute__((ext_vector_type(4)));
__device__ __forceinline__ void kload8(bf16x8*kf,lds_cptr kp){
  kf[0]=*(const __attribute__((address_space(3))) bf16x8*)(kp);      kf[1]=*(const __attribute__((address_space(3))) bf16x8*)(kp+512);
  kf[2]=*(const __attribute__((address_space(3))) bf16x8*)(kp+2048); kf[3]=*(const __attribute__((address_space(3))) bf16x8*)(kp+2560);
  kf[4]=*(const __attribute__((address_space(3))) bf16x8*)(kp+4096); kf[5]=*(const __attribute__((address_space(3))) bf16x8*)(kp+4608);
  kf[6]=*(const __attribute__((address_space(3))) bf16x8*)(kp+6144); kf[7]=*(const __attribute__((address_space(3))) bf16x8*)(kp+6656);
}
__device__ __forceinline__ void kload2(bf16x8*kf,lds_cptr kp,int j){ kf[2*j]=*(const __attribute__((address_space(3))) bf16x8*)(kp+j*2048); kf[2*j+1]=*(const __attribute__((address_space(3))) bf16x8*)(kp+j*2048+512); }
__device__ __forceinline__ s16x4 vtr(lds_cptr p){ return __builtin_bit_cast(s16x4,__builtin_amdgcn_ds_read_tr16_b64_v4i16((__attribute__((address_space(3))) v4i16_t*)p)); }
__device__ __forceinline__ float rowmax(const f32x16&p0,const f32x16&p1){
  float a=max3f(p0[0],p0[1],p1[0]),b=max3f(p0[2],p0[3],p1[1]);a=max3f(a,p1[2],p1[3]);
  #pragma unroll
  for(int r=4;r<16;r+=4){a=max3f(a,p0[r],p0[r+1]);b=max3f(b,p0[r+2],p0[r+3]);a=max3f(a,p1[r],p1[r+1]);b=max3f(b,p1[r+2],p1[r+3]);}
  const float m=max2f(a,b);
  auto rr=__builtin_amdgcn_permlane32_swap(__float_as_uint(m),__float_as_uint(m),false,false);
  return max2f(__uint_as_float(rr[0]),__uint_as_float(rr[1]));
}
__device__ __forceinline__ void pv(f32x16*o,int vb,bf16x8 pa0,bf16x8 pa1,bf16x8 pa2,bf16x8 pa3){
  #pragma unroll
  for(int d0=0;d0<2;++d0){s16x4 lo[4],hi[4];
    #pragma unroll
    for(int ks=0;ks<4;++ks){
      asm volatile("ds_read_b64_tr_b16 %0,%1 offset:%c2":"=&v"(lo[ks]):"v"(vb),"i"(d0*4096+ks*1024):"memory");
      asm volatile("ds_read_b64_tr_b16 %0,%1 offset:%c2":"=&v"(hi[ks]):"v"(vb),"i"(d0*4096+ks*1024+512):"memory");}
    asm volatile("s_waitcnt lgkmcnt(0)":::"memory");SBAR();
    #define PK(k) (bf16x8){lo[k][0],lo[k][1],lo[k][2],lo[k][3],hi[k][0],hi[k][1],hi[k][2],hi[k][3]}
    o[d0]=__builtin_amdgcn_mfma_f32_32x32x16_bf16(pa0,PK(0),o[d0],0,0,0);
    o[d0]=__builtin_amdgcn_mfma_f32_32x32x16_bf16(pa1,PK(1),o[d0],0,0,0);
    o[d0]=__builtin_amdgcn_mfma_f32_32x32x16_bf16(pa2,PK(2),o[d0],0,0,0);
    o[d0]=__builtin_amdgcn_mfma_f32_32x32x16_bf16(pa3,PK(3),o[d0],0,0,0);
    #undef PK
  }
}

#ifndef ATTN_STORE16
#define ATTN_STORE16(p,v) (*(u32x4*)(p)=(v))
#endif
typedef float f32x4b __attribute__((ext_vector_type(4)));
template<int THRL> __device__ __forceinline__ void attn_unit(int b,int h,int qb,const bf16*Q,const bf16*__restrict__ K,const bf16*__restrict__ V,bf16*O,char*shm,const __attribute__((address_space(3))) float*bl0,const int tid_,const int tskip){
  const __attribute__((address_space(3))) float*bl=bl0+tskip*64;
  const int tid=tid_,lane=tid&63,r32=lane&31,hi=lane>>5; const int wid=__builtin_amdgcn_readfirstlane(tid>>6);
  const long rowbase=(long)b*SEQ; const int q0=qb*QB;
  const bf16*Qw=Q+(rowbase+q0+wid*QBLK)*DM+h*D;
  const bf16*Kh=K+(rowbase+(long)tskip*KVBLK)*DM+h*D,*Vh=V+(rowbase+(long)tskip*KVBLK)*DM+h*D;
  const unsigned lds0=(unsigned)(uintptr_t)shm;
  float*wsf=(float*)(shm+LDS_WS)+wid*64;
  const bf16*ksrc=Kh+(long)lane*DM+wid*8;
  const bf16*vsrc=Vh+(long)(16*(wid&3)+(lane>>2))*DM+(wid>>2)*32+(lane&3)*8;
  const unsigned kdst=lds0+LDS_K+wid*1024, vdst=lds0+LDS_V+wid*1024;
  #define DMA_K(t,slot) glds16(ksrc+(long)(t)*KVBLK*DM,(unsigned)__builtin_amdgcn_readfirstlane(kdst+(slot)))
  #define DMA_V(t,slot) glds16(vsrc+(long)(t)*KVBLK*DM,(unsigned)__builtin_amdgcn_readfirstlane(vdst+(slot)))
  const int vb0=(int)(lds0+LDS_V)+((lane>>4)&1)*32+(lane&3)*8+(4*hi+((lane&15)>>2))*64;
  const char*Kbase=shm+LDS_K; bf16x8 kf[8];
  const lds_cptr shm3=(lds_cptr)shm; const lds_cptr kp0=shm3+LDS_K+hi*1024+r32*16; const lds_cptr vp0=shm3+LDS_V+((lane>>4)&1)*32+(lane&3)*8+(4*hi+((lane&15)>>2))*64;
  const int NT=(q0+QB)/KVBLK-tskip;
  DMA_K(0,0);DMA_V(0,0);DMA_K(1,SLOTB);
  bf16x8 qr[4];
  #pragma unroll
  for(int d0=0;d0<4;++d0)qr[d0]=*reinterpret_cast<const bf16x8*>(&Qw[(long)r32*DM+d0*16+hi*8]);
  float mhat=0.f,l_reg=0.f;f32x16 o[2];o[0]=f32x16{};o[1]=f32x16{};
  const int qrel=wid*QBLK+r32;
  #define CMASK(P0,P1,t) do{int jb_=(t)-(NT-4); if(jb_>=0)cmask(P0,P1,jb_,qrel,hi);}while(0)
  #define BIASLD(P0,P1,t) do{ const __attribute__((address_space(3))) f32x4b*bp_=(const __attribute__((address_space(3))) f32x4b*)(bl+(t)*64+hi*4); \
    _Pragma("unroll") for(int g_=0;g_<4;++g_){ const f32x4b b0_=bp_[2*g_],b1_=bp_[8+2*g_]; \
      P0[4*g_]=b0_[0];P0[4*g_+1]=b0_[1];P0[4*g_+2]=b0_[2];P0[4*g_+3]=b0_[3]; P1[4*g_]=b1_[0];P1[4*g_+1]=b1_[1];P1[4*g_+2]=b1_[2];P1[4*g_+3]=b1_[3]; } }while(0)
  bool resc=false;
  #define START(P0,P1) do{ const float rm=rowmax(P0,P1); resc=false; \
    { const float dl=rm; mhat=fadd_s(mhat,dl); \
      _Pragma("unroll") for(int r=0;r<16;++r){P0[r]=fsub_s(P0[r],dl);P1[r]=fsub_s(P1[r],dl);} } \
    _Pragma("unroll") for(int r=0;r<16;++r)P0[r]=__builtin_amdgcn_exp2f(P0[r]); }while(0)
  #define RESC() do{ if(resc){ asm volatile("s_waitcnt lgkmcnt(0)":::"memory"); \
      _Pragma("unroll") for(int d_=0;d_<2;++d_) _Pragma("unroll") for(int r=0;r<16;++r)o[d_][r]*=wsf[crow(r,hi)]; } }while(0)
  f32x16 pA0,pA1,pB0,pB1;
  int sl_prev=0,sl_cur=0,sl_next=SLOTB;
  #define ROT() do{sl_prev=sl_cur;sl_cur=sl_next;sl_next=(sl_next==(NSLOT-1)*SLOTB)?0:sl_next+SLOTB;}while(0)
  DMA_K(2,2*SLOTB);
  WAIT_BAR(3);
  BIASLD(pA0,pA1,0);qkt(pA0,pA1,Kbase,qr,r32,hi);asm volatile("s_nop 15\n\ts_nop 7":"+v"(pA0),"+v"(pA1));CMASK(pA0,pA1,0);
  START(pA0,pA1);
  _Pragma("unroll") for(int r=0;r<16;++r)pA1[r]=__builtin_amdgcn_exp2f(pA1[r]);
  WAIT_BAR(0);
  DMA_K(3,0);DMA_V(1,SLOTB);
  ROT();
  kload8(kf,kp0+sl_cur);
  WAIT_BAR(2);
  s16x4 vlo[8],vhi[8]; u32x4 pw0,pw1,pw2,pw3;
  #define PKW(P,B) cvtpk_s(P[B],P[B+1])
  #define PAF(k) __builtin_bit_cast(bf16x8,pw##k)
  #define VFR(i) (bf16x8){vlo[i][0],vlo[i][1],vlo[i][2],vlo[i][3],vhi[i][0],vhi[i][1],vhi[i][2],vhi[i][3]}
  #define PIN(x) asm volatile("":"+v"(x))
  #define MX3(a,b,c) __builtin_fmaxf(__builtin_fmaxf((a),(b)),(c))
  #define GAPA(MF,A0,A1,A2,A3,W0,W1,PW) do{ MF; sacc+=A0; sacc+=A1; sacc+=A2; sacc+=A3; PIN(sacc); W0; W1; PIN(PW); SBAR(); }while(0)
  #define EX(v) __builtin_amdgcn_exp2f(v)
  #define GAPB(MF,X,B) do{ MF; X[B]=EX(X[B]-mhat); X[B+1]=EX(X[B+1]-mhat); X[B+2]=EX(X[B+2]-mhat); X[B+3]=EX(X[B+3]-mhat); PIN(X); SBAR(); }while(0)
  #define VRD(i) do{ vlo[i]=vtr(vp_+(((i)>>2)*4096+((i)&3)*1024)); vhi[i]=vtr(vp_+(((i)>>2)*4096+((i)&3)*1024+512)); }while(0)
  #define KRD(G,j) do{ if(G){ kload2(kf,kp0+sl_next,j); SBAR(); } }while(0)
  #define STEP(C0,C1,P0,P1,t,GK,GV,GL) do{ SBAR(); BIASLD(C0,C1,t); SBAR(); \
    const lds_cptr vp_=vp0+sl_prev; \
    VRD(0); SBAR(); float sacc=(P0[0]+P0[1]); \
    GAPA(C0=__builtin_amdgcn_mfma_f32_32x32x16_bf16(kf[0],qr[0],C0,0,0,0), P0[2],P0[3],P0[4],P0[5],     pw0[0]=PKW(P0,0), pw0[1]=PKW(P0,2), pw0); \
    VRD(4); SBAR(); GAPA(C1=__builtin_amdgcn_mfma_f32_32x32x16_bf16(kf[1],qr[0],C1,0,0,0), P0[6],P0[7],P0[8],P0[9],     pw0[2]=PKW(P0,4), pw0[3]=PKW(P0,6), pw0); \
    VRD(1); SBAR(); GAPA(C0=__builtin_amdgcn_mfma_f32_32x32x16_bf16(kf[2],qr[1],C0,0,0,0),   P0[10],P0[11],P0[12],P0[13], pw1[0]=PKW(P0,8), pw1[1]=PKW(P0,10), pw1); \
    VRD(5); SBAR(); GAPA(C1=__builtin_amdgcn_mfma_f32_32x32x16_bf16(kf[3],qr[1],C1,0,0,0),   P0[14],P0[15],P1[0],P1[1],   pw1[2]=PKW(P0,12),pw1[3]=PKW(P0,14), pw1); \
    VRD(2); SBAR(); GAPA(C0=__builtin_amdgcn_mfma_f32_32x32x16_bf16(kf[4],qr[2],C0,0,0,0),   P1[2],P1[3],P1[4],P1[5],     pw2[0]=PKW(P1,0), pw2[1]=PKW(P1,2), pw2); \
    VRD(6); SBAR(); GAPA(C1=__builtin_amdgcn_mfma_f32_32x32x16_bf16(kf[5],qr[2],C1,0,0,0),   P1[6],P1[7],P1[8],P1[9],     pw2[2]=PKW(P1,4), pw2[3]=PKW(P1,6), pw2); \
    VRD(3); SBAR(); GAPA(C0=__builtin_amdgcn_mfma_f32_32x32x16_bf16(kf[6],qr[3],C0,0,0,0),   P1[10],P1[11],P1[12],P1[13], pw3[0]=PKW(P1,8), pw3[1]=PKW(P1,10), pw3); \
    VRD(7); SBAR(); GAPA(C1=__builtin_amdgcn_mfma_f32_32x32x16_bf16(kf[7],qr[3],C1,0,0,0),   P1[14],P1[15],0.f,0.f,       pw3[2]=PKW(P1,12),pw3[3]=PKW(P1,14), pw3); \
    l_reg+=sacc; \
    if(GK){DMA_K((t)+3,sl_cur);} if(GV){DMA_V((t)+1,sl_next);} \
    CMASK(C0,C1,t); \
    { float a=MX3(C0[0],C0[1],C1[0]),b=MX3(C0[2],C0[3],C1[1]); a=MX3(a,C1[2],C1[3]); \
      _Pragma("unroll") for(int r=4;r<16;r+=4){a=MX3(a,C0[r],C0[r+1]);b=MX3(b,C0[r+2],C0[r+3]);a=MX3(a,C1[r],C1[r+1]);b=MX3(b,C1[r+2],C1[r+3]);} \
      float rm=__builtin_fmaxf(a,b); { auto rr=__builtin_amdgcn_permlane32_swap(__float_as_uint(rm),__float_as_uint(rm),false,false); rm=__builtin_fmaxf(__uint_as_float(rr[0]),__uint_as_float(rr[1])); } \
      resc=false; const float dm_=rm-mhat; \
      if(__builtin_expect(__any(dm_>(float)THRL),0)){ const float dl=__builtin_fmaxf(dm_,0.f); mhat+=dl; \
        const float f=__builtin_amdgcn_exp2f(-dl); l_reg*=f; if(hi==0)wsf[r32]=f; resc=true; } } \
    SBAR(); \
    GAPB(o[0]=__builtin_amdgcn_mfma_f32_32x32x16_bf16(PAF(0),VFR(0),o[0],0,0,0), C0,0); \
    GAPB(o[1]=__builtin_amdgcn_mfma_f32_32x32x16_bf16(PAF(0),VFR(4),o[1],0,0,0), C0,4); \
    KRD(GL,0); GAPB(o[0]=__builtin_amdgcn_mfma_f32_32x32x16_bf16(PAF(1),VFR(1),o[0],0,0,0), C0,8); \
    KRD(GL,1); GAPB(o[1]=__builtin_amdgcn_mfma_f32_32x32x16_bf16(PAF(1),VFR(5),o[1],0,0,0), C0,12); \
    KRD(GL,2); GAPB(o[0]=__builtin_amdgcn_mfma_f32_32x32x16_bf16(PAF(2),VFR(2),o[0],0,0,0), C1,0); \
    KRD(GL,3); GAPB(o[1]=__builtin_amdgcn_mfma_f32_32x32x16_bf16(PAF(2),VFR(6),o[1],0,0,0), C1,4); \
    GAPB(o[0]=__builtin_amdgcn_mfma_f32_32x32x16_bf16(PAF(3),VFR(3),o[0],0,0,0), C1,8); \
    GAPB(o[1]=__builtin_amdgcn_mfma_f32_32x32x16_bf16(PAF(3),VFR(7),o[1],0,0,0), C1,12); \
    }while(0)
  int t=1;
  #undef CMASK
  #define CMASK(P0,P1,t) do{}while(0)
  for(;t+5<NT;t+=2){
    STEP(pB0,pB1,pA0,pA1,t,true,true,true);     WAIT_BAR(2); RESC(); ROT();
    STEP(pA0,pA1,pB0,pB1,t+1,true,true,true);   WAIT_BAR(2); RESC(); ROT();
  }
  #undef CMASK
  #define CMASK(P0,P1,t) do{int jb_=(t)-(NT-4); if(jb_>=0)cmask(P0,P1,jb_,qrel,hi);}while(0)
  #define ENDW(tt) do{ if((tt)+3<NT){WAIT_BAR(2);} else if((tt)+2<NT){WAIT_BAR(1);} else {WAIT_BAR(0);} }while(0)
  for(;t+1<NT;t+=2){
    STEP(pB0,pB1,pA0,pA1,t,(t+3<NT),(t+1<NT),(t+1<NT));       ENDW(t);   RESC(); ROT();
    STEP(pA0,pA1,pB0,pB1,t+1,(t+4<NT),(t+2<NT),(t+2<NT));     ENDW(t+1); RESC(); ROT();
  }
  STEP(pB0,pB1,pA0,pA1,NT-1,false,false,false); RESC();
  { float sacc=pB0[0]+pB0[1]; _Pragma("unroll") for(int r=2;r<16;++r)sacc+=pB0[r]; _Pragma("unroll") for(int r=0;r<16;++r)sacc+=pB1[r]; l_reg+=sacc;
    pw0=(u32x4){PKW(pB0,0),PKW(pB0,2),PKW(pB0,4),PKW(pB0,6)};pw1=(u32x4){PKW(pB0,8),PKW(pB0,10),PKW(pB0,12),PKW(pB0,14)};pw2=(u32x4){PKW(pB1,0),PKW(pB1,2),PKW(pB1,4),PKW(pB1,6)};pw3=(u32x4){PKW(pB1,8),PKW(pB1,10),PKW(pB1,12),PKW(pB1,14)};
    SBAR(); pv(o,vb0+sl_cur,PAF(0),PAF(1),PAF(2),PAF(3)); }
  #undef PKW
  #undef PAF
  #undef VFR
  #undef PIN
  #undef MX3
  #undef GAPA
  #undef GAPB
  #undef EX
  #undef VRD
  #undef KRD
  #undef STEP
  #undef ENDW
  {auto rr=__builtin_amdgcn_permlane32_swap(__float_as_uint(l_reg),__float_as_uint(l_reg),false,false);l_reg=__uint_as_float(rr[0])+__uint_as_float(rr[1]);}
  if(hi==0)wsf[32+r32]=l_reg;asm volatile("s_waitcnt lgkmcnt(0)":::"memory");
  float rli[16];
  #pragma unroll
  for(int r=0;r<16;++r)rli[r]=__builtin_amdgcn_rcpf(wsf[32+crow(r,hi)]);
  bf16*Ow=O+(rowbase+q0+wid*QBLK)*DM+h*D;
  { bf16*stg=(bf16*)(shm+LDS_OST)+wid*2048;
    #pragma unroll
    for(int r=0;r<16;++r){const int orow=crow(r,hi);
      #pragma unroll
      for(int d0=0;d0<2;++d0)stg[orow*64+d0*32+r32]=__float2bfloat16(o[d0][r]*rli[r]);}
    asm volatile("s_waitcnt lgkmcnt(0)":::"memory");
    #pragma unroll
    for(int i=0;i<4;++i){const int row=i*8+(lane>>3),ch=lane&7; const u32x4 v=*(const u32x4*)(stg+row*64+ch*8); ATTN_STORE16(Ow+(long)row*DM+ch*8,v);} }
  asm volatile("s_waitcnt lgkmcnt(0)\n\ts_barrier":::"memory");
  #undef DMA_K
  #undef DMA_V
  #undef CMASK
  #undef BIASLD
  #undef START
  #undef RESC
  #undef ROT
}
constexpr int ATTN_LDS_BYTES=LDS_BYTES;
struct AttnTensors { const bf16* Q; const bf16* K; const bf16* V; bf16* O; };
struct AttnUnit { int bh; int qb; };
struct StaticOrder {
  int vcu;
  __device__ __forceinline__ explicit StaticOrder(int grid,int block):vcu((block%8)*(grid/8)+block/8){}
  __device__ __forceinline__ bool next(int i,AttnUnit&u)const{ if(i>=4)return false; const int s=vcu&3; u.bh=vcu>>2; u.qb=(i==0)?s:(i==1)?7-s:(i==2)?8+s:15-s; return true; }
};
template<class Sched,int THRL=8> __device__ __forceinline__ void attn_phase(char*lds,const AttnTensors&T,const Sched&S,const __attribute__((address_space(3))) float*bl,const int tid,const __attribute__((address_space(3))) int*tsk){
  AttnUnit u;
  for(int i=0;S.next(i,u);++i){ attn_unit<THRL>(u.bh/NHEAD,u.bh%NHEAD,u.qb,T.Q,T.K,T.V,T.O,lds,bl,tid,__builtin_amdgcn_readfirstlane(tsk[i])); }
}
#undef SBAR
#undef WAIT_BAR
}
namespace mk {
#define LAS __attribute__((address_space(3)))
#define XB_TMO      128
#define XB_XCNT(j)  (256  + 64 * (j))
#define XB_XSUB(j)  (1280 + 64 * (j))
#define XB_XGEN(j)  (2304 + 64 * (j))
#define XB_TOP      3328
#define XB_TOPGEN   3392
#define XCD_BAR_WORDS 3456
#define XB_SPIN_CAP (1u << 18)

__device__ __forceinline__ unsigned xb_ld(unsigned* p)              { return __hip_atomic_load(p, __ATOMIC_RELAXED, __HIP_MEMORY_SCOPE_AGENT); }
__device__ __forceinline__ unsigned xb_add(unsigned* p, unsigned v) { return __hip_atomic_fetch_add(p, v, __ATOMIC_RELAXED, __HIP_MEMORY_SCOPE_AGENT); }
__device__ __forceinline__ unsigned xb_xcc_id() { return (unsigned)__builtin_amdgcn_s_getreg((3 << 11) | 20) & 0xFu; }
#define XB_SPIN(cond, bar) do { unsigned _sp = 0; while (cond) { __builtin_amdgcn_s_sleep(1); \
    if ((++_sp & 255u) == 0u) { if (xb_ld(&(bar)[XB_TMO])) break; if (_sp > XB_SPIN_CAP) { atomicAdd(&(bar)[XB_TMO], 1u); break; } } } } while (0)

struct XcdBarrier {
    unsigned* bar; unsigned x;
    volatile LAS unsigned* st;
};

__device__ __forceinline__ XcdBarrier xcd_barrier_post(unsigned* bar, volatile LAS unsigned* st) {
    XcdBarrier b; b.bar = bar; b.x = xb_xcc_id(); b.st = st;
    if (threadIdx.x == 0) (void)xb_add(&bar[XB_XCNT(b.x)], 1u);
    return b;
}
__device__ __forceinline__ void xcd_barrier_complete(unsigned* bar, unsigned x, unsigned& nloc, unsigned& nx) {
    const unsigned G = gridDim.x * gridDim.y * gridDim.z;
    unsigned sum, cnt, mine, sp = 0u;
    for (;;) {
        sum = 0u; cnt = 0u; mine = 0u;
#pragma unroll
        for (unsigned j = 0; j < 16; ++j) { const unsigned c = xb_ld(&bar[XB_XCNT(j)]); sum += c; cnt += (c > 0u) ? 1u : 0u; mine = (j == x) ? c : mine; }
        if (sum == G) break;
        __builtin_amdgcn_s_sleep(1);
        if ((++sp & 255u) == 0u) { if (xb_ld(&bar[XB_TMO])) break; if (sp > XB_SPIN_CAP) { atomicAdd(&bar[XB_TMO], 1u); break; } }
    }
    nloc = mine > 0u ? mine : 1u; nx = cnt > 0u ? cnt : 1u;
}

__device__ __forceinline__ void xcd_barrier(const XcdBarrier& b) {
    asm volatile("s_waitcnt vmcnt(0)" ::: "memory");
    __syncthreads();
    if (threadIdx.x == 0) {
        unsigned* bar = b.bar;
        __builtin_amdgcn_s_waitcnt(0);
        unsigned nloc = b.st[0], nx = b.st[1];
        if (nloc == 0u) { xcd_barrier_complete(bar, b.x, nloc, nx); b.st[0] = nloc; b.st[1] = nx; }
        const unsigned old = xb_add(&bar[XB_XSUB(b.x)], 1u);
        const unsigned gen = old / nloc;
        if (old + 1u == (gen + 1u) * nloc) {
            __builtin_amdgcn_fence(__ATOMIC_RELEASE, "agent");
            asm volatile("s_waitcnt vmcnt(0)" ::: "memory");
            const unsigned og = xb_add(&bar[XB_TOP], 1u);
            const unsigned tg = og / nx;
            if (og + 1u == (tg + 1u) * nx) xb_add(&bar[XB_TOPGEN], 1u);
            else XB_SPIN(xb_ld(&bar[XB_TOPGEN]) == tg, bar);
            __builtin_amdgcn_fence(__ATOMIC_ACQUIRE, "agent");
            xb_add(&bar[XB_XGEN(b.x)], 1u);
            asm volatile("s_waitcnt vmcnt(0)" ::: "memory");
        } else {
            XB_SPIN(xb_ld(&bar[XB_XGEN(b.x)]) == gen, bar);
            __builtin_amdgcn_fence(__ATOMIC_ACQUIRE, "agent");
            asm volatile("s_waitcnt vmcnt(0)" ::: "memory");
        }
    }
    __syncthreads();
}

#undef LAS
}
namespace mk {
constexpr int NWAVES = 8;
constexpr int D = 1024, BATCH = 4, SEQ = 4096, M = BATCH * SEQ, DEPTH = 4, NH = 16, HD = 64, FOX_IN = 3 * D + NH, DFF = 2816;
constexpr int SG = 64, SP = 64, SC = 16;
constexpr float RMS_EPS = 1e-6f;
constexpr size_t MiB = 1u << 20;
constexpr size_t WS_CTL = 276 * MiB, CTL_ZERO_BYTES = 3 * MiB;
constexpr size_t WS_SSQ = 277 * MiB;
constexpr size_t WS_WQKV = 2 * MiB;
constexpr size_t WS_WO = 14 * MiB;
constexpr size_t WS_WS5IN = 18 * MiB;
constexpr size_t WS_WGLU = 20 * MiB;
constexpr size_t WS_BTA = 24 * MiB;
constexpr size_t WS_BTB = 32 * MiB;
constexpr size_t WS_WPOOL = 44 * MiB;
constexpr size_t WS_WF = 44 * MiB + 512 * 1024;
constexpr size_t WS_KERN = 45 * MiB;
constexpr size_t WS_LAMC = 46 * MiB;
constexpr size_t WS_LF = 47 * MiB;
constexpr size_t WS_WGU = 48 * MiB;
constexpr size_t WS_WDN = 92 * MiB;
constexpr size_t WS_XB = 114 * MiB;
constexpr size_t WS_ACT = 146 * MiB;
constexpr size_t WS_O = 244 * MiB;
constexpr size_t WS_NRM = 279 * MiB;
constexpr size_t WS_END = 283 * MiB;
constexpr int CW_TMO = 0, CW_BAR = 4096, CW_PANEL = 16384, CW_QUEUE = 24576;

constexpr int RING_OFF = 0, RING_BYTES = 131072;
constexpr int LDSCTL_OFF = RING_BYTES, MISC_OFF = LDSCTL_OFF + 320;
constexpr int LDS_BYTES = 147456;

#define GAS __attribute__((address_space(1)))
#define LAS __attribute__((address_space(3)))
typedef unsigned short bf16;
typedef unsigned v4u __attribute__((ext_vector_type(4)));
typedef float f32x4 __attribute__((ext_vector_type(4)));
typedef float f32x2 __attribute__((ext_vector_type(2)));
typedef short bf16x8 __attribute__((ext_vector_type(8)));
typedef GAS unsigned gu32;
#define RLX_AGENT __ATOMIC_RELAXED, __HIP_MEMORY_SCOPE_AGENT
#define LDS_WAIT() asm volatile("s_waitcnt lgkmcnt(0)" ::: "memory")
#define VM_WAIT() asm volatile("s_waitcnt vmcnt(0)" ::: "memory")
__device__ __forceinline__ unsigned f2bf(float f) { unsigned u = __builtin_bit_cast(unsigned, f); return (u + 0x7fffu + ((u >> 16) & 1u)) >> 16; }
__device__ __forceinline__ unsigned pk2(float lo, float hi) { return f2bf(lo) | (f2bf(hi) << 16); }
__device__ __forceinline__ float bf2f(unsigned short b) { return __builtin_bit_cast(float, (unsigned)b << 16); }
__device__ __forceinline__ float lshx(float v, int lane, int m) { return __builtin_bit_cast(float, __builtin_amdgcn_ds_bpermute((lane ^ m) << 2, __builtin_bit_cast(int, v))); }
__device__ __forceinline__ float wave_sum(float v, int lane) {
#pragma unroll
    for (int o = 1; o < 64; o <<= 1) v += lshx(v, lane, o);
    return v;
}

enum Op { OP_PROLOGUE = 0, OP_QKV, OP_ATTN, OP_WO, OP_UP, OP_DOWN, OP_S5IN, OP_SSM, OP_SSMB, OP_GLU, OP_POOLPREP, OP_POOLGEMM, OP_FINAL, OP_NORMX, OP_S5TAB };
struct PhaseEnt { int op, layer, j, sin, sout; };
#define MK_PROGRAM \
    {OP_PROLOGUE, 0, 0, 0, 0}, \
    {OP_QKV, 0, 0, 0, 0}, {OP_ATTN, 0, 0, 0, 0}, {OP_WO, 0, 0, 0, 1}, {OP_UP, 0, 0, 1, 0}, {OP_DOWN, 0, 0, 0, 2}, \
    {OP_S5IN, 1, 0, 2, 0}, {OP_SSM, 1, 0, 0, 0}, {OP_GLU, 1, 0, 0, 3}, {OP_UP, 1, 0, 3, 0}, {OP_DOWN, 1, 0, 0, 4}, \
    {OP_POOLGEMM, 2, 0, 4, 5}, {OP_UP, 2, 0, 5, 0}, {OP_DOWN, 2, 0, 0, 6}, \
    {OP_QKV, 3, 1, 6, 0}, {OP_ATTN, 3, 1, 0, 0}, {OP_WO, 3, 1, 0, 7}, {OP_UP, 3, 0, 7, 0}, {OP_DOWN, 3, 0, 0, 8}, \
    {OP_FINAL, 0, 0, 8, 0}, \
    {OP_NORMX, 0, 0, 0, 1}, {OP_NORMX, 0, 0, 0, 2}, {OP_NORMX, 0, 0, 0, 3}, {OP_NORMX, 0, 0, 0, 4}, {OP_NORMX, 0, 0, 0, 5}, {OP_NORMX, 0, 0, 0, 6}, {OP_NORMX, 0, 0, 0, 7}, {OP_NORMX, 0, 0, 0, 8}, \
    {OP_S5TAB, 0, 0, 0, 0}
constexpr int N_PROG = 29, PH_FINAL = 19, PH_LAST = 18, PH_NORMX1 = 20, PH_S5TAB = 28;
__constant__ PhaseEnt PROG[N_PROG] = { MK_PROGRAM };

struct Args { const float* in[22]; float* out; unsigned char* ws; int ph_lo, ph_hi; };

__device__ __forceinline__ void wt_load(f32x4 (&v)[8], const float* W, int ldw, int n0_src, int k0, int lane) {
    const int c4 = lane & 7, r8 = lane >> 3;
    const GAS f32x4* src = (const GAS f32x4*)(W + (size_t)(k0 + r8) * ldw + n0_src + 4 * c4);
#pragma unroll
    for (int i = 0; i < 8; ++i) v[i] = src[(size_t)i * 2 * ldw];
}
__device__ __forceinline__ void wt_store(f32x4 (&v)[8], int K, const float* gain, bf16* WT, int n0_dst, int k0, LAS float* scr, int lane) {
    const int c4 = lane & 7, r8 = lane >> 3;
    if (gain) {
#pragma unroll
        for (int i = 0; i < 8; ++i) v[i] = v[i] * gain[k0 + r8 + 8 * i]; }
#pragma unroll
    for (int i = 0; i < 8; ++i) { LAS float* d = scr + (r8 + 8 * i) * 33 + 4 * c4; d[0] = v[i].x; d[1] = v[i].y; d[2] = v[i].z; d[3] = v[i].w; }
    LDS_WAIT(); asm volatile("" ::: "memory");
    const int c = lane & 7;
#pragma unroll
    for (int j = 0; j < 4; ++j) { const int n = (lane >> 3) + 8 * j; const LAS float* s = scr + (8 * c) * 33 + n;
        v4u o; o.x = pk2(s[0 * 33], s[1 * 33]); o.y = pk2(s[2 * 33], s[3 * 33]); o.z = pk2(s[4 * 33], s[5 * 33]); o.w = pk2(s[6 * 33], s[7 * 33]);
        *(GAS v4u*)(WT + (size_t)(n0_dst + n) * K + k0 + 8 * c) = o; }
    LDS_WAIT(); asm volatile("" ::: "memory");
}
__device__ __forceinline__ void wt_item(const float* W, int ldw, int K, const float* gain, bf16* WT, int n0_dst, int n0_src, int k0, LAS float* scr, int lane) {
    f32x4 v[8]; wt_load(v, W, ldw, n0_src, k0, lane); wt_store(v, K, gain, WT, n0_dst, k0, scr, lane);
}
template <int NR> __device__ __forceinline__ void normx_rows(const float* x0, size_t xstride, bf16* o0, size_t ostride, pg8::ssq_t* ssq0, size_t sstride, int lane) {
    f32x4 v[NR][4]; float s[NR];
#pragma unroll
    for (int r = 0; r < NR; ++r) { const GAS f32x4* xr = (const GAS f32x4*)(x0 + r * xstride) + lane;
#pragma unroll
        for (int j = 0; j < 4; ++j) v[r][j] = xr[64 * j]; }
#pragma unroll
    for (int r = 0; r < NR; ++r) { s[r] = 0.f;
#pragma unroll
        for (int j = 0; j < 4; ++j) s[r] += (v[r][j].x * v[r][j].x + v[r][j].y * v[r][j].y) + (v[r][j].z * v[r][j].z + v[r][j].w * v[r][j].w);
        s[r] = wave_sum(s[r], lane); }
#pragma unroll
    for (int r = 0; r < NR; ++r) { GAS unsigned long long* o8 = (GAS unsigned long long*)(o0 + r * ostride) + lane;
#pragma unroll
        for (int j = 0; j < 4; ++j) o8[64 * j] = (unsigned long long)pk2(v[r][j].x, v[r][j].y) | ((unsigned long long)pk2(v[r][j].z, v[r][j].w) << 32);
        if (lane == 0) ssq0[r * sstride] = (pg8::ssq_t)__builtin_llrintf(s[r] * pg8::SSQ_SCALE); }
}
__device__ __forceinline__ void normx_row(const float* xrow, bf16* orow, pg8::ssq_t* ssq_slot, int lane) { normx_rows<1>(xrow, 0, orow, 0, ssq_slot, 0, lane); }
template <int W> __device__ __forceinline__ void pool_item(const float* X, const pg8::ssq_t* ssq, const f32x4 gg, bf16* PD, int row0, int t0, int c0) {
    f32x4 ring[W]; f32x4 run = {0.f, 0.f, 0.f, 0.f};
    { f32x4 xw[W]; pg8::ssq_t sw[W];
#pragma unroll
      for (int kk = 1; kk < W; ++kk) { xw[kk] = (f32x4){0.f, 0.f, 0.f, 0.f}; sw[kk] = 0;
          if (t0 - W + kk >= 0) { const int r = row0 - W + kk; xw[kk] = *(const GAS f32x4*)(X + (size_t)r * D + c0); sw[kk] = ((const GAS pg8::ssq_t*)ssq)[r]; } }
#pragma unroll
      for (int kk = 1; kk < W; ++kk) {
          const f32x4 hv = xw[kk] * __builtin_amdgcn_rsqf((float)sw[kk] * (1.0f / (1024.0f * pg8::SSQ_SCALE)) + RMS_EPS) * gg;
          ring[kk % W] = hv; run += hv; } }
    f32x4 xc[16]; pg8::ssq_t sc[16];
#pragma unroll
    for (int i = 0; i < 16; ++i) { xc[i] = *(const GAS f32x4*)(X + (size_t)(row0 + i) * D + c0); sc[i] = ((const GAS pg8::ssq_t*)ssq)[row0 + i]; }
#pragma unroll
    for (int i = 0; i < 16; ++i) { const int r = row0 + i, t = t0 + i;
        const f32x4 hv = xc[i] * __builtin_amdgcn_rsqf((float)sc[i] * (1.0f / (1024.0f * pg8::SSQ_SCALE)) + RMS_EPS) * gg;
        run += hv; ring[i % W] = hv;
        const int cnt = (t + 1 < W) ? (t + 1) : W; const f32x4 o = run * (1.0f / (float)cnt) - hv;
        *(GAS unsigned long long*)(PD + (size_t)r * D + c0) = (unsigned long long)pk2(o[0], o[1]) | ((unsigned long long)pk2(o[2], o[3]) << 32);
        run -= ring[(i + 1) % W]; }
}
__device__ __forceinline__ void touch_lines(const void* p, int bytes, int tid) {
    const GAS unsigned* q = (const GAS unsigned*)p + tid * 32; unsigned acc = 0;
    for (int o = 0; o < bytes; o += 512 * 128 * 8) {
#pragma unroll
        for (int i = 0; i < 8; ++i) acc |= q[(size_t)(o / 4) + (size_t)i * 512 * 32];
    }
    asm volatile("" :: "v"(acc));
}
struct WtDesc { const float* W; const float* gain; bf16* WT; int ldw, K, Ndst, kind, off2; };
__device__ __forceinline__ WtDesc wt_desc(const Args& args, int i) {
    unsigned char* ws = args.ws; const float* mix_g = args.in[1]; const float* ffn_g = args.in[2];
    WtDesc d;
    if (i < 2) { d.W = args.in[4] + (size_t)i * D * FOX_IN; d.gain = mix_g + (i ? 3 * D : 0); d.WT = (bf16*)(ws + WS_WQKV) + (size_t)i * 3 * D * D; d.ldw = FOX_IN; d.K = D; d.Ndst = 3 * D; d.kind = 0; d.off2 = 0; }
    else if (i < 4) { d.W = args.in[6] + (size_t)(i - 2) * D * D; d.gain = nullptr; d.WT = (bf16*)(ws + WS_WO) + (size_t)(i - 2) * D * D; d.ldw = D; d.K = D; d.Ndst = D; d.kind = 0; d.off2 = 0; }
    else if (i == 4) { d.W = args.in[7]; d.gain = mix_g + D; d.WT = (bf16*)(ws + WS_WS5IN); d.ldw = D; d.K = D; d.Ndst = D; d.kind = 0; d.off2 = 0; }
    else if (i == 5) { d.W = args.in[16]; d.gain = nullptr; d.WT = (bf16*)(ws + WS_WGLU); d.ldw = 2 * D; d.K = D; d.Ndst = 2 * D; d.kind = 1; d.off2 = D; }
    else if (i < 10) { d.W = args.in[17] + (size_t)(i - 6) * 65536; d.gain = nullptr; d.WT = (bf16*)(ws + WS_WPOOL) + (size_t)(i - 6) * 65536; d.ldw = 256; d.K = 256; d.Ndst = 256; d.kind = 0; d.off2 = 0; }
    else if (i < 14) { d.W = args.in[20] + (size_t)(i - 10) * D * 2 * DFF; d.gain = ffn_g + (i - 10) * D; d.WT = (bf16*)(ws + WS_WGU) + (size_t)(i - 10) * 2 * DFF * D; d.ldw = 2 * DFF; d.K = D; d.Ndst = 2 * DFF; d.kind = 1; d.off2 = DFF; }
    else { d.W = args.in[21] + (size_t)(i - 14) * DFF * D; d.gain = nullptr; d.WT = (bf16*)(ws + WS_WDN) + (size_t)(i - 14) * D * DFF; d.ldw = D; d.K = DFF; d.Ndst = D; d.kind = 0; d.off2 = 0; }
    return d;
}
__device__ __forceinline__ void ph_s5tables(const Args& args, LAS float* scr, LAS float* wsc, int gw, int NGW, int lane) {
    unsigned char* ws = args.ws;
    { const float* a_re = args.in[8]; const float* a_im = args.in[9]; const float* log_dt = args.in[10];
      const float* b_re = args.in[11]; const float* b_im = args.in[12]; const float* c_re = args.in[13]; const float* c_im = args.in[14];
      float* KERN = (float*)(ws + WS_KERN);
      for (int it = (gw + NGW / 2) % NGW; it < SG * 16; it += NGW) {
          const int g = it >> 4, tau = it & 15, p = lane;
          { const GAS f32x4* s0 = (const GAS f32x4*)(c_re + (size_t)g * 1024), *s1 = (const GAS f32x4*)(c_im + (size_t)g * 1024), *s2 = (const GAS f32x4*)(b_re + (size_t)g * 1024), *s3 = (const GAS f32x4*)(b_im + (size_t)g * 1024);
            f32x4 t0[4], t1[4], t2[4], t3[4];
#pragma unroll
            for (int j = 0; j < 4; ++j) { t0[j] = s0[lane + 64 * j]; t1[j] = s1[lane + 64 * j]; t2[j] = s2[lane + 64 * j]; t3[j] = s3[lane + 64 * j]; }
#pragma unroll
            for (int j = 0; j < 4; ++j) { ((LAS f32x4*)scr)[lane + 64 * j] = t0[j]; ((LAS f32x4*)scr)[256 + lane + 64 * j] = t1[j]; ((LAS f32x4*)scr)[512 + lane + 64 * j] = t2[j]; ((LAS f32x4*)scr)[768 + lane + 64 * j] = t3[j]; } }
          const double lr = a_re[g * SP + p], li = a_im[g * SP + p], dt = exp((double)log_dt[g]);
          const double er = exp(lr * dt), lbr = er * cos(li * dt), lbi = er * sin(li * dt);
          const double nr = lbr - 1.0, ni = lbi, den = lr * lr + li * li, fr = (nr * lr + ni * li) / den, fi = (ni * lr - nr * li) / den;
          const double et = exp(lr * dt * tau), ptr_ = et * cos(li * dt * tau), pti = et * sin(li * dt * tau);
          wsc[p] = (float)(ptr_ * fr - pti * fi); wsc[64 + p] = (float)(ptr_ * fi + pti * fr);
          LDS_WAIT(); asm volatile("" ::: "memory");
          const LAS float* Cr = scr, *Ci = scr + 1024, *Br = scr + 2048, *Bi = scr + 3072, *Wr_ = wsc, *Wi_ = wsc + 64;
          float acc[4] = {0.f, 0.f, 0.f, 0.f}; const int ci = lane & 15, cob = lane >> 4;
#pragma unroll 8
          for (int pp = 0; pp < SP; ++pp) {
              const float wr = Wr_[pp], wi = Wi_[pp], br = Br[pp * 16 + ci], bi = Bi[pp * 16 + ci];
#pragma unroll
              for (int q = 0; q < 4; ++q) { const int co = cob + 4 * q; const float cr = Cr[co * 64 + pp], cim = Ci[co * 64 + pp];
                  const float cwr = cr * wr - cim * wi, cwi = cr * wi + cim * wr; acc[q] += cwr * br - cwi * bi; } }
#pragma unroll
          for (int q = 0; q < 4; ++q) KERN[(size_t)it * 256 + lane + 64 * q] = acc[q];
          LDS_WAIT(); asm volatile("" ::: "memory");
      }
      bf16* BTA = (bf16*)(ws + WS_BTA);
      for (int e = gw * 64 + lane; e < SG * 128 * 16; e += NGW * 64) {
          const int g = e >> 11, n = (e >> 4) & 127, j = e & 15, p = n & 63, im = n >> 6;
          const double lr = a_re[g * SP + p], li = a_im[g * SP + p], dt = exp((double)log_dt[g]);
          const double er = exp(lr * dt), lbr = er * cos(li * dt), lbi = er * sin(li * dt);
          const double nr = lbr - 1.0, ni = lbi, den = lr * lr + li * li, fr = (nr * lr + ni * li) / den, fi = (ni * lr - nr * li) / den;
          const double tt = (double)(15 - j), et = exp(lr * dt * tt), ptr_ = et * cos(li * dt * tt), pti = et * sin(li * dt * tt);
          const float Wr = (float)(ptr_ * fr - pti * fi), Wi = (float)(ptr_ * fi + pti * fr);
          unsigned w[8];
#pragma unroll
          for (int c = 0; c < 16; c += 2) { float v[2];
#pragma unroll
              for (int q = 0; q < 2; ++q) { const float br = b_re[(g * SP + p) * SC + c + q], bi = b_im[(g * SP + p) * SC + c + q]; v[q] = im ? (Wr * bi + Wi * br) : (Wr * br - Wi * bi); }
              w[c >> 1] = pk2(v[0], v[1]); }
          v4u* dst = (v4u*)(BTA + ((size_t)g * 256 + n) * 256 + j * 16);
          dst[0] = (v4u){w[0], w[1], w[2], w[3]}; dst[1] = (v4u){w[4], w[5], w[6], w[7]};
      }
      for (int e = gw * 64 + lane; e < SG * 128 * 32; e += NGW * 64) { const int g = e >> 12, r = e & 4095; ((v4u*)(BTA + ((size_t)g * 256 + 128) * 256))[r] = (v4u){0u, 0u, 0u, 0u}; }
      bf16* BTB = (bf16*)(ws + WS_BTB);
      for (int e = gw * 64 + lane; e < SG * 16 * SP; e += NGW * 64) {
          const int g = e >> 10, i = (e >> 6) & 15, p = e & 63;
          const double lr = a_re[g * SP + p], li = a_im[g * SP + p], dt = exp((double)log_dt[g]);
          const double tt = (double)(i + 1), et = exp(lr * dt * tt); const float pr = (float)(et * cos(li * dt * tt)), pi_ = (float)(et * sin(li * dt * tt));
          float crv[16], civ[16];
#pragma unroll
          for (int co = 0; co < 16; ++co) { crv[co] = c_re[(g * SC + co) * SP + p]; civ[co] = c_im[(g * SC + co) * SP + p]; }
#pragma unroll
          for (int co = 0; co < 16; ++co) { const float cr = crv[co], cim = civ[co];
              bf16* row = BTB + ((size_t)g * 256 + i * 16 + co) * 384 + 256;
              row[p] = (bf16)f2bf(cr * pr - cim * pi_); row[64 + p] = (bf16)f2bf(-(cr * pi_ + cim * pr)); }
      }
      float* LAMC = (float*)(ws + WS_LAMC);
      for (int e = gw * 64 + lane; e < SG * SP; e += NGW * 64) {
          const double lr = a_re[e], li = a_im[e], dt = exp((double)log_dt[e >> 6]), et = exp(lr * dt * 16.0);
          LAMC[2 * e] = (float)(et * cos(li * dt * 16.0)); LAMC[2 * e + 1] = (float)(et * sin(li * dt * 16.0)); }
    }
}
__device__ __forceinline__ bool wt_one(const Args& args, LAS float* scr, unsigned mask, int it, int lane) {
    constexpr int NMAT = 18; int base = 0;
    for (int mi = 0; mi < NMAT; ++mi) { if (!((mask >> mi) & 1u)) continue;
        const WtDesc d = wt_desc(args, mi); const int n_it = (d.K / 64) * (d.Ndst / 32);
        if (it < base + n_it) { const int r = it - base, nblk = d.Ndst / 32, kb = r / nblk, nb = r % nblk, n0 = nb * 32; int ns = n0;
            if (d.kind == 1) { const int pn = n0 >> 8, j = n0 & 255; ns = (j < 128) ? (128 * pn + j) : (d.off2 + 128 * pn + (j - 128)); }
            wt_item(d.W, d.ldw, d.K, d.gain, d.WT, n0, ns, kb * 64, scr, lane); return true; }
        base += n_it; }
    return false;
}
struct WtWork { const float* gain; bf16* WT; int K, n0, k0; bool ok; };
__device__ __forceinline__ WtWork wt_fetch(const Args& args, unsigned mask, int it, f32x4 (&v)[8], int lane) {
    constexpr int NMAT = 18; int base = 0; WtWork w{}; w.ok = false;
    for (int mi = 0; mi < NMAT; ++mi) { if (!((mask >> mi) & 1u)) continue;
        const WtDesc d = wt_desc(args, mi); const int n_it = (d.K / 64) * (d.Ndst / 32);
        if (it < base + n_it) { const int r = it - base, nblk = d.Ndst / 32, kb = r / nblk, nb = r % nblk, n0 = nb * 32; int ns = n0;
            if (d.kind == 1) { const int pn = n0 >> 8, j = n0 & 255; ns = (j < 128) ? (128 * pn + j) : (d.off2 + 128 * pn + (j - 128)); }
            wt_load(v, d.W, d.ldw, ns, kb * 64, lane); w.gain = d.gain; w.WT = d.WT; w.K = d.K; w.n0 = n0; w.k0 = kb * 64; w.ok = true; return w; }
        base += n_it; }
    return w;
}
__device__ __forceinline__ void ph_weights(const Args& args, LAS float* scr, unsigned mask, int rk, int nw, int lane) {
    f32x4 va[8], vb[8];
    WtWork wa = wt_fetch(args, mask, rk, va, lane);
    for (int it = rk; wa.ok; it += 2 * nw) {
        WtWork wb = wt_fetch(args, mask, it + nw, vb, lane);
        wt_store(va, wa.K, wa.gain, wa.WT, wa.n0, wa.k0, scr, lane);
        if (!wb.ok) break;
        wa = wt_fetch(args, mask, it + 2 * nw, va, lane);
        wt_store(vb, wb.K, wb.gain, wb.WT, wb.n0, wb.k0, scr, lane);
    }
}
__device__ __forceinline__ void ph_wf(const Args& args, int j, int rk, int nw, int lane) {
    for (int e = rk * 64 + lane; e < NH * D; e += nw * 64) { const int h = e >> 10, kk = e & 1023;
        ((bf16*)(args.ws + WS_WF))[j * NH * D + e] = (bf16)f2bf(args.in[4][(size_t)j * D * FOX_IN + (size_t)kk * FOX_IN + 3 * D + h] * args.in[1][(j ? 3 * D : 0) + kk]); }
}
constexpr unsigned WMASK_PRO = (1u << 0);
constexpr unsigned WMASK_ATT = (1u << 2) | (1u << 10);
constexpr int WATT_ITEMS = 16 * 32 + 16 * 176;
constexpr unsigned WMASK_L0 = (1u << 14) | (1u << 4) | (1u << 5) | (1u << 11);
constexpr unsigned WMASK_L1 = (1u << 15) | (1u << 6) | (1u << 7) | (1u << 8) | (1u << 9) | (1u << 12);
constexpr unsigned WMASK_L2 = (1u << 16) | (1u << 1) | (1u << 3) | (1u << 13);
constexpr unsigned WMASK_L3 = (1u << 17);
__device__ __forceinline__ void ph_prologue(const Args& args, LAS unsigned char* lds, int gw, int NGW, int wave, int lane) {
    unsigned char* ws = args.ws;
    LAS float* scr = (LAS float*)(lds + RING_OFF + wave * 16384);
    ph_weights(args, scr, MK_DEFER_WEIGHTS ? WMASK_PRO : 0x3ffffu, gw, NGW, lane);
    ph_wf(args, 0, gw, NGW, lane); if (!MK_DEFER_WEIGHTS) ph_wf(args, 1, gw, NGW, lane);
    for (int rep_ = 0; rep_ < MK_S5TAB_REPS; ++rep_) ph_s5tables(args, scr, (LAS float*)(lds + LDSCTL_OFF + 8192 + wave * 512), gw, NGW, lane);
    pg8::ssq_t* ssq0 = (pg8::ssq_t*)(ws + WS_SSQ);
    for (int m = gw; m < M; m += NGW) normx_row(args.in[0] + (size_t)m * D, (bf16*)(ws + WS_XB) + (size_t)m * D, ssq0 + m, lane);
}

__global__ void __launch_bounds__(NWAVES * 64, 2) mega_k(Args args) {
    extern __shared__ __attribute__((aligned(16))) unsigned char lds_raw[];
    LAS unsigned char* lds = (LAS unsigned char*)lds_raw;
    const int vcu0 = (gridDim.x % 8 == 0) ? (blockIdx.x % 8) * (gridDim.x / 8) + blockIdx.x / 8 : blockIdx.x;
    const int vcu = vcu0, NGW = gridDim.x * NWAVES, wave0 = __builtin_amdgcn_readfirstlane(threadIdx.x >> 6);
    for (int u = threadIdx.x; u < (LDS_BYTES - LDSCTL_OFF) / 4; u += NWAVES * 64) ((LAS unsigned*)(lds + LDSCTL_OFF))[u] = 0u;
    __syncthreads();
    MK_BAR_SETUP();
    int e0 = args.ph_lo;
    if (e0 == PH_S5TAB) { const int tid = threadIdx.x, lane = tid & 63, wave = __builtin_amdgcn_readfirstlane(tid >> 6); ph_s5tables(args, (LAS float*)(lds + RING_OFF + wave * 16384), (LAS float*)(lds + LDSCTL_OFF + 8192 + wave * 512), vcu * NWAVES + wave, NGW, lane); return; }
    if (e0 == 0) {
        const int tid = threadIdx.x, lane = tid & 63, wave = __builtin_amdgcn_readfirstlane(tid >> 6);
        ph_prologue(args, lds, vcu * NWAVES + wave, NGW, wave, lane);
        e0 = 1;
        if (e0 < args.ph_hi) { MK_GRID_BAR(); }
    }
    for (int e = e0; e < args.ph_hi; ++e) {
#define MK_LANE_TID() int lane_; asm volatile("v_mbcnt_lo_u32_b32 %0, -1, 0\n\tv_mbcnt_hi_u32_b32 %0, -1, %0" : "=v"(lane_)); const int lane = lane_, tid = wave * 64 + lane, gw = vcu * NWAVES + wave; (void)tid; (void)gw; (void)lane
        const int wave = wave0;
        int G = gridDim.x, bx = blockIdx.x, vcu = vcu0; asm volatile("" : "+s"(G), "+s"(bx), "+s"(vcu));
        const int NGW = G * NWAVES;
        unsigned char* ws = args.ws; float* X = args.out; asm volatile("" : "+s"(ws), "+s"(X));
        bf16* XB = (bf16*)(ws + WS_XB); pg8::ssq_t* SSQ = (pg8::ssq_t*)(ws + WS_SSQ);
        const int op = PROG[e].op, layer = PROG[e].layer, pj = PROG[e].j, sin = PROG[e].sin, sout = PROG[e].sout;
        (void)pj;
        if (op == OP_NORMX) {
            MK_LANE_TID();
            for (int m = gw; m < M; m += NGW) normx_row(X + (size_t)m * D, XB + (size_t)m * D, SSQ + (size_t)sout * M + m, lane);
        } else if (op == OP_UP) {
            MK_LANE_TID();
            pg8::Gemm g{XB, (const bf16*)(ws + WS_WGU) + (size_t)layer * 2 * DFF * D, D, D, D, 0, 0};
            pg8::StaticOrder S; S.init(M / 256, 2 * DFF / 256, G, bx);
            pg8::EpiSwiGLU E{(bf16*)(ws + WS_ACT), DFF, SSQ + (size_t)sin * M, MK_UP_DUMMY};
            pg8::gemm_phase<pg8::EpiSwiGLU, pg8::StaticOrder, MK_ALIGN_UP>(lds + RING_OFF, tid, g, S, E);
            if (MK_DEFER_WEIGHTS && bx >= 128 && !(MK_UP_DUMMY)) {
                LAS float* scr = (LAS float*)(lds + RING_OFF + wave * 16384); const int rk = (bx - 128) * NWAVES + wave;
                ph_weights(args, scr, layer == 0 ? WMASK_L0 : layer == 1 ? WMASK_L1 : layer == 2 ? WMASK_L2 : WMASK_L3, rk, 128 * NWAVES, lane);
                if (layer == 2) ph_wf(args, 1, rk, 128 * NWAVES, lane); }
        } else if (op == OP_DOWN) {
            MK_LANE_TID();
            pg8::Gemm g{(const bf16*)(ws + WS_ACT), (const bf16*)(ws + WS_WDN) + (size_t)layer * D * DFF, DFF, DFF, DFF, 0, 0};
            pg8::StaticOrder S; S.init(M / 256, D / 256, G, bx);
            if (layer == 3 && !(MK_UP_DUMMY)) {
                pg8::EpiResidFinal E{X, X, SSQ + (size_t)sout * M, args.in[3], (unsigned*)(ws + WS_CTL) + CW_PANEL};
                pg8::gemm_phase<pg8::EpiResidFinal, pg8::StaticOrder, false>(lds + RING_OFF, tid, g, S, E);
            } else {
                pg8::EpiResid<0> E{X, X, XB, SSQ + (size_t)sout * M, args.in[18], nullptr, MK_UP_DUMMY};
                pg8::gemm_phase<pg8::EpiResid<0>, pg8::StaticOrder, true>(lds + RING_OFF, tid, g, S, E); }
        }
        else if (op == OP_QKV) {
            MK_LANE_TID();
            if (MK_TOUCH) touch_lines(XB + (size_t)(8 * (bx & 7) + ((bx >> 3) & 7)) * 256 * D, 256 * D * 2, tid);
            if (!(MK_QKV_NOGATES)) {
              const bf16* WfT = (const bf16*)(ws + WS_WF) + (size_t)pj * NH * D; const pg8::ssq_t* ssq = SSQ + (size_t)sin * M; const float* bfp = args.in[5] + pj * NH; float* LF = (float*)(ws + WS_LF);
#pragma unroll
              for (int i = 0; i < 4; ++i) { const int c = tid + 512 * i; *(LAS v4u*)(lds + (c >> 7) * 2064 + (c & 127) * 16) = ((const GAS v4u*)WfT)[c]; }
              LDS_WAIT(); __syncthreads();
              if (wave < 4) {
                const int r0 = (vcu * 4 + wave) * 16, kq = lane >> 4; const GAS bf16x8* ap = (const GAS bf16x8*)(XB + (size_t)(r0 + (lane & 15)) * D + kq * 8); const LAS unsigned char* bp = lds + (lane & 15) * 2064 + kq * 16;
                bf16x8 afr[32];
#pragma unroll
                for (int ks = 0; ks < 32; ++ks) afr[ks] = ap[ks * 4];
                f32x4 acc = {0.f, 0.f, 0.f, 0.f};
#pragma unroll
                for (int ks = 0; ks < 32; ++ks) acc = __builtin_amdgcn_mfma_f32_16x16x32_bf16(afr[ks], *(const LAS bf16x8*)(bp + ks * 64), acc, 0, 0, 0);
                const int rr = r0 + 4 * kq, hh = lane & 15; const float bb = bfp[hh]; f32x4 o;
#pragma unroll
                for (int i = 0; i < 4; ++i) { const float z = acc[i] * pg8::rstd_row(ssq, rr + i) + bb; o[i] = fminf(z, 0.f) - log1pf(expf(-fabsf(z))); }
                *(GAS f32x4*)(LF + ((size_t)(rr / SEQ) * NH + hh) * SEQ + (rr % SEQ)) = o; }
              LDS_WAIT(); __syncthreads(); }
            pg8::Gemm g{XB, (const bf16*)(ws + WS_WQKV) + (size_t)pj * 3 * D * D, D, D, D, 0, 0};
            pg8::StaticOrder S; S.init(M / 256, 3 * D / 256, G, bx);
            pg8::EpiQKV E{(bf16*)(ws + WS_ACT), (size_t)16 * MiB, SSQ + (size_t)sin * M, attn_body::C2, (float*)(ws + WS_NRM)};
            pg8::gemm_phase<pg8::EpiQKV, pg8::StaticOrder, true>(lds + RING_OFF, tid, g, S, E);
        } else if (op == OP_ATTN) {
            MK_LANE_TID();
            LAS float* bl = (LAS float*)(lds + RING_OFF + attn_body::ATTN_LDS_BYTES);
            { const float* lf = (const float*)(ws + WS_LF) + (size_t)(vcu >> 2) * SEQ + tid * 8; LAS float* wt = (LAS float*)(lds + LDSCTL_OFF + 1024);
              const f32x4 a = *(const f32x4*)lf, b = *(const f32x4*)(lf + 4);
              float p[8]; p[0] = a[0]; p[1] = p[0] + a[1]; p[2] = p[1] + a[2]; p[3] = p[2] + a[3]; p[4] = p[3] + b[0]; p[5] = p[4] + b[1]; p[6] = p[5] + b[2]; p[7] = p[6] + b[3];
              float tot = p[7];
#pragma unroll
              for (int o = 1; o < 64; o <<= 1) { const float u = __builtin_bit_cast(float, __builtin_amdgcn_ds_bpermute((lane - o) << 2, __builtin_bit_cast(int, tot))); if (lane >= o) tot += u; }
              if (lane == 63) wt[wave] = tot;
              LDS_WAIT(); __syncthreads();
              float off = tot - p[7];
              for (int w = 0; w < wave; ++w) off += wt[w];
#pragma unroll
              for (int i = 0; i < 8; ++i) bl[tid * 8 + i] = -(p[i] + off) * 1.4426950408889634f;
              LDS_WAIT(); __syncthreads(); }
            LAS int* tsk = (LAS int*)(lds + LDSCTL_OFF + 12288);
            for (int prep_ = 0; prep_ < MK_PREPASS_REPS; ++prep_) { LAS float* kn = (LAS float*)(lds + LDSCTL_OFF + 12288 + 64); LAS float* qn = kn + 64;
              const int bh = vcu >> 2, sq = vcu & 3; const size_t rb = (size_t)(bh >> 4) * SEQ; const int hc = (bh & 15) * HD + (lane & 7) * 8;
              (void)hc;
              const int hd = bh & 15; const GAS f32x2* Nk = (const GAS f32x2*)(ws + WS_NRM) + ((size_t)(4 + (hd >> 2)) * M + rb) * 4 + (hd & 3); const GAS f32x2* Nq = (const GAS f32x2*)(ws + WS_NRM) + ((size_t)(hd >> 2) * M + rb) * 4 + (hd & 3);
              { f32x2 v[8];
#pragma unroll
                for (int i = 0; i < 8; ++i) v[i] = Nk[(size_t)(tid * 8 + i) * 4];
                float mx = 0.f;
#pragma unroll
                for (int i = 0; i < 8; ++i) mx = fmaxf(mx, v[i].x + v[i].y);
                mx = fmaxf(mx, lshx(mx, lane, 1)); mx = fmaxf(mx, lshx(mx, lane, 2)); mx = fmaxf(mx, lshx(mx, lane, 4));
                if ((lane & 7) == 0) kn[tid >> 3] = mx; }
              { f32x2 v[2]; const int i = wave >> 1, qb = (i == 0) ? sq : (i == 1) ? 7 - sq : (i == 2) ? 8 + sq : 15 - sq;
#pragma unroll
                for (int jj = 0; jj < 2; ++jj) v[jj] = Nq[(size_t)(qb * 256 + (wave & 1) * 128 + lane * 2 + jj) * 4];
                float mx = fmaxf(v[0].x + v[0].y, v[1].x + v[1].y);
#pragma unroll
                for (int o = 1; o < 64; o <<= 1) mx = fmaxf(mx, lshx(mx, lane, o));
                if (lane == 0) qn[i * 8 + (wave & 1)] = mx; if (lane == 1) { qn[i * 8 + 2 + (wave & 1) * 3] = 0.f; qn[i * 8 + 3 + (wave & 1) * 3] = 0.f; qn[i * 8 + 4 + (wave & 1) * 3] = 0.f; } }
              LDS_WAIT(); __syncthreads();
              if (wave < 4) { const int i = wave, qb = (i == 0) ? sq : (i == 1) ? 7 - sq : (i == 2) ? 8 + sq : 15 - sq, nt = 4 * qb + 4;
                  float q2 = (lane < 8) ? qn[i * 8 + lane] : 0.f, k2 = (lane < nt) ? kn[lane] : 0.f;
#pragma unroll
                  for (int o = 1; o < 64; o <<= 1) { q2 = fmaxf(q2, lshx(q2, lane, o)); k2 = fmaxf(k2, lshx(k2, lane, o)); }
                  const float lim = MK_SKIP_QK * sqrtf(q2) * sqrtf(k2) * 1.01f + 30.0f, bq = bl[qb * 256];
                  const int ts = 2 * lane;
                  const bool okc = (ts + 2 <= nt - 4) && (bq - bl[64 * (ts + 1) + 63] >= lim);
                  const int cntc = __builtin_popcountll(__ballot(okc));
                  if (lane == 0) tsk[i] = 2 * cntc; }
              LDS_WAIT(); __syncthreads(); }
            const attn_body::AttnTensors AT{(const attn_body::bf16*)(ws + WS_ACT), (const attn_body::bf16*)(ws + WS_ACT + 32 * MiB), (const attn_body::bf16*)(ws + WS_ACT + 64 * MiB), (attn_body::bf16*)(ws + WS_O)};
            const attn_body::StaticOrder S(G, bx);
            attn_body::attn_phase<attn_body::StaticOrder, MK_THRL>((char*)lds_raw + RING_OFF, AT, S, bl, tid, tsk);
            if (MK_DEFER_WEIGHTS && layer == 0) {
                LAS float* scr = (LAS float*)(lds + RING_OFF + wave * 16384); unsigned* q = (unsigned*)(ws + WS_CTL) + CW_QUEUE;
                for (;;) { unsigned b0 = 0; if (lane == 0) b0 = __hip_atomic_fetch_add(q, 4u, __ATOMIC_RELAXED, __HIP_MEMORY_SCOPE_AGENT); b0 = (unsigned)__builtin_amdgcn_readfirstlane((int)b0);
                    if (b0 >= (unsigned)WATT_ITEMS) break;
                    for (int i = 0; i < 4; ++i) if (!wt_one(args, scr, WMASK_ATT, (int)b0 + i, lane)) break; } }
        } else if (op == OP_WO) {
            MK_LANE_TID();
            pg8::Gemm g{(const bf16*)(ws + WS_O), (const bf16*)(ws + WS_WO) + (size_t)pj * D * D, D, D, D, 0, 0};
            pg8::StaticOrder S; S.init(M / 256, D / 256, G, bx);
            pg8::EpiResid<0> E{layer == 0 ? args.in[0] : X, X, XB, SSQ + (size_t)sout * M, nullptr, nullptr, 0};
            pg8::gemm_phase<pg8::EpiResid<0>, pg8::StaticOrder, true>(lds + RING_OFF, tid, g, S, E);
        }
        else if (op == OP_S5IN) {
            MK_LANE_TID();
            { const float* KERN = (const float*)(ws + WS_KERN); bf16* BTB = (bf16*)(ws + WS_BTB);
              for (int e2 = gw * 64 + lane; e2 < SG * 256 * 16; e2 += NGW * 64) { const int g = e2 >> 12, n = (e2 >> 4) & 255, j = e2 & 15, i = n >> 4, co = n & 15;
                  v4u o0 = {0u, 0u, 0u, 0u}, o1 = {0u, 0u, 0u, 0u};
                  if (i >= j) { const f32x4* kp = (const f32x4*)(KERN + (((size_t)g * 16 + (i - j)) * 16 + co) * 16); const f32x4 a = kp[0], b = kp[1], c = kp[2], d = kp[3];
                      o0 = (v4u){pk2(a[0], a[1]), pk2(a[2], a[3]), pk2(b[0], b[1]), pk2(b[2], b[3])}; o1 = (v4u){pk2(c[0], c[1]), pk2(c[2], c[3]), pk2(d[0], d[1]), pk2(d[2], d[3])}; }
                  v4u* dst = (v4u*)(BTB + ((size_t)g * 256 + n) * 384 + j * 16); dst[0] = o0; dst[1] = o1; } }
            pg8::Gemm g{XB, (const bf16*)(ws + WS_WS5IN), D, D, D, 0, 0};
            pg8::StaticOrder S; S.init(M / 256, D / 256, G, bx);
            pg8::EpiU E{(bf16*)(ws + WS_ACT), SSQ + (size_t)sin * M};
            pg8::gemm_phase<pg8::EpiU, pg8::StaticOrder, true>(lds + RING_OFF, tid, g, S, E);
        } else if (op == OP_SSM) {
            MK_LANE_TID();
            pg8::StaticOrder S; S.init(BATCH, SG, G, bx);
            { pg8::Gemm g{(const bf16*)(ws + WS_ACT), (const bf16*)(ws + WS_BTA), 256, 384, 256, 0, 1024 * 384 * 2};
              pg8::EpiSloc E{(const float*)(ws + WS_LAMC), (bf16*)(ws + WS_ACT), lds + LDSCTL_OFF + 2048};
              pg8::gemm_phase<pg8::EpiSloc, pg8::StaticOrder, false>(lds + RING_OFF, tid, g, S, E); }
            { pg8::Gemm g{(const bf16*)(ws + WS_ACT), (const bf16*)(ws + WS_BTB), 384, 384, 384, 0, 1024 * 384 * 2};
              pg8::EpiY E{(const bf16*)(ws + WS_ACT), args.in[15], (bf16*)(ws + WS_ACT + 48 * MiB)};
              pg8::gemm_phase<pg8::EpiY, pg8::StaticOrder, true>(lds + RING_OFF, tid, g, S, E); }
        } else if (op == OP_GLU) {
            MK_LANE_TID();
            pg8::Gemm g{(const bf16*)(ws + WS_ACT + 48 * MiB), (const bf16*)(ws + WS_WGLU), D, MK_G1_NATURAL ? D : 16, D, MK_G1_NATURAL ? 0 : M * 16, 0};
            pg8::StaticOrder S; S.init(M / 256, 2 * D / 256, G, bx);
            pg8::EpiResid<1> E{X, X, XB, SSQ + (size_t)sout * M, nullptr, nullptr, 0};
            pg8::gemm_phase<pg8::EpiResid<1>, pg8::StaticOrder, true>(lds + RING_OFF, tid, g, S, E);
        }
        else if (op == OP_POOLPREP) {
        } else if (op == OP_POOLGEMM) {
            MK_LANE_TID();
            pg8::StaticOrder S; S.init(M / 256, 4, G, bx);
            { pg8::Unit u0; if (S.next(0, u0)) { const pg8::ssq_t* ssq = SSQ + (size_t)sin * M; const float* gain = args.in[1] + (size_t)layer * D; bf16* PD = (bf16*)(ws + WS_ACT);
                const int gi = u0.pn, c0 = gi * 256 + lane * 4; const f32x4 gg = *(const f32x4*)(gain + c0);
                for (int ci = wave; ci < 16; ci += NWAVES) { const int row0 = u0.pm * 256 + ci * 16, t0 = row0 & (SEQ - 1);
                    if (gi == 0) pool_item<2>(X, ssq, gg, PD, row0, t0, c0); else if (gi == 1) pool_item<4>(X, ssq, gg, PD, row0, t0, c0);
                    else if (gi == 2) pool_item<8>(X, ssq, gg, PD, row0, t0, c0); else pool_item<16>(X, ssq, gg, PD, row0, t0, c0); } }
              asm volatile("s_waitcnt vmcnt(0)" ::: "memory"); __syncthreads();
              if (wave == 0) { __builtin_amdgcn_fence(__ATOMIC_ACQUIRE, "agent"); asm volatile("s_waitcnt vmcnt(0)" ::: "memory"); }
              __syncthreads(); }
            pg8::Gemm g{(const bf16*)(ws + WS_ACT), (const bf16*)(ws + WS_WPOOL), 256, D, 256, 0, 512};
            pg8::EpiResid<2> E{X, X, XB, SSQ + (size_t)sout * M, args.in[18], args.in[19], 0};
            pg8::gemm_phase<pg8::EpiResid<2>, pg8::StaticOrder, true>(lds + RING_OFF, tid, g, S, E);
        } else if (op == OP_FINAL) {
            MK_LANE_TID();
            { const pg8::ssq_t* ssq = SSQ + (size_t)sin * M; const float* gain = args.in[3];
              for (int m = gw; m < M; m += NGW) { const float rs = pg8::rstd_row(ssq, m); f32x4* xr = (f32x4*)(X + (size_t)m * D) + lane; const f32x4* gr = (const f32x4*)gain + lane;
#pragma unroll
                  for (int j = 0; j < 4; ++j) xr[64 * j] = xr[64 * j] * rs * gr[64 * j]; } }
        }
        if (e + 1 < args.ph_hi) { MK_GRID_BAR(); }
    }
}
}
extern "C" void kernel_launch(void* const* d_in, const int* in_sizes, int n_in, void* d_out, int out_size, void* d_ws, size_t ws_size, hipStream_t stream) {
    static int grid = 0;
    if (grid == 0) {
        int dev = 0, cus = 0, per_cu = 0;
        if (hipGetDevice(&dev) != hipSuccess || hipDeviceGetAttribute(&cus, hipDeviceAttributeMultiprocessorCount, dev) != hipSuccess) { grid = -1; return; }
        if (hipFuncSetAttribute((const void*)mk::mega_k, hipFuncAttributeMaxDynamicSharedMemorySize, mk::LDS_BYTES) != hipSuccess) { grid = -1; return; }
        if (hipOccupancyMaxActiveBlocksPerMultiprocessor(&per_cu, (const void*)mk::mega_k, mk::NWAVES * 64, mk::LDS_BYTES) != hipSuccess || per_cu < 1) { fprintf(stderr, "kernel_launch: occupancy query says %d blocks per CU\n", per_cu); grid = -1; (void)hipGetLastError(); return; }
        (void)hipGetLastError();
        grid = cus;
        if (n_in != 22 || ws_size < mk::WS_END || cus != 256 || in_sizes[0] != mk::M * mk::D || out_size != mk::M * mk::D) { fprintf(stderr, "kernel_launch: unexpected n_in %d / ws_size %zu / CUs %d\n", n_in, ws_size, cus); grid = -1; }
    }
    if (grid < 0) return;
    (void)hipMemsetAsync((char*)d_ws + mk::WS_CTL, 0, mk::CTL_ZERO_BYTES, stream);
    mk::Args a{};
    for (int i = 0; i < 22; ++i) a.in[i] = (const float*)d_in[i];
    a.out = (float*)d_out; a.ws = (unsigned char*)d_ws;
#if MK_ONE_LAUNCH
    a.ph_lo = 0; a.ph_hi = mk::PH_LAST + 1;
    void* kargs[] = {&a};
    const hipError_t e = hipLaunchCooperativeKernel((const void*)mk::mega_k, dim3(grid), dim3(mk::NWAVES * 64), kargs, mk::LDS_BYTES, stream);
    if (e != hipSuccess) fprintf(stderr, "kernel_launch: cooperative launch failed: %s\n", hipGetErrorString(e));
#else
    for (int ph = 0; ph <= mk::PH_LAST; ++ph) { a.ph_lo = ph; a.ph_hi = ph + 1; hipLaunchKernelGGL(mk::mega_k, dim3(grid), dim3(mk::NWAVES * 64), mk::LDS_BYTES, stream, a);
    }
#endif
}
```

```cpp
#include <hip/hip_runtime.h>
#include <hip/hip_cooperative_groups.h>
#include <cstdio>
#include <cstdint>
#include <cmath>
#define MK_BAR_SETUP() cooperative_groups::grid_group mk_grid = cooperative_groups::this_grid(); bool mk_first = true; \
    XcdBarrier mk_bar = xcd_barrier_post((unsigned*)(args.ws + WS_CTL) + CW_BAR, (volatile LAS unsigned*)(lds + MISC_OFF) + 8)
#define MK_GRID_BAR() do { if (mk_first) { mk_grid.sync(); mk_first = false; } else xcd_barrier(mk_bar); } while (0)
#define MK_ONE_LAUNCH 1
#define MK_NO_NAIVE 1
#define MK_THRL 24
#define MK_UP_DUMMY 0
#define MK_QKV_NOGATES 0
#define MK_DEFER_WEIGHTS 1
#define MK_SKIP_QK 2.0f
#ifndef MK_PREPASS_REPS
#define MK_PREPASS_REPS 1
#endif
#ifndef MK_TOUCH
#define MK_TOUCH 0
#endif
#ifndef MK_WGM
#define MK_WGM 8
#endif
#ifndef MK_ALIGN_UP
#define MK_ALIGN_UP true
#endif
#ifndef MK_S5TAB_REPS
#define MK_S5TAB_REPS 1
#endif
#ifndef MK_G1_NATURAL
#define MK_G1_NATURAL 0
#endif
#ifndef MK_WNT
#define MK_WNT 0
#endif
namespace pg8 {
#define PG8_LAS __attribute__((address_space(3)))
typedef unsigned short bf16_t;
typedef short bf16x8 __attribute__((ext_vector_type(8)));
typedef float f32x4 __attribute__((ext_vector_type(4)));
typedef float f32x2 __attribute__((ext_vector_type(2)));
typedef unsigned u32x4 __attribute__((ext_vector_type(4)));
typedef unsigned u32x2 __attribute__((ext_vector_type(2)));
constexpr int BM = 256, BK = 64, HALF = 128, HTB = HALF * BK * 2  , STAGE_BYTES = 8 * HTB, NXCD = 8, WGM = MK_WGM;

__host__ __device__ __forceinline__ int lds_byte(int r, int c) { const int st = (r >> 4) * 2 + (c >> 5), rr = r & 15, cc = c & 31, ob = rr * 64 + cc * 2; return st * 1024 + (ob ^ (((ob >> 9) & 1) << 5)); }
__host__ __device__ __forceinline__ void stage_rc(int b, int& R, int& C) { const int st = b / 1024, sb = b % 1024, swz = sb ^ (((sb >> 9) & 1) << 5); R = (st >> 1) * 16 + swz / 64; C = (st & 1) * 32 + (swz % 64) / 2; }
__host__ __device__ __forceinline__ int perm32(int rho) { const int n = rho >> 4, i = rho & 15; return 8 * (i >> 2) + 4 * n + (i & 3); }

struct Unit { int pm, pn; };
struct Gemm { const bf16_t* A; const bf16_t* Bt; int K; int lda, ldb; int gatherA; int a_pn_off; };

struct StaticOrder {
    int nM, nN, nwg, G, c;
    __host__ __device__ __forceinline__ void init(int nM_, int nN_, int G_, int c_) { nM = nM_; nN = nN_; nwg = nM * nN; G = G_; c = c_; }
    __host__ __device__ __forceinline__ bool next(int i, Unit& u) const {
        const long L = (long)i * G + c; if (L >= nwg) return false;
        int wgid = (int)L; { const int q = nwg / NXCD, r = nwg % NXCD, xcd = wgid % NXCD, off = wgid / NXCD; wgid = (xcd < r ? xcd * (q + 1) : r * (q + 1) + (xcd - r) * q) + off; }
        const int nig = WGM * nN, gid = wgid / nig, fm = gid * WGM, gsz = (nM - fm) < WGM ? (nM - fm) : WGM;
        u.pm = fm + ((wgid % nig) % gsz); u.pn = (wgid % nig) / gsz; return true;
    }
};

__device__ __forceinline__ unsigned cvt_pk_bf16(float lo, float hi) { unsigned r; asm volatile("v_cvt_pk_bf16_f32 %0, %1, %2" : "=v"(r) : "v"(lo), "v"(hi)); return r; }

template <class Epi, class Sched, bool ALIGN_EPI>
__device__ __forceinline__ void gemm_phase(PG8_LAS unsigned char* lds, const int tid, const Gemm g, const Sched& S, const Epi& E) {
    const int wid = __builtin_amdgcn_readfirstlane(tid >> 6), lane = tid & 63, wr = wid >> 2, wc = wid & 3, fr = lane & 15, fq = lane >> 4;
    const int K = g.K, nt = K / BK;
    unsigned voffA[2], voffB[2];
#pragma unroll
    for (int i = 0; i < 2; ++i) { int R, C; stage_rc(tid * 16 + i * 8192, R, C); const int Rb = Epi::PERM ? ((R & ~31) + perm32(R & 31)) : R;
        voffA[i] = g.gatherA ? (unsigned)(R * g.lda + (C >> 4) * g.gatherA + (C & 15)) * 2u : (unsigned)(R * g.lda + C) * 2u; voffB[i] = (unsigned)(Rb * g.ldb + C) * 2u; }
    const size_t kstepA = g.gatherA ? (size_t)g.gatherA * 8 : (size_t)(BK * 2), kstepB = (size_t)(BK * 2);
    const size_t hstepA = (size_t)HALF * g.lda * 2, hstepB = (size_t)HALF * g.ldb * 2;
    const size_t tstepA = 2 * hstepA, tstepB = 2 * hstepB;
    const unsigned ldsw = (unsigned)wid * 1024u;
    const int aoff = lds_byte(wr * 64 + fr, fq * 8), boff = lds_byte(wc * 32 + fr, fq * 8);
#define PG8_SA(b, h) (((b) * 2 + (h)) * HTB)
#define PG8_SB(b, h) ((4 + (b) * 2 + (h)) * HTB)
#define PG8_STAGE(bufoff, gbase, voff) do { _Pragma("unroll") for (int _i = 0; _i < 2; ++_i) \
        __builtin_amdgcn_global_load_lds((const unsigned*)((const char*)(gbase) + (voff)[_i]), (PG8_LAS unsigned*)(lds + (bufoff) + ldsw + _i * 8192), 16, 0, 0); } while (0)
#define PG8_LDA(dst, b, h) do { _Pragma("unroll") for (int m = 0; m < 4; ++m) _Pragma("unroll") for (int k = 0; k < 2; ++k) dst[m][k] = *(const PG8_LAS bf16x8*)(lds + PG8_SA(b, h) + aoff + m * 2048 + k * 1024); } while (0)
#define PG8_LDB(dst, b, h) do { _Pragma("unroll") for (int n = 0; n < 2; ++n) _Pragma("unroll") for (int k = 0; k < 2; ++k) dst[n][k] = *(const PG8_LAS bf16x8*)(lds + PG8_SB(b, h) + boff + n * 2048 + k * 1024); } while (0)
#define PG8_MMA(ai, bj, At, Bt) do { __builtin_amdgcn_s_setprio(1); _Pragma("unroll") for (int m = 0; m < 4; ++m) _Pragma("unroll") for (int n = 0; n < 2; ++n) _Pragma("unroll") for (int k = 0; k < 2; ++k) \
        acc[ai][bj][m][n] = __builtin_amdgcn_mfma_f32_16x16x32_bf16(Bt[n][k], At[m][k], acc[ai][bj][m][n], 0, 0, 0); __builtin_amdgcn_s_setprio(0); } while (0)
#define PG8_WAIT_V(n) asm volatile("s_waitcnt vmcnt(" #n ")" ::: "memory")
#define PG8_WAIT_L(n) asm volatile("s_waitcnt lgkmcnt(" #n ")" ::: "memory")
#define PG8_BAR __builtin_amdgcn_s_barrier()
#define PG8_SCHED __builtin_amdgcn_sched_barrier(0)
    Unit cur, nxt; int ui = 0;
    if (!S.next(0, cur)) return;
    f32x4 acc[2][2][4][2];
#pragma unroll
    for (int a = 0; a < 2; ++a)
#pragma unroll
        for (int b = 0; b < 2; ++b)
#pragma unroll
            for (int m = 0; m < 4; ++m)
#pragma unroll
                for (int n = 0; n < 2; ++n) acc[a][b][m][n] = (f32x4){0.f, 0.f, 0.f, 0.f};
    bf16x8 At[4][2], B0[2][2], B1[2][2];
    const char* cA = (const char*)g.A + (size_t)cur.pm * tstepA + (size_t)cur.pn * g.a_pn_off; const char* cB = (const char*)g.Bt + (size_t)cur.pn * tstepB;
    PG8_STAGE(PG8_SB(0, 0), cB, voffB); PG8_STAGE(PG8_SB(0, 1), cB + hstepB, voffB); PG8_STAGE(PG8_SA(0, 0), cA, voffA); PG8_STAGE(PG8_SA(0, 1), cA + hstepA, voffA);
    if (wr == 1) PG8_BAR;
    PG8_WAIT_V(2); PG8_BAR;
    PG8_STAGE(PG8_SB(1, 0), cB + kstepB, voffB); PG8_STAGE(PG8_SA(1, 0), cA + kstepA, voffA); PG8_STAGE(PG8_SB(1, 1), cB + hstepB + kstepB, voffB);
    PG8_WAIT_V(6); PG8_BAR;
    for (;;) {
        const bool has_next = S.next(ui + 1, nxt);
        const char* nA = has_next ? (const char*)g.A + (size_t)nxt.pm * tstepA + (size_t)nxt.pn * g.a_pn_off : cA; const char* nB = has_next ? (const char*)g.Bt + (size_t)nxt.pn * tstepB : cB;
        for (int t = 0; t < nt; t += 2) {
            const bool last = (t == nt - 2);
            const char* a1 = cA + (size_t)(t + 1) * kstepA;
            const char* a2 = last ? nA : cA + (size_t)(t + 2) * kstepA; const char* b2 = last ? nB : cB + (size_t)(t + 2) * kstepB;
            const char* a3 = a2 + kstepA; const char* b3 = b2 + kstepB;
            PG8_LDB(B0, 0, 0); PG8_LDB(B1, 0, 1); PG8_SCHED; PG8_LDA(At, 0, 0); PG8_STAGE(PG8_SA(1, 1), a1 + hstepA, voffA);
            PG8_WAIT_V(8); PG8_WAIT_L(0); PG8_BAR; PG8_MMA(0, 0, At, B0); PG8_MMA(0, 1, At, B1); PG8_BAR; PG8_SCHED;
            PG8_LDA(At, 0, 1); PG8_STAGE(PG8_SB(0, 0), b2, voffB); PG8_STAGE(PG8_SB(0, 1), b2 + hstepB, voffB); PG8_STAGE(PG8_SA(0, 0), a2, voffA);
            PG8_WAIT_V(8); PG8_WAIT_L(0); PG8_BAR; PG8_MMA(1, 0, At, B0); PG8_MMA(1, 1, At, B1); PG8_BAR; PG8_SCHED;
            PG8_LDB(B0, 1, 0); PG8_LDB(B1, 1, 1); PG8_SCHED; PG8_LDA(At, 1, 0); PG8_STAGE(PG8_SA(0, 1), a2 + hstepA, voffA);
            PG8_WAIT_V(8); PG8_WAIT_L(0); PG8_BAR; PG8_MMA(0, 0, At, B0); PG8_MMA(0, 1, At, B1); PG8_BAR; PG8_SCHED;
            PG8_LDA(At, 1, 1); PG8_STAGE(PG8_SB(1, 0), b3, voffB); PG8_STAGE(PG8_SB(1, 1), b3 + hstepB, voffB); PG8_STAGE(PG8_SA(1, 0), a3, voffA);
            PG8_WAIT_V(8); PG8_WAIT_L(0); PG8_BAR; PG8_MMA(1, 0, At, B0); PG8_MMA(1, 1, At, B1); PG8_BAR; PG8_SCHED;
        }
        if constexpr (ALIGN_EPI) { if (wr == 0) PG8_BAR; }
        if constexpr (!Epi::AFTER_DRAIN) { int ln_; asm volatile("v_mbcnt_lo_u32_b32 %0, -1, 0\n\tv_mbcnt_hi_u32_b32 %0, -1, %0" : "=v"(ln_)); E(acc, cur, wr, wc, ln_ & 15, ln_ >> 4); }
        if (!has_next) break;
#pragma unroll
        for (int a = 0; a < 2; ++a)
#pragma unroll
            for (int b = 0; b < 2; ++b)
#pragma unroll
                for (int m = 0; m < 4; ++m)
#pragma unroll
                    for (int n = 0; n < 2; ++n) acc[a][b][m][n] = (f32x4){0.f, 0.f, 0.f, 0.f};
        cur = nxt; cA = nA; cB = nB; ++ui;
        if constexpr (ALIGN_EPI) { if (wr == 1) PG8_BAR; }
    }
    PG8_WAIT_V(0);
    if constexpr (!ALIGN_EPI) { if (wr == 0) PG8_BAR; }
    PG8_BAR;
    if constexpr (Epi::AFTER_DRAIN) { int ln_; asm volatile("v_mbcnt_lo_u32_b32 %0, -1, 0\n\tv_mbcnt_hi_u32_b32 %0, -1, %0" : "=v"(ln_)); E.fused(acc, cur, wr, wc, ln_ & 15, ln_ >> 4, lds, wid, ln_); }
#undef PG8_SA
#undef PG8_SB
#undef PG8_STAGE
#undef PG8_LDA
#undef PG8_LDB
#undef PG8_MMA
#undef PG8_WAIT_V
#undef PG8_WAIT_L
#undef PG8_BAR
#undef PG8_SCHED
}

__device__ __forceinline__ float shx(float v, int lane, int m) { return __builtin_bit_cast(float, __builtin_amdgcn_ds_bpermute((lane ^ m) << 2, __builtin_bit_cast(int, v))); }
constexpr float RMS_EPS = 1e-6f;
typedef unsigned long long ssq_t;
constexpr float SSQ_SCALE = 1048576.0f;
__device__ __forceinline__ float rstd_row(const ssq_t* ssq, int row) { return __builtin_amdgcn_rsqf((float)ssq[row] * (1.0f / (1024.0f * SSQ_SCALE)) + RMS_EPS); }
#define PG8_GAS __attribute__((address_space(1)))
#ifndef MK_WT_STORES
#define MK_WT_STORES 0
#endif
template <int OFF = 0, typename V> __device__ __forceinline__ void st_wt(PG8_GAS void* p, const V v) {
    static_assert(OFF >= 0 && OFF < 4096, "immediate offset range");
#if MK_WT_STORES
    if constexpr (sizeof(V) == 16) asm volatile("global_store_dwordx4 %0, %1, off offset:%2 sc1\n\ts_nop 1" :: "v"(p), "v"(v), "n"(OFF) : "memory");
    else if constexpr (sizeof(V) == 8) asm volatile("global_store_dwordx2 %0, %1, off offset:%2 sc1\n\ts_nop 1" :: "v"(p), "v"(v), "n"(OFF) : "memory");
    else { static_assert(sizeof(V) == 4, "store width"); asm volatile("global_store_dword %0, %1, off offset:%2 sc1\n\ts_nop 1" :: "v"(p), "v"(v), "n"(OFF) : "memory"); }
#else
    *(PG8_GAS V*)((PG8_GAS unsigned char*)p + OFF) = v;
#endif
}
#if MK_WT_STORES
#define ATTN_STORE16(p,v) pg8::st_wt((PG8_GAS void*)(p), (v))
#endif
__device__ __forceinline__ void rstd8(const ssq_t* ssq, int row0, float (&rs)[2][4]) {
    ssq_t sv[2][4];
#pragma unroll
    for (int ai = 0; ai < 2; ++ai)
#pragma unroll
        for (int m = 0; m < 4; ++m) sv[ai][m] = ((const PG8_GAS ssq_t*)ssq)[row0 + ai * HALF + m * 16];
#pragma unroll
    for (int ai = 0; ai < 2; ++ai)
#pragma unroll
        for (int m = 0; m < 4; ++m) rs[ai][m] = __builtin_amdgcn_rsqf((float)sv[ai][m] * (1.0f / (1024.0f * SSQ_SCALE)) + RMS_EPS);
}
__device__ __forceinline__ float fast_sigmoid(float x) { return __builtin_amdgcn_rcpf(1.0f + __builtin_amdgcn_exp2f(-1.4426950408889634f * x)); }

struct EpiQKV {
    static constexpr bool PERM = true, AFTER_DRAIN = false;
    bf16_t* O; size_t split_stride; const ssq_t* ssq; float scale0; float* nrm;
    __device__ __forceinline__ void operator()(const f32x4 (&acc)[2][2][4][2], const Unit& u, int wr, int wc, int fr, int fq) const {
        const int row0 = u.pm * BM + wr * 64 + fr, t = u.pn >> 2; bf16_t* base = O + (size_t)t * split_stride; const float sc = (t == 0) ? scale0 : 1.f;
        const int col0 = (u.pn & 3) * BM + wc * 32 + 8 * fq, ln = fq * 16 + fr;
        float rsv[2][4]; rstd8(ssq, row0, rsv);
#pragma unroll
        for (int ai = 0; ai < 2; ++ai)
#pragma unroll
            for (int m = 0; m < 4; ++m) { const int row = row0 + ai * HALF + m * 16; const float rs = rsv[ai][m] * sc; PG8_GAS bf16_t* rowp = (PG8_GAS bf16_t*)base + (size_t)row * 1024 + col0;
#pragma unroll
                for (int bj = 0; bj < 2; ++bj) { const f32x4 v0 = acc[ai][bj][m][0] * rs, v1 = acc[ai][bj][m][1] * rs;
                    u32x4 w; w.x = cvt_pk_bf16(v0[0], v0[1]); w.y = cvt_pk_bf16(v0[2], v0[3]); w.z = cvt_pk_bf16(v1[0], v1[1]); w.w = cvt_pk_bf16(v1[2], v1[3]);
                    if (bj == 0) st_wt<0>(rowp, w); else st_wt<2 * HALF>(rowp, w);
                    if (t < 2) { float s = ((v0[0] * v0[0] + v0[1] * v0[1]) + (v0[2] * v0[2] + v0[3] * v0[3])) + ((v1[0] * v1[0] + v1[1] * v1[1]) + (v1[2] * v1[2] + v1[3] * v1[3]));
                        s += shx(s, ln, 16); s += shx(s, ln, 32);
                        if (fq == 0) ((PG8_GAS float*)nrm)[(((size_t)(t * 4 + (u.pn & 3)) * 16384 + row) * 4 + 2 * bj + (wc >> 1)) * 2 + (wc & 1)] = s; } } }
    }
};
struct EpiSwiGLU {
    static constexpr bool PERM = true, AFTER_DRAIN = false;
    bf16_t* Hh; int ldh; const ssq_t* ssq; int dummy;
    __device__ __forceinline__ void operator()(const f32x4 (&acc)[2][2][4][2], const Unit& u, int wr, int wc, int fr, int fq) const {
        const int row0 = u.pm * BM + wr * 64 + fr, col0 = u.pn * HALF + wc * 32 + 8 * fq;
        if (dummy) { if (fr == 0 && fq == 0) *(PG8_GAS float*)((PG8_GAS bf16_t*)Hh + (size_t)row0 * ldh + col0) = acc[0][0][0][0][0] + acc[1][1][3][1][3]; return; }
        float rsv[2][4]; rstd8(ssq, row0, rsv);
#pragma unroll
        for (int ai = 0; ai < 2; ++ai)
#pragma unroll
            for (int m = 0; m < 4; ++m) { const int row = row0 + ai * HALF + m * 16; const float rs = rsv[ai][m];
                float h[8];
#pragma unroll
                for (int n = 0; n < 2; ++n)
#pragma unroll
                    for (int j = 0; j < 4; j += 2) {
                        const f32x2 g2 = {acc[ai][0][m][n][j], acc[ai][0][m][n][j + 1]}, u2 = {acc[ai][1][m][n][j], acc[ai][1][m][n][j + 1]};
                        const f32x2 gs = g2 * rs, us = u2 * rs, ar = gs * (-1.4426950408889634f);
                        f32x2 e; e.x = __builtin_amdgcn_exp2f(ar.x); e.y = __builtin_amdgcn_exp2f(ar.y);
                        const f32x2 dn = e + 1.0f; f32x2 r; r.x = __builtin_amdgcn_rcpf(dn.x); r.y = __builtin_amdgcn_rcpf(dn.y);
                        const f32x2 hv = (gs * r) * us; h[n * 4 + j] = hv.x; h[n * 4 + j + 1] = hv.y; }
                u32x4 w; w.x = cvt_pk_bf16(h[0], h[1]); w.y = cvt_pk_bf16(h[2], h[3]); w.z = cvt_pk_bf16(h[4], h[5]); w.w = cvt_pk_bf16(h[6], h[7]);
                st_wt((PG8_GAS bf16_t*)Hh + (size_t)row * ldh + col0, w); }
    }
};
__device__ __forceinline__ void bf8_to_f32(const u32x4 w, f32x4& lo, f32x4& hi) {
    lo = (f32x4){__builtin_bit_cast(float, w.x << 16), __builtin_bit_cast(float, w.x & 0xffff0000u), __builtin_bit_cast(float, w.y << 16), __builtin_bit_cast(float, w.y & 0xffff0000u)};
    hi = (f32x4){__builtin_bit_cast(float, w.z << 16), __builtin_bit_cast(float, w.z & 0xffff0000u), __builtin_bit_cast(float, w.w << 16), __builtin_bit_cast(float, w.w & 0xffff0000u)};
}
template <int MODE> struct EpiResid {
    static constexpr bool PERM = true, AFTER_DRAIN = false;
    const bf16_t* base; bf16_t* XB; ssq_t* ssq_out; const float* pb; const float* psc; int dummy;
    __device__ __forceinline__ void operator()(const f32x4 (&acc)[2][2][4][2], const Unit& u, int wr, int wc, int fr, int fq) const {
        if (dummy) { if (acc[0][0][0][0][0] + acc[1][1][3][1][3] == 12345.678f) ((PG8_GAS float*)pb)[0] = 1.f; return; }
        const int row0 = u.pm * BM + wr * 64 + fr;
        const int col0 = (MODE == 1 ? u.pn * HALF : u.pn * BM) + wc * 32 + 8 * fq;
        constexpr int NBJ = (MODE == 1) ? 1 : 2;
        const PG8_GAS bf16_t* gb = (const PG8_GAS bf16_t*)base + (size_t)row0 * 1024 + col0; PG8_GAS bf16_t* gx = (PG8_GAS bf16_t*)XB + (size_t)row0 * 1024 + col0;
        float ss[2][4];
#pragma unroll
        for (int ai = 0; ai < 2; ++ai)
#pragma unroll
            for (int m = 0; m < 4; ++m) ss[ai][m] = 0.f;
#pragma unroll
        for (int bj = 0; bj < NBJ; ++bj) { const int co = bj * HALF;
            f32x4 bb0 = {0.f, 0.f, 0.f, 0.f}, bb1 = bb0, sc0 = {1.f, 1.f, 1.f, 1.f}, sc1 = sc0;
            if (MODE == 2) { bb0 = *(const PG8_GAS f32x4*)((const PG8_GAS float*)pb + col0 + co); bb1 = *(const PG8_GAS f32x4*)((const PG8_GAS float*)pb + col0 + co + 4);
                             sc0 = *(const PG8_GAS f32x4*)((const PG8_GAS float*)psc + col0 + co); sc1 = *(const PG8_GAS f32x4*)((const PG8_GAS float*)psc + col0 + co + 4); }
            constexpr int NAB = (MODE == 2) ? 1 : 2;
#pragma unroll
            for (int a0 = 0; a0 < 2; a0 += NAB) {
                u32x4 bs[NAB][4];
#pragma unroll
                for (int ai = 0; ai < NAB; ++ai)
#pragma unroll
                    for (int m = 0; m < 4; ++m) bs[ai][m] = *(const PG8_GAS u32x4*)(gb + (size_t)((a0 + ai) * HALF + m * 16) * 1024 + co);
#pragma unroll
                for (int aa = 0; aa < NAB; ++aa)
#pragma unroll
                    for (int m = 0; m < 4; ++m) { const int ai = a0 + aa; const size_t off = (size_t)(ai * HALF + m * 16) * 1024 + co; f32x4 d0, d1;
                        if (MODE == 0) { d0 = acc[ai][bj][m][0]; d1 = acc[ai][bj][m][1]; }
                        else if (MODE == 1) { const f32x4 v0 = acc[ai][0][m][0], g0 = acc[ai][1][m][0], v1 = acc[ai][0][m][1], g1 = acc[ai][1][m][1];
                            d0 = (f32x4){v0[0] * fast_sigmoid(g0[0]), v0[1] * fast_sigmoid(g0[1]), v0[2] * fast_sigmoid(g0[2]), v0[3] * fast_sigmoid(g0[3])};
                            d1 = (f32x4){v1[0] * fast_sigmoid(g1[0]), v1[1] * fast_sigmoid(g1[1]), v1[2] * fast_sigmoid(g1[2]), v1[3] * fast_sigmoid(g1[3])}; }
                        else { d0 = (acc[ai][bj][m][0] + bb0) * sc0; d1 = (acc[ai][bj][m][1] + bb1) * sc1; }
                        f32x4 b0, b1; bf8_to_f32(bs[aa][m], b0, b1);
                        const f32x4 o0 = b0 + d0, o1 = b1 + d1;
                        ss[ai][m] += ((o0[0] * o0[0] + o0[1] * o0[1]) + (o0[2] * o0[2] + o0[3] * o0[3])) + ((o1[0] * o1[0] + o1[1] * o1[1]) + (o1[2] * o1[2] + o1[3] * o1[3]));
                        u32x4 w; w.x = cvt_pk_bf16(o0[0], o0[1]); w.y = cvt_pk_bf16(o0[2], o0[3]); w.z = cvt_pk_bf16(o1[0], o1[1]); w.w = cvt_pk_bf16(o1[2], o1[3]);
                        st_wt(gx + off, w); }
                if (NAB == 1) asm volatile("" ::: "memory"); }
            asm volatile("" ::: "memory"); }
        const int ln = fq * 16 + fr;
#pragma unroll
        for (int ai = 0; ai < 2; ++ai)
#pragma unroll
            for (int m = 0; m < 4; ++m) { float s = ss[ai][m]; s += shx(s, ln, 16); s += shx(s, ln, 32);
                if (fq == 0) atomicAdd(ssq_out + row0 + ai * HALF + m * 16, (ssq_t)__builtin_llrintf(s * SSQ_SCALE)); }
    }
};
struct EpiResidFinal {
    static constexpr bool PERM = true, AFTER_DRAIN = true;
    const bf16_t* base; float* out; ssq_t* ssq_out; const float* gain; unsigned* cnt;
    __device__ __forceinline__ void fused(f32x4 (&acc)[2][2][4][2], const Unit& u, int wr, int wc, int fr, int fq, PG8_LAS unsigned char* lds, int wid, int lane) const {
        const int row0 = u.pm * BM + wr * 64 + fr, col0 = u.pn * BM + wc * 32 + 8 * fq;
        const PG8_GAS bf16_t* gb = (const PG8_GAS bf16_t*)base + (size_t)row0 * 1024 + col0;
        float ss[2][4]; float chain_ = 0.f;
#pragma unroll
        for (int ai = 0; ai < 2; ++ai)
#pragma unroll
            for (int m = 0; m < 4; m += 2) { int ro_ = (ai * HALF + m * 16) * 1024; asm volatile("" : "+v"(ro_) : "v"(chain_));
                const PG8_GAS bf16_t* rp = gb + ro_;
                const u32x4 wa = *(const PG8_GAS u32x4*)(rp), wb = *(const PG8_GAS u32x4*)(rp + HALF), wc_ = *(const PG8_GAS u32x4*)(rp + 16 * 1024), wd = *(const PG8_GAS u32x4*)(rp + 16 * 1024 + HALF);
#pragma unroll
                for (int q = 0; q < 2; ++q) { f32x4 b0, b1, b2, b3; bf8_to_f32(q ? wc_ : wa, b0, b1); bf8_to_f32(q ? wd : wb, b2, b3);
                    const f32x4 o0 = b0 + acc[ai][0][m + q][0], o1 = b1 + acc[ai][0][m + q][1], o2 = b2 + acc[ai][1][m + q][0], o3 = b3 + acc[ai][1][m + q][1];
                    ss[ai][m + q] = ((o0[0] * o0[0] + o0[1] * o0[1]) + (o0[2] * o0[2] + o0[3] * o0[3])) + ((o1[0] * o1[0] + o1[1] * o1[1]) + (o1[2] * o1[2] + o1[3] * o1[3]))
                                  + ((o2[0] * o2[0] + o2[1] * o2[1]) + (o2[2] * o2[2] + o2[3] * o2[3])) + ((o3[0] * o3[0] + o3[1] * o3[1]) + (o3[2] * o3[2] + o3[3] * o3[3])); }
                chain_ = ss[ai][m] + ss[ai][m + 1]; }
        const int ln = fq * 16 + fr;
#pragma unroll
        for (int ai = 0; ai < 2; ++ai)
#pragma unroll
            for (int m = 0; m < 4; ++m) { float s = ss[ai][m]; s += shx(s, ln, 16); s += shx(s, ln, 32);
                if (fq == 0) atomicAdd(ssq_out + row0 + ai * HALF + m * 16, (ssq_t)__builtin_llrintf(s * SSQ_SCALE)); }
        asm volatile("s_waitcnt vmcnt(0)" ::: "memory"); __builtin_amdgcn_s_barrier(); asm volatile("" ::: "memory");
        if (wid == 0) {
            unsigned* c = cnt + 64 * u.pm;
            if (lane == 0) __hip_atomic_fetch_add(c, 1u, __ATOMIC_RELAXED, __HIP_MEMORY_SCOPE_AGENT);
            unsigned spins = 0;
            while ((unsigned)__builtin_amdgcn_readfirstlane(__hip_atomic_load(c, __ATOMIC_RELAXED, __HIP_MEMORY_SCOPE_AGENT)) < 4u && ++spins < (1u << 22)) __builtin_amdgcn_s_sleep(2);
        }
        __builtin_amdgcn_s_barrier(); asm volatile("" ::: "memory");
        int l2_; asm volatile("v_mbcnt_lo_u32_b32 %0, -1, 0\n\tv_mbcnt_hi_u32_b32 %0, -1, %0" : "=v"(l2_));
        const int row0b = u.pm * BM + wr * 64 + (l2_ & 15), col0b = u.pn * BM + wc * 32 + 8 * (l2_ >> 4);
        const PG8_GAS bf16_t* gb2 = (const PG8_GAS bf16_t*)base + (size_t)row0b * 1024 + col0b; PG8_GAS float* go = (PG8_GAS float*)out + (size_t)row0b * 1024 + col0b;
        float rs[2][4];
#pragma unroll
        for (int ai = 0; ai < 2; ++ai)
#pragma unroll
            for (int m = 0; m < 4; ++m) rs[ai][m] = __builtin_amdgcn_rsqf((float)__hip_atomic_load(ssq_out + row0b + ai * HALF + m * 16, __ATOMIC_RELAXED, __HIP_MEMORY_SCOPE_AGENT) * (1.0f / (1024.0f * SSQ_SCALE)) + RMS_EPS);
#pragma unroll
        for (int bj = 0; bj < 2; ++bj) { int co = bj * HALF; asm volatile("" : "+v"(co) : "v"(chain_));
            const f32x4 gg0 = *(const PG8_GAS f32x4*)((const PG8_GAS float*)gain + col0b + co), gg1 = *(const PG8_GAS f32x4*)((const PG8_GAS float*)gain + col0b + co + 4); u32x4 bs[2][4];
#pragma unroll
            for (int ai = 0; ai < 2; ++ai)
#pragma unroll
                for (int m = 0; m < 4; ++m) bs[ai][m] = *(const PG8_GAS u32x4*)(gb2 + (size_t)(ai * HALF + m * 16) * 1024 + co);
#pragma unroll
            for (int ai = 0; ai < 2; ++ai)
#pragma unroll
                for (int m = 0; m < 4; ++m) { f32x4 b0, b1; bf8_to_f32(bs[ai][m], b0, b1);
                    const f32x4 ov0 = (b0 + acc[ai][bj][m][0]) * rs[ai][m] * gg0, ov1 = (b1 + acc[ai][bj][m][1]) * rs[ai][m] * gg1;
                    PG8_GAS float* op = go + (size_t)(ai * HALF + m * 16) * 1024 + co; *(PG8_GAS f32x4*)op = ov0; *(PG8_GAS f32x4*)(op + 4) = ov1; chain_ = ov1[0]; }
            asm volatile("" ::: "memory"); }
    }
};
struct EpiU {
    static constexpr bool PERM = true, AFTER_DRAIN = false;
    bf16_t* UX; const ssq_t* ssq;
    __device__ __forceinline__ void operator()(const f32x4 (&acc)[2][2][4][2], const Unit& u, int wr, int wc, int fr, int fq) const {
        const int row0 = u.pm * BM + wr * 64 + fr, col0 = u.pn * BM + wc * 32 + 8 * fq;
        float rsv[2][4]; rstd8(ssq, row0, rsv);
#pragma unroll
        for (int ai = 0; ai < 2; ++ai)
#pragma unroll
            for (int m = 0; m < 4; ++m) { const int row = row0 + ai * HALF + m * 16; const float rs = rsv[ai][m];
#pragma unroll
                for (int bj = 0; bj < 2; ++bj) { const int col = col0 + bj * HALF; const f32x4 v0 = acc[ai][bj][m][0] * rs, v1 = acc[ai][bj][m][1] * rs;
                    u32x4 w; w.x = cvt_pk_bf16(v0[0], v0[1]); w.y = cvt_pk_bf16(v0[2], v0[3]); w.z = cvt_pk_bf16(v1[0], v1[1]); w.w = cvt_pk_bf16(v1[2], v1[3]);
                    st_wt((PG8_GAS bf16_t*)UX + ((size_t)(col >> 4) * 1024 + (row >> 4)) * 384 + (row & 15) * 16 + (col & 15), w); } }
    }
};
struct EpiSloc {
    static constexpr bool PERM = false, AFTER_DRAIN = true;
    const float* lamc; bf16_t* UX; PG8_LAS unsigned char* esc;
    __device__ __forceinline__ void fused(f32x4 (&acc)[2][2][4][2], const Unit& u, int wr, int wc, int fr, int fq, PG8_LAS unsigned char* lds, int wid, int lane) const {
        PG8_LAS float* SL = (PG8_LAS float*)lds;
#pragma unroll
        for (int ai = 0; ai < 2; ++ai)
#pragma unroll
            for (int m = 0; m < 4; ++m)
#pragma unroll
                for (int n = 0; n < 2; ++n) *(PG8_LAS f32x4*)(SL + (ai * HALF + wr * 64 + m * 16 + fr) * 128 + wc * 32 + n * 16 + 4 * fq) = acc[ai][0][m][n];
        asm volatile("s_waitcnt lgkmcnt(0)" ::: "memory"); __builtin_amdgcn_s_barrier(); asm volatile("" ::: "memory");
        const int g = u.pn, b = u.pm, seg = wid, p = lane;
        const float lr = lamc[(g * 64 + p) * 2], li = lamc[(g * 64 + p) * 2 + 1];
        float sr = 0.f, si = 0.f;
        for (int c = seg * 32; c < seg * 32 + 32; ++c) { const float xr = SL[c * 128 + p], xi = SL[c * 128 + 64 + p]; const float nr = lr * sr - li * si + xr, ni = lr * si + li * sr + xi; sr = nr; si = ni; }
        PG8_LAS float* E = (PG8_LAS float*)esc;
        E[(seg * 64 + p) * 2] = sr; E[(seg * 64 + p) * 2 + 1] = si;
        asm volatile("s_waitcnt lgkmcnt(0)" ::: "memory"); __builtin_amdgcn_s_barrier(); asm volatile("" ::: "memory");
        float l32r = lr, l32i = li;
#pragma unroll
        for (int q = 0; q < 5; ++q) { const float t = l32r * l32r - l32i * l32i; l32i = 2.f * l32r * l32i; l32r = t; }
        sr = 0.f; si = 0.f;
        for (int j = 0; j < seg; ++j) { const float er = E[(j * 64 + p) * 2], ei = E[(j * 64 + p) * 2 + 1]; const float nr = l32r * sr - l32i * si + er, ni = l32r * si + l32i * sr + ei; sr = nr; si = ni; }
        bf16_t* dst = UX + ((size_t)g * 1024 + b * 256 + seg * 32) * 384 + 256 + p;
        for (int c = seg * 32; c < seg * 32 + 32; ++c) {
            { unsigned ur = __builtin_bit_cast(unsigned, sr), ui = __builtin_bit_cast(unsigned, si); ur = (ur + 0x7fffu + ((ur >> 16) & 1u)) >> 16; ui = (ui + 0x7fffu + ((ui >> 16) & 1u)) >> 16;
              dst[0] = (bf16_t)ur; dst[64] = (bf16_t)ui; }
            const float xr = SL[c * 128 + p], xi = SL[c * 128 + 64 + p]; const float nr = lr * sr - li * si + xr, ni = lr * si + li * sr + xi; sr = nr; si = ni;
            dst += 384; }
        asm volatile("s_waitcnt vmcnt(0) lgkmcnt(0)" ::: "memory"); __builtin_amdgcn_s_barrier(); asm volatile("" ::: "memory");
        if (wid == 0) { __builtin_amdgcn_fence(__ATOMIC_ACQUIRE, "agent"); asm volatile("s_waitcnt vmcnt(0)" ::: "memory"); }
        __builtin_amdgcn_s_barrier(); asm volatile("" ::: "memory");
    }
};
struct EpiY {
    static constexpr bool PERM = true, AFTER_DRAIN = false;
    const bf16_t* UX; const float* dvec; bf16_t* G1;
    __device__ __forceinline__ void operator()(const f32x4 (&acc)[2][2][4][2], const Unit& u, int wr, int wc, int fr, int fq) const {
        const int g = u.pn, b = u.pm, ch0 = g * 16 + 8 * (fq & 1);
        const f32x4 d0 = *(const f32x4*)(dvec + ch0), d1 = *(const f32x4*)(dvec + ch0 + 4);
#pragma unroll
        for (int ai = 0; ai < 2; ++ai) {
            u32x4 uwv[4][2];
#pragma unroll
            for (int m = 0; m < 4; ++m)
#pragma unroll
                for (int bj = 0; bj < 2; ++bj) uwv[m][bj] = *(const PG8_GAS u32x4*)((const PG8_GAS bf16_t*)UX + ((size_t)g * 1024 + b * 256 + (ai * HALF + wr * 64 + m * 16 + fr)) * 384 + (8 * bj + 2 * wc + (fq >> 1)) * 16 + 8 * (fq & 1));
#pragma unroll
            for (int m = 0; m < 4; ++m) { const int R = ai * HALF + wr * 64 + m * 16 + fr;
#pragma unroll
                for (int bj = 0; bj < 2; ++bj) { const int i = 8 * bj + 2 * wc + (fq >> 1);
                    const u32x4 uw = uwv[m][bj];
                    float y[8];
#pragma unroll
                    for (int j = 0; j < 4; ++j) { y[j] = acc[ai][bj][m][0][j] + d0[j] * __builtin_bit_cast(float, (j & 1) ? (uw[j >> 1] & 0xffff0000u) : (uw[j >> 1] << 16));
                                                  y[4 + j] = acc[ai][bj][m][1][j] + d1[j] * __builtin_bit_cast(float, (j & 1) ? (uw[2 + (j >> 1)] & 0xffff0000u) : (uw[2 + (j >> 1)] << 16)); }
#pragma unroll
                    for (int j = 0; j < 8; ++j) { const float z = 0.7978845608028654f * (y[j] + 0.044715f * y[j] * y[j] * y[j]); y[j] = y[j] * fast_sigmoid(2.f * z); }
                    u32x4 w; w.x = cvt_pk_bf16(y[0], y[1]); w.y = cvt_pk_bf16(y[2], y[3]); w.z = cvt_pk_bf16(y[4], y[5]); w.w = cvt_pk_bf16(y[6], y[7]);
                    st_wt((PG8_GAS bf16_t*)G1 + (MK_G1_NATURAL ? ((size_t)(b * 4096 + 16 * R + i) * 1024 + g * 16 + 8 * (fq & 1)) : (((size_t)g * 16384 + b * 4096 + 16 * R + i) * 16 + 8 * (fq & 1))), w); } }
            asm volatile("" ::: "memory"); }
    }
};
}
#include <hip/hip_bf16.h>
#include <cmath>
namespace attn_body {
using bf16=__hip_bfloat16;
using bf16x8=__attribute__((ext_vector_type(8)))short;
using s16x4=__attribute__((ext_vector_type(4)))short;
using f32x16=__attribute__((ext_vector_type(16)))float;
using u32x4=__attribute__((ext_vector_type(4)))unsigned;
constexpr int BATCH=4,NHEAD=16,SEQ=4096,D=64,DM=NHEAD*D;
constexpr int NW=8,QBLK=32,QB=QBLK*NW,KVBLK=64,NQB=SEQ/QB;
constexpr int ATTN_PITCH=DM, ATTN_UNIT_ROWS=QB;
__device__ __forceinline__ int crow(int r,int hi){return (r&3)+8*(r>>2)+4*hi;}
#define SBAR() __builtin_amdgcn_sched_barrier(0)
__device__ __forceinline__ void cmask(f32x16&p0,f32x16&p1,int jb,int qrel,int hi){
  const float NEG=-INFINITY; int kb=64*jb+4*hi;
  #pragma unroll
  for(int r=0;r<16;++r){int kv=kb+(r&3)+8*(r>>2); if(kv>qrel)p0[r]=NEG; if(kv+32>qrel)p1[r]=NEG;}
}

constexpr int NSLOT=3, SLOTB=8192;
constexpr int LDS_K=0, LDS_V=NSLOT*SLOTB, LDS_WS=2*NSLOT*SLOTB, LDS_OST=LDS_WS+NW*64*4, LDS_BYTES=LDS_OST+NW*4096;
constexpr float C2=0.125f*1.4426950408889634f;
__device__ __forceinline__ void glds16(const void*gsrc,unsigned lds_dst){unsigned keep;
  asm volatile("s_mov_b32 %0, m0\n\ts_mov_b32 m0, %2\n\ts_nop 0\n\tglobal_load_lds_dwordx4 %1, off\n\ts_mov_b32 m0, %0":"=&s"(keep):"v"(gsrc),"s"(lds_dst):"memory");}
__device__ __forceinline__ float max3f(float a,float b,float c){float r;asm("v_max3_f32 %0, %1, %2, %3":"=v"(r):"v"(a),"v"(b),"v"(c));return r;}
__device__ __forceinline__ float max2f(float a,float b){float r;asm("v_max_f32_e32 %0, %1, %2":"=v"(r):"v"(a),"v"(b));return r;}
__device__ __forceinline__ float fadd_s(float a,float b){float r;asm("v_add_f32_e32 %0, %1, %2":"=v"(r):"v"(a),"v"(b));return r;}
__device__ __forceinline__ float fsub_s(float a,float b){float r;asm("v_sub_f32_e32 %0, %1, %2":"=v"(r):"v"(a),"v"(b));return r;}
typedef float f32x2_t __attribute__((ext_vector_type(2))); typedef __bf16 bf16x2_t __attribute__((ext_vector_type(2)));
__device__ __forceinline__ unsigned cvtpk_s(float lo,float hi){f32x2_t v={lo,hi};bf16x2_t b=__builtin_convertvector(v,bf16x2_t);return __builtin_bit_cast(unsigned,b);}
#define WAIT_BAR(N) asm volatile("s_waitcnt vmcnt(" #N ") lgkmcnt(0)\n\ts_barrier":::"memory")

__device__ __forceinline__ void qkt(f32x16&p0,f32x16&p1,const char*Kslot,const bf16x8*qr,int r32,int hi){
  const char*kb=Kslot+hi*1024+r32*16;
  #pragma unroll
  for(int d0=0;d0<4;++d0){
    const bf16x8 b0=*reinterpret_cast<const bf16x8*>(kb+d0*2048);
    const bf16x8 b1=*reinterpret_cast<const bf16x8*>(kb+d0*2048+512);
    {p0=__builtin_amdgcn_mfma_f32_32x32x16_bf16(b0,qr[d0],p0,0,0,0);p1=__builtin_amdgcn_mfma_f32_32x32x16_bf16(b1,qr[d0],p1,0,0,0);}}
}
typedef __attribute__((address_space(3))) const char* lds_cptr;
typedef short v4i16_t __attribute__((ext_vector_type(4)));
__device__ __forceinline__ void kload8(bf16x8*kf,lds_cptr kp){
  kf[0]=*(const __attribute__((address_space(3))) bf16x8*)(kp);      kf[1]=*(const __attribute__((address_space(3))) bf16x8*)(kp+512);
  kf[2]=*(const __attribute__((address_space(3))) bf16x8*)(kp+2048); kf[3]=*(const __attribute__((address_space(3))) bf16x8*)(kp+2560);
  kf[4]=*(const __attribute__((address_space(3))) bf16x8*)(kp+4096); kf[5]=*(const __attribute__((address_space(3))) bf16x8*)(kp+4608);
  kf[6]=*(const __attribute__((address_space(3))) bf16x8*)(kp+6144); kf[7]=*(const __attribute__((address_space(3))) bf16x8*)(kp+6656);
}
__device__ __forceinline__ void kload2(bf16x8*kf,lds_cptr kp,int j){ kf[2*j]=*(const __attribute__((address_space(3))) bf16x8*)(kp+j*2048); kf[2*j+1]=*(const __attribute__((address_space(3))) bf16x8*)(kp+j*2048+512); }
__device__ __forceinline__ s16x4 vtr(lds_cptr p){ return __builtin_bit_cast(s16x4,__builtin_amdgcn_ds_read_tr16_b64_v4i16((__attribute__((address_space(3))) v4i16_t*)p)); }
__device__ __forceinline__ float rowmax(const f32x16&p0,const f32x16&p1){
  float a=max3f(p0[0],p0[1],p1[0]),b=max3f(p0[2],p0[3],p1[1]);a=max3f(a,p1[2],p1[3]);
  #pragma unroll
  for(int r=4;r<16;r+=4){a=max3f(a,p0[r],p0[r+1]);b=max3f(b,p0[r+2],p0[r+3]);a=max3f(a,p1[r],p1[r+1]);b=max3f(b,p1[r+2],p1[r+3]);}
  const float m=max2f(a,b);
  auto rr=__builtin_amdgcn_permlane32_swap(__float_as_uint(m),__float_as_uint(m),false,false);
  return max2f(__uint_as_float(rr[0]),__uint_as_float(rr[1]));
}
__device__ __forceinline__ void pv(f32x16*o,int vb,bf16x8 pa0,bf16x8 pa1,bf16x8 pa2,bf16x8 pa3){
  #pragma unroll
  for(int d0=0;d0<2;++d0){s16x4 lo[4],hi[4];
    #pragma unroll
    for(int ks=0;ks<4;++ks){
      asm volatile("ds_read_b64_tr_b16 %0,%1 offset:%c2":"=&v"(lo[ks]):"v"(vb),"i"(d0*4096+ks*1024):"memory");
      asm volatile("ds_read_b64_tr_b16 %0,%1 offset:%c2":"=&v"(hi[ks]):"v"(vb),"i"(d0*4096+ks*1024+512):"memory");}
    asm volatile("s_waitcnt lgkmcnt(0)":::"memory");SBAR();
    #define PK(k) (bf16x8){lo[k][0],lo[k][1],lo[k][2],lo[k][3],hi[k][0],hi[k][1],hi[k][2],hi[k][3]}
    o[d0]=__builtin_amdgcn_mfma_f32_32x32x16_bf16(pa0,PK(0),o[d0],0,0,0);
    o[d0]=__builtin_amdgcn_mfma_f32_32x32x16_bf16(pa1,PK(1),o[d0],0,0,0);
    o[d0]=__builtin_amdgcn_mfma_f32_32x32x16_bf16(pa2,PK(2),o[d0],0,0,0);
    o[d0]=__builtin_amdgcn_mfma_f32_32x32x16_bf16(pa3,PK(3),o[d0],0,0,0);
    #undef PK
  }
}

#ifndef ATTN_STORE16
#define ATTN_STORE16(p,v) (*(u32x4*)(p)=(v))
#endif
typedef float f32x4b __attribute__((ext_vector_type(4)));
template<int THRL> __device__ __forceinline__ void attn_unit(int b,int h,int qb,const bf16*Q,const bf16*__restrict__ K,const bf16*__restrict__ V,bf16*O,char*shm,const __attribute__((address_space(3))) float*bl0,const int tid_,const int tskip){
  const __attribute__((address_space(3))) float*bl=bl0+tskip*64;
  const int tid=tid_,lane=tid&63,r32=lane&31,hi=lane>>5; const int wid=__builtin_amdgcn_readfirstlane(tid>>6);
  const long rowbase=(long)b*SEQ; const int q0=qb*QB;
  const bf16*Qw=Q+(rowbase+q0+wid*QBLK)*DM+h*D;
  const bf16*Kh=K+(rowbase+(long)tskip*KVBLK)*DM+h*D,*Vh=V+(rowbase+(long)tskip*KVBLK)*DM+h*D;
  const unsigned lds0=(unsigned)(uintptr_t)shm;
  float*wsf=(float*)(shm+LDS_WS)+wid*64;
  const bf16*ksrc=Kh+(long)lane*DM+wid*8;
  const bf16*vsrc=Vh+(long)(16*(wid&3)+(lane>>2))*DM+(wid>>2)*32+(lane&3)*8;
  const unsigned kdst=lds0+LDS_K+wid*1024, vdst=lds0+LDS_V+wid*1024;
  #define DMA_K(t,slot) glds16(ksrc+(long)(t)*KVBLK*DM,(unsigned)__builtin_amdgcn_readfirstlane(kdst+(slot)))
  #define DMA_V(t,slot) glds16(vsrc+(long)(t)*KVBLK*DM,(unsigned)__builtin_amdgcn_readfirstlane(vdst+(slot)))
  const int vb0=(int)(lds0+LDS_V)+((lane>>4)&1)*32+(lane&3)*8+(4*hi+((lane&15)>>2))*64;
  const char*Kbase=shm+LDS_K; bf16x8 kf[8];
  const lds_cptr shm3=(lds_cptr)shm; const lds_cptr kp0=shm3+LDS_K+hi*1024+r32*16; const lds_cptr vp0=shm3+LDS_V+((lane>>4)&1)*32+(lane&3)*8+(4*hi+((lane&15)>>2))*64;
  const int NT=(q0+QB)/KVBLK-tskip;
  DMA_K(0,0);DMA_V(0,0);DMA_K(1,SLOTB);
  bf16x8 qr[4];
  #pragma unroll
  for(int d0=0;d0<4;++d0)qr[d0]=*reinterpret_cast<const bf16x8*>(&Qw[(long)r32*DM+d0*16+hi*8]);
  float mhat=0.f,l_reg=0.f;f32x16 o[2];o[0]=f32x16{};o[1]=f32x16{};
  const int qrel=wid*QBLK+r32;
  #define CMASK(P0,P1,t) do{int jb_=(t)-(NT-4); if(jb_>=0)cmask(P0,P1,jb_,qrel,hi);}while(0)
  #define BIASLD(P0,P1,t) do{ const __attribute__((address_space(3))) f32x4b*bp_=(const __attribute__((address_space(3))) f32x4b*)(bl+(t)*64+hi*4); \
    _Pragma("unroll") for(int g_=0;g_<4;++g_){ const f32x4b b0_=bp_[2*g_],b1_=bp_[8+2*g_]; \
      P0[4*g_]=b0_[0];P0[4*g_+1]=b0_[1];P0[4*g_+2]=b0_[2];P0[4*g_+3]=b0_[3]; P1[4*g_]=b1_[0];P1[4*g_+1]=b1_[1];P1[4*g_+2]=b1_[2];P1[4*g_+3]=b1_[3]; } }while(0)
  bool resc=false;
  #define START(P0,P1) do{ const float rm=rowmax(P0,P1); resc=false; \
    { const float dl=rm; mhat=fadd_s(mhat,dl); \
      _Pragma("unroll") for(int r=0;r<16;++r){P0[r]=fsub_s(P0[r],dl);P1[r]=fsub_s(P1[r],dl);} } \
    _Pragma("unroll") for(int r=0;r<16;++r)P0[r]=__builtin_amdgcn_exp2f(P0[r]); }while(0)
  #define RESC() do{ if(resc){ asm volatile("s_waitcnt lgkmcnt(0)":::"memory"); \
      _Pragma("unroll") for(int d_=0;d_<2;++d_) _Pragma("unroll") for(int r=0;r<16;++r)o[d_][r]*=wsf[crow(r,hi)]; } }while(0)
  f32x16 pA0,pA1,pB0,pB1;
  int sl_prev=0,sl_cur=0,sl_next=SLOTB;
  #define ROT() do{sl_prev=sl_cur;sl_cur=sl_next;sl_next=(sl_next==(NSLOT-1)*SLOTB)?0:sl_next+SLOTB;}while(0)
  DMA_K(2,2*SLOTB);
  WAIT_BAR(3);
  BIASLD(pA0,pA1,0);qkt(pA0,pA1,Kbase,qr,r32,hi);asm volatile("s_nop 15\n\ts_nop 7":"+v"(pA0),"+v"(pA1));CMASK(pA0,pA1,0);
  START(pA0,pA1);
  _Pragma("unroll") for(int r=0;r<16;++r)pA1[r]=__builtin_amdgcn_exp2f(pA1[r]);
  WAIT_BAR(0);
  DMA_K(3,0);DMA_V(1,SLOTB);
  ROT();
  kload8(kf,kp0+sl_cur);
  WAIT_BAR(2);
  s16x4 vlo[8],vhi[8]; u32x4 pw0,pw1,pw2,pw3;
  #define PKW(P,B) cvtpk_s(P[B],P[B+1])
  #define PAF(k) __builtin_bit_cast(bf16x8,pw##k)
  #define VFR(i) (bf16x8){vlo[i][0],vlo[i][1],vlo[i][2],vlo[i][3],vhi[i][0],vhi[i][1],vhi[i][2],vhi[i][3]}
  #define PIN(x) asm volatile("":"+v"(x))
  #define MX3(a,b,c) __builtin_fmaxf(__builtin_fmaxf((a),(b)),(c))
  #define GAPA(MF,A0,A1,A2,A3,W0,W1,PW) do{ MF; sacc+=A0; sacc+=A1; sacc+=A2; sacc+=A3; PIN(sacc); W0; W1; PIN(PW); SBAR(); }while(0)
  #define EX(v) __builtin_amdgcn_exp2f(v)
  #define GAPB(MF,X,B) do{ MF; X[B]=EX(X[B]-mhat); X[B+1]=EX(X[B+1]-mhat); X[B+2]=EX(X[B+2]-mhat); X[B+3]=EX(X[B+3]-mhat); PIN(X); SBAR(); }while(0)
  #define VRD(i) do{ vlo[i]=vtr(vp_+(((i)>>2)*4096+((i)&3)*1024)); vhi[i]=vtr(vp_+(((i)>>2)*4096+((i)&3)*1024+512)); }while(0)
  #define KRD(G,j) do{ if(G){ kload2(kf,kp0+sl_next,j); SBAR(); } }while(0)
  #define STEP(C0,C1,P0,P1,t,GK,GV,GL) do{ SBAR(); BIASLD(C0,C1,t); SBAR(); \
    const lds_cptr vp_=vp0+sl_prev; \
    VRD(0); SBAR(); float sacc=(P0[0]+P0[1]); \
    GAPA(C0=__builtin_amdgcn_mfma_f32_32x32x16_bf16(kf[0],qr[0],C0,0,0,0), P0[2],P0[3],P0[4],P0[5],     pw0[0]=PKW(P0,0), pw0[1]=PKW(P0,2), pw0); \
    VRD(4); SBAR(); GAPA(C1=__builtin_amdgcn_mfma_f32_32x32x16_bf16(kf[1],qr[0],C1,0,0,0), P0[6],P0[7],P0[8],P0[9],     pw0[2]=PKW(P0,4), pw0[3]=PKW(P0,6), pw0); \
    VRD(1); SBAR(); GAPA(C0=__builtin_amdgcn_mfma_f32_32x32x16_bf16(kf[2],qr[1],C0,0,0,0),   P0[10],P0[11],P0[12],P0[13], pw1[0]=PKW(P0,8), pw1[1]=PKW(P0,10), pw1); \
    VRD(5); SBAR(); GAPA(C1=__builtin_amdgcn_mfma_f32_32x32x16_bf16(kf[3],qr[1],C1,0,0,0),   P0[14],P0[15],P1[0],P1[1],   pw1[2]=PKW(P0,12),pw1[3]=PKW(P0,14), pw1); \
    VRD(2); SBAR(); GAPA(C0=__builtin_amdgcn_mfma_f32_32x32x16_bf16(kf[4],qr[2],C0,0,0,0),   P1[2],P1[3],P1[4],P1[5],     pw2[0]=PKW(P1,0), pw2[1]=PKW(P1,2), pw2); \
    VRD(6); SBAR(); GAPA(C1=__builtin_amdgcn_mfma_f32_32x32x16_bf16(kf[5],qr[2],C1,0,0,0),   P1[6],P1[7],P1[8],P1[9],     pw2[2]=PKW(P1,4), pw2[3]=PKW(P1,6), pw2); \
    VRD(3); SBAR(); GAPA(C0=__builtin_amdgcn_mfma_f32_32x32x16_bf16(kf[6],qr[3],C0,0,0,0),   P1[10],P1[11],P1[12],P1[13], pw3[0]=PKW(P1,8), pw3[1]=PKW(P1,10), pw3); \
    VRD(7); SBAR(); GAPA(C1=__builtin_amdgcn_mfma_f32_32x32x16_bf16(kf[7],qr[3],C1,0,0,0),   P1[14],P1[15],0.f,0.f,       pw3[2]=PKW(P1,12),pw3[3]=PKW(P1,14), pw3); \
    l_reg+=sacc; \
    if(GK){DMA_K((t)+3,sl_cur);} if(GV){DMA_V((t)+1,sl_next);} \
    CMASK(C0,C1,t); \
    { float a=MX3(C0[0],C0[1],C1[0]),b=MX3(C0[2],C0[3],C1[1]); a=MX3(a,C1[2],C1[3]); \
      _Pragma("unroll") for(int r=4;r<16;r+=4){a=MX3(a,C0[r],C0[r+1]);b=MX3(b,C0[r+2],C0[r+3]);a=MX3(a,C1[r],C1[r+1]);b=MX3(b,C1[r+2],C1[r+3]);} \
      float rm=__builtin_fmaxf(a,b); { auto rr=__builtin_amdgcn_permlane32_swap(__float_as_uint(rm),__float_as_uint(rm),false,false); rm=__builtin_fmaxf(__uint_as_float(rr[0]),__uint_as_float(rr[1])); } \
      resc=false; const float dm_=rm-mhat; \
      if(__builtin_expect(__any(dm_>(float)THRL),0)){ const float dl=__builtin_fmaxf(dm_,0.f); mhat+=dl; \
        const float f=__builtin_amdgcn_exp2f(-dl); l_reg*=f; if(hi==0)wsf[r32]=f; resc=true; } } \
    SBAR(); \
    GAPB(o[0]=__builtin_amdgcn_mfma_f32_32x32x16_bf16(PAF(0),VFR(0),o[0],0,0,0), C0,0); \
    GAPB(o[1]=__builtin_amdgcn_mfma_f32_32x32x16_bf16(PAF(0),VFR(4),o[1],0,0,0), C0,4); \
    KRD(GL,0); GAPB(o[0]=__builtin_amdgcn_mfma_f32_32x32x16_bf16(PAF(1),VFR(1),o[0],0,0,0), C0,8); \
    KRD(GL,1); GAPB(o[1]=__builtin_amdgcn_mfma_f32_32x32x16_bf16(PAF(1),VFR(5),o[1],0,0,0), C0,12); \
    KRD(GL,2); GAPB(o[0]=__builtin_amdgcn_mfma_f32_32x32x16_bf16(PAF(2),VFR(2),o[0],0,0,0), C1,0); \
    KRD(GL,3); GAPB(o[1]=__builtin_amdgcn_mfma_f32_32x32x16_bf16(PAF(2),VFR(6),o[1],0,0,0), C1,4); \
    GAPB(o[0]=__builtin_amdgcn_mfma_f32_32x32x16_bf16(PAF(3),VFR(3),o[0],0,0,0), C1,8); \
    GAPB(o[1]=__builtin_amdgcn_mfma_f32_32x32x16_bf16(PAF(3),VFR(7),o[1],0,0,0), C1,12); \
    }while(0)
  int t=1;
  #undef CMASK
  #define CMASK(P0,P1,t) do{}while(0)
  for(;t+5<NT;t+=2){
    STEP(pB0,pB1,pA0,pA1,t,true,true,true);     WAIT_BAR(2); RESC(); ROT();
    STEP(pA0,pA1,pB0,pB1,t+1,true,true,true);   WAIT_BAR(2); RESC(); ROT();
  }
  #undef CMASK
  #define CMASK(P0,P1,t) do{int jb_=(t)-(NT-4); if(jb_>=0)cmask(P0,P1,jb_,qrel,hi);}while(0)
  #define ENDW(tt) do{ if((tt)+3<NT){WAIT_BAR(2);} else if((tt)+2<NT){WAIT_BAR(1);} else {WAIT_BAR(0);} }while(0)
  for(;t+1<NT;t+=2){
    STEP(pB0,pB1,pA0,pA1,t,(t+3<NT),(t+1<NT),(t+1<NT));       ENDW(t);   RESC(); ROT();
    STEP(pA0,pA1,pB0,pB1,t+1,(t+4<NT),(t+2<NT),(t+2<NT));     ENDW(t+1); RESC(); ROT();
  }
  STEP(pB0,pB1,pA0,pA1,NT-1,false,false,false); RESC();
  { float sacc=pB0[0]+pB0[1]; _Pragma("unroll") for(int r=2;r<16;++r)sacc+=pB0[r]; _Pragma("unroll") for(int r=0;r<16;++r)sacc+=pB1[r]; l_reg+=sacc;
    pw0=(u32x4){PKW(pB0,0),PKW(pB0,2),PKW(pB0,4),PKW(pB0,6)};pw1=(u32x4){PKW(pB0,8),PKW(pB0,10),PKW(pB0,12),PKW(pB0,14)};pw2=(u32x4){PKW(pB1,0),PKW(pB1,2),PKW(pB1,4),PKW(pB1,6)};pw3=(u32x4){PKW(pB1,8),PKW(pB1,10),PKW(pB1,12),PKW(pB1,14)};
    SBAR(); pv(o,vb0+sl_cur,PAF(0),PAF(1),PAF(2),PAF(3)); }
  #undef PKW
  #undef PAF
  #undef VFR
  #undef PIN
  #undef MX3
  #undef GAPA
  #undef GAPB
  #undef EX
  #undef VRD
  #undef KRD
  #undef STEP
  #undef ENDW
  {auto rr=__builtin_amdgcn_permlane32_swap(__float_as_uint(l_reg),__float_as_uint(l_reg),false,false);l_reg=__uint_as_float(rr[0])+__uint_as_float(rr[1]);}
  if(hi==0)wsf[32+r32]=l_reg;asm volatile("s_waitcnt lgkmcnt(0)":::"memory");
  float rli[16];
  #pragma unroll
  for(int r=0;r<16;++r)rli[r]=__builtin_amdgcn_rcpf(wsf[32+crow(r,hi)]);
  bf16*Ow=O+(rowbase+q0+wid*QBLK)*DM+h*D;
  { bf16*stg=(bf16*)(shm+LDS_OST)+wid*2048;
    #pragma unroll
    for(int r=0;r<16;++r){const int orow=crow(r,hi);
      #pragma unroll
      for(int d0=0;d0<2;++d0)stg[orow*64+d0*32+r32]=__float2bfloat16(o[d0][r]*rli[r]);}
    asm volatile("s_waitcnt lgkmcnt(0)":::"memory");
    #pragma unroll
    for(int i=0;i<4;++i){const int row=i*8+(lane>>3),ch=lane&7; const u32x4 v=*(const u32x4*)(stg+row*64+ch*8); ATTN_STORE16(Ow+(long)row*DM+ch*8,v);} }
  asm volatile("s_waitcnt lgkmcnt(0)\n\ts_barrier":::"memory");
  #undef DMA_K
  #undef DMA_V
  #undef CMASK
  #undef BIASLD
  #undef START
  #undef RESC
  #undef ROT
}
constexpr int ATTN_LDS_BYTES=LDS_BYTES;
struct AttnTensors { const bf16* Q; const bf16* K; const bf16* V; bf16* O; };
struct AttnUnit { int bh; int qb; };
struct StaticOrder {
  int vcu;
  __device__ __forceinline__ explicit StaticOrder(int grid,int block):vcu((block%8)*(grid/8)+block/8){}
  __device__ __forceinline__ bool next(int i,AttnUnit&u)const{ if(i>=4)return false; const int s=vcu&3; u.bh=vcu>>2; u.qb=(i==0)?s:(i==1)?7-s:(i==2)?8+s:15-s; return true; }
};
template<class Sched,int THRL=8> __device__ __forceinline__ void attn_phase(char*lds,const AttnTensors&T,const Sched&S,const __attribute__((address_space(3))) float*bl,const int tid,const __attribute__((address_space(3))) int*tsk){
  AttnUnit u;
  for(int i=0;S.next(i,u);++i){ attn_unit<THRL>(u.bh/NHEAD,u.bh%NHEAD,u.qb,T.Q,T.K,T.V,T.O,lds,bl,tid,__builtin_amdgcn_readfirstlane(tsk[i])); }
}
#undef SBAR
#undef WAIT_BAR
}
namespace mk {
#define LAS __attribute__((address_space(3)))
#define XB_TMO      128
#define XB_XCNT(j)  (256  + 64 * (j))
#define XB_XSUB(j)  (1280 + 64 * (j))
#define XB_XGEN(j)  (2304 + 64 * (j))
#define XB_TOP      3328
#define XB_TOPGEN   3392
#define XCD_BAR_WORDS 3456
#define XB_SPIN_CAP (1u << 18)

__device__ __forceinline__ unsigned xb_ld(unsigned* p)              { return __hip_atomic_load(p, __ATOMIC_RELAXED, __HIP_MEMORY_SCOPE_AGENT); }
__device__ __forceinline__ unsigned xb_add(unsigned* p, unsigned v) { return __hip_atomic_fetch_add(p, v, __ATOMIC_RELAXED, __HIP_MEMORY_SCOPE_AGENT); }
__device__ __forceinline__ unsigned xb_xcc_id() { return (unsigned)__builtin_amdgcn_s_getreg((3 << 11) | 20) & 0xFu; }
#define XB_SPIN(cond, bar) do { unsigned _sp = 0; while (cond) { __builtin_amdgcn_s_sleep(1); \
    if ((++_sp & 255u) == 0u) { if (xb_ld(&(bar)[XB_TMO])) break; if (_sp > XB_SPIN_CAP) { atomicAdd(&(bar)[XB_TMO], 1u); break; } } } } while (0)

struct XcdBarrier {
    unsigned* bar; unsigned x;
    volatile LAS unsigned* st;
};

__device__ __forceinline__ XcdBarrier xcd_barrier_post(unsigned* bar, volatile LAS unsigned* st) {
    XcdBarrier b; b.bar = bar; b.x = xb_xcc_id(); b.st = st;
    if (threadIdx.x == 0) (void)xb_add(&bar[XB_XCNT(b.x)], 1u);
    return b;
}
__device__ __forceinline__ void xcd_barrier_complete(unsigned* bar, unsigned x, unsigned& nloc, unsigned& nx) {
    const unsigned G = gridDim.x * gridDim.y * gridDim.z;
    unsigned sum, cnt, mine, sp = 0u;
    for (;;) {
        sum = 0u; cnt = 0u; mine = 0u;
#pragma unroll
        for (unsigned j = 0; j < 16; ++j) { const unsigned c = xb_ld(&bar[XB_XCNT(j)]); sum += c; cnt += (c > 0u) ? 1u : 0u; mine = (j == x) ? c : mine; }
        if (sum == G) break;
        __builtin_amdgcn_s_sleep(1);
        if ((++sp & 255u) == 0u) { if (xb_ld(&bar[XB_TMO])) break; if (sp > XB_SPIN_CAP) { atomicAdd(&bar[XB_TMO], 1u); break; } }
    }
    nloc = mine > 0u ? mine : 1u; nx = cnt > 0u ? cnt : 1u;
}

__device__ __forceinline__ void xcd_barrier(const XcdBarrier& b) {
    asm volatile("s_waitcnt vmcnt(0)" ::: "memory");
    __syncthreads();
    if (threadIdx.x == 0) {
        unsigned* bar = b.bar;
        __builtin_amdgcn_s_waitcnt(0);
        unsigned nloc = b.st[0], nx = b.st[1];
        if (nloc == 0u) { xcd_barrier_complete(bar, b.x, nloc, nx); b.st[0] = nloc; b.st[1] = nx; }
        const unsigned old = xb_add(&bar[XB_XSUB(b.x)], 1u);
        const unsigned gen = old / nloc;
        if (old + 1u == (gen + 1u) * nloc) {
            __builtin_amdgcn_fence(__ATOMIC_RELEASE, "agent");
            asm volatile("s_waitcnt vmcnt(0)" ::: "memory");
            const unsigned og = xb_add(&bar[XB_TOP], 1u);
            const unsigned tg = og / nx;
            if (og + 1u == (tg + 1u) * nx) xb_add(&bar[XB_TOPGEN], 1u);
            else XB_SPIN(xb_ld(&bar[XB_TOPGEN]) == tg, bar);
            __builtin_amdgcn_fence(__ATOMIC_ACQUIRE, "agent");
            xb_add(&bar[XB_XGEN(b.x)], 1u);
            asm volatile("s_waitcnt vmcnt(0)" ::: "memory");
        } else {
            XB_SPIN(xb_ld(&bar[XB_XGEN(b.x)]) == gen, bar);
            __builtin_amdgcn_fence(__ATOMIC_ACQUIRE, "agent");
            asm volatile("s_waitcnt vmcnt(0)" ::: "memory");
        }
    }
    __syncthreads();
}

#undef LAS
}
namespace mk {
constexpr int NWAVES = 8;
constexpr int D = 1024, BATCH = 4, SEQ = 4096, M = BATCH * SEQ, DEPTH = 4, NH = 16, HD = 64, FOX_IN = 3 * D + NH, DFF = 2816;
constexpr int SG = 64, SP = 64, SC = 16;
constexpr float RMS_EPS = 1e-6f;
constexpr size_t MiB = 1u << 20;
constexpr size_t WS_CTL = 276 * MiB, CTL_ZERO_BYTES = 3 * MiB;
constexpr size_t WS_SSQ = 277 * MiB;
constexpr size_t WS_WQKV = 2 * MiB;
constexpr size_t WS_WO = 14 * MiB;
constexpr size_t WS_WS5IN = 18 * MiB;
constexpr size_t WS_WGLU = 20 * MiB;
constexpr size_t WS_BTA = 24 * MiB;
constexpr size_t WS_BTB = 32 * MiB;
constexpr size_t WS_WPOOL = 44 * MiB;
constexpr size_t WS_WF = 44 * MiB + 512 * 1024;
constexpr size_t WS_KERN = 45 * MiB;
constexpr size_t WS_LAMC = 46 * MiB;
constexpr size_t WS_LF = 47 * MiB;
constexpr size_t WS_WGU = 48 * MiB;
constexpr size_t WS_WDN = 92 * MiB;
constexpr size_t WS_XB = 114 * MiB;
constexpr size_t WS_ACT = 146 * MiB;
constexpr size_t WS_O = 244 * MiB;
constexpr size_t WS_NRM = 279 * MiB;
constexpr size_t WS_END = 283 * MiB;
constexpr int CW_TMO = 0, CW_BAR = 4096, CW_PANEL = 16384, CW_QUEUE = 24576;

constexpr int RING_OFF = 0, RING_BYTES = 131072;
constexpr int LDSCTL_OFF = RING_BYTES, MISC_OFF = LDSCTL_OFF + 320;
constexpr int LDS_BYTES = 147456;

#define GAS __attribute__((address_space(1)))
#define LAS __attribute__((address_space(3)))
typedef unsigned short bf16;
typedef unsigned v4u __attribute__((ext_vector_type(4)));
typedef float f32x4 __attribute__((ext_vector_type(4)));
typedef float f32x2 __attribute__((ext_vector_type(2)));
typedef short bf16x8 __attribute__((ext_vector_type(8)));
typedef GAS unsigned gu32;
#define RLX_AGENT __ATOMIC_RELAXED, __HIP_MEMORY_SCOPE_AGENT
#define LDS_WAIT() asm volatile("s_waitcnt lgkmcnt(0)" ::: "memory")
#define VM_WAIT() asm volatile("s_waitcnt vmcnt(0)" ::: "memory")
__device__ __forceinline__ unsigned f2bf(float f) { unsigned u = __builtin_bit_cast(unsigned, f); return (u + 0x7fffu + ((u >> 16) & 1u)) >> 16; }
__device__ __forceinline__ unsigned pk2(float lo, float hi) { return f2bf(lo) | (f2bf(hi) << 16); }
__device__ __forceinline__ float bf2f(unsigned short b) { return __builtin_bit_cast(float, (unsigned)b << 16); }
__device__ __forceinline__ float lshx(float v, int lane, int m) { return __builtin_bit_cast(float, __builtin_amdgcn_ds_bpermute((lane ^ m) << 2, __builtin_bit_cast(int, v))); }
__device__ __forceinline__ float wave_sum(float v, int lane) {
#pragma unroll
    for (int o = 1; o < 64; o <<= 1) v += lshx(v, lane, o);
    return v;
}

enum Op { OP_PROLOGUE = 0, OP_QKV, OP_ATTN, OP_WO, OP_UP, OP_DOWN, OP_S5IN, OP_SSM, OP_SSMB, OP_GLU, OP_POOLPREP, OP_POOLGEMM, OP_FINAL, OP_NORMX, OP_S5TAB };
struct PhaseEnt { int op, layer, j, sin, sout; };
#define MK_PROGRAM \
    {OP_PROLOGUE, 0, 0, 0, 0}, \
    {OP_QKV, 0, 0, 0, 0}, {OP_ATTN, 0, 0, 0, 0}, {OP_WO, 0, 0, 0, 1}, {OP_UP, 0, 0, 1, 0}, {OP_DOWN, 0, 0, 0, 2}, \
    {OP_S5IN, 1, 0, 2, 0}, {OP_SSM, 1, 0, 0, 0}, {OP_GLU, 1, 0, 0, 3}, {OP_UP, 1, 0, 3, 0}, {OP_DOWN, 1, 0, 0, 4}, \
    {OP_POOLGEMM, 2, 0, 4, 5}, {OP_UP, 2, 0, 5, 0}, {OP_DOWN, 2, 0, 0, 6}, \
    {OP_QKV, 3, 1, 6, 0}, {OP_ATTN, 3, 1, 0, 0}, {OP_WO, 3, 1, 0, 7}, {OP_UP, 3, 0, 7, 0}, {OP_DOWN, 3, 0, 0, 8}, \
    {OP_FINAL, 0, 0, 8, 0}, \
    {OP_NORMX, 0, 0, 0, 1}, {OP_NORMX, 0, 0, 0, 2}, {OP_NORMX, 0, 0, 0, 3}, {OP_NORMX, 0, 0, 0, 4}, {OP_NORMX, 0, 0, 0, 5}, {OP_NORMX, 0, 0, 0, 6}, {OP_NORMX, 0, 0, 0, 7}, {OP_NORMX, 0, 0, 0, 8}, \
    {OP_S5TAB, 0, 0, 0, 0}
constexpr int N_PROG = 29, PH_FINAL = 19, PH_LAST = 18, PH_NORMX1 = 20, PH_S5TAB = 28;
__constant__ PhaseEnt PROG[N_PROG] = { MK_PROGRAM };

struct Args { const float* in[22]; float* out; unsigned char* ws; int ph_lo, ph_hi; };

__device__ __forceinline__ void wt_load(f32x4 (&v)[8], const float* W, int ldw, int n0_src, int k0, int lane) {
    const int c4 = lane & 7, r8 = lane >> 3;
    const GAS f32x4* src = (const GAS f32x4*)(W + (size_t)(k0 + r8) * ldw + n0_src + 4 * c4);
#pragma unroll
    for (int i = 0; i < 8; ++i) v[i] = MK_WNT ? __builtin_nontemporal_load(src + (size_t)i * 2 * ldw) : src[(size_t)i * 2 * ldw];
}
__device__ __forceinline__ void wt_store(f32x4 (&v)[8], int K, const float* gain, bf16* WT, int n0_dst, int k0, LAS float* scr, int lane) {
    const int c4 = lane & 7, r8 = lane >> 3;
    if (gain) {
#pragma unroll
        for (int i = 0; i < 8; ++i) v[i] = v[i] * gain[k0 + r8 + 8 * i]; }
#pragma unroll
    for (int i = 0; i < 8; ++i) { LAS float* d = scr + (r8 + 8 * i) * 33 + 4 * c4; d[0] = v[i].x; d[1] = v[i].y; d[2] = v[i].z; d[3] = v[i].w; }
    LDS_WAIT(); asm volatile("" ::: "memory");
    const int c = lane & 7;
#pragma unroll
    for (int j = 0; j < 4; ++j) { const int n = (lane >> 3) + 8 * j; const LAS float* s = scr + (8 * c) * 33 + n;
        v4u o; o.x = pk2(s[0 * 33], s[1 * 33]); o.y = pk2(s[2 * 33], s[3 * 33]); o.z = pk2(s[4 * 33], s[5 * 33]); o.w = pk2(s[6 * 33], s[7 * 33]);
        pg8::st_wt((GAS bf16*)WT + (size_t)(n0_dst + n) * K + k0 + 8 * c, o); }
    LDS_WAIT(); asm volatile("" ::: "memory");
}
__device__ __forceinline__ void wt_item(const float* W, int ldw, int K, const float* gain, bf16* WT, int n0_dst, int n0_src, int k0, LAS float* scr, int lane) {
    f32x4 v[8]; wt_load(v, W, ldw, n0_src, k0, lane); wt_store(v, K, gain, WT, n0_dst, k0, scr, lane);
}
template <int NR> __device__ __forceinline__ void normx_rows(const float* x0, size_t xstride, bf16* o0, size_t ostride, pg8::ssq_t* ssq0, size_t sstride, int lane) {
    f32x4 v[NR][4]; float s[NR];
#pragma unroll
    for (int r = 0; r < NR; ++r) { const GAS f32x4* xr = (const GAS f32x4*)(x0 + r * xstride) + lane;
#pragma unroll
        for (int j = 0; j < 4; ++j) v[r][j] = xr[64 * j]; }
#pragma unroll
    for (int r = 0; r < NR; ++r) { s[r] = 0.f;
#pragma unroll
        for (int j = 0; j < 4; ++j) s[r] += (v[r][j].x * v[r][j].x + v[r][j].y * v[r][j].y) + (v[r][j].z * v[r][j].z + v[r][j].w * v[r][j].w);
        s[r] = wave_sum(s[r], lane); }
#pragma unroll
    for (int r = 0; r < NR; ++r) { GAS unsigned long long* o8 = (GAS unsigned long long*)(o0 + r * ostride) + lane;
#pragma unroll
        for (int j = 0; j < 4; ++j) pg8::st_wt(o8 + 64 * j, (unsigned long long)pk2(v[r][j].x, v[r][j].y) | ((unsigned long long)pk2(v[r][j].z, v[r][j].w) << 32));
        if (lane == 0) ssq0[r * sstride] = (pg8::ssq_t)__builtin_llrintf(s[r] * pg8::SSQ_SCALE); }
}
__device__ __forceinline__ void normx_row(const float* xrow, bf16* orow, pg8::ssq_t* ssq_slot, int lane) { normx_rows<1>(xrow, 0, orow, 0, ssq_slot, 0, lane); }
__device__ __forceinline__ f32x4 bf4(const pg8::u32x2 w) { return (f32x4){__builtin_bit_cast(float, w.x << 16), __builtin_bit_cast(float, w.x & 0xffff0000u), __builtin_bit_cast(float, w.y << 16), __builtin_bit_cast(float, w.y & 0xffff0000u)}; }
template <int W> __device__ __forceinline__ void pool_item(const bf16* X, const pg8::ssq_t* ssq, const f32x4 gg, bf16* PD, int row0, int t0, int c0) {
    f32x4 ring[W]; f32x4 run = {0.f, 0.f, 0.f, 0.f};
    { pg8::u32x2 xw[W]; pg8::ssq_t sw[W];
#pragma unroll
      for (int kk = 1; kk < W; ++kk) { xw[kk] = (pg8::u32x2){0u, 0u}; sw[kk] = 0;
          if (t0 - W + kk >= 0) { const int r = row0 - W + kk; xw[kk] = *(const GAS pg8::u32x2*)(X + (size_t)r * D + c0); sw[kk] = ((const GAS pg8::ssq_t*)ssq)[r]; } }
#pragma unroll
      for (int kk = 1; kk < W; ++kk) {
          const f32x4 hv = bf4(xw[kk]) * __builtin_amdgcn_rsqf((float)sw[kk] * (1.0f / (1024.0f * pg8::SSQ_SCALE)) + RMS_EPS) * gg;
          ring[kk % W] = hv; run += hv; } }
    pg8::u32x2 xc[16]; pg8::ssq_t sc[16];
#pragma unroll
    for (int i = 0; i < 16; ++i) { xc[i] = *(const GAS pg8::u32x2*)(X + (size_t)(row0 + i) * D + c0); sc[i] = ((const GAS pg8::ssq_t*)ssq)[row0 + i]; }
#pragma unroll
    for (int i = 0; i < 16; ++i) { const int r = row0 + i, t = t0 + i;
        const f32x4 hv = bf4(xc[i]) * __builtin_amdgcn_rsqf((float)sc[i] * (1.0f / (1024.0f * pg8::SSQ_SCALE)) + RMS_EPS) * gg;
        run += hv; ring[i % W] = hv;
        const int cnt = (t + 1 < W) ? (t + 1) : W; const f32x4 o = run * (1.0f / (float)cnt) - hv;
        pg8::st_wt((GAS bf16*)PD + (size_t)r * D + c0, (unsigned long long)pk2(o[0], o[1]) | ((unsigned long long)pk2(o[2], o[3]) << 32));
        run -= ring[(i + 1) % W]; }
}
__device__ __forceinline__ void touch_lines(const void* p, int bytes, int tid) {
    const GAS unsigned* q = (const GAS unsigned*)p + tid * 32; unsigned acc = 0;
    for (int o = 0; o < bytes; o += 512 * 128 * 8) {
#pragma unroll
        for (int i = 0; i < 8; ++i) acc |= q[(size_t)(o / 4) + (size_t)i * 512 * 32];
    }
    asm volatile("" :: "v"(acc));
}
struct WtDesc { const float* W; const float* gain; bf16* WT; int ldw, K, Ndst, kind, off2; };
__device__ __forceinline__ WtDesc wt_desc(const Args& args, int i) {
    unsigned char* ws = args.ws; const float* mix_g = args.in[1]; const float* ffn_g = args.in[2];
    WtDesc d;
    if (i < 2) { d.W = args.in[4] + (size_t)i * D * FOX_IN; d.gain = mix_g + (i ? 3 * D : 0); d.WT = (bf16*)(ws + WS_WQKV) + (size_t)i * 3 * D * D; d.ldw = FOX_IN; d.K = D; d.Ndst = 3 * D; d.kind = 0; d.off2 = 0; }
    else if (i < 4) { d.W = args.in[6] + (size_t)(i - 2) * D * D; d.gain = nullptr; d.WT = (bf16*)(ws + WS_WO) + (size_t)(i - 2) * D * D; d.ldw = D; d.K = D; d.Ndst = D; d.kind = 0; d.off2 = 0; }
    else if (i == 4) { d.W = args.in[7]; d.gain = mix_g + D; d.WT = (bf16*)(ws + WS_WS5IN); d.ldw = D; d.K = D; d.Ndst = D; d.kind = 0; d.off2 = 0; }
    else if (i == 5) { d.W = args.in[16]; d.gain = nullptr; d.WT = (bf16*)(ws + WS_WGLU); d.ldw = 2 * D; d.K = D; d.Ndst = 2 * D; d.kind = 1; d.off2 = D; }
    else if (i < 10) { d.W = args.in[17] + (size_t)(i - 6) * 65536; d.gain = nullptr; d.WT = (bf16*)(ws + WS_WPOOL) + (size_t)(i - 6) * 65536; d.ldw = 256; d.K = 256; d.Ndst = 256; d.kind = 0; d.off2 = 0; }
    else if (i < 14) { d.W = args.in[20] + (size_t)(i - 10) * D * 2 * DFF; d.gain = ffn_g + (i - 10) * D; d.WT = (bf16*)(ws + WS_WGU) + (size_t)(i - 10) * 2 * DFF * D; d.ldw = 2 * DFF; d.K = D; d.Ndst = 2 * DFF; d.kind = 1; d.off2 = DFF; }
    else { d.W = args.in[21] + (size_t)(i - 14) * DFF * D; d.gain = nullptr; d.WT = (bf16*)(ws + WS_WDN) + (size_t)(i - 14) * D * DFF; d.ldw = D; d.K = DFF; d.Ndst = D; d.kind = 0; d.off2 = 0; }
    return d;
}
__device__ __forceinline__ void ph_s5tables(const Args& args, LAS float* scr, LAS float* wsc, int gw, int NGW, int lane) {
    unsigned char* ws = args.ws;
    { const float* a_re = args.in[8]; const float* a_im = args.in[9]; const float* log_dt = args.in[10];
      const float* b_re = args.in[11]; const float* b_im = args.in[12]; const float* c_re = args.in[13]; const float* c_im = args.in[14];
      float* KERN = (float*)(ws + WS_KERN);
      for (int it = (gw + NGW / 2) % NGW; it < SG * 16; it += NGW) {
          const int g = it >> 4, tau = it & 15, p = lane;
          { const GAS f32x4* s0 = (const GAS f32x4*)(c_re + (size_t)g * 1024), *s1 = (const GAS f32x4*)(c_im + (size_t)g * 1024), *s2 = (const GAS f32x4*)(b_re + (size_t)g * 1024), *s3 = (const GAS f32x4*)(b_im + (size_t)g * 1024);
            f32x4 t0[4], t1[4], t2[4], t3[4];
#pragma unroll
            for (int j = 0; j < 4; ++j) { t0[j] = s0[lane + 64 * j]; t1[j] = s1[lane + 64 * j]; t2[j] = s2[lane + 64 * j]; t3[j] = s3[lane + 64 * j]; }
#pragma unroll
            for (int j = 0; j < 4; ++j) { ((LAS f32x4*)scr)[lane + 64 * j] = t0[j]; ((LAS f32x4*)scr)[256 + lane + 64 * j] = t1[j]; ((LAS f32x4*)scr)[512 + lane + 64 * j] = t2[j]; ((LAS f32x4*)scr)[768 + lane + 64 * j] = t3[j]; } }
          const double lr = a_re[g * SP + p], li = a_im[g * SP + p], dt = exp((double)log_dt[g]);
          const double er = exp(lr * dt), lbr = er * cos(li * dt), lbi = er * sin(li * dt);
          const double nr = lbr - 1.0, ni = lbi, den = lr * lr + li * li, fr = (nr * lr + ni * li) / den, fi = (ni * lr - nr * li) / den;
          const double et = exp(lr * dt * tau), ptr_ = et * cos(li * dt * tau), pti = et * sin(li * dt * tau);
          wsc[p] = (float)(ptr_ * fr - pti * fi); wsc[64 + p] = (float)(ptr_ * fi + pti * fr);
          LDS_WAIT(); asm volatile("" ::: "memory");
          const LAS float* Cr = scr, *Ci = scr + 1024, *Br = scr + 2048, *Bi = scr + 3072, *Wr_ = wsc, *Wi_ = wsc + 64;
          float acc[4] = {0.f, 0.f, 0.f, 0.f}; const int ci = lane & 15, cob = lane >> 4;
#pragma unroll 8
          for (int pp = 0; pp < SP; ++pp) {
              const float wr = Wr_[pp], wi = Wi_[pp], br = Br[pp * 16 + ci], bi = Bi[pp * 16 + ci];
#pragma unroll
              for (int q = 0; q < 4; ++q) { const int co = cob + 4 * q; const float cr = Cr[co * 64 + pp], cim = Ci[co * 64 + pp];
                  const float cwr = cr * wr - cim * wi, cwi = cr * wi + cim * wr; acc[q] += cwr * br - cwi * bi; } }
#pragma unroll
          for (int q = 0; q < 4; ++q) KERN[(size_t)it * 256 + lane + 64 * q] = acc[q];
          LDS_WAIT(); asm volatile("" ::: "memory");
      }
      bf16* BTA = (bf16*)(ws + WS_BTA);
      for (int e = gw * 64 + lane; e < SG * 128 * 16; e += NGW * 64) {
          const int g = e >> 11, n = (e >> 4) & 127, j = e & 15, p = n & 63, im = n >> 6;
          const double lr = a_re[g * SP + p], li = a_im[g * SP + p], dt = exp((double)log_dt[g]);
          const double er = exp(lr * dt), lbr = er * cos(li * dt), lbi = er * sin(li * dt);
          const double nr = lbr - 1.0, ni = lbi, den = lr * lr + li * li, fr = (nr * lr + ni * li) / den, fi = (ni * lr - nr * li) / den;
          const double tt = (double)(15 - j), et = exp(lr * dt * tt), ptr_ = et * cos(li * dt * tt), pti = et * sin(li * dt * tt);
          const float Wr = (float)(ptr_ * fr - pti * fi), Wi = (float)(ptr_ * fi + pti * fr);
          unsigned w[8];
#pragma unroll
          for (int c = 0; c < 16; c += 2) { float v[2];
#pragma unroll
              for (int q = 0; q < 2; ++q) { const float br = b_re[(g * SP + p) * SC + c + q], bi = b_im[(g * SP + p) * SC + c + q]; v[q] = im ? (Wr * bi + Wi * br) : (Wr * br - Wi * bi); }
              w[c >> 1] = pk2(v[0], v[1]); }
          v4u* dst = (v4u*)(BTA + ((size_t)g * 256 + n) * 256 + j * 16);
          dst[0] = (v4u){w[0], w[1], w[2], w[3]}; dst[1] = (v4u){w[4], w[5], w[6], w[7]};
      }
      for (int e = gw * 64 + lane; e < SG * 128 * 32; e += NGW * 64) { const int g = e >> 12, r = e & 4095; ((v4u*)(BTA + ((size_t)g * 256 + 128) * 256))[r] = (v4u){0u, 0u, 0u, 0u}; }
      bf16* BTB = (bf16*)(ws + WS_BTB);
      for (int e = gw * 64 + lane; e < SG * 16 * SP; e += NGW * 64) {
          const int g = e >> 10, i = (e >> 6) & 15, p = e & 63;
          const double lr = a_re[g * SP + p], li = a_im[g * SP + p], dt = exp((double)log_dt[g]);
          const double tt = (double)(i + 1), et = exp(lr * dt * tt); const float pr = (float)(et * cos(li * dt * tt)), pi_ = (float)(et * sin(li * dt * tt));
          float crv[16], civ[16];
#pragma unroll
          for (int co = 0; co < 16; ++co) { crv[co] = c_re[(g * SC + co) * SP + p]; civ[co] = c_im[(g * SC + co) * SP + p]; }
#pragma unroll
          for (int co = 0; co < 16; ++co) { const float cr = crv[co], cim = civ[co];
              bf16* row = BTB + ((size_t)g * 256 + i * 16 + co) * 384 + 256;
              row[p] = (bf16)f2bf(cr * pr - cim * pi_); row[64 + p] = (bf16)f2bf(-(cr * pi_ + cim * pr)); }
      }
      float* LAMC = (float*)(ws + WS_LAMC);
      for (int e = gw * 64 + lane; e < SG * SP; e += NGW * 64) {
          const double lr = a_re[e], li = a_im[e], dt = exp((double)log_dt[e >> 6]), et = exp(lr * dt * 16.0);
          LAMC[2 * e] = (float)(et * cos(li * dt * 16.0)); LAMC[2 * e + 1] = (float)(et * sin(li * dt * 16.0)); }
    }
}
__device__ __forceinline__ bool wt_one(const Args& args, LAS float* scr, unsigned mask, int it, int lane) {
    constexpr int NMAT = 18; int base = 0;
    for (int mi = 0; mi < NMAT; ++mi) { if (!((mask >> mi) & 1u)) continue;
        const WtDesc d = wt_desc(args, mi); const int n_it = (d.K / 64) * (d.Ndst / 32);
        if (it < base + n_it) { const int r = it - base, nblk = d.Ndst / 32, kb = r / nblk, nb = r % nblk, n0 = nb * 32; int ns = n0;
            if (d.kind == 1) { const int pn = n0 >> 8, j = n0 & 255; ns = (j < 128) ? (128 * pn + j) : (d.off2 + 128 * pn + (j - 128)); }
            wt_item(d.W, d.ldw, d.K, d.gain, d.WT, n0, ns, kb * 64, scr, lane); return true; }
        base += n_it; }
    return false;
}
struct WtWork { const float* gain; bf16* WT; int K, n0, k0; bool ok; };
__device__ __forceinline__ WtWork wt_fetch(const Args& args, unsigned mask, int it, f32x4 (&v)[8], int lane) {
    constexpr int NMAT = 18; int base = 0; WtWork w{}; w.ok = false;
    for (int mi = 0; mi < NMAT; ++mi) { if (!((mask >> mi) & 1u)) continue;
        const WtDesc d = wt_desc(args, mi); const int n_it = (d.K / 64) * (d.Ndst / 32);
        if (it < base + n_it) { const int r = it - base, nblk = d.Ndst / 32, kb = r / nblk, nb = r % nblk, n0 = nb * 32; int ns = n0;
            if (d.kind == 1) { const int pn = n0 >> 8, j = n0 & 255; ns = (j < 128) ? (128 * pn + j) : (d.off2 + 128 * pn + (j - 128)); }
            wt_load(v, d.W, d.ldw, ns, kb * 64, lane); w.gain = d.gain; w.WT = d.WT; w.K = d.K; w.n0 = n0; w.k0 = kb * 64; w.ok = true; return w; }
        base += n_it; }
    return w;
}
__device__ __forceinline__ void ph_weights(const Args& args, LAS float* scr, unsigned mask, int rk, int nw, int lane) {
    f32x4 va[8], vb[8];
    WtWork wa = wt_fetch(args, mask, rk, va, lane);
    for (int it = rk; wa.ok; it += 2 * nw) {
        WtWork wb = wt_fetch(args, mask, it + nw, vb, lane);
        wt_store(va, wa.K, wa.gain, wa.WT, wa.n0, wa.k0, scr, lane);
        if (!wb.ok) break;
        wa = wt_fetch(args, mask, it + 2 * nw, va, lane);
        wt_store(vb, wb.K, wb.gain, wb.WT, wb.n0, wb.k0, scr, lane);
    }
}
__device__ __forceinline__ void ph_wf(const Args& args, int j, int rk, int nw, int lane) {
    for (int e = rk * 64 + lane; e < NH * D; e += nw * 64) { const int h = e >> 10, kk = e & 1023;
        ((bf16*)(args.ws + WS_WF))[j * NH * D + e] = (bf16)f2bf(args.in[4][(size_t)j * D * FOX_IN + (size_t)kk * FOX_IN + 3 * D + h] * args.in[1][(j ? 3 * D : 0) + kk]); }
}
constexpr unsigned WMASK_PRO = (1u << 0);
constexpr unsigned WMASK_ATT = (1u << 2) | (1u << 10) | (1u << 4) | (1u << 5);
constexpr int WATT_ITEMS = 16 * 32 + 16 * 176 + 16 * 32 + 16 * 64;
constexpr unsigned WMASK_L0 = (1u << 14) | (1u << 11);
constexpr unsigned WMASK_L1 = (1u << 15) | (1u << 6) | (1u << 7) | (1u << 8) | (1u << 9) | (1u << 12);
constexpr unsigned WMASK_L2 = (1u << 16) | (1u << 1) | (1u << 3) | (1u << 13);
constexpr unsigned WMASK_L3 = (1u << 17);
__device__ __forceinline__ void ph_prologue(const Args& args, LAS unsigned char* lds, int gw, int NGW, int wave, int lane) {
    unsigned char* ws = args.ws;
    LAS float* scr = (LAS float*)(lds + RING_OFF + wave * 16384);
    ph_weights(args, scr, MK_DEFER_WEIGHTS ? WMASK_PRO : 0x3ffffu, gw, NGW, lane);
    ph_wf(args, 0, gw, NGW, lane); if (!MK_DEFER_WEIGHTS) ph_wf(args, 1, gw, NGW, lane);
    for (int rep_ = 0; rep_ < MK_S5TAB_REPS; ++rep_) ph_s5tables(args, scr, (LAS float*)(lds + LDSCTL_OFF + 8192 + wave * 512), gw, NGW, lane);
    pg8::ssq_t* ssq0 = (pg8::ssq_t*)(ws + WS_SSQ);
    for (int m = gw; m < M; m += NGW) normx_row(args.in[0] + (size_t)m * D, (bf16*)(ws + WS_XB) + (size_t)m * D, ssq0 + m, lane);
}

__device__ __forceinline__ void ph_toeplitz(unsigned char* ws, int rk, int nw, int lane) {
    const float* KERN = (const float*)(ws + WS_KERN); bf16* BTB = (bf16*)(ws + WS_BTB);
    for (int e2 = rk * 64 + lane; e2 < SG * 256 * 16; e2 += nw * 64) { const int g = e2 >> 12, n = (e2 >> 4) & 255, j = e2 & 15, i = n >> 4, co = n & 15;
        v4u o0 = {0u, 0u, 0u, 0u}, o1 = {0u, 0u, 0u, 0u};
        if (i >= j) { const f32x4* kp = (const f32x4*)(KERN + (((size_t)g * 16 + (i - j)) * 16 + co) * 16); const f32x4 a = kp[0], b = kp[1], c = kp[2], d = kp[3];
            o0 = (v4u){pk2(a[0], a[1]), pk2(a[2], a[3]), pk2(b[0], b[1]), pk2(b[2], b[3])}; o1 = (v4u){pk2(c[0], c[1]), pk2(c[2], c[3]), pk2(d[0], d[1]), pk2(d[2], d[3])}; }
        v4u* dst = (v4u*)(BTB + ((size_t)g * 256 + n) * 384 + j * 16); dst[0] = o0; dst[1] = o1; }
}
__global__ void __launch_bounds__(NWAVES * 64, 2) mega_k(Args args) {
    extern __shared__ __attribute__((aligned(16))) unsigned char lds_raw[];
    LAS unsigned char* lds = (LAS unsigned char*)lds_raw;
    const int vcu0 = (gridDim.x % 8 == 0) ? (blockIdx.x % 8) * (gridDim.x / 8) + blockIdx.x / 8 : blockIdx.x;
    const int vcu = vcu0, NGW = gridDim.x * NWAVES, wave0 = __builtin_amdgcn_readfirstlane(threadIdx.x >> 6);
    for (int u = threadIdx.x; u < (LDS_BYTES - LDSCTL_OFF) / 4; u += NWAVES * 64) ((LAS unsigned*)(lds + LDSCTL_OFF))[u] = 0u;
    __syncthreads();
    MK_BAR_SETUP();
    int e0 = args.ph_lo;
    if (e0 == PH_S5TAB) { const int tid = threadIdx.x, lane = tid & 63, wave = __builtin_amdgcn_readfirstlane(tid >> 6); ph_s5tables(args, (LAS float*)(lds + RING_OFF + wave * 16384), (LAS float*)(lds + LDSCTL_OFF + 8192 + wave * 512), vcu * NWAVES + wave, NGW, lane); return; }
    if (e0 == 0) {
        const int tid = threadIdx.x, lane = tid & 63, wave = __builtin_amdgcn_readfirstlane(tid >> 6);
        ph_prologue(args, lds, vcu * NWAVES + wave, NGW, wave, lane);
        e0 = 1;
        if (e0 < args.ph_hi) { MK_GRID_BAR(); }
    }
    for (int e = e0; e < args.ph_hi; ++e) {
#define MK_LANE_TID() int lane_; asm volatile("v_mbcnt_lo_u32_b32 %0, -1, 0\n\tv_mbcnt_hi_u32_b32 %0, -1, %0" : "=v"(lane_)); const int lane = lane_, tid = wave * 64 + lane, gw = vcu * NWAVES + wave; (void)tid; (void)gw; (void)lane
        const int wave = wave0;
        int G = gridDim.x, bx = blockIdx.x, vcu = vcu0; asm volatile("" : "+s"(G), "+s"(bx), "+s"(vcu));
        const int NGW = G * NWAVES;
        unsigned char* ws = args.ws; float* X = args.out; asm volatile("" : "+s"(ws), "+s"(X));
        pg8::ssq_t* SSQ = (pg8::ssq_t*)(ws + WS_SSQ);
        const int op = PROG[e].op, layer = PROG[e].layer, pj = PROG[e].j, sin = PROG[e].sin, sout = PROG[e].sout;
#define MK_XBS(s_) ((s_) == 5 ? (bf16*)X : (bf16*)(ws + WS_XB))
        bf16* XB = MK_XBS(sin);
        (void)pj;
        if (op == OP_NORMX) {
            MK_LANE_TID();
            for (int m = gw; m < M; m += NGW) normx_row(X + (size_t)m * D, XB + (size_t)m * D, SSQ + (size_t)sout * M + m, lane);
        } else if (op == OP_UP) {
            MK_LANE_TID();
            pg8::Gemm g{XB, (const bf16*)(ws + WS_WGU) + (size_t)layer * 2 * DFF * D, D, D, D, 0, 0};
            pg8::StaticOrder S; S.init(M / 256, 2 * DFF / 256, G, bx);
            pg8::EpiSwiGLU E{(bf16*)(ws + WS_ACT), DFF, SSQ + (size_t)sin * M, MK_UP_DUMMY};
            pg8::gemm_phase<pg8::EpiSwiGLU, pg8::StaticOrder, MK_ALIGN_UP>(lds + RING_OFF, tid, g, S, E);
            if (MK_DEFER_WEIGHTS && bx >= 128 && !(MK_UP_DUMMY)) {
                LAS float* scr = (LAS float*)(lds + RING_OFF + wave * 16384); const int rk = (bx - 128) * NWAVES + wave;
                ph_weights(args, scr, layer == 0 ? WMASK_L0 : layer == 1 ? WMASK_L1 : layer == 2 ? WMASK_L2 : WMASK_L3, rk, 128 * NWAVES, lane);
                if (layer == 2) ph_wf(args, 1, rk, 128 * NWAVES, lane); }
        } else if (op == OP_DOWN) {
            MK_LANE_TID();
            pg8::Gemm g{(const bf16*)(ws + WS_ACT), (const bf16*)(ws + WS_WDN) + (size_t)layer * D * DFF, DFF, DFF, DFF, 0, 0};
            pg8::StaticOrder S; S.init(M / 256, D / 256, G, bx);
            if (layer == 3 && !(MK_UP_DUMMY)) {
                pg8::EpiResidFinal E{MK_XBS(sout - 1), X, SSQ + (size_t)sout * M, args.in[3], (unsigned*)(ws + WS_CTL) + CW_PANEL};
                pg8::gemm_phase<pg8::EpiResidFinal, pg8::StaticOrder, false>(lds + RING_OFF, tid, g, S, E);
            } else {
                pg8::EpiResid<0> E{MK_XBS(sout - 1), MK_XBS(sout), SSQ + (size_t)sout * M, args.in[18], nullptr, MK_UP_DUMMY};
                pg8::gemm_phase<pg8::EpiResid<0>, pg8::StaticOrder, true>(lds + RING_OFF, tid, g, S, E); }
        }
        else if (op == OP_QKV) {
            MK_LANE_TID();
            if (MK_TOUCH) touch_lines(XB + (size_t)(8 * (bx & 7) + ((bx >> 3) & 7)) * 256 * D, 256 * D * 2, tid);
            if (!(MK_QKV_NOGATES)) {
              const bf16* WfT = (const bf16*)(ws + WS_WF) + (size_t)pj * NH * D; const pg8::ssq_t* ssq = SSQ + (size_t)sin * M; const float* bfp = args.in[5] + pj * NH; float* LF = (float*)(ws + WS_LF);
#pragma unroll
              for (int i = 0; i < 4; ++i) { const int c = tid + 512 * i; *(LAS v4u*)(lds + (c >> 7) * 2064 + (c & 127) * 16) = ((const GAS v4u*)WfT)[c]; }
              LDS_WAIT(); __syncthreads();
              if (wave < 4) {
                const int r0 = (vcu * 4 + wave) * 16, kq = lane >> 4; const GAS bf16x8* ap = (const GAS bf16x8*)(XB + (size_t)(r0 + (lane & 15)) * D + kq * 8); const LAS unsigned char* bp = lds + (lane & 15) * 2064 + kq * 16;
                bf16x8 afr[32];
#pragma unroll
                for (int ks = 0; ks < 32; ++ks) afr[ks] = ap[ks * 4];
                f32x4 acc = {0.f, 0.f, 0.f, 0.f};
#pragma unroll
                for (int ks = 0; ks < 32; ++ks) acc = __builtin_amdgcn_mfma_f32_16x16x32_bf16(afr[ks], *(const LAS bf16x8*)(bp + ks * 64), acc, 0, 0, 0);
                const int rr = r0 + 4 * kq, hh = lane & 15; const float bb = bfp[hh]; f32x4 o;
#pragma unroll
                for (int i = 0; i < 4; ++i) { const float z = acc[i] * pg8::rstd_row(ssq, rr + i) + bb; o[i] = fminf(z, 0.f) - log1pf(expf(-fabsf(z))); }
                pg8::st_wt((GAS float*)LF + ((size_t)(rr / SEQ) * NH + hh) * SEQ + (rr % SEQ), o); }
              LDS_WAIT(); __syncthreads(); }
            pg8::Gemm g{XB, (const bf16*)(ws + WS_WQKV) + (size_t)pj * 3 * D * D, D, D, D, 0, 0};
            pg8::StaticOrder S; S.init(M / 256, 3 * D / 256, G, bx);
            pg8::EpiQKV E{(bf16*)(ws + WS_ACT), (size_t)16 * MiB, SSQ + (size_t)sin * M, attn_body::C2, (float*)(ws + WS_NRM)};
            pg8::gemm_phase<pg8::EpiQKV, pg8::StaticOrder, true>(lds + RING_OFF, tid, g, S, E);
        } else if (op == OP_ATTN) {
            MK_LANE_TID();
            LAS float* bl = (LAS float*)(lds + RING_OFF + attn_body::ATTN_LDS_BYTES);
            { const float* lf = (const float*)(ws + WS_LF) + (size_t)(vcu >> 2) * SEQ + tid * 8; LAS float* wt = (LAS float*)(lds + LDSCTL_OFF + 1024);
              const f32x4 a = *(const f32x4*)lf, b = *(const f32x4*)(lf + 4);
              float p[8]; p[0] = a[0]; p[1] = p[0] + a[1]; p[2] = p[1] + a[2]; p[3] = p[2] + a[3]; p[4] = p[3] + b[0]; p[5] = p[4] + b[1]; p[6] = p[5] + b[2]; p[7] = p[6] + b[3];
              float tot = p[7];
#pragma unroll
              for (int o = 1; o < 64; o <<= 1) { const float u = __builtin_bit_cast(float, __builtin_amdgcn_ds_bpermute((lane - o) << 2, __builtin_bit_cast(int, tot))); if (lane >= o) tot += u; }
              if (lane == 63) wt[wave] = tot;
              LDS_WAIT(); __syncthreads();
              float off = tot - p[7];
              for (int w = 0; w < wave; ++w) off += wt[w];
#pragma unroll
              for (int i = 0; i < 8; ++i) bl[tid * 8 + i] = -(p[i] + off) * 1.4426950408889634f;
              LDS_WAIT(); __syncthreads(); }
            LAS int* tsk = (LAS int*)(lds + LDSCTL_OFF + 12288);
            for (int prep_ = 0; prep_ < MK_PREPASS_REPS; ++prep_) { LAS float* kn = (LAS float*)(lds + LDSCTL_OFF + 12288 + 64); LAS float* qn = kn + 64;
              const int bh = vcu >> 2, sq = vcu & 3; const size_t rb = (size_t)(bh >> 4) * SEQ; const int hc = (bh & 15) * HD + (lane & 7) * 8;
              (void)hc;
              const int hd = bh & 15; const GAS f32x2* Nk = (const GAS f32x2*)(ws + WS_NRM) + ((size_t)(4 + (hd >> 2)) * M + rb) * 4 + (hd & 3); const GAS f32x2* Nq = (const GAS f32x2*)(ws + WS_NRM) + ((size_t)(hd >> 2) * M + rb) * 4 + (hd & 3);
              { f32x2 v[8];
#pragma unroll
                for (int i = 0; i < 8; ++i) v[i] = Nk[(size_t)(tid * 8 + i) * 4];
                float mx = 0.f;
#pragma unroll
                for (int i = 0; i < 8; ++i) mx = fmaxf(mx, v[i].x + v[i].y);
                mx = fmaxf(mx, lshx(mx, lane, 1)); mx = fmaxf(mx, lshx(mx, lane, 2)); mx = fmaxf(mx, lshx(mx, lane, 4));
                if ((lane & 7) == 0) kn[tid >> 3] = mx; }
              { f32x2 v[2]; const int i = wave >> 1, qb = (i == 0) ? sq : (i == 1) ? 7 - sq : (i == 2) ? 8 + sq : 15 - sq;
#pragma unroll
                for (int jj = 0; jj < 2; ++jj) v[jj] = Nq[(size_t)(qb * 256 + (wave & 1) * 128 + lane * 2 + jj) * 4];
                float mx = fmaxf(v[0].x + v[0].y, v[1].x + v[1].y);
#pragma unroll
                for (int o = 1; o < 64; o <<= 1) mx = fmaxf(mx, lshx(mx, lane, o));
                if (lane == 0) qn[i * 8 + (wave & 1)] = mx; if (lane == 1) { qn[i * 8 + 2 + (wave & 1) * 3] = 0.f; qn[i * 8 + 3 + (wave & 1) * 3] = 0.f; qn[i * 8 + 4 + (wave & 1) * 3] = 0.f; } }
              LDS_WAIT(); __syncthreads();
              if (wave < 4) { const int i = wave, qb = (i == 0) ? sq : (i == 1) ? 7 - sq : (i == 2) ? 8 + sq : 15 - sq, nt = 4 * qb + 4;
                  float q2 = (lane < 8) ? qn[i * 8 + lane] : 0.f, k2 = (lane < nt) ? kn[lane] : 0.f;
#pragma unroll
                  for (int o = 1; o < 64; o <<= 1) { q2 = fmaxf(q2, lshx(q2, lane, o)); k2 = fmaxf(k2, lshx(k2, lane, o)); }
                  const float lim = MK_SKIP_QK * sqrtf(q2) * sqrtf(k2) * 1.01f + 30.0f, bq = bl[qb * 256];
                  const int ts = 2 * lane;
                  const bool okc = (ts + 2 <= nt - 4) && (bq - bl[64 * (ts + 1) + 63] >= lim);
                  const int cntc = __builtin_popcountll(__ballot(okc));
                  if (lane == 0) tsk[i] = 2 * cntc; }
              LDS_WAIT(); __syncthreads(); }
            const attn_body::AttnTensors AT{(const attn_body::bf16*)(ws + WS_ACT), (const attn_body::bf16*)(ws + WS_ACT + 32 * MiB), (const attn_body::bf16*)(ws + WS_ACT + 64 * MiB), (attn_body::bf16*)(ws + WS_O)};
            const attn_body::StaticOrder S(G, bx);
            attn_body::attn_phase<attn_body::StaticOrder, MK_THRL>((char*)lds_raw + RING_OFF, AT, S, bl, tid, tsk);
            if (MK_DEFER_WEIGHTS && layer == 0) {
                LAS float* scr = (LAS float*)(lds + RING_OFF + wave * 16384); unsigned* q = (unsigned*)(ws + WS_CTL) + CW_QUEUE;
                for (;;) { unsigned b0 = 0; if (lane == 0) b0 = __hip_atomic_fetch_add(q, 4u, __ATOMIC_RELAXED, __HIP_MEMORY_SCOPE_AGENT); b0 = (unsigned)__builtin_amdgcn_readfirstlane((int)b0);
                    if (b0 >= (unsigned)WATT_ITEMS) break;
                    for (int i = 0; i < 4; ++i) if (!wt_one(args, scr, WMASK_ATT, (int)b0 + i, lane)) break; } }
        } else if (op == OP_WO) {
            MK_LANE_TID();
            pg8::Gemm g{(const bf16*)(ws + WS_O), (const bf16*)(ws + WS_WO) + (size_t)pj * D * D, D, D, D, 0, 0};
            pg8::StaticOrder S; S.init(M / 256, D / 256, G, bx);
            pg8::EpiResid<0> E{MK_XBS(sout - 1), MK_XBS(sout), SSQ + (size_t)sout * M, nullptr, nullptr, 0};
            pg8::gemm_phase<pg8::EpiResid<0>, pg8::StaticOrder, true>(lds + RING_OFF, tid, g, S, E);
        }
        else if (op == OP_S5IN) {
            MK_LANE_TID();
            ph_toeplitz(ws, gw, NGW, lane);
            pg8::Gemm g{XB, (const bf16*)(ws + WS_WS5IN), D, D, D, 0, 0};
            pg8::StaticOrder S; S.init(M / 256, D / 256, G, bx);
            pg8::EpiU E{(bf16*)(ws + WS_ACT), SSQ + (size_t)sin * M};
            pg8::gemm_phase<pg8::EpiU, pg8::StaticOrder, true>(lds + RING_OFF, tid, g, S, E);
        } else if (op == OP_SSM) {
            MK_LANE_TID();
            pg8::StaticOrder S; S.init(BATCH, SG, G, bx);
            { pg8::Gemm g{(const bf16*)(ws + WS_ACT), (const bf16*)(ws + WS_BTA), 256, 384, 256, 0, 1024 * 384 * 2};
              pg8::EpiSloc E{(const float*)(ws + WS_LAMC), (bf16*)(ws + WS_ACT), lds + LDSCTL_OFF + 2048};
              pg8::gemm_phase<pg8::EpiSloc, pg8::StaticOrder, false>(lds + RING_OFF, tid, g, S, E); }
            { pg8::Gemm g{(const bf16*)(ws + WS_ACT), (const bf16*)(ws + WS_BTB), 384, 384, 384, 0, 1024 * 384 * 2};
              pg8::EpiY E{(const bf16*)(ws + WS_ACT), args.in[15], (bf16*)(ws + WS_ACT + 48 * MiB)};
              pg8::gemm_phase<pg8::EpiY, pg8::StaticOrder, true>(lds + RING_OFF, tid, g, S, E); }
        } else if (op == OP_GLU) {
            MK_LANE_TID();
            pg8::Gemm g{(const bf16*)(ws + WS_ACT + 48 * MiB), (const bf16*)(ws + WS_WGLU), D, MK_G1_NATURAL ? D : 16, D, MK_G1_NATURAL ? 0 : M * 16, 0};
            pg8::StaticOrder S; S.init(M / 256, 2 * D / 256, G, bx);
            pg8::EpiResid<1> E{MK_XBS(sout - 1), MK_XBS(sout), SSQ + (size_t)sout * M, nullptr, nullptr, 0};
            pg8::gemm_phase<pg8::EpiResid<1>, pg8::StaticOrder, true>(lds + RING_OFF, tid, g, S, E);
        }
        else if (op == OP_POOLPREP) {
        } else if (op == OP_POOLGEMM) {
            MK_LANE_TID();
            pg8::StaticOrder S; S.init(M / 256, 4, G, bx);
            { pg8::Unit u0; if (S.next(0, u0)) { const pg8::ssq_t* ssq = SSQ + (size_t)sin * M; const float* gain = args.in[1] + (size_t)layer * D; bf16* PD = (bf16*)(ws + WS_ACT);
                const int gi = u0.pn, c0 = gi * 256 + lane * 4; const f32x4 gg = *(const f32x4*)(gain + c0);
                for (int ci = wave; ci < 16; ci += NWAVES) { const int row0 = u0.pm * 256 + ci * 16, t0 = row0 & (SEQ - 1);
                    if (gi == 0) pool_item<2>(XB, ssq, gg, PD, row0, t0, c0); else if (gi == 1) pool_item<4>(XB, ssq, gg, PD, row0, t0, c0);
                    else if (gi == 2) pool_item<8>(XB, ssq, gg, PD, row0, t0, c0); else pool_item<16>(XB, ssq, gg, PD, row0, t0, c0); } }
              asm volatile("s_waitcnt vmcnt(0)" ::: "memory"); __syncthreads();
              if (wave == 0) { __builtin_amdgcn_fence(__ATOMIC_ACQUIRE, "agent"); asm volatile("s_waitcnt vmcnt(0)" ::: "memory"); }
              __syncthreads(); }
            pg8::Gemm g{(const bf16*)(ws + WS_ACT), (const bf16*)(ws + WS_WPOOL), 256, D, 256, 0, 512};
            pg8::EpiResid<2> E{MK_XBS(sout - 1), MK_XBS(sout), SSQ + (size_t)sout * M, args.in[18], args.in[19], 0};
            pg8::gemm_phase<pg8::EpiResid<2>, pg8::StaticOrder, true>(lds + RING_OFF, tid, g, S, E);
        } else if (op == OP_FINAL) {
            MK_LANE_TID();
            { const pg8::ssq_t* ssq = SSQ + (size_t)sin * M; const float* gain = args.in[3];
              for (int m = gw; m < M; m += NGW) { const float rs = pg8::rstd_row(ssq, m); f32x4* xr = (f32x4*)(X + (size_t)m * D) + lane; const f32x4* gr = (const f32x4*)gain + lane;
#pragma unroll
                  for (int j = 0; j < 4; ++j) xr[64 * j] = xr[64 * j] * rs * gr[64 * j]; } }
        }
        if (e + 1 < args.ph_hi) { MK_GRID_BAR(); }
    }
}
}
extern "C" void kernel_launch(void* const* d_in, const int* in_sizes, int n_in, void* d_out, int out_size, void* d_ws, size_t ws_size, hipStream_t stream) {
    static int grid = 0;
    if (grid == 0) {
        int dev = 0, cus = 0, per_cu = 0;
        if (hipGetDevice(&dev) != hipSuccess || hipDeviceGetAttribute(&cus, hipDeviceAttributeMultiprocessorCount, dev) != hipSuccess) { grid = -1; return; }
        if (hipFuncSetAttribute((const void*)mk::mega_k, hipFuncAttributeMaxDynamicSharedMemorySize, mk::LDS_BYTES) != hipSuccess) { grid = -1; return; }
        if (hipOccupancyMaxActiveBlocksPerMultiprocessor(&per_cu, (const void*)mk::mega_k, mk::NWAVES * 64, mk::LDS_BYTES) != hipSuccess || per_cu < 1) { fprintf(stderr, "kernel_launch: occupancy query says %d blocks per CU\n", per_cu); grid = -1; (void)hipGetLastError(); return; }
        (void)hipGetLastError();
        grid = cus;
        if (n_in != 22 || ws_size < mk::WS_END || cus != 256 || in_sizes[0] != mk::M * mk::D || out_size != mk::M * mk::D) { fprintf(stderr, "kernel_launch: unexpected n_in %d / ws_size %zu / CUs %d\n", n_in, ws_size, cus); grid = -1; }
    }
    if (grid < 0) return;
    (void)hipMemsetAsync((char*)d_ws + mk::WS_CTL, 0, mk::CTL_ZERO_BYTES, stream);
    mk::Args a{};
    for (int i = 0; i < 22; ++i) a.in[i] = (const float*)d_in[i];
    a.out = (float*)d_out; a.ws = (unsigned char*)d_ws;
#if MK_ONE_LAUNCH
    a.ph_lo = 0; a.ph_hi = mk::PH_LAST + 1;
    void* kargs[] = {&a};
    const hipError_t e = hipLaunchCooperativeKernel((const void*)mk::mega_k, dim3(grid), dim3(mk::NWAVES * 64), kargs, mk::LDS_BYTES, stream);
    if (e != hipSuccess) fprintf(stderr, "kernel_launch: cooperative launch failed: %s\n", hipGetErrorString(e));
#else
    for (int ph = 0; ph <= mk::PH_LAST; ++ph) { a.ph_lo = ph; a.ph_hi = ph + 1; hipLaunchKernelGGL(mk::mega_k, dim3(grid), dim3(mk::NWAVES * 64), mk::LDS_BYTES, stream, a);
    }
#endif
}
```

```cpp
#include <hip/hip_runtime.h>
#include <hip/hip_cooperative_groups.h>
#include <cstdio>
#include <cstdint>
#include <cmath>
#define MK_BAR_SETUP() cooperative_groups::grid_group mk_grid = cooperative_groups::this_grid(); bool mk_first = true; \
    XcdBarrier mk_bar = xcd_barrier_post((unsigned*)(args.ws + WS_CTL) + CW_BAR, (volatile LAS unsigned*)(lds + MISC_OFF) + 8)
#define MK_GRID_BAR() do { if (mk_first) { mk_grid.sync(); mk_first = false; } else xcd_barrier(mk_bar); } while (0)
#define MK_ONE_LAUNCH 1
#define MK_NO_NAIVE 1
#define MK_THRL 24
#define MK_UP_DUMMY 0
#define MK_JUNK false
#define MK_QKV_NOGATES 0
#define MK_DEFER_WEIGHTS 1
#define MK_SKIP_QK 2.0f
#ifndef MK_PREPASS_REPS
#define MK_PREPASS_REPS 1
#endif
#ifndef MK_TOUCH
#define MK_TOUCH 0
#endif
#ifndef MK_WGM
#define MK_WGM 8
#endif
#ifndef MK_ALIGN_UP
#define MK_ALIGN_UP true
#endif
#ifndef MK_S5TAB_REPS
#define MK_S5TAB_REPS 1
#endif
#ifndef MK_G1_NATURAL
#define MK_G1_NATURAL 0
#endif
#ifndef MK_WNT
#define MK_WNT 0
#endif
namespace pg8 {
#define PG8_LAS __attribute__((address_space(3)))
typedef unsigned short bf16_t;
typedef short bf16x8 __attribute__((ext_vector_type(8)));
typedef float f32x4 __attribute__((ext_vector_type(4)));
typedef float f32x2 __attribute__((ext_vector_type(2)));
typedef unsigned u32x4 __attribute__((ext_vector_type(4)));
typedef unsigned u32x2 __attribute__((ext_vector_type(2)));
constexpr int PF_JUNK_OFF = 131072 + 6144;
#ifndef MK_RESID_ALL16
#define MK_RESID_ALL16 0
#endif
#ifndef MK_SWIGLU_V2
#define MK_SWIGLU_V2 1
#endif
#ifndef MK_PF_BASE
#define MK_PF_BASE false
#endif
constexpr int BM = 256, BK = 64, HALF = 128, HTB = HALF * BK * 2  , STAGE_BYTES = 8 * HTB, NXCD = 8, WGM = MK_WGM;

__host__ __device__ __forceinline__ int lds_byte(int r, int c) { const int st = (r >> 4) * 2 + (c >> 5), rr = r & 15, cc = c & 31, ob = rr * 64 + cc * 2; return st * 1024 + (ob ^ (((ob >> 9) & 1) << 5)); }
__host__ __device__ __forceinline__ void stage_rc(int b, int& R, int& C) { const int st = b / 1024, sb = b % 1024, swz = sb ^ (((sb >> 9) & 1) << 5); R = (st >> 1) * 16 + swz / 64; C = (st & 1) * 32 + (swz % 64) / 2; }
__host__ __device__ __forceinline__ int perm32(int rho) { const int n = rho >> 4, i = rho & 15; return 8 * (i >> 2) + 4 * n + (i & 3); }

struct Unit { int pm, pn; };
struct Gemm { const bf16_t* A; const bf16_t* Bt; int K; int lda, ldb; int gatherA; int a_pn_off; };

struct StaticOrder {
    int nM, nN, nwg, G, c;
    __host__ __device__ __forceinline__ void init(int nM_, int nN_, int G_, int c_) { nM = nM_; nN = nN_; nwg = nM * nN; G = G_; c = c_; }
    __host__ __device__ __forceinline__ bool next(int i, Unit& u) const {
        const long L = (long)i * G + c; if (L >= nwg) return false;
        int wgid = (int)L; { const int q = nwg / NXCD, r = nwg % NXCD, xcd = wgid % NXCD, off = wgid / NXCD; wgid = (xcd < r ? xcd * (q + 1) : r * (q + 1) + (xcd - r) * q) + off; }
        const int nig = WGM * nN, gid = wgid / nig, fm = gid * WGM, gsz = (nM - fm) < WGM ? (nM - fm) : WGM;
        u.pm = fm + ((wgid % nig) % gsz); u.pn = (wgid % nig) / gsz; return true;
    }
};

__device__ __forceinline__ unsigned cvt_pk_bf16(float lo, float hi) { unsigned r; asm volatile("v_cvt_pk_bf16_f32 %0, %1, %2" : "=v"(r) : "v"(lo), "v"(hi)); return r; }

template <class Epi, class Sched, bool ALIGN_EPI>
__device__ __forceinline__ void gemm_phase(PG8_LAS unsigned char* lds, const int tid, const Gemm g, const Sched& S, const Epi& E) {
    const int wid = __builtin_amdgcn_readfirstlane(tid >> 6), lane = tid & 63, wr = wid >> 2, wc = wid & 3, fr = lane & 15, fq = lane >> 4;
    const int K = g.K, nt = K / BK;
    unsigned voffA[2], voffB[2];
#pragma unroll
    for (int i = 0; i < 2; ++i) { int R, C; stage_rc(tid * 16 + i * 8192, R, C); const int Rb = Epi::PERM ? ((R & ~31) + perm32(R & 31)) : R;
        voffA[i] = g.gatherA ? (unsigned)(R * g.lda + (C >> 4) * g.gatherA + (C & 15)) * 2u : (unsigned)(R * g.lda + C) * 2u; voffB[i] = (unsigned)(Rb * g.ldb + C) * 2u; }
    const size_t kstepA = g.gatherA ? (size_t)g.gatherA * 8 : (size_t)(BK * 2), kstepB = (size_t)(BK * 2);
    const size_t hstepA = (size_t)HALF * g.lda * 2, hstepB = (size_t)HALF * g.ldb * 2;
    const size_t tstepA = 2 * hstepA, tstepB = 2 * hstepB;
    const unsigned ldsw = (unsigned)wid * 1024u;
    const int aoff = lds_byte(wr * 64 + fr, fq * 8), boff = lds_byte(wc * 32 + fr, fq * 8);
#define PG8_SA(b, h) (((b) * 2 + (h)) * HTB)
#define PG8_SB(b, h) ((4 + (b) * 2 + (h)) * HTB)
#define PG8_STAGE(bufoff, gbase, voff) do { _Pragma("unroll") for (int _i = 0; _i < 2; ++_i) \
        __builtin_amdgcn_global_load_lds((const unsigned*)((const char*)(gbase) + (voff)[_i]), (PG8_LAS unsigned*)(lds + (bufoff) + ldsw + _i * 8192), 16, 0, 0); } while (0)
#define PG8_LDA(dst, b, h) do { _Pragma("unroll") for (int m = 0; m < 4; ++m) _Pragma("unroll") for (int k = 0; k < 2; ++k) dst[m][k] = *(const PG8_LAS bf16x8*)(lds + PG8_SA(b, h) + aoff + m * 2048 + k * 1024); } while (0)
#define PG8_LDB(dst, b, h) do { _Pragma("unroll") for (int n = 0; n < 2; ++n) _Pragma("unroll") for (int k = 0; k < 2; ++k) dst[n][k] = *(const PG8_LAS bf16x8*)(lds + PG8_SB(b, h) + boff + n * 2048 + k * 1024); } while (0)
#define PG8_MMA(ai, bj, At, Bt) do { __builtin_amdgcn_s_setprio(1); _Pragma("unroll") for (int m = 0; m < 4; ++m) _Pragma("unroll") for (int n = 0; n < 2; ++n) _Pragma("unroll") for (int k = 0; k < 2; ++k) \
        acc[ai][bj][m][n] = __builtin_amdgcn_mfma_f32_16x16x32_bf16(Bt[n][k], At[m][k], acc[ai][bj][m][n], 0, 0, 0); __builtin_amdgcn_s_setprio(0); } while (0)
#define PG8_WAIT_V(n) asm volatile("s_waitcnt vmcnt(" #n ")" ::: "memory")
#define PG8_WAIT_L(n) asm volatile("s_waitcnt lgkmcnt(" #n ")" ::: "memory")
#define PG8_BAR __builtin_amdgcn_s_barrier()
#define PG8_SCHED __builtin_amdgcn_sched_barrier(0)
    Unit cur, nxt; int ui = 0;
    if (!S.next(0, cur)) return;
    f32x4 acc[2][2][4][2];
#pragma unroll
    for (int a = 0; a < 2; ++a)
#pragma unroll
        for (int b = 0; b < 2; ++b)
#pragma unroll
            for (int m = 0; m < 4; ++m)
#pragma unroll
                for (int n = 0; n < 2; ++n) acc[a][b][m][n] = (f32x4){0.f, 0.f, 0.f, 0.f};
    bf16x8 At[4][2], B0[2][2], B1[2][2];
    const char* cA = (const char*)g.A + (size_t)cur.pm * tstepA + (size_t)cur.pn * g.a_pn_off; const char* cB = (const char*)g.Bt + (size_t)cur.pn * tstepB;
    PG8_STAGE(PG8_SB(0, 0), cB, voffB); PG8_STAGE(PG8_SB(0, 1), cB + hstepB, voffB); PG8_STAGE(PG8_SA(0, 0), cA, voffA); PG8_STAGE(PG8_SA(0, 1), cA + hstepA, voffA);
    if (wr == 1) PG8_BAR;
    PG8_WAIT_V(2); PG8_BAR;
    PG8_STAGE(PG8_SB(1, 0), cB + kstepB, voffB); PG8_STAGE(PG8_SA(1, 0), cA + kstepA, voffA); PG8_STAGE(PG8_SB(1, 1), cB + hstepB + kstepB, voffB);
    PG8_WAIT_V(6); PG8_BAR;
    for (;;) {
        const bool has_next = S.next(ui + 1, nxt);
        const char* nA = has_next ? (const char*)g.A + (size_t)nxt.pm * tstepA + (size_t)nxt.pn * g.a_pn_off : cA; const char* nB = has_next ? (const char*)g.Bt + (size_t)nxt.pn * tstepB : cB;
        for (int t = 0; t < nt; t += 2) {
            const bool last = (t == nt - 2);
            const char* a1 = cA + (size_t)(t + 1) * kstepA;
            const char* a2 = last ? nA : cA + (size_t)(t + 2) * kstepA; const char* b2 = last ? nB : cB + (size_t)(t + 2) * kstepB;
            const char* a3 = a2 + kstepA; const char* b3 = b2 + kstepB;
            if constexpr (Epi::PREFETCH) { if (last) { int pl_; asm volatile("v_mbcnt_lo_u32_b32 %0, -1, 0\n\tv_mbcnt_hi_u32_b32 %0, -1, %0" : "=v"(pl_)); E.prefetch(cur, wid * 64 + pl_, lds + PF_JUNK_OFF + ldsw / 4); } }
            PG8_LDB(B0, 0, 0); PG8_LDB(B1, 0, 1); PG8_SCHED; PG8_LDA(At, 0, 0); PG8_STAGE(PG8_SA(1, 1), a1 + hstepA, voffA);
            PG8_WAIT_V(8); PG8_WAIT_L(0); PG8_BAR; PG8_MMA(0, 0, At, B0); PG8_MMA(0, 1, At, B1); PG8_BAR; PG8_SCHED;
            PG8_LDA(At, 0, 1); PG8_STAGE(PG8_SB(0, 0), b2, voffB); PG8_STAGE(PG8_SB(0, 1), b2 + hstepB, voffB); PG8_STAGE(PG8_SA(0, 0), a2, voffA);
            PG8_WAIT_V(8); PG8_WAIT_L(0); PG8_BAR; PG8_MMA(1, 0, At, B0); PG8_MMA(1, 1, At, B1); PG8_BAR; PG8_SCHED;
            PG8_LDB(B0, 1, 0); PG8_LDB(B1, 1, 1); PG8_SCHED; PG8_LDA(At, 1, 0); PG8_STAGE(PG8_SA(0, 1), a2 + hstepA, voffA);
            PG8_WAIT_V(8); PG8_WAIT_L(0); PG8_BAR; PG8_MMA(0, 0, At, B0); PG8_MMA(0, 1, At, B1); PG8_BAR; PG8_SCHED;
            PG8_LDA(At, 1, 1); PG8_STAGE(PG8_SB(1, 0), b3, voffB); PG8_STAGE(PG8_SB(1, 1), b3 + hstepB, voffB); PG8_STAGE(PG8_SA(1, 0), a3, voffA);
            PG8_WAIT_V(8); PG8_WAIT_L(0); PG8_BAR; PG8_MMA(1, 0, At, B0); PG8_MMA(1, 1, At, B1); PG8_BAR; PG8_SCHED;
        }
        if constexpr (ALIGN_EPI) { if (wr == 0) PG8_BAR; }
        if constexpr (!Epi::AFTER_DRAIN) { int ln_; asm volatile("v_mbcnt_lo_u32_b32 %0, -1, 0\n\tv_mbcnt_hi_u32_b32 %0, -1, %0" : "=v"(ln_)); E(acc, cur, wr, wc, ln_ & 15, ln_ >> 4); }
        if (!has_next) break;
#pragma unroll
        for (int a = 0; a < 2; ++a)
#pragma unroll
            for (int b = 0; b < 2; ++b)
#pragma unroll
                for (int m = 0; m < 4; ++m)
#pragma unroll
                    for (int n = 0; n < 2; ++n) acc[a][b][m][n] = (f32x4){0.f, 0.f, 0.f, 0.f};
        cur = nxt; cA = nA; cB = nB; ++ui;
        if constexpr (ALIGN_EPI) { if (wr == 1) PG8_BAR; }
    }
    PG8_WAIT_V(0);
    if constexpr (!ALIGN_EPI) { if (wr == 0) PG8_BAR; }
    PG8_BAR;
    if constexpr (Epi::AFTER_DRAIN) { int ln_; asm volatile("v_mbcnt_lo_u32_b32 %0, -1, 0\n\tv_mbcnt_hi_u32_b32 %0, -1, %0" : "=v"(ln_)); E.fused(acc, cur, wr, wc, ln_ & 15, ln_ >> 4, lds, wid, ln_); }
#undef PG8_SA
#undef PG8_SB
#undef PG8_STAGE
#undef PG8_LDA
#undef PG8_LDB
#undef PG8_MMA
#undef PG8_WAIT_V
#undef PG8_WAIT_L
#undef PG8_BAR
#undef PG8_SCHED
}

__device__ __forceinline__ float shx(float v, int lane, int m) { return __builtin_bit_cast(float, __builtin_amdgcn_ds_bpermute((lane ^ m) << 2, __builtin_bit_cast(int, v))); }
constexpr float RMS_EPS = 1e-6f;
typedef unsigned long long ssq_t;
constexpr float SSQ_SCALE = 1048576.0f;
__device__ __forceinline__ float rstd_row(const ssq_t* ssq, int row) { return __builtin_amdgcn_rsqf((float)ssq[row] * (1.0f / (1024.0f * SSQ_SCALE)) + RMS_EPS); }
#define PG8_GAS __attribute__((address_space(1)))
#ifndef MK_WT_STORES
#define MK_WT_STORES 0
#endif
template <int OFF = 0, typename V> __device__ __forceinline__ void st_wt(PG8_GAS void* p, const V v) {
    static_assert(OFF >= 0 && OFF < 4096, "immediate offset range");
#if MK_WT_STORES
    if constexpr (sizeof(V) == 16) asm volatile("global_store_dwordx4 %0, %1, off offset:%2 sc1\n\ts_nop 1" :: "v"(p), "v"(v), "n"(OFF) : "memory");
    else if constexpr (sizeof(V) == 8) asm volatile("global_store_dwordx2 %0, %1, off offset:%2 sc1\n\ts_nop 1" :: "v"(p), "v"(v), "n"(OFF) : "memory");
    else { static_assert(sizeof(V) == 4, "store width"); asm volatile("global_store_dword %0, %1, off offset:%2 sc1\n\ts_nop 1" :: "v"(p), "v"(v), "n"(OFF) : "memory"); }
#else
    *(PG8_GAS V*)((PG8_GAS unsigned char*)p + OFF) = v;
#endif
}
#ifndef MK_WT_RESID
#define MK_WT_RESID 0
#endif
__device__ __forceinline__ void st_resid(PG8_GAS unsigned char* base, unsigned off, const u32x4 v) {
#if MK_WT_RESID
    asm volatile("global_store_dwordx4 %0, %1, %2 sc1\n\ts_nop 1" :: "v"(off), "v"(v), "s"(base) : "memory");
#else
    *(PG8_GAS u32x4*)(base + off) = v;
#endif
}
#ifndef MK_NT_STORES
#define MK_NT_STORES 0
#endif
template <typename V> __device__ __forceinline__ void st_big(PG8_GAS void* p, const V v) {
#if MK_NT_STORES
    __builtin_nontemporal_store(v, (PG8_GAS V*)p);
#else
    st_wt(p, v);
#endif
}
#if MK_WT_STORES
#define ATTN_STORE16(p,v) pg8::st_wt((PG8_GAS void*)(p), (v))
#endif
__device__ __forceinline__ void rstd8(const ssq_t* ssq, int row0, float (&rs)[2][4]) {
    ssq_t sv[2][4];
#pragma unroll
    for (int ai = 0; ai < 2; ++ai)
#pragma unroll
        for (int m = 0; m < 4; ++m) sv[ai][m] = ((const PG8_GAS ssq_t*)ssq)[row0 + ai * HALF + m * 16];
#pragma unroll
    for (int ai = 0; ai < 2; ++ai)
#pragma unroll
        for (int m = 0; m < 4; ++m) rs[ai][m] = __builtin_amdgcn_rsqf((float)sv[ai][m] * (1.0f / (1024.0f * SSQ_SCALE)) + RMS_EPS);
}
__device__ __forceinline__ float fast_sigmoid(float x) { return __builtin_amdgcn_rcpf(1.0f + __builtin_amdgcn_exp2f(-1.4426950408889634f * x)); }

struct EpiQKV {
    static constexpr bool PERM = true, AFTER_DRAIN = false, PREFETCH = false;
    bf16_t* O; size_t split_stride; const ssq_t* ssq; float scale0; float* nrm; int dummy;
    __device__ __forceinline__ void operator()(const f32x4 (&acc)[2][2][4][2], const Unit& u, int wr, int wc, int fr, int fq) const {
        const int row0 = u.pm * BM + wr * 64 + fr, t = u.pn >> 2; bf16_t* base = O + (size_t)t * split_stride; const float sc = (t == 0) ? scale0 : 1.f;
        const int col0 = (u.pn & 3) * BM + wc * 32 + 8 * fq, ln = fq * 16 + fr;
        float rsv[2][4]; rstd8(ssq, row0, rsv);
#pragma unroll
        for (int ai = 0; ai < 2; ++ai)
#pragma unroll
            for (int m = 0; m < 4; ++m) { const int row = row0 + ai * HALF + m * 16; const float rs = rsv[ai][m] * sc; PG8_GAS bf16_t* rowp = (PG8_GAS bf16_t*)base + (size_t)row * 1024 + col0;
#pragma unroll
                for (int bj = 0; bj < 2; ++bj) { const f32x4 v0 = acc[ai][bj][m][0] * rs, v1 = acc[ai][bj][m][1] * rs;
                    u32x4 w; w.x = cvt_pk_bf16(v0[0], v0[1]); w.y = cvt_pk_bf16(v0[2], v0[3]); w.z = cvt_pk_bf16(v1[0], v1[1]); w.w = cvt_pk_bf16(v1[2], v1[3]);
                    st_big(rowp + bj * HALF, w);
                    if (t < 2) { float s = ((v0[0] * v0[0] + v0[1] * v0[1]) + (v0[2] * v0[2] + v0[3] * v0[3])) + ((v1[0] * v1[0] + v1[1] * v1[1]) + (v1[2] * v1[2] + v1[3] * v1[3]));
                        s += shx(s, ln, 16); s += shx(s, ln, 32);
                        if (fq == 0) ((PG8_GAS float*)nrm)[(((size_t)(t * 4 + (u.pn & 3)) * 16384 + row) * 4 + 2 * bj + (wc >> 1)) * 2 + (wc & 1)] = s; } } }
    }
};
struct EpiSwiGLU {
    static constexpr bool PERM = true, AFTER_DRAIN = false, PREFETCH = false;
    bf16_t* Hh; int ldh; const ssq_t* ssq; int dummy;
    __device__ __forceinline__ void operator()(const f32x4 (&acc)[2][2][4][2], const Unit& u, int wr, int wc, int fr, int fq) const {
        const int row0 = u.pm * BM + wr * 64 + fr, col0 = u.pn * HALF + wc * 32 + 8 * fq;
        if (dummy == 1) { if (fr == 0 && fq == 0) *(PG8_GAS float*)((PG8_GAS bf16_t*)Hh + (size_t)row0 * ldh + col0) = acc[0][0][0][0][0] + acc[1][1][3][1][3]; return; }
#if MK_SWIGLU_V2
        ssq_t sv[2][4];
#pragma unroll
        for (int ai = 0; ai < 2; ++ai)
#pragma unroll
            for (int m = 0; m < 4; ++m) sv[ai][m] = ((const PG8_GAS ssq_t*)ssq)[row0 + ai * HALF + m * 16];
#pragma unroll
        for (int ai = 0; ai < 2; ++ai)
#pragma unroll
            for (int m = 0; m < 4; ++m) { const int row = row0 + ai * HALF + m * 16;
                const float ms = (float)sv[ai][m] * (1.0f / (1024.0f * SSQ_SCALE)) + RMS_EPS, rsn = __builtin_amdgcn_rsqf(ms) * (-1.4426950408889634f);
                float h[8];
#pragma unroll
                for (int n = 0; n < 2; ++n)
#pragma unroll
                    for (int j = 0; j < 4; j += 2) {
                        const f32x2 g2 = {acc[ai][0][m][n][j], acc[ai][0][m][n][j + 1]}, u2 = {acc[ai][1][m][n][j], acc[ai][1][m][n][j + 1]};
                        const f32x2 ar = g2 * rsn, t = g2 * u2;
                        f32x2 e; e.x = __builtin_amdgcn_exp2f(ar.x); e.y = __builtin_amdgcn_exp2f(ar.y);
                        const f32x2 msv = {ms, ms}; const f32x2 dn = __builtin_elementwise_fma(e, msv, msv); f32x2 r; r.x = __builtin_amdgcn_rcpf(dn.x); r.y = __builtin_amdgcn_rcpf(dn.y);
                        const f32x2 hv = t * r; h[n * 4 + j] = hv.x; h[n * 4 + j + 1] = hv.y; }
#else
        float rsv[2][4]; rstd8(ssq, row0, rsv);
#pragma unroll
        for (int ai = 0; ai < 2; ++ai)
#pragma unroll
            for (int m = 0; m < 4; ++m) { const int row = row0 + ai * HALF + m * 16; const float rs = rsv[ai][m];
                float h[8];
#pragma unroll
                for (int n = 0; n < 2; ++n)
#pragma unroll
                    for (int j = 0; j < 4; j += 2) {
                        const f32x2 g2 = {acc[ai][0][m][n][j], acc[ai][0][m][n][j + 1]}, u2 = {acc[ai][1][m][n][j], acc[ai][1][m][n][j + 1]};
                        const f32x2 gs = g2 * rs, us = u2 * rs, ar = gs * (-1.4426950408889634f);
                        f32x2 e; e.x = __builtin_amdgcn_exp2f(ar.x); e.y = __builtin_amdgcn_exp2f(ar.y);
                        const f32x2 dn = e + 1.0f; f32x2 r; r.x = __builtin_amdgcn_rcpf(dn.x); r.y = __builtin_amdgcn_rcpf(dn.y);
                        const f32x2 hv = (gs * r) * us; h[n * 4 + j] = hv.x; h[n * 4 + j + 1] = hv.y; }
#endif
                u32x4 w; w.x = cvt_pk_bf16(h[0], h[1]); w.y = cvt_pk_bf16(h[2], h[3]); w.z = cvt_pk_bf16(h[4], h[5]); w.w = cvt_pk_bf16(h[6], h[7]);
                st_big((PG8_GAS bf16_t*)Hh + (size_t)row * ldh + col0, w); }
    }
};
__device__ __forceinline__ void bf8_to_f32(const u32x4 w, f32x4& lo, f32x4& hi) {
    lo = (f32x4){__builtin_bit_cast(float, w.x << 16), __builtin_bit_cast(float, w.x & 0xffff0000u), __builtin_bit_cast(float, w.y << 16), __builtin_bit_cast(float, w.y & 0xffff0000u)};
    hi = (f32x4){__builtin_bit_cast(float, w.z << 16), __builtin_bit_cast(float, w.z & 0xffff0000u), __builtin_bit_cast(float, w.w << 16), __builtin_bit_cast(float, w.w & 0xffff0000u)};
}
template <int MODE> struct EpiResid {
    static constexpr bool PERM = true, AFTER_DRAIN = false, PREFETCH = MK_PF_BASE && MODE == 0;
    const bf16_t* base; bf16_t* XB; ssq_t* ssq_out; const float* pb; const float* psc; int dummy;
    __device__ __forceinline__ void prefetch(const Unit& u, int tid, PG8_LAS unsigned char* junk) const {
        const int r = tid >> 1, h = tid & 1;
        const char* p = (const char*)base + ((size_t)(u.pm * BM + r) * 1024 + (MODE == 1 ? u.pn * HALF : u.pn * BM)) * 2 + h * (MODE == 1 ? 128 : 256);
        __builtin_amdgcn_global_load_lds((const unsigned*)p, (PG8_LAS unsigned*)junk, 4, 0, 0);
        if (MODE != 1) __builtin_amdgcn_global_load_lds((const unsigned*)(p + 128), (PG8_LAS unsigned*)junk, 4, 0, 0);
    }
    __device__ __forceinline__ void operator()(const f32x4 (&acc)[2][2][4][2], const Unit& u, int wr, int wc, int fr, int fq) const {
        if (dummy == 1) { if (acc[0][0][0][0][0] + acc[1][1][3][1][3] == 12345.678f) ((PG8_GAS float*)pb)[0] = 1.f; return; }
        const int row0 = u.pm * BM + wr * 64 + fr;
        const int col0 = (MODE == 1 ? u.pn * HALF : u.pn * BM) + wc * 32 + 8 * fq;
        constexpr int NBJ = (MODE == 1) ? 1 : 2;
        const PG8_GAS unsigned char* gb = (const PG8_GAS unsigned char*)base; PG8_GAS unsigned char* gx = (PG8_GAS unsigned char*)XB; const unsigned ob = ((unsigned)row0 * 1024u + (unsigned)col0) * 2u;
        float ss[2][4];
#pragma unroll
        for (int ai = 0; ai < 2; ++ai)
#pragma unroll
            for (int m = 0; m < 4; ++m) ss[ai][m] = 0.f;
        constexpr bool ALL16 = (MODE == 0) && MK_RESID_ALL16;
        u32x4 bsall[ALL16 ? 2 : 1][2][4];
        if constexpr (ALL16) {
#pragma unroll
            for (int bj = 0; bj < 2; ++bj)
#pragma unroll
                for (int ai = 0; ai < 2; ++ai)
#pragma unroll
                    for (int m = 0; m < 4; ++m) bsall[bj][ai][m] = *(const PG8_GAS u32x4*)(gb + (ob + (unsigned)(((ai * HALF + m * 16) * 1024 + bj * HALF) * 2))); }
#pragma unroll
        for (int bj = 0; bj < NBJ; ++bj) { const int co = bj * HALF;
            f32x4 bb0 = {0.f, 0.f, 0.f, 0.f}, bb1 = bb0, sc0 = {1.f, 1.f, 1.f, 1.f}, sc1 = sc0;
            if (MODE == 2) { bb0 = *(const PG8_GAS f32x4*)((const PG8_GAS float*)pb + col0 + co); bb1 = *(const PG8_GAS f32x4*)((const PG8_GAS float*)pb + col0 + co + 4);
                             sc0 = *(const PG8_GAS f32x4*)((const PG8_GAS float*)psc + col0 + co); sc1 = *(const PG8_GAS f32x4*)((const PG8_GAS float*)psc + col0 + co + 4); }
            constexpr int NAB = (MODE == 2) ? 1 : 2;
#pragma unroll
            for (int a0 = 0; a0 < 2; a0 += NAB) {
                u32x4 bs[NAB][4];
#pragma unroll
                for (int ai = 0; ai < NAB; ++ai)
#pragma unroll
                    for (int m = 0; m < 4; ++m) { if constexpr (ALL16) bs[ai][m] = bsall[bj][ai][m]; else bs[ai][m] = *(const PG8_GAS u32x4*)(gb + (ob + (unsigned)((((a0 + ai) * HALF + m * 16) * 1024 + co) * 2))); }
#pragma unroll
                for (int aa = 0; aa < NAB; ++aa)
#pragma unroll
                    for (int m = 0; m < 4; ++m) { const int ai = a0 + aa; const unsigned off = ob + (unsigned)(((ai * HALF + m * 16) * 1024 + co) * 2); f32x4 d0, d1;
                        if (MODE == 0) { d0 = acc[ai][bj][m][0]; d1 = acc[ai][bj][m][1]; }
                        else if (MODE == 1) { const f32x4 v0 = acc[ai][0][m][0], g0 = acc[ai][1][m][0], v1 = acc[ai][0][m][1], g1 = acc[ai][1][m][1];
                            d0 = (f32x4){v0[0] * fast_sigmoid(g0[0]), v0[1] * fast_sigmoid(g0[1]), v0[2] * fast_sigmoid(g0[2]), v0[3] * fast_sigmoid(g0[3])};
                            d1 = (f32x4){v1[0] * fast_sigmoid(g1[0]), v1[1] * fast_sigmoid(g1[1]), v1[2] * fast_sigmoid(g1[2]), v1[3] * fast_sigmoid(g1[3])}; }
                        else { d0 = (acc[ai][bj][m][0] + bb0) * sc0; d1 = (acc[ai][bj][m][1] + bb1) * sc1; }
                        f32x4 b0, b1; bf8_to_f32(bs[aa][m], b0, b1);
                        const f32x4 o0 = b0 + d0, o1 = b1 + d1;
                        ss[ai][m] += ((o0[0] * o0[0] + o0[1] * o0[1]) + (o0[2] * o0[2] + o0[3] * o0[3])) + ((o1[0] * o1[0] + o1[1] * o1[1]) + (o1[2] * o1[2] + o1[3] * o1[3]));
                        u32x4 w; w.x = cvt_pk_bf16(o0[0], o0[1]); w.y = cvt_pk_bf16(o0[2], o0[3]); w.z = cvt_pk_bf16(o1[0], o1[1]); w.w = cvt_pk_bf16(o1[2], o1[3]);
                        st_resid(gx, off, w); }
                if (NAB == 1) asm volatile("" ::: "memory"); }
            asm volatile("" ::: "memory"); }
        const int ln = fq * 16 + fr;
#pragma unroll
        for (int ai = 0; ai < 2; ++ai)
#pragma unroll
            for (int m = 0; m < 4; ++m) { float s = ss[ai][m]; s += shx(s, ln, 16); s += shx(s, ln, 32);
                if (fq == 0) atomicAdd(ssq_out + row0 + ai * HALF + m * 16, (ssq_t)__builtin_llrintf(s * SSQ_SCALE)); }
    }
};
struct EpiResidFinal {
    static constexpr bool PERM = true, AFTER_DRAIN = true, PREFETCH = false;
    const bf16_t* base; float* out; ssq_t* ssq_out; const float* gain; unsigned* cnt;
    __device__ __forceinline__ void prefetch(const Unit& u, int tid, PG8_LAS unsigned char* junk) const {
        const int r = tid >> 1, h = tid & 1;
        const char* p = (const char*)base + ((size_t)(u.pm * BM + r) * 1024 + u.pn * BM) * 2 + h * 256;
        __builtin_amdgcn_global_load_lds((const unsigned*)p, (PG8_LAS unsigned*)junk, 4, 0, 0);
        __builtin_amdgcn_global_load_lds((const unsigned*)(p + 128), (PG8_LAS unsigned*)junk, 4, 0, 0);
    }
    __device__ __forceinline__ void fused(f32x4 (&acc)[2][2][4][2], const Unit& u, int wr, int wc, int fr, int fq, PG8_LAS unsigned char* lds, int wid, int lane) const {
        const int row0 = u.pm * BM + wr * 64 + fr, col0 = u.pn * BM + wc * 32 + 8 * fq;
        const PG8_GAS bf16_t* gb = (const PG8_GAS bf16_t*)base + (size_t)row0 * 1024 + col0;
        float ss[2][4]; float chain_ = 0.f;
#pragma unroll
        for (int ai = 0; ai < 2; ++ai)
#pragma unroll
            for (int m = 0; m < 4; m += 2) { int ro_ = (ai * HALF + m * 16) * 1024; asm volatile("" : "+v"(ro_) : "v"(chain_));
                const PG8_GAS bf16_t* rp = gb + ro_;
                const u32x4 wa = *(const PG8_GAS u32x4*)(rp), wb = *(const PG8_GAS u32x4*)(rp + HALF), wc_ = *(const PG8_GAS u32x4*)(rp + 16 * 1024), wd = *(const PG8_GAS u32x4*)(rp + 16 * 1024 + HALF);
#pragma unroll
                for (int q = 0; q < 2; ++q) { f32x4 b0, b1, b2, b3; bf8_to_f32(q ? wc_ : wa, b0, b1); bf8_to_f32(q ? wd : wb, b2, b3);
                    const f32x4 o0 = b0 + acc[ai][0][m + q][0], o1 = b1 + acc[ai][0][m + q][1], o2 = b2 + acc[ai][1][m + q][0], o3 = b3 + acc[ai][1][m + q][1];
                    acc[ai][0][m + q][0] = o0; acc[ai][0][m + q][1] = o1; acc[ai][1][m + q][0] = o2; acc[ai][1][m + q][1] = o3;
                    ss[ai][m + q] = ((o0[0] * o0[0] + o0[1] * o0[1]) + (o0[2] * o0[2] + o0[3] * o0[3])) + ((o1[0] * o1[0] + o1[1] * o1[1]) + (o1[2] * o1[2] + o1[3] * o1[3]))
                                  + ((o2[0] * o2[0] + o2[1] * o2[1]) + (o2[2] * o2[2] + o2[3] * o2[3])) + ((o3[0] * o3[0] + o3[1] * o3[1]) + (o3[2] * o3[2] + o3[3] * o3[3])); }
                chain_ = ss[ai][m] + ss[ai][m + 1]; }
        const int ln = fq * 16 + fr;
#pragma unroll
        for (int ai = 0; ai < 2; ++ai)
#pragma unroll
            for (int m = 0; m < 4; ++m) { float s = ss[ai][m]; s += shx(s, ln, 16); s += shx(s, ln, 32);
                if (fq == 0) atomicAdd(ssq_out + row0 + ai * HALF + m * 16, (ssq_t)__builtin_llrintf(s * SSQ_SCALE)); }
        asm volatile("s_waitcnt vmcnt(0)" ::: "memory"); __builtin_amdgcn_s_barrier(); asm volatile("" ::: "memory");
        if (wid == 0) {
            unsigned* c = cnt + 64 * u.pm;
            if (lane == 0) __hip_atomic_fetch_add(c, 1u, __ATOMIC_RELAXED, __HIP_MEMORY_SCOPE_AGENT);
            unsigned spins = 0;
            while ((unsigned)__builtin_amdgcn_readfirstlane(__hip_atomic_load(c, __ATOMIC_RELAXED, __HIP_MEMORY_SCOPE_AGENT)) < 4u && ++spins < (1u << 22)) __builtin_amdgcn_s_sleep(2);
        }
        __builtin_amdgcn_s_barrier(); asm volatile("" ::: "memory");
        int l2_; asm volatile("v_mbcnt_lo_u32_b32 %0, -1, 0\n\tv_mbcnt_hi_u32_b32 %0, -1, %0" : "=v"(l2_));
        const int row0b = u.pm * BM + wr * 64 + (l2_ & 15), col0b = u.pn * BM + wc * 32 + 8 * (l2_ >> 4);
        PG8_GAS float* go = (PG8_GAS float*)out + (size_t)row0b * 1024 + col0b;
        float rs[2][4];
#pragma unroll
        for (int ai = 0; ai < 2; ++ai)
#pragma unroll
            for (int m = 0; m < 4; ++m) rs[ai][m] = __builtin_amdgcn_rsqf((float)__hip_atomic_load(ssq_out + row0b + ai * HALF + m * 16, __ATOMIC_RELAXED, __HIP_MEMORY_SCOPE_AGENT) * (1.0f / (1024.0f * SSQ_SCALE)) + RMS_EPS);
#pragma unroll
        for (int bj = 0; bj < 2; ++bj) { int co = bj * HALF; asm volatile("" : "+v"(co) : "v"(chain_));
            const f32x4 gg0 = *(const PG8_GAS f32x4*)((const PG8_GAS float*)gain + col0b + co), gg1 = *(const PG8_GAS f32x4*)((const PG8_GAS float*)gain + col0b + co + 4);
#pragma unroll
            for (int ai = 0; ai < 2; ++ai)
#pragma unroll
                for (int m = 0; m < 4; ++m) {
                    const f32x4 ov0 = acc[ai][bj][m][0] * rs[ai][m] * gg0, ov1 = acc[ai][bj][m][1] * rs[ai][m] * gg1;
                    PG8_GAS float* op = go + (size_t)(ai * HALF + m * 16) * 1024 + co; *(PG8_GAS f32x4*)op = ov0; *(PG8_GAS f32x4*)(op + 4) = ov1; chain_ = ov1[0]; }
            asm volatile("" ::: "memory"); }
    }
};
struct EpiU {
    static constexpr bool PERM = true, AFTER_DRAIN = false, PREFETCH = false;
    bf16_t* UX; const ssq_t* ssq;
    __device__ __forceinline__ void operator()(const f32x4 (&acc)[2][2][4][2], const Unit& u, int wr, int wc, int fr, int fq) const {
        const int row0 = u.pm * BM + wr * 64 + fr, col0 = u.pn * BM + wc * 32 + 8 * fq;
        float rsv[2][4]; rstd8(ssq, row0, rsv);
#pragma unroll
        for (int ai = 0; ai < 2; ++ai)
#pragma unroll
            for (int m = 0; m < 4; ++m) { const int row = row0 + ai * HALF + m * 16; const float rs = rsv[ai][m];
#pragma unroll
                for (int bj = 0; bj < 2; ++bj) { const int col = col0 + bj * HALF; const f32x4 v0 = acc[ai][bj][m][0] * rs, v1 = acc[ai][bj][m][1] * rs;
                    u32x4 w; w.x = cvt_pk_bf16(v0[0], v0[1]); w.y = cvt_pk_bf16(v0[2], v0[3]); w.z = cvt_pk_bf16(v1[0], v1[1]); w.w = cvt_pk_bf16(v1[2], v1[3]);
                    st_wt((PG8_GAS bf16_t*)UX + ((size_t)(col >> 4) * 1024 + (row >> 4)) * 384 + (row & 15) * 16 + (col & 15), w); } }
    }
};
struct EpiSloc {
    static constexpr bool PERM = false, AFTER_DRAIN = true, PREFETCH = false;
    const float* lamc; bf16_t* UX; PG8_LAS unsigned char* esc;
    __device__ __forceinline__ void fused(f32x4 (&acc)[2][2][4][2], const Unit& u, int wr, int wc, int fr, int fq, PG8_LAS unsigned char* lds, int wid, int lane) const {
        PG8_LAS float* SL = (PG8_LAS float*)lds;
#pragma unroll
        for (int ai = 0; ai < 2; ++ai)
#pragma unroll
            for (int m = 0; m < 4; ++m)
#pragma unroll
                for (int n = 0; n < 2; ++n) *(PG8_LAS f32x4*)(SL + (ai * HALF + wr * 64 + m * 16 + fr) * 128 + wc * 32 + n * 16 + 4 * fq) = acc[ai][0][m][n];
        asm volatile("s_waitcnt lgkmcnt(0)" ::: "memory"); __builtin_amdgcn_s_barrier(); asm volatile("" ::: "memory");
        const int g = u.pn, b = u.pm, seg = wid, p = lane;
        const float lr = lamc[(g * 64 + p) * 2], li = lamc[(g * 64 + p) * 2 + 1];
        float sr = 0.f, si = 0.f;
        for (int c = seg * 32; c < seg * 32 + 32; ++c) { const float xr = SL[c * 128 + p], xi = SL[c * 128 + 64 + p]; const float nr = lr * sr - li * si + xr, ni = lr * si + li * sr + xi; sr = nr; si = ni; }
        PG8_LAS float* E = (PG8_LAS float*)esc;
        E[(seg * 64 + p) * 2] = sr; E[(seg * 64 + p) * 2 + 1] = si;
        asm volatile("s_waitcnt lgkmcnt(0)" ::: "memory"); __builtin_amdgcn_s_barrier(); asm volatile("" ::: "memory");
        float l32r = lr, l32i = li;
#pragma unroll
        for (int q = 0; q < 5; ++q) { const float t = l32r * l32r - l32i * l32i; l32i = 2.f * l32r * l32i; l32r = t; }
        sr = 0.f; si = 0.f;
        for (int j = 0; j < seg; ++j) { const float er = E[(j * 64 + p) * 2], ei = E[(j * 64 + p) * 2 + 1]; const float nr = l32r * sr - l32i * si + er, ni = l32r * si + l32i * sr + ei; sr = nr; si = ni; }
        bf16_t* dst = UX + ((size_t)g * 1024 + b * 256 + seg * 32) * 384 + 256 + p;
        for (int c = seg * 32; c < seg * 32 + 32; ++c) {
            { unsigned ur = __builtin_bit_cast(unsigned, sr), ui = __builtin_bit_cast(unsigned, si); ur = (ur + 0x7fffu + ((ur >> 16) & 1u)) >> 16; ui = (ui + 0x7fffu + ((ui >> 16) & 1u)) >> 16;
              dst[0] = (bf16_t)ur; dst[64] = (bf16_t)ui; }
            const float xr = SL[c * 128 + p], xi = SL[c * 128 + 64 + p]; const float nr = lr * sr - li * si + xr, ni = lr * si + li * sr + xi; sr = nr; si = ni;
            dst += 384; }
        asm volatile("s_waitcnt vmcnt(0) lgkmcnt(0)" ::: "memory"); __builtin_amdgcn_s_barrier(); asm volatile("" ::: "memory");
        if (wid == 0) { __builtin_amdgcn_fence(__ATOMIC_ACQUIRE, "agent"); asm volatile("s_waitcnt vmcnt(0)" ::: "memory"); }
        __builtin_amdgcn_s_barrier(); asm volatile("" ::: "memory");
    }
};
struct EpiY {
    static constexpr bool PERM = true, AFTER_DRAIN = false, PREFETCH = false;
    const bf16_t* UX; const float* dvec; bf16_t* G1;
    __device__ __forceinline__ void operator()(const f32x4 (&acc)[2][2][4][2], const Unit& u, int wr, int wc, int fr, int fq) const {
        const int g = u.pn, b = u.pm, ch0 = g * 16 + 8 * (fq & 1);
        const f32x4 d0 = *(const f32x4*)(dvec + ch0), d1 = *(const f32x4*)(dvec + ch0 + 4);
#pragma unroll
        for (int ai = 0; ai < 2; ++ai) {
            u32x4 uwv[4][2];
#pragma unroll
            for (int m = 0; m < 4; ++m)
#pragma unroll
                for (int bj = 0; bj < 2; ++bj) uwv[m][bj] = *(const PG8_GAS u32x4*)((const PG8_GAS bf16_t*)UX + ((size_t)g * 1024 + b * 256 + (ai * HALF + wr * 64 + m * 16 + fr)) * 384 + (8 * bj + 2 * wc + (fq >> 1)) * 16 + 8 * (fq & 1));
#pragma unroll
            for (int m = 0; m < 4; ++m) { const int R = ai * HALF + wr * 64 + m * 16 + fr;
#pragma unroll
                for (int bj = 0; bj < 2; ++bj) { const int i = 8 * bj + 2 * wc + (fq >> 1);
                    const u32x4 uw = uwv[m][bj];
                    float y[8];
#pragma unroll
                    for (int j = 0; j < 4; ++j) { y[j] = acc[ai][bj][m][0][j] + d0[j] * __builtin_bit_cast(float, (j & 1) ? (uw[j >> 1] & 0xffff0000u) : (uw[j >> 1] << 16));
                                                  y[4 + j] = acc[ai][bj][m][1][j] + d1[j] * __builtin_bit_cast(float, (j & 1) ? (uw[2 + (j >> 1)] & 0xffff0000u) : (uw[2 + (j >> 1)] << 16)); }
#pragma unroll
                    for (int j = 0; j < 8; ++j) { const float z = 0.7978845608028654f * (y[j] + 0.044715f * y[j] * y[j] * y[j]); y[j] = y[j] * fast_sigmoid(2.f * z); }
                    u32x4 w; w.x = cvt_pk_bf16(y[0], y[1]); w.y = cvt_pk_bf16(y[2], y[3]); w.z = cvt_pk_bf16(y[4], y[5]); w.w = cvt_pk_bf16(y[6], y[7]);
                    st_wt((PG8_GAS bf16_t*)G1 + (MK_G1_NATURAL ? ((size_t)(b * 4096 + 16 * R + i) * 1024 + g * 16 + 8 * (fq & 1)) : (((size_t)g * 16384 + b * 4096 + 16 * R + i) * 16 + 8 * (fq & 1))), w); } }
            asm volatile("" ::: "memory"); }
    }
};
}
#include <hip/hip_bf16.h>
#include <cmath>
namespace attn_body {
using bf16=__hip_bfloat16;
using bf16x8=__attribute__((ext_vector_type(8)))short;
using s16x4=__attribute__((ext_vector_type(4)))short;
using f32x16=__attribute__((ext_vector_type(16)))float;
using u32x4=__attribute__((ext_vector_type(4)))unsigned;
constexpr int BATCH=4,NHEAD=16,SEQ=4096,D=64,DM=NHEAD*D;
constexpr int NW=8,QBLK=32,QB=QBLK*NW,KVBLK=64,NQB=SEQ/QB;
constexpr int ATTN_PITCH=DM, ATTN_UNIT_ROWS=QB;
__device__ __forceinline__ int crow(int r,int hi){return (r&3)+8*(r>>2)+4*hi;}
#define SBAR() __builtin_amdgcn_sched_barrier(0)
__device__ __forceinline__ void cmask(f32x16&p0,f32x16&p1,int jb,int qrel,int hi){
  const float NEG=-INFINITY; int kb=64*jb+4*hi;
  #pragma unroll
  for(int r=0;r<16;++r){int kv=kb+(r&3)+8*(r>>2); if(kv>qrel)p0[r]=NEG; if(kv+32>qrel)p1[r]=NEG;}
}

constexpr int NSLOT=3, SLOTB=8192;
constexpr int LDS_K=0, LDS_V=NSLOT*SLOTB, LDS_WS=2*NSLOT*SLOTB, LDS_OST=LDS_WS+NW*64*4, LDS_BYTES=LDS_OST+NW*4096;
constexpr float C2=0.125f*1.4426950408889634f;
__device__ __forceinline__ void glds16(const void*gsrc,unsigned lds_dst){unsigned keep;
  asm volatile("s_mov_b32 %0, m0\n\ts_mov_b32 m0, %2\n\ts_nop 0\n\tglobal_load_lds_dwordx4 %1, off\n\ts_mov_b32 m0, %0":"=&s"(keep):"v"(gsrc),"s"(lds_dst):"memory");}
__device__ __forceinline__ float max3f(float a,float b,float c){float r;asm("v_max3_f32 %0, %1, %2, %3":"=v"(r):"v"(a),"v"(b),"v"(c));return r;}
__device__ __forceinline__ float max2f(float a,float b){float r;asm("v_max_f32_e32 %0, %1, %2":"=v"(r):"v"(a),"v"(b));return r;}
__device__ __forceinline__ float fadd_s(float a,float b){float r;asm("v_add_f32_e32 %0, %1, %2":"=v"(r):"v"(a),"v"(b));return r;}
__device__ __forceinline__ float fsub_s(float a,float b){float r;asm("v_sub_f32_e32 %0, %1, %2":"=v"(r):"v"(a),"v"(b));return r;}
typedef float f32x2_t __attribute__((ext_vector_type(2))); typedef __bf16 bf16x2_t __attribute__((ext_vector_type(2)));
__device__ __forceinline__ unsigned cvtpk_s(float lo,float hi){f32x2_t v={lo,hi};bf16x2_t b=__builtin_convertvector(v,bf16x2_t);return __builtin_bit_cast(unsigned,b);}
#define WAIT_BAR(N) asm volatile("s_waitcnt vmcnt(" #N ") lgkmcnt(0)\n\ts_barrier":::"memory")

__device__ __forceinline__ void qkt(f32x16&p0,f32x16&p1,const char*Kslot,const bf16x8*qr,int r32,int hi){
  const char*kb=Kslot+hi*1024+r32*16;
  #pragma unroll
  for(int d0=0;d0<4;++d0){
    const bf16x8 b0=*reinterpret_cast<const bf16x8*>(kb+d0*2048);
    const bf16x8 b1=*reinterpret_cast<const bf16x8*>(kb+d0*2048+512);
    {p0=__builtin_amdgcn_mfma_f32_32x32x16_bf16(b0,qr[d0],p0,0,0,0);p1=__builtin_amdgcn_mfma_f32_32x32x16_bf16(b1,qr[d0],p1,0,0,0);}}
}
typedef __attribute__((address_space(3))) const char* lds_cptr;
typedef short v4i16_t __attribute__((ext_vector_type(4)));
__device__ __forceinline__ void kload8(bf16x8*kf,lds_cptr kp){
  kf[0]=*(const __attribute__((address_space(3))) bf16x8*)(kp);      kf[1]=*(const __attribute__((address_space(3))) bf16x8*)(kp+512);
  kf[2]=*(const __attribute__((address_space(3))) bf16x8*)(kp+2048); kf[3]=*(const __attribute__((address_space(3))) bf16x8*)(kp+2560);
  kf[4]=*(const __attribute__((address_space(3))) bf16x8*)(kp+4096); kf[5]=*(const __attribute__((address_space(3))) bf16x8*)(kp+4608);
  kf[6]=*(const __attribute__((address_space(3))) bf16x8*)(kp+6144); kf[7]=*(const __attribute__((address_space(3))) bf16x8*)(kp+6656);
}
__device__ __forceinline__ void kload2(bf16x8*kf,lds_cptr kp,int j){ kf[2*j]=*(const __attribute__((address_space(3))) bf16x8*)(kp+j*2048); kf[2*j+1]=*(const __attribute__((address_space(3))) bf16x8*)(kp+j*2048+512); }
__device__ __forceinline__ s16x4 vtr(lds_cptr p){ return __builtin_bit_cast(s16x4,__builtin_amdgcn_ds_read_tr16_b64_v4i16((__attribute__((address_space(3))) v4i16_t*)p)); }
__device__ __forceinline__ float rowmax(const f32x16&p0,const f32x16&p1){
  float a=max3f(p0[0],p0[1],p1[0]),b=max3f(p0[2],p0[3],p1[1]);a=max3f(a,p1[2],p1[3]);
  #pragma unroll
  for(int r=4;r<16;r+=4){a=max3f(a,p0[r],p0[r+1]);b=max3f(b,p0[r+2],p0[r+3]);a=max3f(a,p1[r],p1[r+1]);b=max3f(b,p1[r+2],p1[r+3]);}
  const float m=max2f(a,b);
  auto rr=__builtin_amdgcn_permlane32_swap(__float_as_uint(m),__float_as_uint(m),false,false);
  return max2f(__uint_as_float(rr[0]),__uint_as_float(rr[1]));
}
__device__ __forceinline__ void pv(f32x16*o,int vb,bf16x8 pa0,bf16x8 pa1,bf16x8 pa2,bf16x8 pa3){
  #pragma unroll
  for(int d0=0;d0<2;++d0){s16x4 lo[4],hi[4];
    #pragma unroll
    for(int ks=0;ks<4;++ks){
      asm volatile("ds_read_b64_tr_b16 %0,%1 offset:%c2":"=&v"(lo[ks]):"v"(vb),"i"(d0*4096+ks*1024):"memory");
      asm volatile("ds_read_b64_tr_b16 %0,%1 offset:%c2":"=&v"(hi[ks]):"v"(vb),"i"(d0*4096+ks*1024+512):"memory");}
    asm volatile("s_waitcnt lgkmcnt(0)":::"memory");SBAR();
    #define PK(k) (bf16x8){lo[k][0],lo[k][1],lo[k][2],lo[k][3],hi[k][0],hi[k][1],hi[k][2],hi[k][3]}
    o[d0]=__builtin_amdgcn_mfma_f32_32x32x16_bf16(pa0,PK(0),o[d0],0,0,0);
    o[d0]=__builtin_amdgcn_mfma_f32_32x32x16_bf16(pa1,PK(1),o[d0],0,0,0);
    o[d0]=__builtin_amdgcn_mfma_f32_32x32x16_bf16(pa2,PK(2),o[d0],0,0,0);
    o[d0]=__builtin_amdgcn_mfma_f32_32x32x16_bf16(pa3,PK(3),o[d0],0,0,0);
    #undef PK
  }
}

#ifndef ATTN_STORE16
#define ATTN_STORE16(p,v) (*(u32x4*)(p)=(v))
#endif
typedef float f32x4b __attribute__((ext_vector_type(4)));
template<int THRL> __device__ __forceinline__ void attn_unit(int b,int h,int qb,const bf16*Q,const bf16*__restrict__ K,const bf16*__restrict__ V,bf16*O,char*shm,const __attribute__((address_space(3))) float*bl0,const int tid_,const int tskip){
  const __attribute__((address_space(3))) float*bl=bl0+tskip*64;
  const int tid=tid_,lane=tid&63,r32=lane&31,hi=lane>>5; const int wid=__builtin_amdgcn_readfirstlane(tid>>6);
  const long rowbase=(long)b*SEQ; const int q0=qb*QB;
  const bf16*Qw=Q+(rowbase+q0+wid*QBLK)*DM+h*D;
  const bf16*Kh=K+(rowbase+(long)tskip*KVBLK)*DM+h*D,*Vh=V+(rowbase+(long)tskip*KVBLK)*DM+h*D;
  const unsigned lds0=(unsigned)(uintptr_t)shm;
  float*wsf=(float*)(shm+LDS_WS)+wid*64;
  const bf16*ksrc=Kh+(long)lane*DM+wid*8;
  const bf16*vsrc=Vh+(long)(16*(wid&3)+(lane>>2))*DM+(wid>>2)*32+(lane&3)*8;
  const unsigned kdst=lds0+LDS_K+wid*1024, vdst=lds0+LDS_V+wid*1024;
  #define DMA_K(t,slot) glds16(ksrc+(long)(t)*KVBLK*DM,(unsigned)__builtin_amdgcn_readfirstlane(kdst+(slot)))
  #define DMA_V(t,slot) glds16(vsrc+(long)(t)*KVBLK*DM,(unsigned)__builtin_amdgcn_readfirstlane(vdst+(slot)))
  const int vb0=(int)(lds0+LDS_V)+((lane>>4)&1)*32+(lane&3)*8+(4*hi+((lane&15)>>2))*64;
  const char*Kbase=shm+LDS_K; bf16x8 kf[8];
  const lds_cptr shm3=(lds_cptr)shm; const lds_cptr kp0=shm3+LDS_K+hi*1024+r32*16; const lds_cptr vp0=shm3+LDS_V+((lane>>4)&1)*32+(lane&3)*8+(4*hi+((lane&15)>>2))*64;
  const int NT=(q0+QB)/KVBLK-tskip;
  DMA_K(0,0);DMA_V(0,0);DMA_K(1,SLOTB);
  bf16x8 qr[4];
  #pragma unroll
  for(int d0=0;d0<4;++d0)qr[d0]=*reinterpret_cast<const bf16x8*>(&Qw[(long)r32*DM+d0*16+hi*8]);
  float mhat=0.f,l_reg=0.f;f32x16 o[2];o[0]=f32x16{};o[1]=f32x16{};
  const int qrel=wid*QBLK+r32;
  #define CMASK(P0,P1,t) do{int jb_=(t)-(NT-4); if(jb_>=0)cmask(P0,P1,jb_,qrel,hi);}while(0)
  #define BIASLD(P0,P1,t) do{ const __attribute__((address_space(3))) f32x4b*bp_=(const __attribute__((address_space(3))) f32x4b*)(bl+(t)*64+hi*4); \
    _Pragma("unroll") for(int g_=0;g_<4;++g_){ const f32x4b b0_=bp_[2*g_],b1_=bp_[8+2*g_]; \
      P0[4*g_]=b0_[0];P0[4*g_+1]=b0_[1];P0[4*g_+2]=b0_[2];P0[4*g_+3]=b0_[3]; P1[4*g_]=b1_[0];P1[4*g_+1]=b1_[1];P1[4*g_+2]=b1_[2];P1[4*g_+3]=b1_[3]; } }while(0)
  bool resc=false;
  #define START(P0,P1) do{ const float rm=rowmax(P0,P1); resc=false; \
    { const float dl=rm; mhat=fadd_s(mhat,dl); \
      _Pragma("unroll") for(int r=0;r<16;++r){P0[r]=fsub_s(P0[r],dl);P1[r]=fsub_s(P1[r],dl);} } \
    _Pragma("unroll") for(int r=0;r<16;++r)P0[r]=__builtin_amdgcn_exp2f(P0[r]); }while(0)
  #define RESC() do{ if(resc){ asm volatile("s_waitcnt lgkmcnt(0)":::"memory"); \
      _Pragma("unroll") for(int d_=0;d_<2;++d_) _Pragma("unroll") for(int r=0;r<16;++r)o[d_][r]*=wsf[crow(r,hi)]; } }while(0)
  f32x16 pA0,pA1,pB0,pB1;
  int sl_prev=0,sl_cur=0,sl_next=SLOTB;
  #define ROT() do{sl_prev=sl_cur;sl_cur=sl_next;sl_next=(sl_next==(NSLOT-1)*SLOTB)?0:sl_next+SLOTB;}while(0)
  DMA_K(2,2*SLOTB);
  WAIT_BAR(3);
  BIASLD(pA0,pA1,0);qkt(pA0,pA1,Kbase,qr,r32,hi);asm volatile("s_nop 15\n\ts_nop 7":"+v"(pA0),"+v"(pA1));CMASK(pA0,pA1,0);
  START(pA0,pA1);
  _Pragma("unroll") for(int r=0;r<16;++r)pA1[r]=__builtin_amdgcn_exp2f(pA1[r]);
  WAIT_BAR(0);
  DMA_K(3,0);DMA_V(1,SLOTB);
  ROT();
  kload8(kf,kp0+sl_cur);
  WAIT_BAR(2);
  s16x4 vlo[8],vhi[8]; u32x4 pw0,pw1,pw2,pw3;
  #define PKW(P,B) cvtpk_s(P[B],P[B+1])
  #define PAF(k) __builtin_bit_cast(bf16x8,pw##k)
  #define VFR(i) (bf16x8){vlo[i][0],vlo[i][1],vlo[i][2],vlo[i][3],vhi[i][0],vhi[i][1],vhi[i][2],vhi[i][3]}
  #define PIN(x) asm volatile("":"+v"(x))
  #define MX3(a,b,c) __builtin_fmaxf(__builtin_fmaxf((a),(b)),(c))
  #define GAPA(MF,A0,A1,A2,A3,W0,W1,PW) do{ MF; sacc+=A0; sacc+=A1; sacc+=A2; sacc+=A3; PIN(sacc); W0; W1; PIN(PW); SBAR(); }while(0)
  #define EX(v) __builtin_amdgcn_exp2f(v)
  #define GAPB(MF,X,B) do{ MF; X[B]=EX(X[B]-mhat); X[B+1]=EX(X[B+1]-mhat); X[B+2]=EX(X[B+2]-mhat); X[B+3]=EX(X[B+3]-mhat); PIN(X); SBAR(); }while(0)
  #define VRD(i) do{ vlo[i]=vtr(vp_+(((i)>>2)*4096+((i)&3)*1024)); vhi[i]=vtr(vp_+(((i)>>2)*4096+((i)&3)*1024+512)); }while(0)
  #define KRD(G,j) do{ if(G){ kload2(kf,kp0+sl_next,j); SBAR(); } }while(0)
  #define STEP(C0,C1,P0,P1,t,GK,GV,GL) do{ SBAR(); BIASLD(C0,C1,t); SBAR(); \
    const lds_cptr vp_=vp0+sl_prev; \
    VRD(0); SBAR(); float sacc=(P0[0]+P0[1]); \
    GAPA(C0=__builtin_amdgcn_mfma_f32_32x32x16_bf16(kf[0],qr[0],C0,0,0,0), P0[2],P0[3],P0[4],P0[5],     pw0[0]=PKW(P0,0), pw0[1]=PKW(P0,2), pw0); \
    VRD(4); SBAR(); GAPA(C1=__builtin_amdgcn_mfma_f32_32x32x16_bf16(kf[1],qr[0],C1,0,0,0), P0[6],P0[7],P0[8],P0[9],     pw0[2]=PKW(P0,4), pw0[3]=PKW(P0,6), pw0); \
    VRD(1); SBAR(); GAPA(C0=__builtin_amdgcn_mfma_f32_32x32x16_bf16(kf[2],qr[1],C0,0,0,0),   P0[10],P0[11],P0[12],P0[13], pw1[0]=PKW(P0,8), pw1[1]=PKW(P0,10), pw1); \
    VRD(5); SBAR(); GAPA(C1=__builtin_amdgcn_mfma_f32_32x32x16_bf16(kf[3],qr[1],C1,0,0,0),   P0[14],P0[15],P1[0],P1[1],   pw1[2]=PKW(P0,12),pw1[3]=PKW(P0,14), pw1); \
    VRD(2); SBAR(); GAPA(C0=__builtin_amdgcn_mfma_f32_32x32x16_bf16(kf[4],qr[2],C0,0,0,0),   P1[2],P1[3],P1[4],P1[5],     pw2[0]=PKW(P1,0), pw2[1]=PKW(P1,2), pw2); \
    VRD(6); SBAR(); GAPA(C1=__builtin_amdgcn_mfma_f32_32x32x16_bf16(kf[5],qr[2],C1,0,0,0),   P1[6],P1[7],P1[8],P1[9],     pw2[2]=PKW(P1,4), pw2[3]=PKW(P1,6), pw2); \
    VRD(3); SBAR(); GAPA(C0=__builtin_amdgcn_mfma_f32_32x32x16_bf16(kf[6],qr[3],C0,0,0,0),   P1[10],P1[11],P1[12],P1[13], pw3[0]=PKW(P1,8), pw3[1]=PKW(P1,10), pw3); \
    VRD(7); SBAR(); GAPA(C1=__builtin_amdgcn_mfma_f32_32x32x16_bf16(kf[7],qr[3],C1,0,0,0),   P1[14],P1[15],0.f,0.f,       pw3[2]=PKW(P1,12),pw3[3]=PKW(P1,14), pw3); \
    l_reg+=sacc; \
    if(GK){DMA_K((t)+3,sl_cur);} if(GV){DMA_V((t)+1,sl_next);} \
    CMASK(C0,C1,t); \
    { float a=MX3(C0[0],C0[1],C1[0]),b=MX3(C0[2],C0[3],C1[1]); a=MX3(a,C1[2],C1[3]); \
      _Pragma("unroll") for(int r=4;r<16;r+=4){a=MX3(a,C0[r],C0[r+1]);b=MX3(b,C0[r+2],C0[r+3]);a=MX3(a,C1[r],C1[r+1]);b=MX3(b,C1[r+2],C1[r+3]);} \
      float rm=__builtin_fmaxf(a,b); { auto rr=__builtin_amdgcn_permlane32_swap(__float_as_uint(rm),__float_as_uint(rm),false,false); rm=__builtin_fmaxf(__uint_as_float(rr[0]),__uint_as_float(rr[1])); } \
      resc=false; const float dm_=rm-mhat; \
      if(__builtin_expect(__any(dm_>(float)THRL),0)){ const float dl=__builtin_fmaxf(dm_,0.f); mhat+=dl; \
        const float f=__builtin_amdgcn_exp2f(-dl); l_reg*=f; if(hi==0)wsf[r32]=f; resc=true; } } \
    SBAR(); \
    GAPB(o[0]=__builtin_amdgcn_mfma_f32_32x32x16_bf16(PAF(0),VFR(0),o[0],0,0,0), C0,0); \
    GAPB(o[1]=__builtin_amdgcn_mfma_f32_32x32x16_bf16(PAF(0),VFR(4),o[1],0,0,0), C0,4); \
    KRD(GL,0); GAPB(o[0]=__builtin_amdgcn_mfma_f32_32x32x16_bf16(PAF(1),VFR(1),o[0],0,0,0), C0,8); \
    KRD(GL,1); GAPB(o[1]=__builtin_amdgcn_mfma_f32_32x32x16_bf16(PAF(1),VFR(5),o[1],0,0,0), C0,12); \
    KRD(GL,2); GAPB(o[0]=__builtin_amdgcn_mfma_f32_32x32x16_bf16(PAF(2),VFR(2),o[0],0,0,0), C1,0); \
    KRD(GL,3); GAPB(o[1]=__builtin_amdgcn_mfma_f32_32x32x16_bf16(PAF(2),VFR(6),o[1],0,0,0), C1,4); \
    GAPB(o[0]=__builtin_amdgcn_mfma_f32_32x32x16_bf16(PAF(3),VFR(3),o[0],0,0,0), C1,8); \
    GAPB(o[1]=__builtin_amdgcn_mfma_f32_32x32x16_bf16(PAF(3),VFR(7),o[1],0,0,0), C1,12); \
    }while(0)
  int t=1;
  #undef CMASK
  #define CMASK(P0,P1,t) do{}while(0)
  for(;t+5<NT;t+=2){
    STEP(pB0,pB1,pA0,pA1,t,true,true,true);     WAIT_BAR(2); RESC(); ROT();
    STEP(pA0,pA1,pB0,pB1,t+1,true,true,true);   WAIT_BAR(2); RESC(); ROT();
  }
  #undef CMASK
  #define CMASK(P0,P1,t) do{int jb_=(t)-(NT-4); if(jb_>=0)cmask(P0,P1,jb_,qrel,hi);}while(0)
  #define ENDW(tt) do{ if((tt)+3<NT){WAIT_BAR(2);} else if((tt)+2<NT){WAIT_BAR(1);} else {WAIT_BAR(0);} }while(0)
  for(;t+1<NT;t+=2){
    STEP(pB0,pB1,pA0,pA1,t,(t+3<NT),(t+1<NT),(t+1<NT));       ENDW(t);   RESC(); ROT();
    STEP(pA0,pA1,pB0,pB1,t+1,(t+4<NT),(t+2<NT),(t+2<NT));     ENDW(t+1); RESC(); ROT();
  }
  STEP(pB0,pB1,pA0,pA1,NT-1,false,false,false); RESC();
  { float sacc=pB0[0]+pB0[1]; _Pragma("unroll") for(int r=2;r<16;++r)sacc+=pB0[r]; _Pragma("unroll") for(int r=0;r<16;++r)sacc+=pB1[r]; l_reg+=sacc;
    pw0=(u32x4){PKW(pB0,0),PKW(pB0,2),PKW(pB0,4),PKW(pB0,6)};pw1=(u32x4){PKW(pB0,8),PKW(pB0,10),PKW(pB0,12),PKW(pB0,14)};pw2=(u32x4){PKW(pB1,0),PKW(pB1,2),PKW(pB1,4),PKW(pB1,6)};pw3=(u32x4){PKW(pB1,8),PKW(pB1,10),PKW(pB1,12),PKW(pB1,14)};
    SBAR(); pv(o,vb0+sl_cur,PAF(0),PAF(1),PAF(2),PAF(3)); }
  #undef PKW
  #undef PAF
  #undef VFR
  #undef PIN
  #undef MX3
  #undef GAPA
  #undef GAPB
  #undef EX
  #undef VRD
  #undef KRD
  #undef STEP
  #undef ENDW
  {auto rr=__builtin_amdgcn_permlane32_swap(__float_as_uint(l_reg),__float_as_uint(l_reg),false,false);l_reg=__uint_as_float(rr[0])+__uint_as_float(rr[1]);}
  if(hi==0)wsf[32+r32]=l_reg;asm volatile("s_waitcnt lgkmcnt(0)":::"memory");
  float rli[16];
  #pragma unroll
  for(int r=0;r<16;++r)rli[r]=__builtin_amdgcn_rcpf(wsf[32+crow(r,hi)]);
  bf16*Ow=O+(rowbase+q0+wid*QBLK)*DM+h*D;
  { bf16*stg=(bf16*)(shm+LDS_OST)+wid*2048;
    #pragma unroll
    for(int r=0;r<16;++r){const int orow=crow(r,hi);
      #pragma unroll
      for(int d0=0;d0<2;++d0)stg[orow*64+d0*32+r32]=__float2bfloat16(o[d0][r]*rli[r]);}
    asm volatile("s_waitcnt lgkmcnt(0)":::"memory");
    #pragma unroll
    for(int i=0;i<4;++i){const int row=i*8+(lane>>3),ch=lane&7; const u32x4 v=*(const u32x4*)(stg+row*64+ch*8); ATTN_STORE16(Ow+(long)row*DM+ch*8,v);} }
  asm volatile("s_waitcnt lgkmcnt(0)\n\ts_barrier":::"memory");
  #undef DMA_K
  #undef DMA_V
  #undef CMASK
  #undef BIASLD
  #undef START
  #undef RESC
  #undef ROT
}
constexpr int ATTN_LDS_BYTES=LDS_BYTES;
struct AttnTensors { const bf16* Q; const bf16* K; const bf16* V; bf16* O; };
struct AttnUnit { int bh; int qb; };
struct StaticOrder {
  int vcu;
  __device__ __forceinline__ explicit StaticOrder(int grid,int block):vcu((block%8)*(grid/8)+block/8){}
  __device__ __forceinline__ bool next(int i,AttnUnit&u)const{ if(i>=4)return false; const int s=vcu&3; u.bh=vcu>>2; u.qb=(i==0)?s:(i==1)?7-s:(i==2)?8+s:15-s; return true; }
};
template<class Sched,int THRL=8> __device__ __forceinline__ void attn_phase(char*lds,const AttnTensors&T,const Sched&S,const __attribute__((address_space(3))) float*bl,const int tid,const __attribute__((address_space(3))) int*tsk){
  AttnUnit u;
  for(int i=0;S.next(i,u);++i){ attn_unit<THRL>(u.bh/NHEAD,u.bh%NHEAD,u.qb,T.Q,T.K,T.V,T.O,lds,bl,tid,__builtin_amdgcn_readfirstlane(tsk[i])); }
}
#undef SBAR
#undef WAIT_BAR
}
namespace mk {
#define LAS __attribute__((address_space(3)))
#define XB_TMO      128
#define XB_XCNT(j)  (256  + 64 * (j))
#define XB_XSUB(j)  (1280 + 64 * (j))
#define XB_XGEN(j)  (2304 + 64 * (j))
#define XB_TOP      3328
#define XB_TOPGEN   3392
#define XCD_BAR_WORDS 3456
#define XB_SPIN_CAP (1u << 18)

__device__ __forceinline__ unsigned xb_ld(unsigned* p)              { return __hip_atomic_load(p, __ATOMIC_RELAXED, __HIP_MEMORY_SCOPE_AGENT); }
__device__ __forceinline__ unsigned xb_add(unsigned* p, unsigned v) { return __hip_atomic_fetch_add(p, v, __ATOMIC_RELAXED, __HIP_MEMORY_SCOPE_AGENT); }
__device__ __forceinline__ unsigned xb_xcc_id() { return (unsigned)__builtin_amdgcn_s_getreg((3 << 11) | 20) & 0xFu; }
#define XB_SPIN(cond, bar) do { unsigned _sp = 0; while (cond) { __builtin_amdgcn_s_sleep(1); \
    if ((++_sp & 255u) == 0u) { if (xb_ld(&(bar)[XB_TMO])) break; if (_sp > XB_SPIN_CAP) { atomicAdd(&(bar)[XB_TMO], 1u); break; } } } } while (0)

struct XcdBarrier {
    unsigned* bar; unsigned x;
    volatile LAS unsigned* st;
};

__device__ __forceinline__ XcdBarrier xcd_barrier_post(unsigned* bar, volatile LAS unsigned* st) {
    XcdBarrier b; b.bar = bar; b.x = xb_xcc_id(); b.st = st;
    if (threadIdx.x == 0) (void)xb_add(&bar[XB_XCNT(b.x)], 1u);
    return b;
}
__device__ __forceinline__ void xcd_barrier_complete(unsigned* bar, unsigned x, unsigned& nloc, unsigned& nx) {
    const unsigned G = gridDim.x * gridDim.y * gridDim.z;
    unsigned sum, cnt, mine, sp = 0u;
    for (;;) {
        sum = 0u; cnt = 0u; mine = 0u;
#pragma unroll
        for (unsigned j = 0; j < 16; ++j) { const unsigned c = xb_ld(&bar[XB_XCNT(j)]); sum += c; cnt += (c > 0u) ? 1u : 0u; mine = (j == x) ? c : mine; }
        if (sum == G) break;
        __builtin_amdgcn_s_sleep(1);
        if ((++sp & 255u) == 0u) { if (xb_ld(&bar[XB_TMO])) break; if (sp > XB_SPIN_CAP) { atomicAdd(&bar[XB_TMO], 1u); break; } }
    }
    nloc = mine > 0u ? mine : 1u; nx = cnt > 0u ? cnt : 1u;
}

__device__ __forceinline__ void xcd_barrier(const XcdBarrier& b) {
    asm volatile("s_waitcnt vmcnt(0)" ::: "memory");
    __syncthreads();
    if (threadIdx.x == 0) {
        unsigned* bar = b.bar;
        __builtin_amdgcn_s_waitcnt(0);
        unsigned nloc = b.st[0], nx = b.st[1];
        if (nloc == 0u) { xcd_barrier_complete(bar, b.x, nloc, nx); b.st[0] = nloc; b.st[1] = nx; }
        const unsigned old = xb_add(&bar[XB_XSUB(b.x)], 1u);
        const unsigned gen = old / nloc;
        if (old + 1u == (gen + 1u) * nloc) {
            __builtin_amdgcn_fence(__ATOMIC_RELEASE, "agent");
            asm volatile("s_waitcnt vmcnt(0)" ::: "memory");
            const unsigned og = xb_add(&bar[XB_TOP], 1u);
            const unsigned tg = og / nx;
            if (og + 1u == (tg + 1u) * nx) xb_add(&bar[XB_TOPGEN], 1u);
            else XB_SPIN(xb_ld(&bar[XB_TOPGEN]) == tg, bar);
            __builtin_amdgcn_fence(__ATOMIC_ACQUIRE, "agent");
            xb_add(&bar[XB_XGEN(b.x)], 1u);
            asm volatile("s_waitcnt vmcnt(0)" ::: "memory");
        } else {
            XB_SPIN(xb_ld(&bar[XB_XGEN(b.x)]) == gen, bar);
            __builtin_amdgcn_fence(__ATOMIC_ACQUIRE, "agent");
            asm volatile("s_waitcnt vmcnt(0)" ::: "memory");
        }
    }
    __syncthreads();
}

#undef LAS
}
namespace mk {
constexpr int NWAVES = 8;
constexpr int D = 1024, BATCH = 4, SEQ = 4096, M = BATCH * SEQ, DEPTH = 4, NH = 16, HD = 64, FOX_IN = 3 * D + NH, DFF = 2816;
constexpr int SG = 64, SP = 64, SC = 16;
constexpr float RMS_EPS = 1e-6f;
constexpr size_t MiB = 1u << 20;
constexpr size_t WS_CTL = 276 * MiB, CTL_ZERO_BYTES = 3 * MiB;
constexpr size_t WS_SSQ = 277 * MiB;
constexpr size_t WS_WQKV = 2 * MiB;
constexpr size_t WS_WO = 14 * MiB;
constexpr size_t WS_WS5IN = 18 * MiB;
constexpr size_t WS_WGLU = 20 * MiB;
constexpr size_t WS_BTA = 24 * MiB;
constexpr size_t WS_BTB = 32 * MiB;
constexpr size_t WS_WPOOL = 44 * MiB;
constexpr size_t WS_WF = 44 * MiB + 512 * 1024;
constexpr size_t WS_KERN = 45 * MiB;
constexpr size_t WS_LAMC = 46 * MiB;
constexpr size_t WS_LF = 47 * MiB;
constexpr size_t WS_WGU = 48 * MiB;
constexpr size_t WS_WDN = 92 * MiB;
constexpr size_t WS_XB = 114 * MiB;
constexpr size_t WS_ACT = 146 * MiB;
constexpr size_t WS_O = 244 * MiB;
constexpr size_t WS_NRM = 279 * MiB;
constexpr size_t WS_END = 283 * MiB;
constexpr int CW_TMO = 0, CW_BAR = 4096, CW_PANEL = 16384, CW_QUEUE = 24576;

constexpr int RING_OFF = 0, RING_BYTES = 131072;
constexpr int LDSCTL_OFF = RING_BYTES, MISC_OFF = LDSCTL_OFF + 320;
constexpr int LDS_BYTES = 147456;

#define GAS __attribute__((address_space(1)))
#define LAS __attribute__((address_space(3)))
typedef unsigned short bf16;
typedef unsigned v4u __attribute__((ext_vector_type(4)));
typedef float f32x4 __attribute__((ext_vector_type(4)));
typedef float f32x2 __attribute__((ext_vector_type(2)));
typedef short bf16x8 __attribute__((ext_vector_type(8)));
typedef GAS unsigned gu32;
#define RLX_AGENT __ATOMIC_RELAXED, __HIP_MEMORY_SCOPE_AGENT
#define LDS_WAIT() asm volatile("s_waitcnt lgkmcnt(0)" ::: "memory")
#define VM_WAIT() asm volatile("s_waitcnt vmcnt(0)" ::: "memory")
__device__ __forceinline__ unsigned f2bf(float f) { unsigned u = __builtin_bit_cast(unsigned, f); return (u + 0x7fffu + ((u >> 16) & 1u)) >> 16; }
__device__ __forceinline__ unsigned pk2(float lo, float hi) { return f2bf(lo) | (f2bf(hi) << 16); }
__device__ __forceinline__ float bf2f(unsigned short b) { return __builtin_bit_cast(float, (unsigned)b << 16); }
__device__ __forceinline__ float lshx(float v, int lane, int m) { return __builtin_bit_cast(float, __builtin_amdgcn_ds_bpermute((lane ^ m) << 2, __builtin_bit_cast(int, v))); }
__device__ __forceinline__ float wave_sum(float v, int lane) {
#pragma unroll
    for (int o = 1; o < 64; o <<= 1) v += lshx(v, lane, o);
    return v;
}

enum Op { OP_PROLOGUE = 0, OP_QKV, OP_ATTN, OP_WO, OP_UP, OP_DOWN, OP_S5IN, OP_SSM, OP_SSMB, OP_GLU, OP_POOLPREP, OP_POOLGEMM, OP_FINAL, OP_NORMX, OP_S5TAB };
struct PhaseEnt { int op, layer, j, sin, sout; };
#define MK_PROGRAM \
    {OP_PROLOGUE, 0, 0, 0, 0}, \
    {OP_QKV, 0, 0, 0, 0}, {OP_ATTN, 0, 0, 0, 0}, {OP_WO, 0, 0, 0, 1}, {OP_UP, 0, 0, 1, 0}, {OP_DOWN, 0, 0, 0, 2}, \
    {OP_S5IN, 1, 0, 2, 0}, {OP_SSM, 1, 0, 0, 0}, {OP_GLU, 1, 0, 0, 3}, {OP_UP, 1, 0, 3, 0}, {OP_DOWN, 1, 0, 0, 4}, \
    {OP_POOLGEMM, 2, 0, 4, 5}, {OP_UP, 2, 0, 5, 0}, {OP_DOWN, 2, 0, 0, 6}, \
    {OP_QKV, 3, 1, 6, 0}, {OP_ATTN, 3, 1, 0, 0}, {OP_WO, 3, 1, 0, 7}, {OP_UP, 3, 0, 7, 0}, {OP_DOWN, 3, 0, 0, 8}, \
    {OP_FINAL, 0, 0, 8, 0}, \
    {OP_NORMX, 0, 0, 0, 1}, {OP_NORMX, 0, 0, 0, 2}, {OP_NORMX, 0, 0, 0, 3}, {OP_NORMX, 0, 0, 0, 4}, {OP_NORMX, 0, 0, 0, 5}, {OP_NORMX, 0, 0, 0, 6}, {OP_NORMX, 0, 0, 0, 7}, {OP_NORMX, 0, 0, 0, 8}, \
    {OP_S5TAB, 0, 0, 0, 0}
constexpr int N_PROG = 29, PH_FINAL = 19, PH_LAST = 18, PH_NORMX1 = 20, PH_S5TAB = 28;
__constant__ PhaseEnt PROG[N_PROG] = { MK_PROGRAM };

struct Args { const float* in[22]; float* out; unsigned char* ws; int ph_lo, ph_hi; };

__device__ __forceinline__ void wt_load(f32x4 (&v)[8], const float* W, int ldw, int n0_src, int k0, int lane) {
    const int c4 = lane & 7, r8 = lane >> 3;
    const GAS f32x4* src = (const GAS f32x4*)(W + (size_t)(k0 + r8) * ldw + n0_src + 4 * c4);
#pragma unroll
    for (int i = 0; i < 8; ++i) v[i] = MK_WNT ? __builtin_nontemporal_load(src + (size_t)i * 2 * ldw) : src[(size_t)i * 2 * ldw];
}
__device__ __forceinline__ void wt_store(f32x4 (&v)[8], int K, const float* gain, bf16* WT, int n0_dst, int k0, LAS float* scr, int lane) {
    const int c4 = lane & 7, r8 = lane >> 3;
    if (gain) {
#pragma unroll
        for (int i = 0; i < 8; ++i) v[i] = v[i] * gain[k0 + r8 + 8 * i]; }
#pragma unroll
    for (int i = 0; i < 8; ++i) { LAS float* d = scr + (r8 + 8 * i) * 33 + 4 * c4; d[0] = v[i].x; d[1] = v[i].y; d[2] = v[i].z; d[3] = v[i].w; }
    LDS_WAIT(); asm volatile("" ::: "memory");
    const int c = lane & 7;
#pragma unroll
    for (int j = 0; j < 4; ++j) { const int n = (lane >> 3) + 8 * j; const LAS float* s = scr + (8 * c) * 33 + n;
        v4u o; o.x = pk2(s[0 * 33], s[1 * 33]); o.y = pk2(s[2 * 33], s[3 * 33]); o.z = pk2(s[4 * 33], s[5 * 33]); o.w = pk2(s[6 * 33], s[7 * 33]);
        pg8::st_wt((GAS bf16*)WT + (size_t)(n0_dst + n) * K + k0 + 8 * c, o); }
    LDS_WAIT(); asm volatile("" ::: "memory");
}
__device__ __forceinline__ void wt_item(const float* W, int ldw, int K, const float* gain, bf16* WT, int n0_dst, int n0_src, int k0, LAS float* scr, int lane) {
    f32x4 v[8]; wt_load(v, W, ldw, n0_src, k0, lane); wt_store(v, K, gain, WT, n0_dst, k0, scr, lane);
}
template <int NR> __device__ __forceinline__ void normx_rows(const float* x0, size_t xstride, bf16* o0, size_t ostride, pg8::ssq_t* ssq0, size_t sstride, int lane) {
    f32x4 v[NR][4]; float s[NR];
#pragma unroll
    for (int r = 0; r < NR; ++r) { const GAS f32x4* xr = (const GAS f32x4*)(x0 + r * xstride) + lane;
#pragma unroll
        for (int j = 0; j < 4; ++j) v[r][j] = xr[64 * j]; }
#pragma unroll
    for (int r = 0; r < NR; ++r) { s[r] = 0.f;
#pragma unroll
        for (int j = 0; j < 4; ++j) s[r] += (v[r][j].x * v[r][j].x + v[r][j].y * v[r][j].y) + (v[r][j].z * v[r][j].z + v[r][j].w * v[r][j].w);
        s[r] = wave_sum(s[r], lane); }
#pragma unroll
    for (int r = 0; r < NR; ++r) { GAS unsigned long long* o8 = (GAS unsigned long long*)(o0 + r * ostride) + lane;
#pragma unroll
        for (int j = 0; j < 4; ++j) pg8::st_wt(o8 + 64 * j, (unsigned long long)pk2(v[r][j].x, v[r][j].y) | ((unsigned long long)pk2(v[r][j].z, v[r][j].w) << 32));
        if (lane == 0) ssq0[r * sstride] = (pg8::ssq_t)__builtin_llrintf(s[r] * pg8::SSQ_SCALE); }
}
__device__ __forceinline__ void normx_row(const float* xrow, bf16* orow, pg8::ssq_t* ssq_slot, int lane) { normx_rows<1>(xrow, 0, orow, 0, ssq_slot, 0, lane); }
__device__ __forceinline__ f32x4 bf4(const pg8::u32x2 w) { return (f32x4){__builtin_bit_cast(float, w.x << 16), __builtin_bit_cast(float, w.x & 0xffff0000u), __builtin_bit_cast(float, w.y << 16), __builtin_bit_cast(float, w.y & 0xffff0000u)}; }
template <int W> __device__ __forceinline__ void pool_item(const bf16* X, const pg8::ssq_t* ssq, const f32x4 gg, bf16* PD, int row0, int t0, int c0) {
    f32x4 ring[W]; f32x4 run = {0.f, 0.f, 0.f, 0.f};
    { pg8::u32x2 xw[W]; pg8::ssq_t sw[W];
#pragma unroll
      for (int kk = 1; kk < W; ++kk) { xw[kk] = (pg8::u32x2){0u, 0u}; sw[kk] = 0;
          if (t0 - W + kk >= 0) { const int r = row0 - W + kk; xw[kk] = *(const GAS pg8::u32x2*)(X + (size_t)r * D + c0); sw[kk] = ((const GAS pg8::ssq_t*)ssq)[r]; } }
#pragma unroll
      for (int kk = 1; kk < W; ++kk) {
          const f32x4 hv = bf4(xw[kk]) * __builtin_amdgcn_rsqf((float)sw[kk] * (1.0f / (1024.0f * pg8::SSQ_SCALE)) + RMS_EPS) * gg;
          ring[kk % W] = hv; run += hv; } }
    pg8::u32x2 xc[16]; pg8::ssq_t sc[16];
#pragma unroll
    for (int i = 0; i < 16; ++i) { xc[i] = *(const GAS pg8::u32x2*)(X + (size_t)(row0 + i) * D + c0); sc[i] = ((const GAS pg8::ssq_t*)ssq)[row0 + i]; }
#pragma unroll
    for (int i = 0; i < 16; ++i) { const int r = row0 + i, t = t0 + i;
        const f32x4 hv = bf4(xc[i]) * __builtin_amdgcn_rsqf((float)sc[i] * (1.0f / (1024.0f * pg8::SSQ_SCALE)) + RMS_EPS) * gg;
        run += hv; ring[i % W] = hv;
        const int cnt = (t + 1 < W) ? (t + 1) : W; const f32x4 o = run * (1.0f / (float)cnt) - hv;
        pg8::st_wt((GAS bf16*)PD + (size_t)r * D + c0, (unsigned long long)pk2(o[0], o[1]) | ((unsigned long long)pk2(o[2], o[3]) << 32));
        run -= ring[(i + 1) % W]; }
}
__device__ __forceinline__ void touch_lines(const void* p, int bytes, int tid) {
    const GAS unsigned* q = (const GAS unsigned*)p + tid * 32; unsigned acc = 0;
    for (int o = 0; o < bytes; o += 512 * 128 * 8) {
#pragma unroll
        for (int i = 0; i < 8; ++i) acc |= q[(size_t)(o / 4) + (size_t)i * 512 * 32];
    }
    asm volatile("" :: "v"(acc));
}
struct WtDesc { const float* W; const float* gain; bf16* WT; int ldw, K, Ndst, kind, off2; };
__device__ __forceinline__ WtDesc wt_desc(const Args& args, int i) {
    unsigned char* ws = args.ws; const float* mix_g = args.in[1]; const float* ffn_g = args.in[2];
    WtDesc d;
    if (i < 2) { d.W = args.in[4] + (size_t)i * D * FOX_IN; d.gain = mix_g + (i ? 3 * D : 0); d.WT = (bf16*)(ws + WS_WQKV) + (size_t)i * 3 * D * D; d.ldw = FOX_IN; d.K = D; d.Ndst = 3 * D; d.kind = 0; d.off2 = 0; }
    else if (i < 4) { d.W = args.in[6] + (size_t)(i - 2) * D * D; d.gain = nullptr; d.WT = (bf16*)(ws + WS_WO) + (size_t)(i - 2) * D * D; d.ldw = D; d.K = D; d.Ndst = D; d.kind = 0; d.off2 = 0; }
    else if (i == 4) { d.W = args.in[7]; d.gain = mix_g + D; d.WT = (bf16*)(ws + WS_WS5IN); d.ldw = D; d.K = D; d.Ndst = D; d.kind = 0; d.off2 = 0; }
    else if (i == 5) { d.W = args.in[16]; d.gain = nullptr; d.WT = (bf16*)(ws + WS_WGLU); d.ldw = 2 * D; d.K = D; d.Ndst = 2 * D; d.kind = 1; d.off2 = D; }
    else if (i < 10) { d.W = args.in[17] + (size_t)(i - 6) * 65536; d.gain = nullptr; d.WT = (bf16*)(ws + WS_WPOOL) + (size_t)(i - 6) * 65536; d.ldw = 256; d.K = 256; d.Ndst = 256; d.kind = 0; d.off2 = 0; }
    else if (i < 14) { d.W = args.in[20] + (size_t)(i - 10) * D * 2 * DFF; d.gain = ffn_g + (i - 10) * D; d.WT = (bf16*)(ws + WS_WGU) + (size_t)(i - 10) * 2 * DFF * D; d.ldw = 2 * DFF; d.K = D; d.Ndst = 2 * DFF; d.kind = 1; d.off2 = DFF; }
    else { d.W = args.in[21] + (size_t)(i - 14) * DFF * D; d.gain = nullptr; d.WT = (bf16*)(ws + WS_WDN) + (size_t)(i - 14) * D * DFF; d.ldw = D; d.K = DFF; d.Ndst = D; d.kind = 0; d.off2 = 0; }
    return d;
}
__device__ __forceinline__ void ph_s5tables(const Args& args, LAS float* scr, LAS float* wsc, int gw, int NGW, int lane) {
    unsigned char* ws = args.ws;
    { const float* a_re = args.in[8]; const float* a_im = args.in[9]; const float* log_dt = args.in[10];
      const float* b_re = args.in[11]; const float* b_im = args.in[12]; const float* c_re = args.in[13]; const float* c_im = args.in[14];
      float* KERN = (float*)(ws + WS_KERN);
      for (int it = (gw + NGW / 2) % NGW; it < SG * 16; it += NGW) {
          const int g = it >> 4, tau = it & 15, p = lane;
          { const GAS f32x4* s0 = (const GAS f32x4*)(c_re + (size_t)g * 1024), *s1 = (const GAS f32x4*)(c_im + (size_t)g * 1024), *s2 = (const GAS f32x4*)(b_re + (size_t)g * 1024), *s3 = (const GAS f32x4*)(b_im + (size_t)g * 1024);
            f32x4 t0[4], t1[4], t2[4], t3[4];
#pragma unroll
            for (int j = 0; j < 4; ++j) { t0[j] = s0[lane + 64 * j]; t1[j] = s1[lane + 64 * j]; t2[j] = s2[lane + 64 * j]; t3[j] = s3[lane + 64 * j]; }
#pragma unroll
            for (int j = 0; j < 4; ++j) { ((LAS f32x4*)scr)[lane + 64 * j] = t0[j]; ((LAS f32x4*)scr)[256 + lane + 64 * j] = t1[j]; ((LAS f32x4*)scr)[512 + lane + 64 * j] = t2[j]; ((LAS f32x4*)scr)[768 + lane + 64 * j] = t3[j]; } }
          const double lr = a_re[g * SP + p], li = a_im[g * SP + p], dt = exp((double)log_dt[g]);
          const double er = exp(lr * dt), lbr = er * cos(li * dt), lbi = er * sin(li * dt);
          const double nr = lbr - 1.0, ni = lbi, den = lr * lr + li * li, fr = (nr * lr + ni * li) / den, fi = (ni * lr - nr * li) / den;
          const double et = exp(lr * dt * tau), ptr_ = et * cos(li * dt * tau), pti = et * sin(li * dt * tau);
          wsc[p] = (float)(ptr_ * fr - pti * fi); wsc[64 + p] = (float)(ptr_ * fi + pti * fr);
          LDS_WAIT(); asm volatile("" ::: "memory");
          const LAS float* Cr = scr, *Ci = scr + 1024, *Br = scr + 2048, *Bi = scr + 3072, *Wr_ = wsc, *Wi_ = wsc + 64;
          float acc[4] = {0.f, 0.f, 0.f, 0.f}; const int ci = lane & 15, cob = lane >> 4;
#pragma unroll 8
          for (int pp = 0; pp < SP; ++pp) {
              const float wr = Wr_[pp], wi = Wi_[pp], br = Br[pp * 16 + ci], bi = Bi[pp * 16 + ci];
#pragma unroll
              for (int q = 0; q < 4; ++q) { const int co = cob + 4 * q; const float cr = Cr[co * 64 + pp], cim = Ci[co * 64 + pp];
                  const float cwr = cr * wr - cim * wi, cwi = cr * wi + cim * wr; acc[q] += cwr * br - cwi * bi; } }
#pragma unroll
          for (int q = 0; q < 4; ++q) KERN[(size_t)it * 256 + lane + 64 * q] = acc[q];
          LDS_WAIT(); asm volatile("" ::: "memory");
      }
      bf16* BTA = (bf16*)(ws + WS_BTA);
      for (int e = gw * 64 + lane; e < SG * 128 * 16; e += NGW * 64) {
          const int g = e >> 11, n = (e >> 4) & 127, j = e & 15, p = n & 63, im = n >> 6;
          const double lr = a_re[g * SP + p], li = a_im[g * SP + p], dt = exp((double)log_dt[g]);
          const double er = exp(lr * dt), lbr = er * cos(li * dt), lbi = er * sin(li * dt);
          const double nr = lbr - 1.0, ni = lbi, den = lr * lr + li * li, fr = (nr * lr + ni * li) / den, fi = (ni * lr - nr * li) / den;
          const double tt = (double)(15 - j), et = exp(lr * dt * tt), ptr_ = et * cos(li * dt * tt), pti = et * sin(li * dt * tt);
          const float Wr = (float)(ptr_ * fr - pti * fi), Wi = (float)(ptr_ * fi + pti * fr);
          unsigned w[8];
#pragma unroll
          for (int c = 0; c < 16; c += 2) { float v[2];
#pragma unroll
              for (int q = 0; q < 2; ++q) { const float br = b_re[(g * SP + p) * SC + c + q], bi = b_im[(g * SP + p) * SC + c + q]; v[q] = im ? (Wr * bi + Wi * br) : (Wr * br - Wi * bi); }
              w[c >> 1] = pk2(v[0], v[1]); }
          v4u* dst = (v4u*)(BTA + ((size_t)g * 256 + n) * 256 + j * 16);
          dst[0] = (v4u){w[0], w[1], w[2], w[3]}; dst[1] = (v4u){w[4], w[5], w[6], w[7]};
      }
      for (int e = gw * 64 + lane; e < SG * 128 * 32; e += NGW * 64) { const int g = e >> 12, r = e & 4095; ((v4u*)(BTA + ((size_t)g * 256 + 128) * 256))[r] = (v4u){0u, 0u, 0u, 0u}; }
      bf16* BTB = (bf16*)(ws + WS_BTB);
      for (int e = gw * 64 + lane; e < SG * 16 * SP; e += NGW * 64) {
          const int g = e >> 10, i = (e >> 6) & 15, p = e & 63;
          const double lr = a_re[g * SP + p], li = a_im[g * SP + p], dt = exp((double)log_dt[g]);
          const double tt = (double)(i + 1), et = exp(lr * dt * tt); const float pr = (float)(et * cos(li * dt * tt)), pi_ = (float)(et * sin(li * dt * tt));
          float crv[16], civ[16];
#pragma unroll
          for (int co = 0; co < 16; ++co) { crv[co] = c_re[(g * SC + co) * SP + p]; civ[co] = c_im[(g * SC + co) * SP + p]; }
#pragma unroll
          for (int co = 0; co < 16; ++co) { const float cr = crv[co], cim = civ[co];
              bf16* row = BTB + ((size_t)g * 256 + i * 16 + co) * 384 + 256;
              row[p] = (bf16)f2bf(cr * pr - cim * pi_); row[64 + p] = (bf16)f2bf(-(cr * pi_ + cim * pr)); }
      }
      float* LAMC = (float*)(ws + WS_LAMC);
      for (int e = gw * 64 + lane; e < SG * SP; e += NGW * 64) {
          const double lr = a_re[e], li = a_im[e], dt = exp((double)log_dt[e >> 6]), et = exp(lr * dt * 16.0);
          LAMC[2 * e] = (float)(et * cos(li * dt * 16.0)); LAMC[2 * e + 1] = (float)(et * sin(li * dt * 16.0)); }
    }
}
__device__ __forceinline__ bool wt_one(const Args& args, LAS float* scr, unsigned mask, int it, int lane) {
    constexpr int NMAT = 18; int base = 0;
    for (int mi = 0; mi < NMAT; ++mi) { if (!((mask >> mi) & 1u)) continue;
        const WtDesc d = wt_desc(args, mi); const int n_it = (d.K / 64) * (d.Ndst / 32);
        if (it < base + n_it) { const int r = it - base, nblk = d.Ndst / 32, kb = r / nblk, nb = r % nblk, n0 = nb * 32; int ns = n0;
            if (d.kind == 1) { const int pn = n0 >> 8, j = n0 & 255; ns = (j < 128) ? (128 * pn + j) : (d.off2 + 128 * pn + (j - 128)); }
            wt_item(d.W, d.ldw, d.K, d.gain, d.WT, n0, ns, kb * 64, scr, lane); return true; }
        base += n_it; }
    return false;
}
struct WtWork { const float* gain; bf16* WT; int K, n0, k0; bool ok; };
__device__ __forceinline__ WtWork wt_fetch(const Args& args, unsigned mask, int it, f32x4 (&v)[8], int lane) {
    constexpr int NMAT = 18; int base = 0; WtWork w{}; w.ok = false;
    for (int mi = 0; mi < NMAT; ++mi) { if (!((mask >> mi) & 1u)) continue;
        const WtDesc d = wt_desc(args, mi); const int n_it = (d.K / 64) * (d.Ndst / 32);
        if (it < base + n_it) { const int r = it - base, nblk = d.Ndst / 32, kb = r / nblk, nb = r % nblk, n0 = nb * 32; int ns = n0;
            if (d.kind == 1) { const int pn = n0 >> 8, j = n0 & 255; ns = (j < 128) ? (128 * pn + j) : (d.off2 + 128 * pn + (j - 128)); }
            wt_load(v, d.W, d.ldw, ns, kb * 64, lane); w.gain = d.gain; w.WT = d.WT; w.K = d.K; w.n0 = n0; w.k0 = kb * 64; w.ok = true; return w; }
        base += n_it; }
    return w;
}
__device__ __forceinline__ void ph_weights(const Args& args, LAS float* scr, unsigned mask, int rk, int nw, int lane) {
    f32x4 va[8], vb[8];
    WtWork wa = wt_fetch(args, mask, rk, va, lane);
    for (int it = rk; wa.ok; it += 2 * nw) {
        WtWork wb = wt_fetch(args, mask, it + nw, vb, lane);
        wt_store(va, wa.K, wa.gain, wa.WT, wa.n0, wa.k0, scr, lane);
        if (!wb.ok) break;
        wa = wt_fetch(args, mask, it + 2 * nw, va, lane);
        wt_store(vb, wb.K, wb.gain, wb.WT, wb.n0, wb.k0, scr, lane);
    }
}
__device__ __forceinline__ void ph_wf(const Args& args, int j, int rk, int nw, int lane) {
    for (int e = rk * 64 + lane; e < NH * D; e += nw * 64) { const int h = e >> 10, kk = e & 1023;
        ((bf16*)(args.ws + WS_WF))[j * NH * D + e] = (bf16)f2bf(args.in[4][(size_t)j * D * FOX_IN + (size_t)kk * FOX_IN + 3 * D + h] * args.in[1][(j ? 3 * D : 0) + kk]); }
}
constexpr unsigned WMASK_PRO = (1u << 0);
constexpr unsigned WMASK_ATT = (1u << 2) | (1u << 10) | (1u << 4) | (1u << 5);
constexpr int WATT_ITEMS = 16 * 32 + 16 * 176 + 16 * 32 + 16 * 64;
constexpr unsigned WMASK_L0 = (1u << 14) | (1u << 11);
constexpr unsigned WMASK_L1 = (1u << 15) | (1u << 6) | (1u << 7) | (1u << 8) | (1u << 9) | (1u << 12);
constexpr unsigned WMASK_L2 = (1u << 16) | (1u << 1) | (1u << 3) | (1u << 13);
constexpr unsigned WMASK_L3 = (1u << 17);
__device__ __forceinline__ void ph_prologue(const Args& args, LAS unsigned char* lds, int gw, int NGW, int wave, int lane) {
    unsigned char* ws = args.ws;
    LAS float* scr = (LAS float*)(lds + RING_OFF + wave * 16384);
    ph_weights(args, scr, MK_DEFER_WEIGHTS ? WMASK_PRO : 0x3ffffu, gw, NGW, lane);
    ph_wf(args, 0, gw, NGW, lane); if (!MK_DEFER_WEIGHTS) ph_wf(args, 1, gw, NGW, lane);
    for (int rep_ = 0; rep_ < MK_S5TAB_REPS; ++rep_) ph_s5tables(args, scr, (LAS float*)(lds + LDSCTL_OFF + 8192 + wave * 512), gw, NGW, lane);
    pg8::ssq_t* ssq0 = (pg8::ssq_t*)(ws + WS_SSQ);
    for (int m = gw; m < M; m += NGW) normx_row(args.in[0] + (size_t)m * D, (bf16*)(ws + WS_XB) + (size_t)m * D, ssq0 + m, lane);
}

__device__ __forceinline__ void ph_toeplitz(unsigned char* ws, int rk, int nw, int lane) {
    const float* KERN = (const float*)(ws + WS_KERN); bf16* BTB = (bf16*)(ws + WS_BTB);
    for (int e2 = rk * 64 + lane; e2 < SG * 256 * 16; e2 += nw * 64) { const int g = e2 >> 12, n = (e2 >> 4) & 255, j = e2 & 15, i = n >> 4, co = n & 15;
        v4u o0 = {0u, 0u, 0u, 0u}, o1 = {0u, 0u, 0u, 0u};
        if (i >= j) { const f32x4* kp = (const f32x4*)(KERN + (((size_t)g * 16 + (i - j)) * 16 + co) * 16); const f32x4 a = kp[0], b = kp[1], c = kp[2], d = kp[3];
            o0 = (v4u){pk2(a[0], a[1]), pk2(a[2], a[3]), pk2(b[0], b[1]), pk2(b[2], b[3])}; o1 = (v4u){pk2(c[0], c[1]), pk2(c[2], c[3]), pk2(d[0], d[1]), pk2(d[2], d[3])}; }
        v4u* dst = (v4u*)(BTB + ((size_t)g * 256 + n) * 384 + j * 16); dst[0] = o0; dst[1] = o1; }
}
__global__ void __launch_bounds__(NWAVES * 64, 2) mega_k(Args args) {
    extern __shared__ __attribute__((aligned(16))) unsigned char lds_raw[];
    LAS unsigned char* lds = (LAS unsigned char*)lds_raw;
    const int vcu0 = (gridDim.x % 8 == 0) ? (blockIdx.x % 8) * (gridDim.x / 8) + blockIdx.x / 8 : blockIdx.x;
    const int vcu = vcu0, NGW = gridDim.x * NWAVES, wave0 = __builtin_amdgcn_readfirstlane(threadIdx.x >> 6);
    for (int u = threadIdx.x; u < (LDS_BYTES - LDSCTL_OFF) / 4; u += NWAVES * 64) ((LAS unsigned*)(lds + LDSCTL_OFF))[u] = 0u;
    __syncthreads();
    MK_BAR_SETUP();
    int e0 = args.ph_lo;
    if (e0 == PH_S5TAB) { const int tid = threadIdx.x, lane = tid & 63, wave = __builtin_amdgcn_readfirstlane(tid >> 6); ph_s5tables(args, (LAS float*)(lds + RING_OFF + wave * 16384), (LAS float*)(lds + LDSCTL_OFF + 8192 + wave * 512), vcu * NWAVES + wave, NGW, lane); return; }
    if (e0 == 0) {
        const int tid = threadIdx.x, lane = tid & 63, wave = __builtin_amdgcn_readfirstlane(tid >> 6);
        ph_prologue(args, lds, vcu * NWAVES + wave, NGW, wave, lane);
        e0 = 1;
        if (e0 < args.ph_hi) { MK_GRID_BAR(); }
    }
    for (int e = e0; e < args.ph_hi; ++e) {
#define MK_LANE_TID() int lane_; asm volatile("v_mbcnt_lo_u32_b32 %0, -1, 0\n\tv_mbcnt_hi_u32_b32 %0, -1, %0" : "=v"(lane_)); const int lane = lane_, tid = wave * 64 + lane, gw = vcu * NWAVES + wave; (void)tid; (void)gw; (void)lane
        const int wave = wave0;
        int G = gridDim.x, bx = blockIdx.x, vcu = vcu0; asm volatile("" : "+s"(G), "+s"(bx), "+s"(vcu));
        const int NGW = G * NWAVES;
        unsigned char* ws = args.ws; float* X = args.out; asm volatile("" : "+s"(ws), "+s"(X));
        pg8::ssq_t* SSQ = (pg8::ssq_t*)(ws + WS_SSQ);
        const int op = PROG[e].op, layer = PROG[e].layer, pj = PROG[e].j, sin = PROG[e].sin, sout = PROG[e].sout;
#define MK_XBS(s_) ((s_) == 5 ? (bf16*)(ws + WS_O) : (bf16*)(ws + WS_XB))
#define MK_XBO(s_) (MK_JUNK ? (bf16*)X + (size_t)M * D : MK_XBS(s_))
#define MK_SSQO(s_) (SSQ + (size_t)(MK_JUNK ? 12 : (s_)) * M)
        bf16* XB = MK_XBS(sin);
        (void)pj;
        if (op == OP_NORMX) {
            MK_LANE_TID();
            for (int m = gw; m < M; m += NGW) normx_row(X + (size_t)m * D, XB + (size_t)m * D, SSQ + (size_t)sout * M + m, lane);
        } else if (op == OP_UP) {
            MK_LANE_TID();
            pg8::Gemm g{XB, (const bf16*)(ws + WS_WGU) + (size_t)layer * 2 * DFF * D, D, D, D, 0, 0};
            pg8::StaticOrder S; S.init(M / 256, 2 * DFF / 256, G, bx);
            pg8::EpiSwiGLU E{(bf16*)(ws + WS_ACT), DFF, SSQ + (size_t)sin * M, MK_UP_DUMMY};
            pg8::gemm_phase<pg8::EpiSwiGLU, pg8::StaticOrder, MK_ALIGN_UP>(lds + RING_OFF, tid, g, S, E);
            if (MK_DEFER_WEIGHTS && bx >= 128 && !(MK_UP_DUMMY)) {
                LAS float* scr = (LAS float*)(lds + RING_OFF + wave * 16384); const int rk = (bx - 128) * NWAVES + wave;
                ph_weights(args, scr, layer == 0 ? WMASK_L0 : layer == 1 ? WMASK_L1 : layer == 2 ? WMASK_L2 : WMASK_L3, rk, 128 * NWAVES, lane);
                if (layer == 2) ph_wf(args, 1, rk, 128 * NWAVES, lane); }
        } else if (op == OP_DOWN) {
            MK_LANE_TID();
            pg8::Gemm g{(const bf16*)(ws + WS_ACT), (const bf16*)(ws + WS_WDN) + (size_t)layer * D * DFF, DFF, DFF, DFF, 0, 0};
            pg8::StaticOrder S; S.init(M / 256, D / 256, G, bx);
            if (layer == 3 && !(MK_JUNK)) {
                pg8::EpiResidFinal E{MK_XBS(sout - 1), X, SSQ + (size_t)sout * M, args.in[3], (unsigned*)(ws + WS_CTL) + CW_PANEL};
                pg8::gemm_phase<pg8::EpiResidFinal, pg8::StaticOrder, false>(lds + RING_OFF, tid, g, S, E);
            } else {
                pg8::EpiResid<0> E{MK_XBS(sout - 1), MK_XBO(sout), MK_SSQO(sout), args.in[18], nullptr, MK_UP_DUMMY};
                pg8::gemm_phase<pg8::EpiResid<0>, pg8::StaticOrder, true>(lds + RING_OFF, tid, g, S, E); }
        }
        else if (op == OP_QKV) {
            MK_LANE_TID();
            if (MK_TOUCH) touch_lines(XB + (size_t)(8 * (bx & 7) + ((bx >> 3) & 7)) * 256 * D, 256 * D * 2, tid);
            if (!(MK_QKV_NOGATES)) {
              const bf16* WfT = (const bf16*)(ws + WS_WF) + (size_t)pj * NH * D; const pg8::ssq_t* ssq = SSQ + (size_t)sin * M; const float* bfp = args.in[5] + pj * NH; float* LF = (float*)(ws + WS_LF);
#pragma unroll
              for (int i = 0; i < 4; ++i) { const int c = tid + 512 * i; *(LAS v4u*)(lds + (c >> 7) * 2064 + (c & 127) * 16) = ((const GAS v4u*)WfT)[c]; }
              LDS_WAIT(); __syncthreads();
              if (wave < 4) {
                const int r0 = (vcu * 4 + wave) * 16, kq = lane >> 4; const GAS bf16x8* ap = (const GAS bf16x8*)(XB + (size_t)(r0 + (lane & 15)) * D + kq * 8); const LAS unsigned char* bp = lds + (lane & 15) * 2064 + kq * 16;
                bf16x8 afr[32];
#pragma unroll
                for (int ks = 0; ks < 32; ++ks) afr[ks] = ap[ks * 4];
                f32x4 acc = {0.f, 0.f, 0.f, 0.f};
#pragma unroll
                for (int ks = 0; ks < 32; ++ks) acc = __builtin_amdgcn_mfma_f32_16x16x32_bf16(afr[ks], *(const LAS bf16x8*)(bp + ks * 64), acc, 0, 0, 0);
                const int rr = r0 + 4 * kq, hh = lane & 15; const float bb = bfp[hh]; f32x4 o;
#pragma unroll
                for (int i = 0; i < 4; ++i) { const float z = acc[i] * pg8::rstd_row(ssq, rr + i) + bb; o[i] = fminf(z, 0.f) - log1pf(expf(-fabsf(z))); }
                pg8::st_wt((GAS float*)LF + ((size_t)(rr / SEQ) * NH + hh) * SEQ + (rr % SEQ), o); }
              LDS_WAIT(); __syncthreads(); }
            pg8::Gemm g{XB, (const bf16*)(ws + WS_WQKV) + (size_t)pj * 3 * D * D, D, D, D, 0, 0};
            pg8::StaticOrder S; S.init(M / 256, 3 * D / 256, G, bx);
            pg8::EpiQKV E{(bf16*)(ws + WS_ACT), (size_t)16 * MiB, SSQ + (size_t)sin * M, attn_body::C2, (float*)(ws + WS_NRM), MK_UP_DUMMY};
            pg8::gemm_phase<pg8::EpiQKV, pg8::StaticOrder, true>(lds + RING_OFF, tid, g, S, E);
        } else if (op == OP_ATTN) {
            MK_LANE_TID();
            LAS float* bl = (LAS float*)(lds + RING_OFF + attn_body::ATTN_LDS_BYTES);
            { const float* lf = (const float*)(ws + WS_LF) + (size_t)(vcu >> 2) * SEQ + tid * 8; LAS float* wt = (LAS float*)(lds + LDSCTL_OFF + 1024);
              const f32x4 a = *(const f32x4*)lf, b = *(const f32x4*)(lf + 4);
              float p[8]; p[0] = a[0]; p[1] = p[0] + a[1]; p[2] = p[1] + a[2]; p[3] = p[2] + a[3]; p[4] = p[3] + b[0]; p[5] = p[4] + b[1]; p[6] = p[5] + b[2]; p[7] = p[6] + b[3];
              float tot = p[7];
#pragma unroll
              for (int o = 1; o < 64; o <<= 1) { const float u = __builtin_bit_cast(float, __builtin_amdgcn_ds_bpermute((lane - o) << 2, __builtin_bit_cast(int, tot))); if (lane >= o) tot += u; }
              if (lane == 63) wt[wave] = tot;
              LDS_WAIT(); __syncthreads();
              float off = tot - p[7];
              for (int w = 0; w < wave; ++w) off += wt[w];
#pragma unroll
              for (int i = 0; i < 8; ++i) bl[tid * 8 + i] = -(p[i] + off) * 1.4426950408889634f;
              LDS_WAIT(); __syncthreads(); }
            LAS int* tsk = (LAS int*)(lds + LDSCTL_OFF + 12288);
            for (int prep_ = 0; prep_ < MK_PREPASS_REPS; ++prep_) { LAS float* kn = (LAS float*)(lds + LDSCTL_OFF + 12288 + 64); LAS float* qn = kn + 64;
              const int bh = vcu >> 2, sq = vcu & 3; const size_t rb = (size_t)(bh >> 4) * SEQ; const int hc = (bh & 15) * HD + (lane & 7) * 8;
              (void)hc;
              const int hd = bh & 15; const GAS f32x2* Nk = (const GAS f32x2*)(ws + WS_NRM) + ((size_t)(4 + (hd >> 2)) * M + rb) * 4 + (hd & 3); const GAS f32x2* Nq = (const GAS f32x2*)(ws + WS_NRM) + ((size_t)(hd >> 2) * M + rb) * 4 + (hd & 3);
              { f32x2 v[8];
#pragma unroll
                for (int i = 0; i < 8; ++i) v[i] = Nk[(size_t)(tid * 8 + i) * 4];
                float mx = 0.f;
#pragma unroll
                for (int i = 0; i < 8; ++i) mx = fmaxf(mx, v[i].x + v[i].y);
                mx = fmaxf(mx, lshx(mx, lane, 1)); mx = fmaxf(mx, lshx(mx, lane, 2)); mx = fmaxf(mx, lshx(mx, lane, 4));
                if ((lane & 7) == 0) kn[tid >> 3] = mx; }
              { f32x2 v[2]; const int i = wave >> 1, qb = (i == 0) ? sq : (i == 1) ? 7 - sq : (i == 2) ? 8 + sq : 15 - sq;
#pragma unroll
                for (int jj = 0; jj < 2; ++jj) v[jj] = Nq[(size_t)(qb * 256 + (wave & 1) * 128 + lane * 2 + jj) * 4];
                float mx = fmaxf(v[0].x + v[0].y, v[1].x + v[1].y);
#pragma unroll
                for (int o = 1; o < 64; o <<= 1) mx = fmaxf(mx, lshx(mx, lane, o));
                if (lane == 0) qn[i * 8 + (wave & 1)] = mx; if (lane == 1) { qn[i * 8 + 2 + (wave & 1) * 3] = 0.f; qn[i * 8 + 3 + (wave & 1) * 3] = 0.f; qn[i * 8 + 4 + (wave & 1) * 3] = 0.f; } }
              LDS_WAIT(); __syncthreads();
              if (wave < 4) { const int i = wave, qb = (i == 0) ? sq : (i == 1) ? 7 - sq : (i == 2) ? 8 + sq : 15 - sq, nt = 4 * qb + 4;
                  float q2 = (lane < 8) ? qn[i * 8 + lane] : 0.f, k2 = (lane < nt) ? kn[lane] : 0.f;
#pragma unroll
                  for (int o = 1; o < 64; o <<= 1) { q2 = fmaxf(q2, lshx(q2, lane, o)); k2 = fmaxf(k2, lshx(k2, lane, o)); }
                  const float lim = MK_SKIP_QK * sqrtf(q2) * sqrtf(k2) * 1.01f + 30.0f, bq = bl[qb * 256];
                  const int ts = 2 * lane;
                  const bool okc = (ts + 2 <= nt - 4) && (bq - bl[64 * (ts + 1) + 63] >= lim);
                  const int cntc = __builtin_popcountll(__ballot(okc));
                  if (lane == 0) tsk[i] = 2 * cntc; }
              LDS_WAIT(); __syncthreads(); }
            const attn_body::AttnTensors AT{(const attn_body::bf16*)(ws + WS_ACT), (const attn_body::bf16*)(ws + WS_ACT + 32 * MiB), (const attn_body::bf16*)(ws + WS_ACT + 64 * MiB), (attn_body::bf16*)(ws + WS_O)};
            const attn_body::StaticOrder S(G, bx);
            attn_body::attn_phase<attn_body::StaticOrder, MK_THRL>((char*)lds_raw + RING_OFF, AT, S, bl, tid, tsk);
            if (MK_DEFER_WEIGHTS && layer == 0) {
                LAS float* scr = (LAS float*)(lds + RING_OFF + wave * 16384); unsigned* q = (unsigned*)(ws + WS_CTL) + CW_QUEUE;
                for (;;) { unsigned b0 = 0; if (lane == 0) b0 = __hip_atomic_fetch_add(q, 4u, __ATOMIC_RELAXED, __HIP_MEMORY_SCOPE_AGENT); b0 = (unsigned)__builtin_amdgcn_readfirstlane((int)b0);
                    if (b0 >= (unsigned)WATT_ITEMS) break;
                    for (int i = 0; i < 4; ++i) if (!wt_one(args, scr, WMASK_ATT, (int)b0 + i, lane)) break; } }
        } else if (op == OP_WO) {
            MK_LANE_TID();
            pg8::Gemm g{(const bf16*)(ws + WS_O), (const bf16*)(ws + WS_WO) + (size_t)pj * D * D, D, D, D, 0, 0};
            pg8::StaticOrder S; S.init(M / 256, D / 256, G, bx);
            pg8::EpiResid<0> E{MK_XBS(sout - 1), MK_XBO(sout), MK_SSQO(sout), args.in[18], nullptr, MK_UP_DUMMY};
            pg8::gemm_phase<pg8::EpiResid<0>, pg8::StaticOrder, true>(lds + RING_OFF, tid, g, S, E);
        }
        else if (op == OP_S5IN) {
            MK_LANE_TID();
            ph_toeplitz(ws, gw, NGW, lane);
            pg8::Gemm g{XB, (const bf16*)(ws + WS_WS5IN), D, D, D, 0, 0};
            pg8::StaticOrder S; S.init(M / 256, D / 256, G, bx);
            pg8::EpiU E{(bf16*)(ws + WS_ACT), SSQ + (size_t)sin * M};
            pg8::gemm_phase<pg8::EpiU, pg8::StaticOrder, true>(lds + RING_OFF, tid, g, S, E);
        } else if (op == OP_SSM) {
            MK_LANE_TID();
            pg8::StaticOrder S; S.init(BATCH, SG, G, bx);
            { pg8::Gemm g{(const bf16*)(ws + WS_ACT), (const bf16*)(ws + WS_BTA), 256, 384, 256, 0, 1024 * 384 * 2};
              pg8::EpiSloc E{(const float*)(ws + WS_LAMC), (bf16*)(ws + WS_ACT), lds + LDSCTL_OFF + 2048};
              pg8::gemm_phase<pg8::EpiSloc, pg8::StaticOrder, false>(lds + RING_OFF, tid, g, S, E); }
            { pg8::Gemm g{(const bf16*)(ws + WS_ACT), (const bf16*)(ws + WS_BTB), 384, 384, 384, 0, 1024 * 384 * 2};
              pg8::EpiY E{(const bf16*)(ws + WS_ACT), args.in[15], (bf16*)(ws + WS_ACT + 48 * MiB)};
              pg8::gemm_phase<pg8::EpiY, pg8::StaticOrder, true>(lds + RING_OFF, tid, g, S, E); }
        } else if (op == OP_GLU) {
            MK_LANE_TID();
            pg8::Gemm g{(const bf16*)(ws + WS_ACT + 48 * MiB), (const bf16*)(ws + WS_WGLU), D, MK_G1_NATURAL ? D : 16, D, MK_G1_NATURAL ? 0 : M * 16, 0};
            pg8::StaticOrder S; S.init(M / 256, 2 * D / 256, G, bx);
            pg8::EpiResid<1> E{MK_XBS(sout - 1), MK_XBO(sout), MK_SSQO(sout), args.in[18], nullptr, MK_UP_DUMMY};
            pg8::gemm_phase<pg8::EpiResid<1>, pg8::StaticOrder, true>(lds + RING_OFF, tid, g, S, E);
        }
        else if (op == OP_POOLPREP) {
        } else if (op == OP_POOLGEMM) {
            MK_LANE_TID();
            pg8::StaticOrder S; S.init(M / 256, 4, G, bx);
            { pg8::Unit u0; if (S.next(0, u0)) { const pg8::ssq_t* ssq = SSQ + (size_t)sin * M; const float* gain = args.in[1] + (size_t)layer * D; bf16* PD = (bf16*)(ws + WS_ACT);
                const int gi = u0.pn, c0 = gi * 256 + lane * 4; const f32x4 gg = *(const f32x4*)(gain + c0);
                for (int ci = wave; ci < 16; ci += NWAVES) { const int row0 = u0.pm * 256 + ci * 16, t0 = row0 & (SEQ - 1);
                    if (gi == 0) pool_item<2>(XB, ssq, gg, PD, row0, t0, c0); else if (gi == 1) pool_item<4>(XB, ssq, gg, PD, row0, t0, c0);
                    else if (gi == 2) pool_item<8>(XB, ssq, gg, PD, row0, t0, c0); else pool_item<16>(XB, ssq, gg, PD, row0, t0, c0); } }
              asm volatile("s_waitcnt vmcnt(0)" ::: "memory"); __syncthreads();
              if (wave == 0) { __builtin_amdgcn_fence(__ATOMIC_ACQUIRE, "agent"); asm volatile("s_waitcnt vmcnt(0)" ::: "memory"); }
              __syncthreads(); }
            pg8::Gemm g{(const bf16*)(ws + WS_ACT), (const bf16*)(ws + WS_WPOOL), 256, D, 256, 0, 512};
            pg8::EpiResid<2> E{MK_XBS(sout - 1), MK_XBS(sout), SSQ + (size_t)sout * M, args.in[18], args.in[19], 0};
            pg8::gemm_phase<pg8::EpiResid<2>, pg8::StaticOrder, true>(lds + RING_OFF, tid, g, S, E);
        } else if (op == OP_FINAL) {
            MK_LANE_TID();
            { const pg8::ssq_t* ssq = SSQ + (size_t)sin * M; const float* gain = args.in[3];
              for (int m = gw; m < M; m += NGW) { const float rs = pg8::rstd_row(ssq, m); f32x4* xr = (f32x4*)(X + (size_t)m * D) + lane; const f32x4* gr = (const f32x4*)gain + lane;
#pragma unroll
                  for (int j = 0; j < 4; ++j) xr[64 * j] = xr[64 * j] * rs * gr[64 * j]; } }
        }
        if (e + 1 < args.ph_hi) { MK_GRID_BAR(); }
    }
}
}
extern "C" void kernel_launch(void* const* d_in, const int* in_sizes, int n_in, void* d_out, int out_size, void* d_ws, size_t ws_size, hipStream_t stream) {
    static int grid = 0;
    if (grid == 0) {
        int dev = 0, cus = 0, per_cu = 0;
        if (hipGetDevice(&dev) != hipSuccess || hipDeviceGetAttribute(&cus, hipDeviceAttributeMultiprocessorCount, dev) != hipSuccess) { grid = -1; return; }
        if (hipFuncSetAttribute((const void*)mk::mega_k, hipFuncAttributeMaxDynamicSharedMemorySize, mk::LDS_BYTES) != hipSuccess) { grid = -1; return; }
        if (hipOccupancyMaxActiveBlocksPerMultiprocessor(&per_cu, (const void*)mk::mega_k, mk::NWAVES * 64, mk::LDS_BYTES) != hipSuccess || per_cu < 1) { fprintf(stderr, "kernel_launch: occupancy query says %d blocks per CU\n", per_cu); grid = -1; (void)hipGetLastError(); return; }
        (void)hipGetLastError();
        grid = cus;
        if (n_in != 22 || ws_size < mk::WS_END || cus != 256 || in_sizes[0] != mk::M * mk::D || out_size != mk::M * mk::D) { fprintf(stderr, "kernel_launch: unexpected n_in %d / ws_size %zu / CUs %d\n", n_in, ws_size, cus); grid = -1; }
    }
    if (grid < 0) return;
    (void)hipMemsetAsync((char*)d_ws + mk::WS_CTL, 0, mk::CTL_ZERO_BYTES, stream);
    mk::Args a{};
    for (int i = 0; i < 22; ++i) a.in[i] = (const float*)d_in[i];
    a.out = (float*)d_out; a.ws = (unsigned char*)d_ws;
#if MK_ONE_LAUNCH
    a.ph_lo = 0; a.ph_hi = mk::PH_LAST + 1;
    void* kargs[] = {&a};
    const hipError_t e = hipLaunchCooperativeKernel((const void*)mk::mega_k, dim3(grid), dim3(mk::NWAVES * 64), kargs, mk::LDS_BYTES, stream);
    if (e != hipSuccess) fprintf(stderr, "kernel_launch: cooperative launch failed: %s\n", hipGetErrorString(e));
#else
    for (int ph = 0; ph <= mk::PH_LAST; ++ph) { a.ph_lo = ph; a.ph_hi = ph + 1; hipLaunchKernelGGL(mk::mega_k, dim3(grid), dim3(mk::NWAVES * 64), mk::LDS_BYTES, stream, a);
    }
#endif
}
```

```cpp
#include <hip/hip_runtime.h>
#include <hip/hip_cooperative_groups.h>
#include <cstdio>
#include <cstdint>
#include <cmath>
#define MK_BAR_SETUP() cooperative_groups::grid_group mk_grid = cooperative_groups::this_grid(); bool mk_first = true; \
    XcdBarrier mk_bar = xcd_barrier_post((unsigned*)(args.ws + WS_CTL) + CW_BAR, (volatile LAS unsigned*)(lds + MISC_OFF) + 8)
#ifndef MK_CG_FIRST
#define MK_CG_FIRST 0
#endif
#define MK_GRID_BAR() do { if (MK_CG_FIRST ? mk_first : (args.ph_lo < 0)) { mk_grid.sync(); mk_first = false; } else xcd_barrier(mk_bar); } while (0)
#define MK_ONE_LAUNCH 1
#define MK_NO_NAIVE 1
#define MK_THRL 24
#define MK_UP_DUMMY 0
#define MK_JUNK false
#define MK_QKV_NOGATES 0
#define MK_DEFER_WEIGHTS 1
#define MK_SKIP_QK 2.0f
#ifndef MK_PREPASS_REPS
#define MK_PREPASS_REPS 1
#endif
#ifndef MK_TOUCH
#define MK_TOUCH 0
#endif
#ifndef MK_WGM
#define MK_WGM 8
#endif
#ifndef MK_ALIGN_UP
#define MK_ALIGN_UP true
#endif
#ifndef MK_S5TAB_REPS
#define MK_S5TAB_REPS 1
#endif
#ifndef MK_G1_NATURAL
#define MK_G1_NATURAL 0
#endif
#ifndef MK_WNT
#define MK_WNT 0
#endif
namespace pg8 {
#define PG8_LAS __attribute__((address_space(3)))
typedef unsigned short bf16_t;
typedef short bf16x8 __attribute__((ext_vector_type(8)));
typedef float f32x4 __attribute__((ext_vector_type(4)));
typedef float f32x2 __attribute__((ext_vector_type(2)));
typedef unsigned u32x4 __attribute__((ext_vector_type(4)));
typedef unsigned u32x2 __attribute__((ext_vector_type(2)));
constexpr int PF_JUNK_OFF = 131072 + 6144;
#ifndef MK_RESID_ALL16
#define MK_RESID_ALL16 0
#endif
#ifndef MK_SWIGLU_V2
#define MK_SWIGLU_V2 1
#endif
#ifndef MK_PF_BASE
#define MK_PF_BASE false
#endif
constexpr int BM = 256, BK = 64, HALF = 128, HTB = HALF * BK * 2  , STAGE_BYTES = 8 * HTB, NXCD = 8, WGM = MK_WGM;

__host__ __device__ __forceinline__ int lds_byte(int r, int c) { const int st = (r >> 4) * 2 + (c >> 5), rr = r & 15, cc = c & 31, ob = rr * 64 + cc * 2; return st * 1024 + (ob ^ (((ob >> 9) & 1) << 5)); }
__host__ __device__ __forceinline__ void stage_rc(int b, int& R, int& C) { const int st = b / 1024, sb = b % 1024, swz = sb ^ (((sb >> 9) & 1) << 5); R = (st >> 1) * 16 + swz / 64; C = (st & 1) * 32 + (swz % 64) / 2; }
__host__ __device__ __forceinline__ int perm32(int rho) { const int n = rho >> 4, i = rho & 15; return 8 * (i >> 2) + 4 * n + (i & 3); }

struct Unit { int pm, pn; };
struct Gemm { const bf16_t* A; const bf16_t* Bt; int K; int lda, ldb; int gatherA; int a_pn_off; };

struct StaticOrder {
    int nM, nN, nwg, G, c;
    __host__ __device__ __forceinline__ void init(int nM_, int nN_, int G_, int c_) { nM = nM_; nN = nN_; nwg = nM * nN; G = G_; c = c_; }
    __host__ __device__ __forceinline__ bool next(int i, Unit& u) const {
        const long L = (long)i * G + c; if (L >= nwg) return false;
        int wgid = (int)L; { const int q = nwg / NXCD, r = nwg % NXCD, xcd = wgid % NXCD, off = wgid / NXCD; wgid = (xcd < r ? xcd * (q + 1) : r * (q + 1) + (xcd - r) * q) + off; }
        const int nig = WGM * nN, gid = wgid / nig, fm = gid * WGM, gsz = (nM - fm) < WGM ? (nM - fm) : WGM;
        u.pm = fm + ((wgid % nig) % gsz); u.pn = (wgid % nig) / gsz; return true;
    }
};

__device__ __forceinline__ unsigned cvt_pk_bf16(float lo, float hi) { unsigned r; asm volatile("v_cvt_pk_bf16_f32 %0, %1, %2" : "=v"(r) : "v"(lo), "v"(hi)); return r; }

template <class Epi, class Sched, bool ALIGN_EPI>
__device__ __forceinline__ void gemm_phase(PG8_LAS unsigned char* lds, const int tid, const Gemm g, const Sched& S, const Epi& E) {
    const int wid = __builtin_amdgcn_readfirstlane(tid >> 6), lane = tid & 63, wr = wid >> 2, wc = wid & 3, fr = lane & 15, fq = lane >> 4;
    const int K = g.K, nt = K / BK;
    unsigned voffA[2], voffB[2];
#pragma unroll
    for (int i = 0; i < 2; ++i) { int R, C; stage_rc(tid * 16 + i * 8192, R, C); const int Rb = Epi::PERM ? ((R & ~31) + perm32(R & 31)) : R;
        voffA[i] = g.gatherA ? (unsigned)(R * g.lda + (C >> 4) * g.gatherA + (C & 15)) * 2u : (unsigned)(R * g.lda + C) * 2u; voffB[i] = (unsigned)(Rb * g.ldb + C) * 2u; }
    const size_t kstepA = g.gatherA ? (size_t)g.gatherA * 8 : (size_t)(BK * 2), kstepB = (size_t)(BK * 2);
    const size_t hstepA = (size_t)HALF * g.lda * 2, hstepB = (size_t)HALF * g.ldb * 2;
    const size_t tstepA = 2 * hstepA, tstepB = 2 * hstepB;
    const unsigned ldsw = (unsigned)wid * 1024u;
    const int aoff = lds_byte(wr * 64 + fr, fq * 8), boff = lds_byte(wc * 32 + fr, fq * 8);
#define PG8_SA(b, h) (((b) * 2 + (h)) * HTB)
#define PG8_SB(b, h) ((4 + (b) * 2 + (h)) * HTB)
#define PG8_STAGE(bufoff, gbase, voff) do { _Pragma("unroll") for (int _i = 0; _i < 2; ++_i) \
        __builtin_amdgcn_global_load_lds((const unsigned*)((const char*)(gbase) + (voff)[_i]), (PG8_LAS unsigned*)(lds + (bufoff) + ldsw + _i * 8192), 16, 0, 0); } while (0)
#define PG8_LDA(dst, b, h) do { _Pragma("unroll") for (int m = 0; m < 4; ++m) _Pragma("unroll") for (int k = 0; k < 2; ++k) dst[m][k] = *(const PG8_LAS bf16x8*)(lds + PG8_SA(b, h) + aoff + m * 2048 + k * 1024); } while (0)
#define PG8_LDB(dst, b, h) do { _Pragma("unroll") for (int n = 0; n < 2; ++n) _Pragma("unroll") for (int k = 0; k < 2; ++k) dst[n][k] = *(const PG8_LAS bf16x8*)(lds + PG8_SB(b, h) + boff + n * 2048 + k * 1024); } while (0)
#define PG8_MMA(ai, bj, At, Bt) do { __builtin_amdgcn_s_setprio(1); _Pragma("unroll") for (int m = 0; m < 4; ++m) _Pragma("unroll") for (int n = 0; n < 2; ++n) _Pragma("unroll") for (int k = 0; k < 2; ++k) \
        acc[ai][bj][m][n] = __builtin_amdgcn_mfma_f32_16x16x32_bf16(Bt[n][k], At[m][k], acc[ai][bj][m][n], 0, 0, 0); __builtin_amdgcn_s_setprio(0); } while (0)
#define PG8_WAIT_V(n) asm volatile("s_waitcnt vmcnt(" #n ")" ::: "memory")
#define PG8_WAIT_L(n) asm volatile("s_waitcnt lgkmcnt(" #n ")" ::: "memory")
#define PG8_BAR __builtin_amdgcn_s_barrier()
#define PG8_SCHED __builtin_amdgcn_sched_barrier(0)
    Unit cur, nxt; int ui = 0;
    if (!S.next(0, cur)) return;
    f32x4 acc[2][2][4][2];
#pragma unroll
    for (int a = 0; a < 2; ++a)
#pragma unroll
        for (int b = 0; b < 2; ++b)
#pragma unroll
            for (int m = 0; m < 4; ++m)
#pragma unroll
                for (int n = 0; n < 2; ++n) acc[a][b][m][n] = (f32x4){0.f, 0.f, 0.f, 0.f};
    bf16x8 At[4][2], B0[2][2], B1[2][2];
    const char* cA = (const char*)g.A + (size_t)cur.pm * tstepA + (size_t)cur.pn * g.a_pn_off; const char* cB = (const char*)g.Bt + (size_t)cur.pn * tstepB;
    PG8_STAGE(PG8_SB(0, 0), cB, voffB); PG8_STAGE(PG8_SB(0, 1), cB + hstepB, voffB); PG8_STAGE(PG8_SA(0, 0), cA, voffA); PG8_STAGE(PG8_SA(0, 1), cA + hstepA, voffA);
    if (wr == 1) PG8_BAR;
    PG8_WAIT_V(2); PG8_BAR;
    PG8_STAGE(PG8_SB(1, 0), cB + kstepB, voffB); PG8_STAGE(PG8_SA(1, 0), cA + kstepA, voffA); PG8_STAGE(PG8_SB(1, 1), cB + hstepB + kstepB, voffB);
    PG8_WAIT_V(6); PG8_BAR;
    for (;;) {
        const bool has_next = S.next(ui + 1, nxt);
        const char* nA = has_next ? (const char*)g.A + (size_t)nxt.pm * tstepA + (size_t)nxt.pn * g.a_pn_off : cA; const char* nB = has_next ? (const char*)g.Bt + (size_t)nxt.pn * tstepB : cB;
        for (int t = 0; t < nt; t += 2) {
            const bool last = (t == nt - 2);
            const char* a1 = cA + (size_t)(t + 1) * kstepA;
            const char* a2 = last ? nA : cA + (size_t)(t + 2) * kstepA; const char* b2 = last ? nB : cB + (size_t)(t + 2) * kstepB;
            const char* a3 = a2 + kstepA; const char* b3 = b2 + kstepB;
            if constexpr (Epi::PREFETCH) { if (last) { int pl_; asm volatile("v_mbcnt_lo_u32_b32 %0, -1, 0\n\tv_mbcnt_hi_u32_b32 %0, -1, %0" : "=v"(pl_)); E.prefetch(cur, wid * 64 + pl_, lds + PF_JUNK_OFF + ldsw / 4); } }
            PG8_LDB(B0, 0, 0); PG8_LDB(B1, 0, 1); PG8_SCHED; PG8_LDA(At, 0, 0); PG8_STAGE(PG8_SA(1, 1), a1 + hstepA, voffA);
            PG8_WAIT_V(8); PG8_WAIT_L(0); PG8_BAR; PG8_MMA(0, 0, At, B0); PG8_MMA(0, 1, At, B1); PG8_BAR; PG8_SCHED;
            PG8_LDA(At, 0, 1); PG8_STAGE(PG8_SB(0, 0), b2, voffB); PG8_STAGE(PG8_SB(0, 1), b2 + hstepB, voffB); PG8_STAGE(PG8_SA(0, 0), a2, voffA);
            PG8_WAIT_V(8); PG8_WAIT_L(0); PG8_BAR; PG8_MMA(1, 0, At, B0); PG8_MMA(1, 1, At, B1); PG8_BAR; PG8_SCHED;
            PG8_LDB(B0, 1, 0); PG8_LDB(B1, 1, 1); PG8_SCHED; PG8_LDA(At, 1, 0); PG8_STAGE(PG8_SA(0, 1), a2 + hstepA, voffA);
            PG8_WAIT_V(8); PG8_WAIT_L(0); PG8_BAR; PG8_MMA(0, 0, At, B0); PG8_MMA(0, 1, At, B1); PG8_BAR; PG8_SCHED;
            PG8_LDA(At, 1, 1); PG8_STAGE(PG8_SB(1, 0), b3, voffB); PG8_STAGE(PG8_SB(1, 1), b3 + hstepB, voffB); PG8_STAGE(PG8_SA(1, 0), a3, voffA);
            PG8_WAIT_V(8); PG8_WAIT_L(0); PG8_BAR; PG8_MMA(1, 0, At, B0); PG8_MMA(1, 1, At, B1); PG8_BAR; PG8_SCHED;
        }
        if constexpr (ALIGN_EPI) { if (wr == 0) PG8_BAR; }
        if constexpr (!Epi::AFTER_DRAIN) { int ln_; asm volatile("v_mbcnt_lo_u32_b32 %0, -1, 0\n\tv_mbcnt_hi_u32_b32 %0, -1, %0" : "=v"(ln_)); E(acc, cur, wr, wc, ln_ & 15, ln_ >> 4); }
        if (!has_next) break;
#pragma unroll
        for (int a = 0; a < 2; ++a)
#pragma unroll
            for (int b = 0; b < 2; ++b)
#pragma unroll
                for (int m = 0; m < 4; ++m)
#pragma unroll
                    for (int n = 0; n < 2; ++n) acc[a][b][m][n] = (f32x4){0.f, 0.f, 0.f, 0.f};
        cur = nxt; cA = nA; cB = nB; ++ui;
        if constexpr (ALIGN_EPI) { if (wr == 1) PG8_BAR; }
    }
    PG8_WAIT_V(0);
    if constexpr (!ALIGN_EPI) { if (wr == 0) PG8_BAR; }
    PG8_BAR;
    if constexpr (Epi::AFTER_DRAIN) { int ln_; asm volatile("v_mbcnt_lo_u32_b32 %0, -1, 0\n\tv_mbcnt_hi_u32_b32 %0, -1, %0" : "=v"(ln_)); E.fused(acc, cur, wr, wc, ln_ & 15, ln_ >> 4, lds, wid, ln_); }
#undef PG8_SA
#undef PG8_SB
#undef PG8_STAGE
#undef PG8_LDA
#undef PG8_LDB
#undef PG8_MMA
#undef PG8_WAIT_V
#undef PG8_WAIT_L
#undef PG8_BAR
#undef PG8_SCHED
}

__device__ __forceinline__ float shx(float v, int lane, int m) { return __builtin_bit_cast(float, __builtin_amdgcn_ds_bpermute((lane ^ m) << 2, __builtin_bit_cast(int, v))); }
constexpr float RMS_EPS = 1e-6f;
typedef unsigned long long ssq_t;
constexpr float SSQ_SCALE = 1048576.0f;
__device__ __forceinline__ float rstd_row(const ssq_t* ssq, int row) { return __builtin_amdgcn_rsqf((float)ssq[row] * (1.0f / (1024.0f * SSQ_SCALE)) + RMS_EPS); }
#define PG8_GAS __attribute__((address_space(1)))
#ifndef MK_WT_STORES
#define MK_WT_STORES 0
#endif
template <int OFF = 0, typename V> __device__ __forceinline__ void st_wt(PG8_GAS void* p, const V v) {
    static_assert(OFF >= 0 && OFF < 4096, "immediate offset range");
#if MK_WT_STORES
    if constexpr (sizeof(V) == 16) asm volatile("global_store_dwordx4 %0, %1, off offset:%2 sc1\n\ts_nop 1" :: "v"(p), "v"(v), "n"(OFF) : "memory");
    else if constexpr (sizeof(V) == 8) asm volatile("global_store_dwordx2 %0, %1, off offset:%2 sc1\n\ts_nop 1" :: "v"(p), "v"(v), "n"(OFF) : "memory");
    else { static_assert(sizeof(V) == 4, "store width"); asm volatile("global_store_dword %0, %1, off offset:%2 sc1\n\ts_nop 1" :: "v"(p), "v"(v), "n"(OFF) : "memory"); }
#else
    *(PG8_GAS V*)((PG8_GAS unsigned char*)p + OFF) = v;
#endif
}
#ifndef MK_WT_RESID
#define MK_WT_RESID 0
#endif
__device__ __forceinline__ void st_resid(PG8_GAS unsigned char* base, unsigned off, const u32x4 v) {
#if MK_WT_RESID
    asm volatile("global_store_dwordx4 %0, %1, %2 sc1\n\ts_nop 1" :: "v"(off), "v"(v), "s"(base) : "memory");
#else
    *(PG8_GAS u32x4*)(base + off) = v;
#endif
}
#ifndef MK_NT_STORES
#define MK_NT_STORES 0
#endif
template <typename V> __device__ __forceinline__ void st_big(PG8_GAS void* p, const V v) {
#if MK_NT_STORES
    __builtin_nontemporal_store(v, (PG8_GAS V*)p);
#else
    st_wt(p, v);
#endif
}
#if MK_WT_STORES
#define ATTN_STORE16(p,v) pg8::st_wt((PG8_GAS void*)(p), (v))
#endif
__device__ __forceinline__ void rstd8(const ssq_t* ssq, int row0, float (&rs)[2][4]) {
    ssq_t sv[2][4];
#pragma unroll
    for (int ai = 0; ai < 2; ++ai)
#pragma unroll
        for (int m = 0; m < 4; ++m) sv[ai][m] = ((const PG8_GAS ssq_t*)ssq)[row0 + ai * HALF + m * 16];
#pragma unroll
    for (int ai = 0; ai < 2; ++ai)
#pragma unroll
        for (int m = 0; m < 4; ++m) rs[ai][m] = __builtin_amdgcn_rsqf((float)sv[ai][m] * (1.0f / (1024.0f * SSQ_SCALE)) + RMS_EPS);
}
__device__ __forceinline__ float fast_sigmoid(float x) { return __builtin_amdgcn_rcpf(1.0f + __builtin_amdgcn_exp2f(-1.4426950408889634f * x)); }

struct EpiQKV {
    static constexpr bool PERM = true, AFTER_DRAIN = false, PREFETCH = false;
    bf16_t* O; size_t split_stride; const ssq_t* ssq; float scale0; float* nrm; int dummy;
    __device__ __forceinline__ void operator()(const f32x4 (&acc)[2][2][4][2], const Unit& u, int wr, int wc, int fr, int fq) const {
        const int row0 = u.pm * BM + wr * 64 + fr, t = u.pn >> 2; bf16_t* base = O + (size_t)t * split_stride; const float sc = (t == 0) ? scale0 : 1.f;
        const int col0 = (u.pn & 3) * BM + wc * 32 + 8 * fq, ln = fq * 16 + fr;
        float rsv[2][4]; rstd8(ssq, row0, rsv);
#pragma unroll
        for (int ai = 0; ai < 2; ++ai)
#pragma unroll
            for (int m = 0; m < 4; ++m) { const int row = row0 + ai * HALF + m * 16; const float rs = rsv[ai][m] * sc; PG8_GAS bf16_t* rowp = (PG8_GAS bf16_t*)base + (size_t)row * 1024 + col0;
#pragma unroll
                for (int bj = 0; bj < 2; ++bj) { const f32x4 v0 = acc[ai][bj][m][0] * rs, v1 = acc[ai][bj][m][1] * rs;
                    u32x4 w; w.x = cvt_pk_bf16(v0[0], v0[1]); w.y = cvt_pk_bf16(v0[2], v0[3]); w.z = cvt_pk_bf16(v1[0], v1[1]); w.w = cvt_pk_bf16(v1[2], v1[3]);
                    st_big(rowp + bj * HALF, w);
                    if (t < 2) { float s = ((v0[0] * v0[0] + v0[1] * v0[1]) + (v0[2] * v0[2] + v0[3] * v0[3])) + ((v1[0] * v1[0] + v1[1] * v1[1]) + (v1[2] * v1[2] + v1[3] * v1[3]));
                        s += shx(s, ln, 16); s += shx(s, ln, 32);
                        if (fq == 0) ((PG8_GAS float*)nrm)[(((size_t)(t * 4 + (u.pn & 3)) * 16384 + row) * 4 + 2 * bj + (wc >> 1)) * 2 + (wc & 1)] = s; } } }
    }
};
struct EpiSwiGLU {
    static constexpr bool PERM = true, AFTER_DRAIN = false, PREFETCH = false;
    bf16_t* Hh; int ldh; const ssq_t* ssq; int dummy;
    __device__ __forceinline__ void operator()(const f32x4 (&acc)[2][2][4][2], const Unit& u, int wr, int wc, int fr, int fq) const {
        const int row0 = u.pm * BM + wr * 64 + fr, col0 = u.pn * HALF + wc * 32 + 8 * fq;
        if (dummy == 1) { if (fr == 0 && fq == 0) *(PG8_GAS float*)((PG8_GAS bf16_t*)Hh + (size_t)row0 * ldh + col0) = acc[0][0][0][0][0] + acc[1][1][3][1][3]; return; }
#if MK_SWIGLU_V2
        ssq_t sv[2][4];
#pragma unroll
        for (int ai = 0; ai < 2; ++ai)
#pragma unroll
            for (int m = 0; m < 4; ++m) sv[ai][m] = ((const PG8_GAS ssq_t*)ssq)[row0 + ai * HALF + m * 16];
#pragma unroll
        for (int ai = 0; ai < 2; ++ai)
#pragma unroll
            for (int m = 0; m < 4; ++m) { const int row = row0 + ai * HALF + m * 16;
                const float ms = (float)sv[ai][m] * (1.0f / (1024.0f * SSQ_SCALE)) + RMS_EPS, rsn = __builtin_amdgcn_rsqf(ms) * (-1.4426950408889634f);
                float h[8];
#pragma unroll
                for (int n = 0; n < 2; ++n)
#pragma unroll
                    for (int j = 0; j < 4; j += 2) {
                        const f32x2 g2 = {acc[ai][0][m][n][j], acc[ai][0][m][n][j + 1]}, u2 = {acc[ai][1][m][n][j], acc[ai][1][m][n][j + 1]};
                        const f32x2 ar = g2 * rsn, t = g2 * u2;
                        f32x2 e; e.x = __builtin_amdgcn_exp2f(ar.x); e.y = __builtin_amdgcn_exp2f(ar.y);
                        const f32x2 msv = {ms, ms}; const f32x2 dn = __builtin_elementwise_fma(e, msv, msv); f32x2 r; r.x = __builtin_amdgcn_rcpf(dn.x); r.y = __builtin_amdgcn_rcpf(dn.y);
                        const f32x2 hv = t * r; h[n * 4 + j] = hv.x; h[n * 4 + j + 1] = hv.y; }
#else
        float rsv[2][4]; rstd8(ssq, row0, rsv);
#pragma unroll
        for (int ai = 0; ai < 2; ++ai)
#pragma unroll
            for (int m = 0; m < 4; ++m) { const int row = row0 + ai * HALF + m * 16; const float rs = rsv[ai][m];
                float h[8];
#pragma unroll
                for (int n = 0; n < 2; ++n)
#pragma unroll
                    for (int j = 0; j < 4; j += 2) {
                        const f32x2 g2 = {acc[ai][0][m][n][j], acc[ai][0][m][n][j + 1]}, u2 = {acc[ai][1][m][n][j], acc[ai][1][m][n][j + 1]};
                        const f32x2 gs = g2 * rs, us = u2 * rs, ar = gs * (-1.4426950408889634f);
                        f32x2 e; e.x = __builtin_amdgcn_exp2f(ar.x); e.y = __builtin_amdgcn_exp2f(ar.y);
                        const f32x2 dn = e + 1.0f; f32x2 r; r.x = __builtin_amdgcn_rcpf(dn.x); r.y = __builtin_amdgcn_rcpf(dn.y);
                        const f32x2 hv = (gs * r) * us; h[n * 4 + j] = hv.x; h[n * 4 + j + 1] = hv.y; }
#endif
                u32x4 w; w.x = cvt_pk_bf16(h[0], h[1]); w.y = cvt_pk_bf16(h[2], h[3]); w.z = cvt_pk_bf16(h[4], h[5]); w.w = cvt_pk_bf16(h[6], h[7]);
                st_big((PG8_GAS bf16_t*)Hh + (size_t)row * ldh + col0, w); }
    }
};
__device__ __forceinline__ void bf8_to_f32(const u32x4 w, f32x4& lo, f32x4& hi) {
    lo = (f32x4){__builtin_bit_cast(float, w.x << 16), __builtin_bit_cast(float, w.x & 0xffff0000u), __builtin_bit_cast(float, w.y << 16), __builtin_bit_cast(float, w.y & 0xffff0000u)};
    hi = (f32x4){__builtin_bit_cast(float, w.z << 16), __builtin_bit_cast(float, w.z & 0xffff0000u), __builtin_bit_cast(float, w.w << 16), __builtin_bit_cast(float, w.w & 0xffff0000u)};
}
template <int MODE> struct EpiResid {
    static constexpr bool PERM = true, AFTER_DRAIN = false, PREFETCH = MK_PF_BASE && MODE == 0;
    const bf16_t* base; bf16_t* XB; ssq_t* ssq_out; const float* pb; const float* psc; int dummy;
    __device__ __forceinline__ void prefetch(const Unit& u, int tid, PG8_LAS unsigned char* junk) const {
        const int r = tid >> 1, h = tid & 1;
        const char* p = (const char*)base + ((size_t)(u.pm * BM + r) * 1024 + (MODE == 1 ? u.pn * HALF : u.pn * BM)) * 2 + h * (MODE == 1 ? 128 : 256);
        __builtin_amdgcn_global_load_lds((const unsigned*)p, (PG8_LAS unsigned*)junk, 4, 0, 0);
        if (MODE != 1) __builtin_amdgcn_global_load_lds((const unsigned*)(p + 128), (PG8_LAS unsigned*)junk, 4, 0, 0);
    }
    __device__ __forceinline__ void operator()(const f32x4 (&acc)[2][2][4][2], const Unit& u, int wr, int wc, int fr, int fq) const {
        if (dummy == 1) { if (acc[0][0][0][0][0] + acc[1][1][3][1][3] == 12345.678f) ((PG8_GAS float*)pb)[0] = 1.f; return; }
        const int row0 = u.pm * BM + wr * 64 + fr;
        const int col0 = (MODE == 1 ? u.pn * HALF : u.pn * BM) + wc * 32 + 8 * fq;
        constexpr int NBJ = (MODE == 1) ? 1 : 2;
        const PG8_GAS unsigned char* gb = (const PG8_GAS unsigned char*)base; PG8_GAS unsigned char* gx = (PG8_GAS unsigned char*)XB; const unsigned ob = ((unsigned)row0 * 1024u + (unsigned)col0) * 2u;
#define PG8_ROFF(dr, co_) (ob + (unsigned)((((dr)) * 1024 + (co_)) * 2))
        float ss[2][4];
#pragma unroll
        for (int ai = 0; ai < 2; ++ai)
#pragma unroll
            for (int m = 0; m < 4; ++m) ss[ai][m] = 0.f;
        constexpr bool ALL16 = (MODE == 0) && MK_RESID_ALL16;
        u32x4 bsall[ALL16 ? 2 : 1][2][4];
        if constexpr (ALL16) {
#pragma unroll
            for (int bj = 0; bj < 2; ++bj)
#pragma unroll
                for (int ai = 0; ai < 2; ++ai)
#pragma unroll
                    for (int m = 0; m < 4; ++m) bsall[bj][ai][m] = *(const PG8_GAS u32x4*)(gb + (ob + (unsigned)(((ai * HALF + m * 16) * 1024 + bj * HALF) * 2))); }
#pragma unroll
        for (int bj = 0; bj < NBJ; ++bj) { const int co = bj * HALF;
            f32x4 bb0 = {0.f, 0.f, 0.f, 0.f}, bb1 = bb0, sc0 = {1.f, 1.f, 1.f, 1.f}, sc1 = sc0;
            if (MODE == 2) { bb0 = *(const PG8_GAS f32x4*)((const PG8_GAS float*)pb + col0 + co); bb1 = *(const PG8_GAS f32x4*)((const PG8_GAS float*)pb + col0 + co + 4);
                             sc0 = *(const PG8_GAS f32x4*)((const PG8_GAS float*)psc + col0 + co); sc1 = *(const PG8_GAS f32x4*)((const PG8_GAS float*)psc + col0 + co + 4); }
            constexpr int NAB = (MODE == 2) ? 1 : 2;
#pragma unroll
            for (int a0 = 0; a0 < 2; a0 += NAB) {
                u32x4 bs[NAB][4];
#pragma unroll
                for (int ai = 0; ai < NAB; ++ai)
#pragma unroll
                    for (int m = 0; m < 4; ++m) { if constexpr (ALL16) bs[ai][m] = bsall[bj][ai][m]; else bs[ai][m] = *(const PG8_GAS u32x4*)(gb + PG8_ROFF((a0 + ai) * HALF + m * 16, co)); }
#pragma unroll
                for (int aa = 0; aa < NAB; ++aa)
#pragma unroll
                    for (int m = 0; m < 4; ++m) { const int ai = a0 + aa; const unsigned off = PG8_ROFF(ai * HALF + m * 16, co); f32x4 d0, d1;
                        if (MODE == 0) { d0 = acc[ai][bj][m][0]; d1 = acc[ai][bj][m][1]; }
                        else if (MODE == 1) { const f32x4 v0 = acc[ai][0][m][0], g0 = acc[ai][1][m][0], v1 = acc[ai][0][m][1], g1 = acc[ai][1][m][1];
                            d0 = (f32x4){v0[0] * fast_sigmoid(g0[0]), v0[1] * fast_sigmoid(g0[1]), v0[2] * fast_sigmoid(g0[2]), v0[3] * fast_sigmoid(g0[3])};
                            d1 = (f32x4){v1[0] * fast_sigmoid(g1[0]), v1[1] * fast_sigmoid(g1[1]), v1[2] * fast_sigmoid(g1[2]), v1[3] * fast_sigmoid(g1[3])}; }
                        else { d0 = (acc[ai][bj][m][0] + bb0) * sc0; d1 = (acc[ai][bj][m][1] + bb1) * sc1; }
                        f32x4 b0, b1; bf8_to_f32(bs[aa][m], b0, b1);
                        const f32x4 o0 = b0 + d0, o1 = b1 + d1;
                        ss[ai][m] += ((o0[0] * o0[0] + o0[1] * o0[1]) + (o0[2] * o0[2] + o0[3] * o0[3])) + ((o1[0] * o1[0] + o1[1] * o1[1]) + (o1[2] * o1[2] + o1[3] * o1[3]));
                        u32x4 w; w.x = cvt_pk_bf16(o0[0], o0[1]); w.y = cvt_pk_bf16(o0[2], o0[3]); w.z = cvt_pk_bf16(o1[0], o1[1]); w.w = cvt_pk_bf16(o1[2], o1[3]);
                        st_resid(gx, off, w); }
                if (NAB == 1) asm volatile("" ::: "memory"); }
            asm volatile("" ::: "memory"); }
        const int ln = fq * 16 + fr;
#pragma unroll
        for (int ai = 0; ai < 2; ++ai)
#pragma unroll
            for (int m = 0; m < 4; ++m) { float s = ss[ai][m]; s += shx(s, ln, 16); s += shx(s, ln, 32);
                if (fq == 0) atomicAdd(ssq_out + row0 + ai * HALF + m * 16, (ssq_t)__builtin_llrintf(s * SSQ_SCALE)); }
    }
};
struct EpiResidFinal {
    static constexpr bool PERM = true, AFTER_DRAIN = true, PREFETCH = false;
    const bf16_t* base; float* out; ssq_t* ssq_out; const float* gain; unsigned* cnt;
    __device__ __forceinline__ void prefetch(const Unit& u, int tid, PG8_LAS unsigned char* junk) const {
        const int r = tid >> 1, h = tid & 1;
        const char* p = (const char*)base + ((size_t)(u.pm * BM + r) * 1024 + u.pn * BM) * 2 + h * 256;
        __builtin_amdgcn_global_load_lds((const unsigned*)p, (PG8_LAS unsigned*)junk, 4, 0, 0);
        __builtin_amdgcn_global_load_lds((const unsigned*)(p + 128), (PG8_LAS unsigned*)junk, 4, 0, 0);
    }
    __device__ __forceinline__ void fused(f32x4 (&acc)[2][2][4][2], const Unit& u, int wr, int wc, int fr, int fq, PG8_LAS unsigned char* lds, int wid, int lane) const {
        const int row0 = u.pm * BM + wr * 64 + fr, col0 = u.pn * BM + wc * 32 + 8 * fq;
        const PG8_GAS bf16_t* gb = (const PG8_GAS bf16_t*)base + (size_t)row0 * 1024 + col0;
        float ss[2][4]; float chain_ = 0.f;
#pragma unroll
        for (int ai = 0; ai < 2; ++ai)
#pragma unroll
            for (int m = 0; m < 4; m += 2) { int ro_ = (ai * HALF + m * 16) * 1024; asm volatile("" : "+v"(ro_) : "v"(chain_));
                const PG8_GAS bf16_t* rp = gb + ro_;
                const u32x4 wa = *(const PG8_GAS u32x4*)(rp), wb = *(const PG8_GAS u32x4*)(rp + HALF), wc_ = *(const PG8_GAS u32x4*)(rp + 16 * 1024), wd = *(const PG8_GAS u32x4*)(rp + 16 * 1024 + HALF);
#pragma unroll
                for (int q = 0; q < 2; ++q) { f32x4 b0, b1, b2, b3; bf8_to_f32(q ? wc_ : wa, b0, b1); bf8_to_f32(q ? wd : wb, b2, b3);
                    const f32x4 o0 = b0 + acc[ai][0][m + q][0], o1 = b1 + acc[ai][0][m + q][1], o2 = b2 + acc[ai][1][m + q][0], o3 = b3 + acc[ai][1][m + q][1];
                    acc[ai][0][m + q][0] = o0; acc[ai][0][m + q][1] = o1; acc[ai][1][m + q][0] = o2; acc[ai][1][m + q][1] = o3;
                    ss[ai][m + q] = ((o0[0] * o0[0] + o0[1] * o0[1]) + (o0[2] * o0[2] + o0[3] * o0[3])) + ((o1[0] * o1[0] + o1[1] * o1[1]) + (o1[2] * o1[2] + o1[3] * o1[3]))
                                  + ((o2[0] * o2[0] + o2[1] * o2[1]) + (o2[2] * o2[2] + o2[3] * o2[3])) + ((o3[0] * o3[0] + o3[1] * o3[1]) + (o3[2] * o3[2] + o3[3] * o3[3])); }
                chain_ = ss[ai][m] + ss[ai][m + 1]; }
        const int ln = fq * 16 + fr;
#pragma unroll
        for (int ai = 0; ai < 2; ++ai)
#pragma unroll
            for (int m = 0; m < 4; ++m) { float s = ss[ai][m]; s += shx(s, ln, 16); s += shx(s, ln, 32);
                if (fq == 0) atomicAdd(ssq_out + row0 + ai * HALF + m * 16, (ssq_t)__builtin_llrintf(s * SSQ_SCALE)); }
        asm volatile("s_waitcnt vmcnt(0)" ::: "memory"); __builtin_amdgcn_s_barrier(); asm volatile("" ::: "memory");
        if (wid == 0) {
            unsigned* c = cnt + 64 * u.pm;
            if (lane == 0) __hip_atomic_fetch_add(c, 1u, __ATOMIC_RELAXED, __HIP_MEMORY_SCOPE_AGENT);
            unsigned spins = 0;
            while ((unsigned)__builtin_amdgcn_readfirstlane(__hip_atomic_load(c, __ATOMIC_RELAXED, __HIP_MEMORY_SCOPE_AGENT)) < 4u && ++spins < (1u << 22)) __builtin_amdgcn_s_sleep(2);
        }
        __builtin_amdgcn_s_barrier(); asm volatile("" ::: "memory");
        int l2_; asm volatile("v_mbcnt_lo_u32_b32 %0, -1, 0\n\tv_mbcnt_hi_u32_b32 %0, -1, %0" : "=v"(l2_));
        const int row0b = u.pm * BM + wr * 64 + (l2_ & 15), col0b = u.pn * BM + wc * 32 + 8 * (l2_ >> 4);
        PG8_GAS float* go = (PG8_GAS float*)out + (size_t)row0b * 1024 + col0b;
        float rs[2][4];
#pragma unroll
        for (int ai = 0; ai < 2; ++ai)
#pragma unroll
            for (int m = 0; m < 4; ++m) rs[ai][m] = __builtin_amdgcn_rsqf((float)__hip_atomic_load(ssq_out + row0b + ai * HALF + m * 16, __ATOMIC_RELAXED, __HIP_MEMORY_SCOPE_AGENT) * (1.0f / (1024.0f * SSQ_SCALE)) + RMS_EPS);
#pragma unroll
        for (int bj = 0; bj < 2; ++bj) { int co = bj * HALF; asm volatile("" : "+v"(co) : "v"(chain_));
            const f32x4 gg0 = *(const PG8_GAS f32x4*)((const PG8_GAS float*)gain + col0b + co), gg1 = *(const PG8_GAS f32x4*)((const PG8_GAS float*)gain + col0b + co + 4);
#pragma unroll
            for (int ai = 0; ai < 2; ++ai)
#pragma unroll
                for (int m = 0; m < 4; ++m) {
                    const f32x4 ov0 = acc[ai][bj][m][0] * rs[ai][m] * gg0, ov1 = acc[ai][bj][m][1] * rs[ai][m] * gg1;
                    PG8_GAS float* op = go + (size_t)(ai * HALF + m * 16) * 1024 + co; *(PG8_GAS f32x4*)op = ov0; *(PG8_GAS f32x4*)(op + 4) = ov1; chain_ = ov1[0]; }
            asm volatile("" ::: "memory"); }
    }
};
struct EpiU {
    static constexpr bool PERM = true, AFTER_DRAIN = false, PREFETCH = false;
    bf16_t* UX; const ssq_t* ssq;
    __device__ __forceinline__ void operator()(const f32x4 (&acc)[2][2][4][2], const Unit& u, int wr, int wc, int fr, int fq) const {
        const int row0 = u.pm * BM + wr * 64 + fr, col0 = u.pn * BM + wc * 32 + 8 * fq;
        float rsv[2][4]; rstd8(ssq, row0, rsv);
#pragma unroll
        for (int ai = 0; ai < 2; ++ai)
#pragma unroll
            for (int m = 0; m < 4; ++m) { const int row = row0 + ai * HALF + m * 16; const float rs = rsv[ai][m];
#pragma unroll
                for (int bj = 0; bj < 2; ++bj) { const int col = col0 + bj * HALF; const f32x4 v0 = acc[ai][bj][m][0] * rs, v1 = acc[ai][bj][m][1] * rs;
                    u32x4 w; w.x = cvt_pk_bf16(v0[0], v0[1]); w.y = cvt_pk_bf16(v0[2], v0[3]); w.z = cvt_pk_bf16(v1[0], v1[1]); w.w = cvt_pk_bf16(v1[2], v1[3]);
                    st_wt((PG8_GAS bf16_t*)UX + ((size_t)(col >> 4) * 1024 + (row >> 4)) * 384 + (row & 15) * 16 + (col & 15), w); } }
    }
};
struct EpiSloc {
    static constexpr bool PERM = false, AFTER_DRAIN = true, PREFETCH = false;
    const float* lamc; bf16_t* UX; PG8_LAS unsigned char* esc;
    __device__ __forceinline__ void fused(f32x4 (&acc)[2][2][4][2], const Unit& u, int wr, int wc, int fr, int fq, PG8_LAS unsigned char* lds, int wid, int lane) const {
        PG8_LAS float* SL = (PG8_LAS float*)lds;
#pragma unroll
        for (int ai = 0; ai < 2; ++ai)
#pragma unroll
            for (int m = 0; m < 4; ++m)
#pragma unroll
                for (int n = 0; n < 2; ++n) *(PG8_LAS f32x4*)(SL + (ai * HALF + wr * 64 + m * 16 + fr) * 128 + wc * 32 + n * 16 + 4 * fq) = acc[ai][0][m][n];
        asm volatile("s_waitcnt lgkmcnt(0)" ::: "memory"); __builtin_amdgcn_s_barrier(); asm volatile("" ::: "memory");
        const int g = u.pn, b = u.pm, seg = wid, p = lane;
        const float lr = lamc[(g * 64 + p) * 2], li = lamc[(g * 64 + p) * 2 + 1];
        float sr = 0.f, si = 0.f;
        for (int c = seg * 32; c < seg * 32 + 32; ++c) { const float xr = SL[c * 128 + p], xi = SL[c * 128 + 64 + p]; const float nr = lr * sr - li * si + xr, ni = lr * si + li * sr + xi; sr = nr; si = ni; }
        PG8_LAS float* E = (PG8_LAS float*)esc;
        E[(seg * 64 + p) * 2] = sr; E[(seg * 64 + p) * 2 + 1] = si;
        asm volatile("s_waitcnt lgkmcnt(0)" ::: "memory"); __builtin_amdgcn_s_barrier(); asm volatile("" ::: "memory");
        float l32r = lr, l32i = li;
#pragma unroll
        for (int q = 0; q < 5; ++q) { const float t = l32r * l32r - l32i * l32i; l32i = 2.f * l32r * l32i; l32r = t; }
        sr = 0.f; si = 0.f;
        for (int j = 0; j < seg; ++j) { const float er = E[(j * 64 + p) * 2], ei = E[(j * 64 + p) * 2 + 1]; const float nr = l32r * sr - l32i * si + er, ni = l32r * si + l32i * sr + ei; sr = nr; si = ni; }
        bf16_t* dst = UX + ((size_t)g * 1024 + b * 256 + seg * 32) * 384 + 256 + p;
        for (int c = seg * 32; c < seg * 32 + 32; ++c) {
            { unsigned ur = __builtin_bit_cast(unsigned, sr), ui = __builtin_bit_cast(unsigned, si); ur = (ur + 0x7fffu + ((ur >> 16) & 1u)) >> 16; ui = (ui + 0x7fffu + ((ui >> 16) & 1u)) >> 16;
              dst[0] = (bf16_t)ur; dst[64] = (bf16_t)ui; }
            const float xr = SL[c * 128 + p], xi = SL[c * 128 + 64 + p]; const float nr = lr * sr - li * si + xr, ni = lr * si + li * sr + xi; sr = nr; si = ni;
            dst += 384; }
        asm volatile("s_waitcnt vmcnt(0) lgkmcnt(0)" ::: "memory"); __builtin_amdgcn_s_barrier(); asm volatile("" ::: "memory");
        if (wid == 0) { __builtin_amdgcn_fence(__ATOMIC_ACQUIRE, "agent"); asm volatile("s_waitcnt vmcnt(0)" ::: "memory"); }
        __builtin_amdgcn_s_barrier(); asm volatile("" ::: "memory");
    }
};
struct EpiY {
    static constexpr bool PERM = true, AFTER_DRAIN = false, PREFETCH = false;
    const bf16_t* UX; const float* dvec; bf16_t* G1;
    __device__ __forceinline__ void operator()(const f32x4 (&acc)[2][2][4][2], const Unit& u, int wr, int wc, int fr, int fq) const {
        const int g = u.pn, b = u.pm, ch0 = g * 16 + 8 * (fq & 1);
        const f32x4 d0 = *(const f32x4*)(dvec + ch0), d1 = *(const f32x4*)(dvec + ch0 + 4);
#pragma unroll
        for (int ai = 0; ai < 2; ++ai) {
            u32x4 uwv[4][2];
#pragma unroll
            for (int m = 0; m < 4; ++m)
#pragma unroll
                for (int bj = 0; bj < 2; ++bj) uwv[m][bj] = *(const PG8_GAS u32x4*)((const PG8_GAS bf16_t*)UX + ((size_t)g * 1024 + b * 256 + (ai * HALF + wr * 64 + m * 16 + fr)) * 384 + (8 * bj + 2 * wc + (fq >> 1)) * 16 + 8 * (fq & 1));
#pragma unroll
            for (int m = 0; m < 4; ++m) { const int R = ai * HALF + wr * 64 + m * 16 + fr;
#pragma unroll
                for (int bj = 0; bj < 2; ++bj) { const int i = 8 * bj + 2 * wc + (fq >> 1);
                    const u32x4 uw = uwv[m][bj];
                    float y[8];
#pragma unroll
                    for (int j = 0; j < 4; ++j) { y[j] = acc[ai][bj][m][0][j] + d0[j] * __builtin_bit_cast(float, (j & 1) ? (uw[j >> 1] & 0xffff0000u) : (uw[j >> 1] << 16));
                                                  y[4 + j] = acc[ai][bj][m][1][j] + d1[j] * __builtin_bit_cast(float, (j & 1) ? (uw[2 + (j >> 1)] & 0xffff0000u) : (uw[2 + (j >> 1)] << 16)); }
#pragma unroll
                    for (int j = 0; j < 8; ++j) { const float z = 0.7978845608028654f * (y[j] + 0.044715f * y[j] * y[j] * y[j]); y[j] = y[j] * fast_sigmoid(2.f * z); }
                    u32x4 w; w.x = cvt_pk_bf16(y[0], y[1]); w.y = cvt_pk_bf16(y[2], y[3]); w.z = cvt_pk_bf16(y[4], y[5]); w.w = cvt_pk_bf16(y[6], y[7]);
                    st_wt((PG8_GAS bf16_t*)G1 + (MK_G1_NATURAL ? ((size_t)(b * 4096 + 16 * R + i) * 1024 + g * 16 + 8 * (fq & 1)) : (((size_t)g * 16384 + b * 4096 + 16 * R + i) * 16 + 8 * (fq & 1))), w); } }
            asm volatile("" ::: "memory"); }
    }
};
}
#include <hip/hip_bf16.h>
#include <cmath>
namespace attn_body {
using bf16=__hip_bfloat16;
using bf16x8=__attribute__((ext_vector_type(8)))short;
using s16x4=__attribute__((ext_vector_type(4)))short;
using f32x16=__attribute__((ext_vector_type(16)))float;
using u32x4=__attribute__((ext_vector_type(4)))unsigned;
constexpr int BATCH=4,NHEAD=16,SEQ=4096,D=64,DM=NHEAD*D;
constexpr int NW=8,QBLK=32,QB=QBLK*NW,KVBLK=64,NQB=SEQ/QB;
constexpr int ATTN_PITCH=DM, ATTN_UNIT_ROWS=QB;
__device__ __forceinline__ int crow(int r,int hi){return (r&3)+8*(r>>2)+4*hi;}
#define SBAR() __builtin_amdgcn_sched_barrier(0)
__device__ __forceinline__ void cmask(f32x16&p0,f32x16&p1,int jb,int qrel,int hi){
  const float NEG=-INFINITY; int kb=64*jb+4*hi;
  #pragma unroll
  for(int r=0;r<16;++r){int kv=kb+(r&3)+8*(r>>2); if(kv>qrel)p0[r]=NEG; if(kv+32>qrel)p1[r]=NEG;}
}

constexpr int NSLOT=3, SLOTB=8192;
constexpr int LDS_K=0, LDS_V=NSLOT*SLOTB, LDS_WS=2*NSLOT*SLOTB, LDS_OST=LDS_WS+NW*64*4, LDS_BYTES=LDS_OST+NW*4096;
constexpr float C2=0.125f*1.4426950408889634f;
__device__ __forceinline__ void glds16(const void*gsrc,unsigned lds_dst){unsigned keep;
  asm volatile("s_mov_b32 %0, m0\n\ts_mov_b32 m0, %2\n\ts_nop 0\n\tglobal_load_lds_dwordx4 %1, off\n\ts_mov_b32 m0, %0":"=&s"(keep):"v"(gsrc),"s"(lds_dst):"memory");}
__device__ __forceinline__ float max3f(float a,float b,float c){float r;asm("v_max3_f32 %0, %1, %2, %3":"=v"(r):"v"(a),"v"(b),"v"(c));return r;}
__device__ __forceinline__ float max2f(float a,float b){float r;asm("v_max_f32_e32 %0, %1, %2":"=v"(r):"v"(a),"v"(b));return r;}
__device__ __forceinline__ float fadd_s(float a,float b){float r;asm("v_add_f32_e32 %0, %1, %2":"=v"(r):"v"(a),"v"(b));return r;}
__device__ __forceinline__ float fsub_s(float a,float b){float r;asm("v_sub_f32_e32 %0, %1, %2":"=v"(r):"v"(a),"v"(b));return r;}
typedef float f32x2_t __attribute__((ext_vector_type(2))); typedef __bf16 bf16x2_t __attribute__((ext_vector_type(2)));
__device__ __forceinline__ unsigned cvtpk_s(float lo,float hi){f32x2_t v={lo,hi};bf16x2_t b=__builtin_convertvector(v,bf16x2_t);return __builtin_bit_cast(unsigned,b);}
#define WAIT_BAR(N) asm volatile("s_waitcnt vmcnt(" #N ") lgkmcnt(0)\n\ts_barrier":::"memory")

__device__ __forceinline__ void qkt(f32x16&p0,f32x16&p1,const char*Kslot,const bf16x8*qr,int r32,int hi){
  const char*kb=Kslot+hi*1024+r32*16;
  #pragma unroll
  for(int d0=0;d0<4;++d0){
    const bf16x8 b0=*reinterpret_cast<const bf16x8*>(kb+d0*2048);
    const bf16x8 b1=*reinterpret_cast<const bf16x8*>(kb+d0*2048+512);
    {p0=__builtin_amdgcn_mfma_f32_32x32x16_bf16(b0,qr[d0],p0,0,0,0);p1=__builtin_amdgcn_mfma_f32_32x32x16_bf16(b1,qr[d0],p1,0,0,0);}}
}
typedef __attribute__((address_space(3))) const char* lds_cptr;
typedef short v4i16_t __attribute__((ext_vector_type(4)));
__device__ __forceinline__ void kload8(bf16x8*kf,lds_cptr kp){
  kf[0]=*(const __attribute__((address_space(3))) bf16x8*)(kp);      kf[1]=*(const __attribute__((address_space(3))) bf16x8*)(kp+512);
  kf[2]=*(const __attribute__((address_space(3))) bf16x8*)(kp+2048); kf[3]=*(const __attribute__((address_space(3))) bf16x8*)(kp+2560);
  kf[4]=*(const __attribute__((address_space(3))) bf16x8*)(kp+4096); kf[5]=*(const __attribute__((address_space(3))) bf16x8*)(kp+4608);
  kf[6]=*(const __attribute__((address_space(3))) bf16x8*)(kp+6144); kf[7]=*(const __attribute__((address_space(3))) bf16x8*)(kp+6656);
}
__device__ __forceinline__ void kload2(bf16x8*kf,lds_cptr kp,int j){ kf[2*j]=*(const __attribute__((address_space(3))) bf16x8*)(kp+j*2048); kf[2*j+1]=*(const __attribute__((address_space(3))) bf16x8*)(kp+j*2048+512); }
__device__ __forceinline__ s16x4 vtr(lds_cptr p){ return __builtin_bit_cast(s16x4,__builtin_amdgcn_ds_read_tr16_b64_v4i16((__attribute__((address_space(3))) v4i16_t*)p)); }
__device__ __forceinline__ float rowmax(const f32x16&p0,const f32x16&p1){
  float a=max3f(p0[0],p0[1],p1[0]),b=max3f(p0[2],p0[3],p1[1]);a=max3f(a,p1[2],p1[3]);
  #pragma unroll
  for(int r=4;r<16;r+=4){a=max3f(a,p0[r],p0[r+1]);b=max3f(b,p0[r+2],p0[r+3]);a=max3f(a,p1[r],p1[r+1]);b=max3f(b,p1[r+2],p1[r+3]);}
  const float m=max2f(a,b);
  auto rr=__builtin_amdgcn_permlane32_swap(__float_as_uint(m),__float_as_uint(m),false,false);
  return max2f(__uint_as_float(rr[0]),__uint_as_float(rr[1]));
}
__device__ __forceinline__ void pv(f32x16*o,int vb,bf16x8 pa0,bf16x8 pa1,bf16x8 pa2,bf16x8 pa3){
  #pragma unroll
  for(int d0=0;d0<2;++d0){s16x4 lo[4],hi[4];
    #pragma unroll
    for(int ks=0;ks<4;++ks){
      asm volatile("ds_read_b64_tr_b16 %0,%1 offset:%c2":"=&v"(lo[ks]):"v"(vb),"i"(d0*4096+ks*1024):"memory");
      asm volatile("ds_read_b64_tr_b16 %0,%1 offset:%c2":"=&v"(hi[ks]):"v"(vb),"i"(d0*4096+ks*1024+512):"memory");}
    asm volatile("s_waitcnt lgkmcnt(0)":::"memory");SBAR();
    #define PK(k) (bf16x8){lo[k][0],lo[k][1],lo[k][2],lo[k][3],hi[k][0],hi[k][1],hi[k][2],hi[k][3]}
    o[d0]=__builtin_amdgcn_mfma_f32_32x32x16_bf16(pa0,PK(0),o[d0],0,0,0);
    o[d0]=__builtin_amdgcn_mfma_f32_32x32x16_bf16(pa1,PK(1),o[d0],0,0,0);
    o[d0]=__builtin_amdgcn_mfma_f32_32x32x16_bf16(pa2,PK(2),o[d0],0,0,0);
    o[d0]=__builtin_amdgcn_mfma_f32_32x32x16_bf16(pa3,PK(3),o[d0],0,0,0);
    #undef PK
  }
}

#ifndef ATTN_STORE16
#define ATTN_STORE16(p,v) (*(u32x4*)(p)=(v))
#endif
typedef float f32x4b __attribute__((ext_vector_type(4)));
template<int THRL> __device__ __forceinline__ void attn_unit(int b,int h,int qb,const bf16*Q,const bf16*__restrict__ K,const bf16*__restrict__ V,bf16*O,char*shm,const __attribute__((address_space(3))) float*bl0,const int tid_,const int tskip){
  const __attribute__((address_space(3))) float*bl=bl0+tskip*64;
  const int tid=tid_,lane=tid&63,r32=lane&31,hi=lane>>5; const int wid=__builtin_amdgcn_readfirstlane(tid>>6);
  const long rowbase=(long)b*SEQ; const int q0=qb*QB;
  const bf16*Qw=Q+(rowbase+q0+wid*QBLK)*DM+h*D;
  const bf16*Kh=K+(rowbase+(long)tskip*KVBLK)*DM+h*D,*Vh=V+(rowbase+(long)tskip*KVBLK)*DM+h*D;
  const unsigned lds0=(unsigned)(uintptr_t)shm;
  float*wsf=(float*)(shm+LDS_WS)+wid*64;
  const bf16*ksrc=Kh+(long)lane*DM+wid*8;
  const bf16*vsrc=Vh+(long)(16*(wid&3)+(lane>>2))*DM+(wid>>2)*32+(lane&3)*8;
  const unsigned kdst=lds0+LDS_K+wid*1024, vdst=lds0+LDS_V+wid*1024;
  #define DMA_K(t,slot) glds16(ksrc+(long)(t)*KVBLK*DM,(unsigned)__builtin_amdgcn_readfirstlane(kdst+(slot)))
  #define DMA_V(t,slot) glds16(vsrc+(long)(t)*KVBLK*DM,(unsigned)__builtin_amdgcn_readfirstlane(vdst+(slot)))
  const int vb0=(int)(lds0+LDS_V)+((lane>>4)&1)*32+(lane&3)*8+(4*hi+((lane&15)>>2))*64;
  const char*Kbase=shm+LDS_K; bf16x8 kf[8];
  const lds_cptr shm3=(lds_cptr)shm; const lds_cptr kp0=shm3+LDS_K+hi*1024+r32*16; const lds_cptr vp0=shm3+LDS_V+((lane>>4)&1)*32+(lane&3)*8+(4*hi+((lane&15)>>2))*64;
  const int NT=(q0+QB)/KVBLK-tskip;
  DMA_K(0,0);DMA_V(0,0);DMA_K(1,SLOTB);
  bf16x8 qr[4];
  #pragma unroll
  for(int d0=0;d0<4;++d0)qr[d0]=*reinterpret_cast<const bf16x8*>(&Qw[(long)r32*DM+d0*16+hi*8]);
  float mhat=0.f,l_reg=0.f;f32x16 o[2];o[0]=f32x16{};o[1]=f32x16{};
  const int qrel=wid*QBLK+r32;
  #define CMASK(P0,P1,t) do{int jb_=(t)-(NT-4); if(jb_>=0)cmask(P0,P1,jb_,qrel,hi);}while(0)
  #define BIASLD(P0,P1,t) do{ const __attribute__((address_space(3))) f32x4b*bp_=(const __attribute__((address_space(3))) f32x4b*)(bl+(t)*64+hi*4); \
    _Pragma("unroll") for(int g_=0;g_<4;++g_){ const f32x4b b0_=bp_[2*g_],b1_=bp_[8+2*g_]; \
      P0[4*g_]=b0_[0];P0[4*g_+1]=b0_[1];P0[4*g_+2]=b0_[2];P0[4*g_+3]=b0_[3]; P1[4*g_]=b1_[0];P1[4*g_+1]=b1_[1];P1[4*g_+2]=b1_[2];P1[4*g_+3]=b1_[3]; } }while(0)
  bool resc=false;
  #define START(P0,P1) do{ const float rm=rowmax(P0,P1); resc=false; \
    { const float dl=rm; mhat=fadd_s(mhat,dl); \
      _Pragma("unroll") for(int r=0;r<16;++r){P0[r]=fsub_s(P0[r],dl);P1[r]=fsub_s(P1[r],dl);} } \
    _Pragma("unroll") for(int r=0;r<16;++r)P0[r]=__builtin_amdgcn_exp2f(P0[r]); }while(0)
  #define RESC() do{ if(resc){ asm volatile("s_waitcnt lgkmcnt(0)":::"memory"); \
      _Pragma("unroll") for(int d_=0;d_<2;++d_) _Pragma("unroll") for(int r=0;r<16;++r)o[d_][r]*=wsf[crow(r,hi)]; } }while(0)
  f32x16 pA0,pA1,pB0,pB1;
  int sl_prev=0,sl_cur=0,sl_next=SLOTB;
  #define ROT() do{sl_prev=sl_cur;sl_cur=sl_next;sl_next=(sl_next==(NSLOT-1)*SLOTB)?0:sl_next+SLOTB;}while(0)
  DMA_K(2,2*SLOTB);
  WAIT_BAR(3);
  BIASLD(pA0,pA1,0);qkt(pA0,pA1,Kbase,qr,r32,hi);asm volatile("s_nop 15\n\ts_nop 7":"+v"(pA0),"+v"(pA1));CMASK(pA0,pA1,0);
  START(pA0,pA1);
  _Pragma("unroll") for(int r=0;r<16;++r)pA1[r]=__builtin_amdgcn_exp2f(pA1[r]);
  WAIT_BAR(0);
  DMA_K(3,0);DMA_V(1,SLOTB);
  ROT();
  kload8(kf,kp0+sl_cur);
  WAIT_BAR(2);
  s16x4 vlo[8],vhi[8]; u32x4 pw0,pw1,pw2,pw3;
  #define PKW(P,B) cvtpk_s(P[B],P[B+1])
  #define PAF(k) __builtin_bit_cast(bf16x8,pw##k)
  #define VFR(i) (bf16x8){vlo[i][0],vlo[i][1],vlo[i][2],vlo[i][3],vhi[i][0],vhi[i][1],vhi[i][2],vhi[i][3]}
  #define PIN(x) asm volatile("":"+v"(x))
  #define MX3(a,b,c) __builtin_fmaxf(__builtin_fmaxf((a),(b)),(c))
  #define GAPA(MF,A0,A1,A2,A3,W0,W1,PW) do{ MF; sacc+=A0; sacc+=A1; sacc+=A2; sacc+=A3; PIN(sacc); W0; W1; PIN(PW); SBAR(); }while(0)
  #define EX(v) __builtin_amdgcn_exp2f(v)
  #define GAPB(MF,X,B) do{ MF; X[B]=EX(X[B]-mhat); X[B+1]=EX(X[B+1]-mhat); X[B+2]=EX(X[B+2]-mhat); X[B+3]=EX(X[B+3]-mhat); PIN(X); SBAR(); }while(0)
  #define VRD(i) do{ vlo[i]=vtr(vp_+(((i)>>2)*4096+((i)&3)*1024)); vhi[i]=vtr(vp_+(((i)>>2)*4096+((i)&3)*1024+512)); }while(0)
  #define KRD(G,j) do{ if(G){ kload2(kf,kp0+sl_next,j); SBAR(); } }while(0)
  #define STEP(C0,C1,P0,P1,t,GK,GV,GL) do{ SBAR(); BIASLD(C0,C1,t); SBAR(); \
    const lds_cptr vp_=vp0+sl_prev; \
    VRD(0); SBAR(); float sacc=(P0[0]+P0[1]); \
    GAPA(C0=__builtin_amdgcn_mfma_f32_32x32x16_bf16(kf[0],qr[0],C0,0,0,0), P0[2],P0[3],P0[4],P0[5],     pw0[0]=PKW(P0,0), pw0[1]=PKW(P0,2), pw0); \
    VRD(4); SBAR(); GAPA(C1=__builtin_amdgcn_mfma_f32_32x32x16_bf16(kf[1],qr[0],C1,0,0,0), P0[6],P0[7],P0[8],P0[9],     pw0[2]=PKW(P0,4), pw0[3]=PKW(P0,6), pw0); \
    VRD(1); SBAR(); GAPA(C0=__builtin_amdgcn_mfma_f32_32x32x16_bf16(kf[2],qr[1],C0,0,0,0),   P0[10],P0[11],P0[12],P0[13], pw1[0]=PKW(P0,8), pw1[1]=PKW(P0,10), pw1); \
    VRD(5); SBAR(); GAPA(C1=__builtin_amdgcn_mfma_f32_32x32x16_bf16(kf[3],qr[1],C1,0,0,0),   P0[14],P0[15],P1[0],P1[1],   pw1[2]=PKW(P0,12),pw1[3]=PKW(P0,14), pw1); \
    VRD(2); SBAR(); GAPA(C0=__builtin_amdgcn_mfma_f32_32x32x16_bf16(kf[4],qr[2],C0,0,0,0),   P1[2],P1[3],P1[4],P1[5],     pw2[0]=PKW(P1,0), pw2[1]=PKW(P1,2), pw2); \
    VRD(6); SBAR(); GAPA(C1=__builtin_amdgcn_mfma_f32_32x32x16_bf16(kf[5],qr[2],C1,0,0,0),   P1[6],P1[7],P1[8],P1[9],     pw2[2]=PKW(P1,4), pw2[3]=PKW(P1,6), pw2); \
    VRD(3); SBAR(); GAPA(C0=__builtin_amdgcn_mfma_f32_32x32x16_bf16(kf[6],qr[3],C0,0,0,0),   P1[10],P1[11],P1[12],P1[13], pw3[0]=PKW(P1,8), pw3[1]=PKW(P1,10), pw3); \
    VRD(7); SBAR(); GAPA(C1=__builtin_amdgcn_mfma_f32_32x32x16_bf16(kf[7],qr[3],C1,0,0,0),   P1[14],P1[15],0.f,0.f,       pw3[2]=PKW(P1,12),pw3[3]=PKW(P1,14), pw3); \
    l_reg+=sacc; \
    if(GK){DMA_K((t)+3,sl_cur);} if(GV){DMA_V((t)+1,sl_next);} \
    CMASK(C0,C1,t); \
    { float a=MX3(C0[0],C0[1],C1[0]),b=MX3(C0[2],C0[3],C1[1]); a=MX3(a,C1[2],C1[3]); \
      _Pragma("unroll") for(int r=4;r<16;r+=4){a=MX3(a,C0[r],C0[r+1]);b=MX3(b,C0[r+2],C0[r+3]);a=MX3(a,C1[r],C1[r+1]);b=MX3(b,C1[r+2],C1[r+3]);} \
      float rm=__builtin_fmaxf(a,b); { auto rr=__builtin_amdgcn_permlane32_swap(__float_as_uint(rm),__float_as_uint(rm),false,false); rm=__builtin_fmaxf(__uint_as_float(rr[0]),__uint_as_float(rr[1])); } \
      resc=false; const float dm_=rm-mhat; \
      if(__builtin_expect(__any(dm_>(float)THRL),0)){ const float dl=__builtin_fmaxf(dm_,0.f); mhat+=dl; \
        const float f=__builtin_amdgcn_exp2f(-dl); l_reg*=f; if(hi==0)wsf[r32]=f; resc=true; } } \
    SBAR(); \
    GAPB(o[0]=__builtin_amdgcn_mfma_f32_32x32x16_bf16(PAF(0),VFR(0),o[0],0,0,0), C0,0); \
    GAPB(o[1]=__builtin_amdgcn_mfma_f32_32x32x16_bf16(PAF(0),VFR(4),o[1],0,0,0), C0,4); \
    KRD(GL,0); GAPB(o[0]=__builtin_amdgcn_mfma_f32_32x32x16_bf16(PAF(1),VFR(1),o[0],0,0,0), C0,8); \
    KRD(GL,1); GAPB(o[1]=__builtin_amdgcn_mfma_f32_32x32x16_bf16(PAF(1),VFR(5),o[1],0,0,0), C0,12); \
    KRD(GL,2); GAPB(o[0]=__builtin_amdgcn_mfma_f32_32x32x16_bf16(PAF(2),VFR(2),o[0],0,0,0), C1,0); \
    KRD(GL,3); GAPB(o[1]=__builtin_amdgcn_mfma_f32_32x32x16_bf16(PAF(2),VFR(6),o[1],0,0,0), C1,4); \
    GAPB(o[0]=__builtin_amdgcn_mfma_f32_32x32x16_bf16(PAF(3),VFR(3),o[0],0,0,0), C1,8); \
    GAPB(o[1]=__builtin_amdgcn_mfma_f32_32x32x16_bf16(PAF(3),VFR(7),o[1],0,0,0), C1,12); \
    }while(0)
  int t=1;
  #undef CMASK
  #define CMASK(P0,P1,t) do{}while(0)
  for(;t+5<NT;t+=2){
    STEP(pB0,pB1,pA0,pA1,t,true,true,true);     WAIT_BAR(2); RESC(); ROT();
    STEP(pA0,pA1,pB0,pB1,t+1,true,true,true);   WAIT_BAR(2); RESC(); ROT();
  }
  #undef CMASK
  #define CMASK(P0,P1,t) do{int jb_=(t)-(NT-4); if(jb_>=0)cmask(P0,P1,jb_,qrel,hi);}while(0)
  #define ENDW(tt) do{ if((tt)+3<NT){WAIT_BAR(2);} else if((tt)+2<NT){WAIT_BAR(1);} else {WAIT_BAR(0);} }while(0)
  for(;t+1<NT;t+=2){
    STEP(pB0,pB1,pA0,pA1,t,(t+3<NT),(t+1<NT),(t+1<NT));       ENDW(t);   RESC(); ROT();
    STEP(pA0,pA1,pB0,pB1,t+1,(t+4<NT),(t+2<NT),(t+2<NT));     ENDW(t+1); RESC(); ROT();
  }
  STEP(pB0,pB1,pA0,pA1,NT-1,false,false,false); RESC();
  { float sacc=pB0[0]+pB0[1]; _Pragma("unroll") for(int r=2;r<16;++r)sacc+=pB0[r]; _Pragma("unroll") for(int r=0;r<16;++r)sacc+=pB1[r]; l_reg+=sacc;
    pw0=(u32x4){PKW(pB0,0),PKW(pB0,2),PKW(pB0,4),PKW(pB0,6)};pw1=(u32x4){PKW(pB0,8),PKW(pB0,10),PKW(pB0,12),PKW(pB0,14)};pw2=(u32x4){PKW(pB1,0),PKW(pB1,2),PKW(pB1,4),PKW(pB1,6)};pw3=(u32x4){PKW(pB1,8),PKW(pB1,10),PKW(pB1,12),PKW(pB1,14)};
    SBAR(); pv(o,vb0+sl_cur,PAF(0),PAF(1),PAF(2),PAF(3)); }
  #undef PKW
  #undef PAF
  #undef VFR
  #undef PIN
  #undef MX3
  #undef GAPA
  #undef GAPB
  #undef EX
  #undef VRD
  #undef KRD
  #undef STEP
  #undef ENDW
  {auto rr=__builtin_amdgcn_permlane32_swap(__float_as_uint(l_reg),__float_as_uint(l_reg),false,false);l_reg=__uint_as_float(rr[0])+__uint_as_float(rr[1]);}
  if(hi==0)wsf[32+r32]=l_reg;asm volatile("s_waitcnt lgkmcnt(0)":::"memory");
  float rli[16];
  #pragma unroll
  for(int r=0;r<16;++r)rli[r]=__builtin_amdgcn_rcpf(wsf[32+crow(r,hi)]);
  bf16*Ow=O+(rowbase+q0+wid*QBLK)*DM+h*D;
  { bf16*stg=(bf16*)(shm+LDS_OST)+wid*2048;
    #pragma unroll
    for(int r=0;r<16;++r){const int orow=crow(r,hi);
      #pragma unroll
      for(int d0=0;d0<2;++d0)stg[orow*64+d0*32+r32]=__float2bfloat16(o[d0][r]*rli[r]);}
    asm volatile("s_waitcnt lgkmcnt(0)":::"memory");
    #pragma unroll
    for(int i=0;i<4;++i){const int row=i*8+(lane>>3),ch=lane&7; const u32x4 v=*(const u32x4*)(stg+row*64+ch*8); ATTN_STORE16(Ow+(long)row*DM+ch*8,v);} }
  asm volatile("s_waitcnt lgkmcnt(0)\n\ts_barrier":::"memory");
  #undef DMA_K
  #undef DMA_V
  #undef CMASK
  #undef BIASLD
  #undef START
  #undef RESC
  #undef ROT
}
constexpr int ATTN_LDS_BYTES=LDS_BYTES;
struct AttnTensors { const bf16* Q; const bf16* K; const bf16* V; bf16* O; };
struct AttnUnit { int bh; int qb; };
struct StaticOrder {
  int vcu;
  __device__ __forceinline__ explicit StaticOrder(int grid,int block):vcu((block%8)*(grid/8)+block/8){}
  __device__ __forceinline__ bool next(int i,AttnUnit&u)const{ if(i>=4)return false; const int s=vcu&3; u.bh=vcu>>2; u.qb=(i==0)?s:(i==1)?7-s:(i==2)?8+s:15-s; return true; }
};
template<class Sched,int THRL=8> __device__ __forceinline__ void attn_phase(char*lds,const AttnTensors&T,const Sched&S,const __attribute__((address_space(3))) float*bl,const int tid,const __attribute__((address_space(3))) int*tsk){
  AttnUnit u;
  for(int i=0;S.next(i,u);++i){ attn_unit<THRL>(u.bh/NHEAD,u.bh%NHEAD,u.qb,T.Q,T.K,T.V,T.O,lds,bl,tid,__builtin_amdgcn_readfirstlane(tsk[i])); }
}
#undef SBAR
#undef WAIT_BAR
}
namespace mk {
#define LAS __attribute__((address_space(3)))
#define XB_TMO      128
#define XB_XCNT(j)  (256  + 64 * (j))
#define XB_XSUB(j)  (1280 + 64 * (j))
#define XB_XGEN(j)  (2304 + 64 * (j))
#define XB_TOP      3328
#define XB_TOPGEN   3392
#define XCD_BAR_WORDS 3456
#define XB_SPIN_CAP (1u << 18)

__device__ __forceinline__ unsigned xb_ld(unsigned* p)              { return __hip_atomic_load(p, __ATOMIC_RELAXED, __HIP_MEMORY_SCOPE_AGENT); }
__device__ __forceinline__ unsigned xb_add(unsigned* p, unsigned v) { return __hip_atomic_fetch_add(p, v, __ATOMIC_RELAXED, __HIP_MEMORY_SCOPE_AGENT); }
__device__ __forceinline__ unsigned xb_xcc_id() { return (unsigned)__builtin_amdgcn_s_getreg((3 << 11) | 20) & 0xFu; }
#define XB_SPIN(cond, bar) do { unsigned _sp = 0; while (cond) { __builtin_amdgcn_s_sleep(1); \
    if ((++_sp & 255u) == 0u) { if (xb_ld(&(bar)[XB_TMO])) break; if (_sp > XB_SPIN_CAP) { atomicAdd(&(bar)[XB_TMO], 1u); break; } } } } while (0)

struct XcdBarrier {
    unsigned* bar; unsigned x;
    volatile LAS unsigned* st;
};

__device__ __forceinline__ XcdBarrier xcd_barrier_post(unsigned* bar, volatile LAS unsigned* st) {
    XcdBarrier b; b.bar = bar; b.x = xb_xcc_id(); b.st = st;
    if (threadIdx.x == 0) (void)xb_add(&bar[XB_XCNT(b.x)], 1u);
    return b;
}
__device__ __forceinline__ void xcd_barrier_complete(unsigned* bar, unsigned x, unsigned& nloc, unsigned& nx) {
    const unsigned G = gridDim.x * gridDim.y * gridDim.z;
    unsigned sum, cnt, mine, sp = 0u;
    for (;;) {
        sum = 0u; cnt = 0u; mine = 0u;
#pragma unroll
        for (unsigned j = 0; j < 16; ++j) { const unsigned c = xb_ld(&bar[XB_XCNT(j)]); sum += c; cnt += (c > 0u) ? 1u : 0u; mine = (j == x) ? c : mine; }
        if (sum == G) break;
        __builtin_amdgcn_s_sleep(1);
        if ((++sp & 255u) == 0u) { if (xb_ld(&bar[XB_TMO])) break; if (sp > XB_SPIN_CAP) { atomicAdd(&bar[XB_TMO], 1u); break; } }
    }
    nloc = mine > 0u ? mine : 1u; nx = cnt > 0u ? cnt : 1u;
}

__device__ __forceinline__ void xcd_barrier(const XcdBarrier& b) {
    asm volatile("s_waitcnt vmcnt(0)" ::: "memory");
    __syncthreads();
    if (threadIdx.x == 0) {
        unsigned* bar = b.bar;
        __builtin_amdgcn_s_waitcnt(0);
        unsigned nloc = b.st[0], nx = b.st[1];
        if (nloc == 0u) { xcd_barrier_complete(bar, b.x, nloc, nx); b.st[0] = nloc; b.st[1] = nx; }
        const unsigned old = xb_add(&bar[XB_XSUB(b.x)], 1u);
        const unsigned gen = old / nloc;
        if (old + 1u == (gen + 1u) * nloc) {
            __builtin_amdgcn_fence(__ATOMIC_RELEASE, "agent");
            asm volatile("s_waitcnt vmcnt(0)" ::: "memory");
            const unsigned og = xb_add(&bar[XB_TOP], 1u);
            const unsigned tg = og / nx;
            if (og + 1u == (tg + 1u) * nx) xb_add(&bar[XB_TOPGEN], 1u);
            else XB_SPIN(xb_ld(&bar[XB_TOPGEN]) == tg, bar);
            __builtin_amdgcn_fence(__ATOMIC_ACQUIRE, "agent");
            xb_add(&bar[XB_XGEN(b.x)], 1u);
            asm volatile("s_waitcnt vmcnt(0)" ::: "memory");
        } else {
            XB_SPIN(xb_ld(&bar[XB_XGEN(b.x)]) == gen, bar);
            __builtin_amdgcn_fence(__ATOMIC_ACQUIRE, "agent");
            asm volatile("s_waitcnt vmcnt(0)" ::: "memory");
        }
    }
    __syncthreads();
}

#undef LAS
}
namespace mk {
constexpr int NWAVES = 8;
constexpr int D = 1024, BATCH = 4, SEQ = 4096, M = BATCH * SEQ, DEPTH = 4, NH = 16, HD = 64, FOX_IN = 3 * D + NH, DFF = 2816;
constexpr int SG = 64, SP = 64, SC = 16;
constexpr float RMS_EPS = 1e-6f;
constexpr size_t MiB = 1u << 20;
constexpr size_t WS_CTL = 276 * MiB, CTL_ZERO_BYTES = 3 * MiB;
constexpr size_t WS_SSQ = 277 * MiB;
constexpr size_t WS_WQKV = 2 * MiB;
constexpr size_t WS_WO = 14 * MiB;
constexpr size_t WS_WS5IN = 18 * MiB;
constexpr size_t WS_WGLU = 20 * MiB;
constexpr size_t WS_BTA = 24 * MiB;
constexpr size_t WS_BTB = 32 * MiB;
constexpr size_t WS_WPOOL = 44 * MiB;
constexpr size_t WS_WF = 44 * MiB + 512 * 1024;
constexpr size_t WS_KERN = 45 * MiB;
constexpr size_t WS_LAMC = 46 * MiB;
constexpr size_t WS_LF = 47 * MiB;
constexpr size_t WS_WGU = 48 * MiB;
constexpr size_t WS_WDN = 92 * MiB;
constexpr size_t WS_XB = 114 * MiB;
constexpr size_t WS_ACT = 146 * MiB;
constexpr size_t WS_O = 244 * MiB;
constexpr size_t WS_NRM = 279 * MiB;
constexpr size_t WS_END = 283 * MiB;
constexpr int CW_TMO = 0, CW_BAR = 4096, CW_PANEL = 16384, CW_QUEUE = 24576;

constexpr int RING_OFF = 0, RING_BYTES = 131072;
constexpr int LDSCTL_OFF = RING_BYTES, MISC_OFF = LDSCTL_OFF + 320;
constexpr int LDS_BYTES = 147456;

#define GAS __attribute__((address_space(1)))
#define LAS __attribute__((address_space(3)))
typedef unsigned short bf16;
typedef unsigned v4u __attribute__((ext_vector_type(4)));
typedef float f32x4 __attribute__((ext_vector_type(4)));
typedef float f32x2 __attribute__((ext_vector_type(2)));
typedef short bf16x8 __attribute__((ext_vector_type(8)));
typedef GAS unsigned gu32;
#define RLX_AGENT __ATOMIC_RELAXED, __HIP_MEMORY_SCOPE_AGENT
#define LDS_WAIT() asm volatile("s_waitcnt lgkmcnt(0)" ::: "memory")
#define VM_WAIT() asm volatile("s_waitcnt vmcnt(0)" ::: "memory")
__device__ __forceinline__ unsigned f2bf(float f) { unsigned u = __builtin_bit_cast(unsigned, f); return (u + 0x7fffu + ((u >> 16) & 1u)) >> 16; }
__device__ __forceinline__ unsigned pk2(float lo, float hi) { return f2bf(lo) | (f2bf(hi) << 16); }
__device__ __forceinline__ float bf2f(unsigned short b) { return __builtin_bit_cast(float, (unsigned)b << 16); }
__device__ __forceinline__ float lshx(float v, int lane, int m) { return __builtin_bit_cast(float, __builtin_amdgcn_ds_bpermute((lane ^ m) << 2, __builtin_bit_cast(int, v))); }
__device__ __forceinline__ float wave_sum(float v, int lane) {
#pragma unroll
    for (int o = 1; o < 64; o <<= 1) v += lshx(v, lane, o);
    return v;
}

enum Op { OP_PROLOGUE = 0, OP_QKV, OP_ATTN, OP_WO, OP_UP, OP_DOWN, OP_S5IN, OP_SSM, OP_SSMB, OP_GLU, OP_POOLPREP, OP_POOLGEMM, OP_FINAL, OP_NORMX, OP_S5TAB };
struct PhaseEnt { int op, layer, j, sin, sout; };
#define MK_PROGRAM \
    {OP_PROLOGUE, 0, 0, 0, 0}, \
    {OP_QKV, 0, 0, 0, 0}, {OP_ATTN, 0, 0, 0, 0}, {OP_WO, 0, 0, 0, 1}, {OP_UP, 0, 0, 1, 0}, {OP_DOWN, 0, 0, 0, 2}, \
    {OP_S5IN, 1, 0, 2, 0}, {OP_SSM, 1, 0, 0, 0}, {OP_GLU, 1, 0, 0, 3}, {OP_UP, 1, 0, 3, 0}, {OP_DOWN, 1, 0, 0, 4}, \
    {OP_POOLGEMM, 2, 0, 4, 5}, {OP_UP, 2, 0, 5, 0}, {OP_DOWN, 2, 0, 0, 6}, \
    {OP_QKV, 3, 1, 6, 0}, {OP_ATTN, 3, 1, 0, 0}, {OP_WO, 3, 1, 0, 7}, {OP_UP, 3, 0, 7, 0}, {OP_DOWN, 3, 0, 0, 8}, \
    {OP_FINAL, 0, 0, 8, 0}, \
    {OP_NORMX, 0, 0, 0, 1}, {OP_NORMX, 0, 0, 0, 2}, {OP_NORMX, 0, 0, 0, 3}, {OP_NORMX, 0, 0, 0, 4}, {OP_NORMX, 0, 0, 0, 5}, {OP_NORMX, 0, 0, 0, 6}, {OP_NORMX, 0, 0, 0, 7}, {OP_NORMX, 0, 0, 0, 8}, \
    {OP_S5TAB, 0, 0, 0, 0}
constexpr int N_PROG = 29, PH_FINAL = 19, PH_LAST = 18, PH_NORMX1 = 20, PH_S5TAB = 28;
__constant__ PhaseEnt PROG[N_PROG] = { MK_PROGRAM };

struct Args { const float* in[22]; float* out; unsigned char* ws; int ph_lo, ph_hi; };

__device__ __forceinline__ void wt_load(f32x4 (&v)[8], const float* W, int ldw, int n0_src, int k0, int lane) {
    const int c4 = lane & 7, r8 = lane >> 3;
    const GAS f32x4* src = (const GAS f32x4*)(W + (size_t)(k0 + r8) * ldw + n0_src + 4 * c4);
#pragma unroll
    for (int i = 0; i < 8; ++i) v[i] = MK_WNT ? __builtin_nontemporal_load(src + (size_t)i * 2 * ldw) : src[(size_t)i * 2 * ldw];
}
__device__ __forceinline__ void wt_store(f32x4 (&v)[8], int K, const float* gain, bf16* WT, int n0_dst, int k0, LAS float* scr, int lane) {
    const int c4 = lane & 7, r8 = lane >> 3;
    if (gain) {
#pragma unroll
        for (int i = 0; i < 8; ++i) v[i] = v[i] * gain[k0 + r8 + 8 * i]; }
#pragma unroll
    for (int i = 0; i < 8; ++i) { LAS float* d = scr + (r8 + 8 * i) * 33 + 4 * c4; d[0] = v[i].x; d[1] = v[i].y; d[2] = v[i].z; d[3] = v[i].w; }
    LDS_WAIT(); asm volatile("" ::: "memory");
    const int c = lane & 7;
#pragma unroll
    for (int j = 0; j < 4; ++j) { const int n = (lane >> 3) + 8 * j; const LAS float* s = scr + (8 * c) * 33 + n;
        v4u o; o.x = pk2(s[0 * 33], s[1 * 33]); o.y = pk2(s[2 * 33], s[3 * 33]); o.z = pk2(s[4 * 33], s[5 * 33]); o.w = pk2(s[6 * 33], s[7 * 33]);
        pg8::st_wt((GAS bf16*)WT + (size_t)(n0_dst + n) * K + k0 + 8 * c, o); }
    LDS_WAIT(); asm volatile("" ::: "memory");
}
__device__ __forceinline__ void wt_item(const float* W, int ldw, int K, const float* gain, bf16* WT, int n0_dst, int n0_src, int k0, LAS float* scr, int lane) {
    f32x4 v[8]; wt_load(v, W, ldw, n0_src, k0, lane); wt_store(v, K, gain, WT, n0_dst, k0, scr, lane);
}
template <int NR> __device__ __forceinline__ void normx_rows(const float* x0, size_t xstride, bf16* o0, size_t ostride, pg8::ssq_t* ssq0, size_t sstride, int lane) {
    f32x4 v[NR][4]; float s[NR];
#pragma unroll
    for (int r = 0; r < NR; ++r) { const GAS f32x4* xr = (const GAS f32x4*)(x0 + r * xstride) + lane;
#pragma unroll
        for (int j = 0; j < 4; ++j) v[r][j] = xr[64 * j]; }
#pragma unroll
    for (int r = 0; r < NR; ++r) { s[r] = 0.f;
#pragma unroll
        for (int j = 0; j < 4; ++j) s[r] += (v[r][j].x * v[r][j].x + v[r][j].y * v[r][j].y) + (v[r][j].z * v[r][j].z + v[r][j].w * v[r][j].w);
        s[r] = wave_sum(s[r], lane); }
#pragma unroll
    for (int r = 0; r < NR; ++r) { GAS unsigned long long* o8 = (GAS unsigned long long*)(o0 + r * ostride) + lane;
#pragma unroll
        for (int j = 0; j < 4; ++j) pg8::st_wt(o8 + 64 * j, (unsigned long long)pk2(v[r][j].x, v[r][j].y) | ((unsigned long long)pk2(v[r][j].z, v[r][j].w) << 32));
        if (lane == 0) ssq0[r * sstride] = (pg8::ssq_t)__builtin_llrintf(s[r] * pg8::SSQ_SCALE); }
}
__device__ __forceinline__ void normx_row(const float* xrow, bf16* orow, pg8::ssq_t* ssq_slot, int lane) { normx_rows<1>(xrow, 0, orow, 0, ssq_slot, 0, lane); }
__device__ __forceinline__ f32x4 bf4(const pg8::u32x2 w) { return (f32x4){__builtin_bit_cast(float, w.x << 16), __builtin_bit_cast(float, w.x & 0xffff0000u), __builtin_bit_cast(float, w.y << 16), __builtin_bit_cast(float, w.y & 0xffff0000u)}; }
template <int W> __device__ __forceinline__ void pool_item(const bf16* X, const pg8::ssq_t* ssq, const f32x4 gg, bf16* PD, int row0, int t0, int c0) {
    f32x4 ring[W]; f32x4 run = {0.f, 0.f, 0.f, 0.f};
    { pg8::u32x2 xw[W]; pg8::ssq_t sw[W];
#pragma unroll
      for (int kk = 1; kk < W; ++kk) { xw[kk] = (pg8::u32x2){0u, 0u}; sw[kk] = 0;
          if (t0 - W + kk >= 0) { const int r = row0 - W + kk; xw[kk] = *(const GAS pg8::u32x2*)(X + (size_t)r * D + c0); sw[kk] = ((const GAS pg8::ssq_t*)ssq)[r]; } }
#pragma unroll
      for (int kk = 1; kk < W; ++kk) {
          const f32x4 hv = bf4(xw[kk]) * __builtin_amdgcn_rsqf((float)sw[kk] * (1.0f / (1024.0f * pg8::SSQ_SCALE)) + RMS_EPS) * gg;
          ring[kk % W] = hv; run += hv; } }
    pg8::u32x2 xc[16]; pg8::ssq_t sc[16];
#pragma unroll
    for (int i = 0; i < 16; ++i) { xc[i] = *(const GAS pg8::u32x2*)(X + (size_t)(row0 + i) * D + c0); sc[i] = ((const GAS pg8::ssq_t*)ssq)[row0 + i]; }
#pragma unroll
    for (int i = 0; i < 16; ++i) { const int r = row0 + i, t = t0 + i;
        const f32x4 hv = bf4(xc[i]) * __builtin_amdgcn_rsqf((float)sc[i] * (1.0f / (1024.0f * pg8::SSQ_SCALE)) + RMS_EPS) * gg;
        run += hv; ring[i % W] = hv;
        const int cnt = (t + 1 < W) ? (t + 1) : W; const f32x4 o = run * (1.0f / (float)cnt) - hv;
        pg8::st_wt((GAS bf16*)PD + (size_t)r * D + c0, (unsigned long long)pk2(o[0], o[1]) | ((unsigned long long)pk2(o[2], o[3]) << 32));
        run -= ring[(i + 1) % W]; }
}
__device__ __forceinline__ void touch_lines(const void* p, int bytes, int tid) {
    const GAS unsigned* q = (const GAS unsigned*)p + tid * 32; unsigned acc = 0;
    for (int o = 0; o < bytes; o += 512 * 128 * 8) {
#pragma unroll
        for (int i = 0; i < 8; ++i) acc |= q[(size_t)(o / 4) + (size_t)i * 512 * 32];
    }
    asm volatile("" :: "v"(acc));
}
struct WtDesc { const float* W; const float* gain; bf16* WT; int ldw, K, Ndst, kind, off2; };
__device__ __forceinline__ WtDesc wt_desc(const Args& args, int i) {
    unsigned char* ws = args.ws; const float* mix_g = args.in[1]; const float* ffn_g = args.in[2];
    WtDesc d;
    if (i < 2) { d.W = args.in[4] + (size_t)i * D * FOX_IN; d.gain = mix_g + (i ? 3 * D : 0); d.WT = (bf16*)(ws + WS_WQKV) + (size_t)i * 3 * D * D; d.ldw = FOX_IN; d.K = D; d.Ndst = 3 * D; d.kind = 0; d.off2 = 0; }
    else if (i < 4) { d.W = args.in[6] + (size_t)(i - 2) * D * D; d.gain = nullptr; d.WT = (bf16*)(ws + WS_WO) + (size_t)(i - 2) * D * D; d.ldw = D; d.K = D; d.Ndst = D; d.kind = 0; d.off2 = 0; }
    else if (i == 4) { d.W = args.in[7]; d.gain = mix_g + D; d.WT = (bf16*)(ws + WS_WS5IN); d.ldw = D; d.K = D; d.Ndst = D; d.kind = 0; d.off2 = 0; }
    else if (i == 5) { d.W = args.in[16]; d.gain = nullptr; d.WT = (bf16*)(ws + WS_WGLU); d.ldw = 2 * D; d.K = D; d.Ndst = 2 * D; d.kind = 1; d.off2 = D; }
    else if (i < 10) { d.W = args.in[17] + (size_t)(i - 6) * 65536; d.gain = nullptr; d.WT = (bf16*)(ws + WS_WPOOL) + (size_t)(i - 6) * 65536; d.ldw = 256; d.K = 256; d.Ndst = 256; d.kind = 0; d.off2 = 0; }
    else if (i < 14) { d.W = args.in[20] + (size_t)(i - 10) * D * 2 * DFF; d.gain = ffn_g + (i - 10) * D; d.WT = (bf16*)(ws + WS_WGU) + (size_t)(i - 10) * 2 * DFF * D; d.ldw = 2 * DFF; d.K = D; d.Ndst = 2 * DFF; d.kind = 1; d.off2 = DFF; }
    else { d.W = args.in[21] + (size_t)(i - 14) * DFF * D; d.gain = nullptr; d.WT = (bf16*)(ws + WS_WDN) + (size_t)(i - 14) * D * DFF; d.ldw = D; d.K = DFF; d.Ndst = D; d.kind = 0; d.off2 = 0; }
    return d;
}
__device__ __forceinline__ void ph_s5tables(const Args& args, LAS float* scr, LAS float* wsc, int gw, int NGW, int lane) {
    unsigned char* ws = args.ws;
    { const float* a_re = args.in[8]; const float* a_im = args.in[9]; const float* log_dt = args.in[10];
      const float* b_re = args.in[11]; const float* b_im = args.in[12]; const float* c_re = args.in[13]; const float* c_im = args.in[14];
      float* KERN = (float*)(ws + WS_KERN);
      for (int it = (gw + NGW / 2) % NGW; it < SG * 16; it += NGW) {
          const int g = it >> 4, tau = it & 15, p = lane;
          { const GAS f32x4* s0 = (const GAS f32x4*)(c_re + (size_t)g * 1024), *s1 = (const GAS f32x4*)(c_im + (size_t)g * 1024), *s2 = (const GAS f32x4*)(b_re + (size_t)g * 1024), *s3 = (const GAS f32x4*)(b_im + (size_t)g * 1024);
            f32x4 t0[4], t1[4], t2[4], t3[4];
#pragma unroll
            for (int j = 0; j < 4; ++j) { t0[j] = s0[lane + 64 * j]; t1[j] = s1[lane + 64 * j]; t2[j] = s2[lane + 64 * j]; t3[j] = s3[lane + 64 * j]; }
#pragma unroll
            for (int j = 0; j < 4; ++j) { ((LAS f32x4*)scr)[lane + 64 * j] = t0[j]; ((LAS f32x4*)scr)[256 + lane + 64 * j] = t1[j]; ((LAS f32x4*)scr)[512 + lane + 64 * j] = t2[j]; ((LAS f32x4*)scr)[768 + lane + 64 * j] = t3[j]; } }
          const double lr = a_re[g * SP + p], li = a_im[g * SP + p], dt = exp((double)log_dt[g]);
          const double er = exp(lr * dt), lbr = er * cos(li * dt), lbi = er * sin(li * dt);
          const double nr = lbr - 1.0, ni = lbi, den = lr * lr + li * li, fr = (nr * lr + ni * li) / den, fi = (ni * lr - nr * li) / den;
          const double et = exp(lr * dt * tau), ptr_ = et * cos(li * dt * tau), pti = et * sin(li * dt * tau);
          wsc[p] = (float)(ptr_ * fr - pti * fi); wsc[64 + p] = (float)(ptr_ * fi + pti * fr);
          LDS_WAIT(); asm volatile("" ::: "memory");
          const LAS float* Cr = scr, *Ci = scr + 1024, *Br = scr + 2048, *Bi = scr + 3072, *Wr_ = wsc, *Wi_ = wsc + 64;
          float acc[4] = {0.f, 0.f, 0.f, 0.f}; const int ci = lane & 15, cob = lane >> 4;
#pragma unroll 8
          for (int pp = 0; pp < SP; ++pp) {
              const float wr = Wr_[pp], wi = Wi_[pp], br = Br[pp * 16 + ci], bi = Bi[pp * 16 + ci];
#pragma unroll
              for (int q = 0; q < 4; ++q) { const int co = cob + 4 * q; const float cr = Cr[co * 64 + pp], cim = Ci[co * 64 + pp];
                  const float cwr = cr * wr - cim * wi, cwi = cr * wi + cim * wr; acc[q] += cwr * br - cwi * bi; } }
#pragma unroll
          for (int q = 0; q < 4; ++q) KERN[(size_t)it * 256 + lane + 64 * q] = acc[q];
          LDS_WAIT(); asm volatile("" ::: "memory");
      }
      bf16* BTA = (bf16*)(ws + WS_BTA);
      for (int e = gw * 64 + lane; e < SG * 128 * 16; e += NGW * 64) {
          const int g = e >> 11, n = (e >> 4) & 127, j = e & 15, p = n & 63, im = n >> 6;
          const double lr = a_re[g * SP + p], li = a_im[g * SP + p], dt = exp((double)log_dt[g]);
          const double er = exp(lr * dt), lbr = er * cos(li * dt), lbi = er * sin(li * dt);
          const double nr = lbr - 1.0, ni = lbi, den = lr * lr + li * li, fr = (nr * lr + ni * li) / den, fi = (ni * lr - nr * li) / den;
          const double tt = (double)(15 - j), et = exp(lr * dt * tt), ptr_ = et * cos(li * dt * tt), pti = et * sin(li * dt * tt);
          const float Wr = (float)(ptr_ * fr - pti * fi), Wi = (float)(ptr_ * fi + pti * fr);
          unsigned w[8];
#pragma unroll
          for (int c = 0; c < 16; c += 2) { float v[2];
#pragma unroll
              for (int q = 0; q < 2; ++q) { const float br = b_re[(g * SP + p) * SC + c + q], bi = b_im[(g * SP + p) * SC + c + q]; v[q] = im ? (Wr * bi + Wi * br) : (Wr * br - Wi * bi); }
              w[c >> 1] = pk2(v[0], v[1]); }
          v4u* dst = (v4u*)(BTA + ((size_t)g * 256 + n) * 256 + j * 16);
          dst[0] = (v4u){w[0], w[1], w[2], w[3]}; dst[1] = (v4u){w[4], w[5], w[6], w[7]};
      }
      for (int e = gw * 64 + lane; e < SG * 128 * 32; e += NGW * 64) { const int g = e >> 12, r = e & 4095; ((v4u*)(BTA + ((size_t)g * 256 + 128) * 256))[r] = (v4u){0u, 0u, 0u, 0u}; }
      bf16* BTB = (bf16*)(ws + WS_BTB);
      for (int e = gw * 64 + lane; e < SG * 16 * SP; e += NGW * 64) {
          const int g = e >> 10, i = (e >> 6) & 15, p = e & 63;
          const double lr = a_re[g * SP + p], li = a_im[g * SP + p], dt = exp((double)log_dt[g]);
          const double tt = (double)(i + 1), et = exp(lr * dt * tt); const float pr = (float)(et * cos(li * dt * tt)), pi_ = (float)(et * sin(li * dt * tt));
          float crv[16], civ[16];
#pragma unroll
          for (int co = 0; co < 16; ++co) { crv[co] = c_re[(g * SC + co) * SP + p]; civ[co] = c_im[(g * SC + co) * SP + p]; }
#pragma unroll
          for (int co = 0; co < 16; ++co) { const float cr = crv[co], cim = civ[co];
              bf16* row = BTB + ((size_t)g * 256 + i * 16 + co) * 384 + 256;
              row[p] = (bf16)f2bf(cr * pr - cim * pi_); row[64 + p] = (bf16)f2bf(-(cr * pi_ + cim * pr)); }
      }
      float* LAMC = (float*)(ws + WS_LAMC);
      for (int e = gw * 64 + lane; e < SG * SP; e += NGW * 64) {
          const double lr = a_re[e], li = a_im[e], dt = exp((double)log_dt[e >> 6]), et = exp(lr * dt * 16.0);
          LAMC[2 * e] = (float)(et * cos(li * dt * 16.0)); LAMC[2 * e + 1] = (float)(et * sin(li * dt * 16.0)); }
    }
}
__device__ __forceinline__ bool wt_one(const Args& args, LAS float* scr, unsigned mask, int it, int lane) {
    constexpr int NMAT = 18; int base = 0;
    for (int mi = 0; mi < NMAT; ++mi) { if (!((mask >> mi) & 1u)) continue;
        const WtDesc d = wt_desc(args, mi); const int n_it = (d.K / 64) * (d.Ndst / 32);
        if (it < base + n_it) { const int r = it - base, nblk = d.Ndst / 32, kb = r / nblk, nb = r % nblk, n0 = nb * 32; int ns = n0;
            if (d.kind == 1) { const int pn = n0 >> 8, j = n0 & 255; ns = (j < 128) ? (128 * pn + j) : (d.off2 + 128 * pn + (j - 128)); }
            wt_item(d.W, d.ldw, d.K, d.gain, d.WT, n0, ns, kb * 64, scr, lane); return true; }
        base += n_it; }
    return false;
}
struct WtWork { const float* gain; bf16* WT; int K, n0, k0; bool ok; };
__device__ __forceinline__ WtWork wt_fetch(const Args& args, unsigned mask, int it, f32x4 (&v)[8], int lane) {
    constexpr int NMAT = 18; int base = 0; WtWork w{}; w.ok = false;
    for (int mi = 0; mi < NMAT; ++mi) { if (!((mask >> mi) & 1u)) continue;
        const WtDesc d = wt_desc(args, mi); const int n_it = (d.K / 64) * (d.Ndst / 32);
        if (it < base + n_it) { const int r = it - base, nblk = d.Ndst / 32, kb = r / nblk, nb = r % nblk, n0 = nb * 32; int ns = n0;
            if (d.kind == 1) { const int pn = n0 >> 8, j = n0 & 255; ns = (j < 128) ? (128 * pn + j) : (d.off2 + 128 * pn + (j - 128)); }
            wt_load(v, d.W, d.ldw, ns, kb * 64, lane); w.gain = d.gain; w.WT = d.WT; w.K = d.K; w.n0 = n0; w.k0 = kb * 64; w.ok = true; return w; }
        base += n_it; }
    return w;
}
__device__ __forceinline__ void ph_weights(const Args& args, LAS float* scr, unsigned mask, int rk, int nw, int lane) {
    f32x4 va[8], vb[8];
    WtWork wa = wt_fetch(args, mask, rk, va, lane);
    for (int it = rk; wa.ok; it += 2 * nw) {
        WtWork wb = wt_fetch(args, mask, it + nw, vb, lane);
        wt_store(va, wa.K, wa.gain, wa.WT, wa.n0, wa.k0, scr, lane);
        if (!wb.ok) break;
        wa = wt_fetch(args, mask, it + 2 * nw, va, lane);
        wt_store(vb, wb.K, wb.gain, wb.WT, wb.n0, wb.k0, scr, lane);
    }
}
__device__ __forceinline__ void ph_wf(const Args& args, int j, int rk, int nw, int lane) {
    for (int e = rk * 64 + lane; e < NH * D; e += nw * 64) { const int h = e >> 10, kk = e & 1023;
        ((bf16*)(args.ws + WS_WF))[j * NH * D + e] = (bf16)f2bf(args.in[4][(size_t)j * D * FOX_IN + (size_t)kk * FOX_IN + 3 * D + h] * args.in[1][(j ? 3 * D : 0) + kk]); }
}
constexpr unsigned WMASK_PRO = (1u << 0);
constexpr unsigned WMASK_ATT = (1u << 2) | (1u << 10) | (1u << 4) | (1u << 5);
constexpr int WATT_ITEMS = 16 * 32 + 16 * 176 + 16 * 32 + 16 * 64;
constexpr unsigned WMASK_L0 = (1u << 14) | (1u << 11);
constexpr unsigned WMASK_L1 = (1u << 15) | (1u << 6) | (1u << 7) | (1u << 8) | (1u << 9) | (1u << 12);
constexpr unsigned WMASK_L2 = (1u << 16) | (1u << 1) | (1u << 3) | (1u << 13);
constexpr unsigned WMASK_L3 = (1u << 17);
__device__ __forceinline__ void ph_prologue(const Args& args, LAS unsigned char* lds, int gw, int NGW, int wave, int lane) {
    unsigned char* ws = args.ws;
    LAS float* scr = (LAS float*)(lds + RING_OFF + wave * 16384);
    ph_weights(args, scr, MK_DEFER_WEIGHTS ? WMASK_PRO : 0x3ffffu, gw, NGW, lane);
    ph_wf(args, 0, gw, NGW, lane); if (!MK_DEFER_WEIGHTS) ph_wf(args, 1, gw, NGW, lane);
    for (int rep_ = 0; rep_ < MK_S5TAB_REPS; ++rep_) ph_s5tables(args, scr, (LAS float*)(lds + LDSCTL_OFF + 8192 + wave * 512), gw, NGW, lane);
    pg8::ssq_t* ssq0 = (pg8::ssq_t*)(ws + WS_SSQ);
    for (int m = gw; m < M; m += NGW) normx_row(args.in[0] + (size_t)m * D, (bf16*)(ws + WS_XB) + (size_t)m * D, ssq0 + m, lane);
}

__device__ __forceinline__ void ph_toeplitz(unsigned char* ws, int rk, int nw, int lane) {
    const float* KERN = (const float*)(ws + WS_KERN); bf16* BTB = (bf16*)(ws + WS_BTB);
    for (int e2 = rk * 64 + lane; e2 < SG * 256 * 16; e2 += nw * 64) { const int g = e2 >> 12, n = (e2 >> 4) & 255, j = e2 & 15, i = n >> 4, co = n & 15;
        v4u o0 = {0u, 0u, 0u, 0u}, o1 = {0u, 0u, 0u, 0u};
        if (i >= j) { const f32x4* kp = (const f32x4*)(KERN + (((size_t)g * 16 + (i - j)) * 16 + co) * 16); const f32x4 a = kp[0], b = kp[1], c = kp[2], d = kp[3];
            o0 = (v4u){pk2(a[0], a[1]), pk2(a[2], a[3]), pk2(b[0], b[1]), pk2(b[2], b[3])}; o1 = (v4u){pk2(c[0], c[1]), pk2(c[2], c[3]), pk2(d[0], d[1]), pk2(d[2], d[3])}; }
        v4u* dst = (v4u*)(BTB + ((size_t)g * 256 + n) * 384 + j * 16); dst[0] = o0; dst[1] = o1; }
}
__global__ void __launch_bounds__(NWAVES * 64, 2) mega_k(Args args) {
    extern __shared__ __attribute__((aligned(16))) unsigned char lds_raw[];
    LAS unsigned char* lds = (LAS unsigned char*)lds_raw;
    const int vcu0 = (gridDim.x % 8 == 0) ? (blockIdx.x % 8) * (gridDim.x / 8) + blockIdx.x / 8 : blockIdx.x;
    const int vcu = vcu0, NGW = gridDim.x * NWAVES, wave0 = __builtin_amdgcn_readfirstlane(threadIdx.x >> 6);
    for (int u = threadIdx.x; u < (LDS_BYTES - LDSCTL_OFF) / 4; u += NWAVES * 64) ((LAS unsigned*)(lds + LDSCTL_OFF))[u] = 0u;
    __syncthreads();
    MK_BAR_SETUP();
    int e0 = args.ph_lo;
    if (e0 == PH_S5TAB) { const int tid = threadIdx.x, lane = tid & 63, wave = __builtin_amdgcn_readfirstlane(tid >> 6); ph_s5tables(args, (LAS float*)(lds + RING_OFF + wave * 16384), (LAS float*)(lds + LDSCTL_OFF + 8192 + wave * 512), vcu * NWAVES + wave, NGW, lane); return; }
    if (e0 == 0) {
        const int tid = threadIdx.x, lane = tid & 63, wave = __builtin_amdgcn_readfirstlane(tid >> 6);
        ph_prologue(args, lds, vcu * NWAVES + wave, NGW, wave, lane);
        e0 = 1;
        if (e0 < args.ph_hi) { MK_GRID_BAR(); }
    }
    for (int e = e0; e < args.ph_hi; ++e) {
#define MK_LANE_TID() int lane_; asm volatile("v_mbcnt_lo_u32_b32 %0, -1, 0\n\tv_mbcnt_hi_u32_b32 %0, -1, %0" : "=v"(lane_)); const int lane = lane_, tid = wave * 64 + lane, gw = vcu * NWAVES + wave; (void)tid; (void)gw; (void)lane
        const int wave = wave0;
        int G = gridDim.x, bx = blockIdx.x, vcu = vcu0; asm volatile("" : "+s"(G), "+s"(bx), "+s"(vcu));
        const int NGW = G * NWAVES;
        unsigned char* ws = args.ws; float* X = args.out; asm volatile("" : "+s"(ws), "+s"(X));
        pg8::ssq_t* SSQ = (pg8::ssq_t*)(ws + WS_SSQ);
        const int op = PROG[e].op, layer = PROG[e].layer, pj = PROG[e].j, sin = PROG[e].sin, sout = PROG[e].sout;
#define MK_XBS(s_) ((s_) == 5 ? (bf16*)(ws + WS_O) : (bf16*)(ws + WS_XB))
#define MK_XBO(s_) (MK_JUNK ? (bf16*)X + (size_t)M * D : MK_XBS(s_))
#define MK_SSQO(s_) (SSQ + (size_t)(MK_JUNK ? 12 : (s_)) * M)
        bf16* XB = MK_XBS(sin);
        (void)pj;
        if (op == OP_NORMX) {
            MK_LANE_TID();
            for (int m = gw; m < M; m += NGW) normx_row(X + (size_t)m * D, XB + (size_t)m * D, SSQ + (size_t)sout * M + m, lane);
        } else if (op == OP_UP) {
            MK_LANE_TID();
            pg8::Gemm g{XB, (const bf16*)(ws + WS_WGU) + (size_t)layer * 2 * DFF * D, D, D, D, 0, 0};
            pg8::StaticOrder S; S.init(M / 256, 2 * DFF / 256, G, bx);
            pg8::EpiSwiGLU E{(bf16*)(ws + WS_ACT), DFF, SSQ + (size_t)sin * M, MK_UP_DUMMY};
            pg8::gemm_phase<pg8::EpiSwiGLU, pg8::StaticOrder, MK_ALIGN_UP>(lds + RING_OFF, tid, g, S, E);
            if (MK_DEFER_WEIGHTS && bx >= 128 && !(MK_UP_DUMMY)) {
                LAS float* scr = (LAS float*)(lds + RING_OFF + wave * 16384); const int rk = (bx - 128) * NWAVES + wave;
                ph_weights(args, scr, layer == 0 ? WMASK_L0 : layer == 1 ? WMASK_L1 : layer == 2 ? WMASK_L2 : WMASK_L3, rk, 128 * NWAVES, lane);
                if (layer == 2) ph_wf(args, 1, rk, 128 * NWAVES, lane); }
        } else if (op == OP_DOWN) {
            MK_LANE_TID();
            pg8::Gemm g{(const bf16*)(ws + WS_ACT), (const bf16*)(ws + WS_WDN) + (size_t)layer * D * DFF, DFF, DFF, DFF, 0, 0};
            pg8::StaticOrder S; S.init(M / 256, D / 256, G, bx);
            if (layer == 3 && !(MK_JUNK)) {
                pg8::EpiResidFinal E{MK_XBS(sout - 1), X, SSQ + (size_t)sout * M, args.in[3], (unsigned*)(ws + WS_CTL) + CW_PANEL};
                pg8::gemm_phase<pg8::EpiResidFinal, pg8::StaticOrder, false>(lds + RING_OFF, tid, g, S, E);
            } else {
                pg8::EpiResid<0> E{MK_XBS(sout - 1), MK_XBO(sout), MK_SSQO(sout), args.in[18], nullptr, MK_UP_DUMMY};
                pg8::gemm_phase<pg8::EpiResid<0>, pg8::StaticOrder, true>(lds + RING_OFF, tid, g, S, E); }
        }
        else if (op == OP_QKV) {
            MK_LANE_TID();
            if (MK_TOUCH) touch_lines(XB + (size_t)(8 * (bx & 7) + ((bx >> 3) & 7)) * 256 * D, 256 * D * 2, tid);
            if (!(MK_QKV_NOGATES)) {
              const bf16* WfT = (const bf16*)(ws + WS_WF) + (size_t)pj * NH * D; const pg8::ssq_t* ssq = SSQ + (size_t)sin * M; const float* bfp = args.in[5] + pj * NH; float* LF = (float*)(ws + WS_LF);
#pragma unroll
              for (int i = 0; i < 4; ++i) { const int c = tid + 512 * i; *(LAS v4u*)(lds + (c >> 7) * 2064 + (c & 127) * 16) = ((const GAS v4u*)WfT)[c]; }
              LDS_WAIT(); __syncthreads();
              if (wave < 4) {
                const int r0 = (vcu * 4 + wave) * 16, kq = lane >> 4; const GAS bf16x8* ap = (const GAS bf16x8*)(XB + (size_t)(r0 + (lane & 15)) * D + kq * 8); const LAS unsigned char* bp = lds + (lane & 15) * 2064 + kq * 16;
                bf16x8 afr[32];
#pragma unroll
                for (int ks = 0; ks < 32; ++ks) afr[ks] = ap[ks * 4];
                f32x4 acc = {0.f, 0.f, 0.f, 0.f};
#pragma unroll
                for (int ks = 0; ks < 32; ++ks) acc = __builtin_amdgcn_mfma_f32_16x16x32_bf16(afr[ks], *(const LAS bf16x8*)(bp + ks * 64), acc, 0, 0, 0);
                const int rr = r0 + 4 * kq, hh = lane & 15; const float bb = bfp[hh]; f32x4 o;
#pragma unroll
                for (int i = 0; i < 4; ++i) { const float z = acc[i] * pg8::rstd_row(ssq, rr + i) + bb; o[i] = fminf(z, 0.f) - log1pf(expf(-fabsf(z))); }
                pg8::st_wt((GAS float*)LF + ((size_t)(rr / SEQ) * NH + hh) * SEQ + (rr % SEQ), o); }
              LDS_WAIT(); __syncthreads(); }
            pg8::Gemm g{XB, (const bf16*)(ws + WS_WQKV) + (size_t)pj * 3 * D * D, D, D, D, 0, 0};
            pg8::StaticOrder S; S.init(M / 256, 3 * D / 256, G, bx);
            pg8::EpiQKV E{(bf16*)(ws + WS_ACT), (size_t)16 * MiB, SSQ + (size_t)sin * M, attn_body::C2, (float*)(ws + WS_NRM), MK_UP_DUMMY};
            pg8::gemm_phase<pg8::EpiQKV, pg8::StaticOrder, true>(lds + RING_OFF, tid, g, S, E);
        } else if (op == OP_ATTN) {
            MK_LANE_TID();
            LAS float* bl = (LAS float*)(lds + RING_OFF + attn_body::ATTN_LDS_BYTES);
            { const float* lf = (const float*)(ws + WS_LF) + (size_t)(vcu >> 2) * SEQ + tid * 8; LAS float* wt = (LAS float*)(lds + LDSCTL_OFF + 1024);
              const f32x4 a = *(const f32x4*)lf, b = *(const f32x4*)(lf + 4);
              float p[8]; p[0] = a[0]; p[1] = p[0] + a[1]; p[2] = p[1] + a[2]; p[3] = p[2] + a[3]; p[4] = p[3] + b[0]; p[5] = p[4] + b[1]; p[6] = p[5] + b[2]; p[7] = p[6] + b[3];
              float tot = p[7];
#pragma unroll
              for (int o = 1; o < 64; o <<= 1) { const float u = __builtin_bit_cast(float, __builtin_amdgcn_ds_bpermute((lane - o) << 2, __builtin_bit_cast(int, tot))); if (lane >= o) tot += u; }
              if (lane == 63) wt[wave] = tot;
              LDS_WAIT(); __syncthreads();
              float off = tot - p[7];
              for (int w = 0; w < wave; ++w) off += wt[w];
#pragma unroll
              for (int i = 0; i < 8; ++i) bl[tid * 8 + i] = -(p[i] + off) * 1.4426950408889634f;
              LDS_WAIT(); __syncthreads(); }
            LAS int* tsk = (LAS int*)(lds + LDSCTL_OFF + 12288);
            for (int prep_ = 0; prep_ < MK_PREPASS_REPS; ++prep_) { LAS float* kn = (LAS float*)(lds + LDSCTL_OFF + 12288 + 64); LAS float* qn = kn + 64;
              const int bh = vcu >> 2, sq = vcu & 3; const size_t rb = (size_t)(bh >> 4) * SEQ; const int hc = (bh & 15) * HD + (lane & 7) * 8;
              (void)hc;
              const int hd = bh & 15; const GAS f32x2* Nk = (const GAS f32x2*)(ws + WS_NRM) + ((size_t)(4 + (hd >> 2)) * M + rb) * 4 + (hd & 3); const GAS f32x2* Nq = (const GAS f32x2*)(ws + WS_NRM) + ((size_t)(hd >> 2) * M + rb) * 4 + (hd & 3);
              { f32x2 v[8];
#pragma unroll
                for (int i = 0; i < 8; ++i) v[i] = Nk[(size_t)(tid * 8 + i) * 4];
                float mx = 0.f;
#pragma unroll
                for (int i = 0; i < 8; ++i) mx = fmaxf(mx, v[i].x + v[i].y);
                mx = fmaxf(mx, lshx(mx, lane, 1)); mx = fmaxf(mx, lshx(mx, lane, 2)); mx = fmaxf(mx, lshx(mx, lane, 4));
                if ((lane & 7) == 0) kn[tid >> 3] = mx; }
              { f32x2 v[2]; const int i = wave >> 1, qb = (i == 0) ? sq : (i == 1) ? 7 - sq : (i == 2) ? 8 + sq : 15 - sq;
#pragma unroll
                for (int jj = 0; jj < 2; ++jj) v[jj] = Nq[(size_t)(qb * 256 + (wave & 1) * 128 + lane * 2 + jj) * 4];
                float mx = fmaxf(v[0].x + v[0].y, v[1].x + v[1].y);
#pragma unroll
                for (int o = 1; o < 64; o <<= 1) mx = fmaxf(mx, lshx(mx, lane, o));
                if (lane == 0) qn[i * 8 + (wave & 1)] = mx; if (lane == 1) { qn[i * 8 + 2 + (wave & 1) * 3] = 0.f; qn[i * 8 + 3 + (wave & 1) * 3] = 0.f; qn[i * 8 + 4 + (wave & 1) * 3] = 0.f; } }
              LDS_WAIT(); __syncthreads();
              if (wave < 4) { const int i = wave, qb = (i == 0) ? sq : (i == 1) ? 7 - sq : (i == 2) ? 8 + sq : 15 - sq, nt = 4 * qb + 4;
                  float q2 = (lane < 8) ? qn[i * 8 + lane] : 0.f, k2 = (lane < nt) ? kn[lane] : 0.f;
#pragma unroll
                  for (int o = 1; o < 64; o <<= 1) { q2 = fmaxf(q2, lshx(q2, lane, o)); k2 = fmaxf(k2, lshx(k2, lane, o)); }
                  const float lim = MK_SKIP_QK * sqrtf(q2) * sqrtf(k2) * 1.01f + 30.0f, bq = bl[qb * 256];
                  const int ts = 2 * lane;
                  const bool okc = (ts + 2 <= nt - 4) && (bq - bl[64 * (ts + 1) + 63] >= lim);
                  const int cntc = __builtin_popcountll(__ballot(okc));
                  if (lane == 0) tsk[i] = 2 * cntc; }
              LDS_WAIT(); __syncthreads(); }
            const attn_body::AttnTensors AT{(const attn_body::bf16*)(ws + WS_ACT), (const attn_body::bf16*)(ws + WS_ACT + 32 * MiB), (const attn_body::bf16*)(ws + WS_ACT + 64 * MiB), (attn_body::bf16*)(ws + WS_O)};
            const attn_body::StaticOrder S(G, bx);
            attn_body::attn_phase<attn_body::StaticOrder, MK_THRL>((char*)lds_raw + RING_OFF, AT, S, bl, tid, tsk);
            if (MK_DEFER_WEIGHTS && layer == 0) {
                LAS float* scr = (LAS float*)(lds + RING_OFF + wave * 16384); unsigned* q = (unsigned*)(ws + WS_CTL) + CW_QUEUE;
                for (;;) { unsigned b0 = 0; if (lane == 0) b0 = __hip_atomic_fetch_add(q, 4u, __ATOMIC_RELAXED, __HIP_MEMORY_SCOPE_AGENT); b0 = (unsigned)__builtin_amdgcn_readfirstlane((int)b0);
                    if (b0 >= (unsigned)WATT_ITEMS) break;
                    for (int i = 0; i < 4; ++i) if (!wt_one(args, scr, WMASK_ATT, (int)b0 + i, lane)) break; } }
        } else if (op == OP_WO) {
            MK_LANE_TID();
            pg8::Gemm g{(const bf16*)(ws + WS_O), (const bf16*)(ws + WS_WO) + (size_t)pj * D * D, D, D, D, 0, 0};
            pg8::StaticOrder S; S.init(M / 256, D / 256, G, bx);
            pg8::EpiResid<0> E{MK_XBS(sout - 1), MK_XBO(sout), MK_SSQO(sout), args.in[18], nullptr, MK_UP_DUMMY};
            pg8::gemm_phase<pg8::EpiResid<0>, pg8::StaticOrder, true>(lds + RING_OFF, tid, g, S, E);
        }
        else if (op == OP_S5IN) {
            MK_LANE_TID();
            ph_toeplitz(ws, gw, NGW, lane);
            pg8::Gemm g{XB, (const bf16*)(ws + WS_WS5IN), D, D, D, 0, 0};
            pg8::StaticOrder S; S.init(M / 256, D / 256, G, bx);
            pg8::EpiU E{(bf16*)(ws + WS_ACT), SSQ + (size_t)sin * M};
            pg8::gemm_phase<pg8::EpiU, pg8::StaticOrder, true>(lds + RING_OFF, tid, g, S, E);
        } else if (op == OP_SSM) {
            MK_LANE_TID();
            pg8::StaticOrder S; S.init(BATCH, SG, G, bx);
            { pg8::Gemm g{(const bf16*)(ws + WS_ACT), (const bf16*)(ws + WS_BTA), 256, 384, 256, 0, 1024 * 384 * 2};
              pg8::EpiSloc E{(const float*)(ws + WS_LAMC), (bf16*)(ws + WS_ACT), lds + LDSCTL_OFF + 2048};
              pg8::gemm_phase<pg8::EpiSloc, pg8::StaticOrder, false>(lds + RING_OFF, tid, g, S, E); }
            { pg8::Gemm g{(const bf16*)(ws + WS_ACT), (const bf16*)(ws + WS_BTB), 384, 384, 384, 0, 1024 * 384 * 2};
              pg8::EpiY E{(const bf16*)(ws + WS_ACT), args.in[15], (bf16*)(ws + WS_ACT + 48 * MiB)};
              pg8::gemm_phase<pg8::EpiY, pg8::StaticOrder, true>(lds + RING_OFF, tid, g, S, E); }
        } else if (op == OP_GLU) {
            MK_LANE_TID();
            pg8::Gemm g{(const bf16*)(ws + WS_ACT + 48 * MiB), (const bf16*)(ws + WS_WGLU), D, MK_G1_NATURAL ? D : 16, D, MK_G1_NATURAL ? 0 : M * 16, 0};
            pg8::StaticOrder S; S.init(M / 256, 2 * D / 256, G, bx);
            pg8::EpiResid<1> E{MK_XBS(sout - 1), MK_XBO(sout), MK_SSQO(sout), args.in[18], nullptr, MK_UP_DUMMY};
            pg8::gemm_phase<pg8::EpiResid<1>, pg8::StaticOrder, true>(lds + RING_OFF, tid, g, S, E);
        }
        else if (op == OP_POOLPREP) {
        } else if (op == OP_POOLGEMM) {
            MK_LANE_TID();
            pg8::StaticOrder S; S.init(M / 256, 4, G, bx);
            { pg8::Unit u0; if (S.next(0, u0)) { const pg8::ssq_t* ssq = SSQ + (size_t)sin * M; const float* gain = args.in[1] + (size_t)layer * D; bf16* PD = (bf16*)(ws + WS_ACT);
                const int gi = u0.pn, c0 = gi * 256 + lane * 4; const f32x4 gg = *(const f32x4*)(gain + c0);
                for (int ci = wave; ci < 16; ci += NWAVES) { const int row0 = u0.pm * 256 + ci * 16, t0 = row0 & (SEQ - 1);
                    if (gi == 0) pool_item<2>(XB, ssq, gg, PD, row0, t0, c0); else if (gi == 1) pool_item<4>(XB, ssq, gg, PD, row0, t0, c0);
                    else if (gi == 2) pool_item<8>(XB, ssq, gg, PD, row0, t0, c0); else pool_item<16>(XB, ssq, gg, PD, row0, t0, c0); } }
              asm volatile("s_waitcnt vmcnt(0)" ::: "memory"); __syncthreads();
              if (wave == 0) { __builtin_amdgcn_fence(__ATOMIC_ACQUIRE, "agent"); asm volatile("s_waitcnt vmcnt(0)" ::: "memory"); }
              __syncthreads(); }
            pg8::Gemm g{(const bf16*)(ws + WS_ACT), (const bf16*)(ws + WS_WPOOL), 256, D, 256, 0, 512};
            pg8::EpiResid<2> E{MK_XBS(sout - 1), MK_XBS(sout), SSQ + (size_t)sout * M, args.in[18], args.in[19], 0};
            pg8::gemm_phase<pg8::EpiResid<2>, pg8::StaticOrder, true>(lds + RING_OFF, tid, g, S, E);
        } else if (op == OP_FINAL) {
            MK_LANE_TID();
            { const pg8::ssq_t* ssq = SSQ + (size_t)sin * M; const float* gain = args.in[3];
              for (int m = gw; m < M; m += NGW) { const float rs = pg8::rstd_row(ssq, m); f32x4* xr = (f32x4*)(X + (size_t)m * D) + lane; const f32x4* gr = (const f32x4*)gain + lane;
#pragma unroll
                  for (int j = 0; j < 4; ++j) xr[64 * j] = xr[64 * j] * rs * gr[64 * j]; } }
        }
        if (e + 1 < args.ph_hi) { MK_GRID_BAR(); }
    }
}
}
extern "C" void kernel_launch(void* const* d_in, const int* in_sizes, int n_in, void* d_out, int out_size, void* d_ws, size_t ws_size, hipStream_t stream) {
    static int grid = 0;
    if (grid == 0) {
        int dev = 0, cus = 0, per_cu = 0;
        if (hipGetDevice(&dev) != hipSuccess || hipDeviceGetAttribute(&cus, hipDeviceAttributeMultiprocessorCount, dev) != hipSuccess) { grid = -1; return; }
        if (hipFuncSetAttribute((const void*)mk::mega_k, hipFuncAttributeMaxDynamicSharedMemorySize, mk::LDS_BYTES) != hipSuccess) { grid = -1; return; }
        if (hipOccupancyMaxActiveBlocksPerMultiprocessor(&per_cu, (const void*)mk::mega_k, mk::NWAVES * 64, mk::LDS_BYTES) != hipSuccess || per_cu < 1) { fprintf(stderr, "kernel_launch: occupancy query says %d blocks per CU\n", per_cu); grid = -1; (void)hipGetLastError(); return; }
        (void)hipGetLastError();
        grid = cus;
        if (n_in != 22 || ws_size < mk::WS_END || cus != 256 || in_sizes[0] != mk::M * mk::D || out_size != mk::M * mk::D) { fprintf(stderr, "kernel_launch: unexpected n_in %d / ws_size %zu / CUs %d\n", n_in, ws_size, cus); grid = -1; }
    }
    if (grid < 0) return;
    (void)hipMemsetAsync((char*)d_ws + mk::WS_CTL, 0, mk::CTL_ZERO_BYTES, stream);
    mk::Args a{};
    for (int i = 0; i < 22; ++i) a.in[i] = (const float*)d_in[i];
    a.out = (float*)d_out; a.ws = (unsigned char*)d_ws;
#if MK_ONE_LAUNCH
    a.ph_lo = 0; a.ph_hi = mk::PH_LAST + 1;
    void* kargs[] = {&a};
    const hipError_t e = hipLaunchCooperativeKernel((const void*)mk::mega_k, dim3(grid), dim3(mk::NWAVES * 64), kargs, mk::LDS_BYTES, stream);
    if (e != hipSuccess) fprintf(stderr, "kernel_launch: cooperative launch failed: %s\n", hipGetErrorString(e));
#else
    for (int ph = 0; ph <= mk::PH_LAST; ++ph) { a.ph_lo = ph; a.ph_hi = ph + 1; hipLaunchKernelGGL(mk::mega_k, dim3(grid), dim3(mk::NWAVES * 64), mk::LDS_BYTES, stream, a);
    }
#endif
}
```

```cpp
#include <hip/hip_runtime.h>
#include <hip/hip_cooperative_groups.h>
#include <cstdio>
#include <cstdint>
#include <cmath>
#define MK_BAR_SETUP() cooperative_groups::grid_group mk_grid = cooperative_groups::this_grid(); bool mk_first = true; \
    XcdBarrier mk_bar = xcd_barrier_post((unsigned*)(args.ws + WS_CTL) + CW_BAR, (volatile LAS unsigned*)(lds + MISC_OFF) + 8)
#ifndef MK_CG_FIRST
#define MK_CG_FIRST 0
#endif
#define MK_GRID_BAR() do { if (MK_CG_FIRST ? mk_first : (args.ph_lo < 0)) { mk_grid.sync(); mk_first = false; } else xcd_barrier(mk_bar); } while (0)
#define MK_ONE_LAUNCH 1
#define MK_NO_NAIVE 1
#define MK_THRL 24
#define MK_UP_DUMMY 0
#define MK_JUNK false
#define MK_QKV_NOGATES 0
#define MK_DEFER_WEIGHTS 1
#define MK_SKIP_QK 2.0f
#ifndef MK_PREPASS_REPS
#define MK_PREPASS_REPS 1
#endif
#ifndef MK_TOUCH
#define MK_TOUCH 0
#endif
#ifndef MK_WGM
#define MK_WGM 8
#endif
#ifndef MK_ALIGN_UP
#define MK_ALIGN_UP true
#endif
#ifndef MK_S5TAB_REPS
#define MK_S5TAB_REPS 1
#endif
#ifndef MK_G1_NATURAL
#define MK_G1_NATURAL 0
#endif
#ifndef MK_WNT
#define MK_WNT 0
#endif
#ifndef MK_ATT_DYN
#define MK_ATT_DYN 0
#endif
namespace pg8 {
#define PG8_LAS __attribute__((address_space(3)))
typedef unsigned short bf16_t;
typedef short bf16x8 __attribute__((ext_vector_type(8)));
typedef float f32x4 __attribute__((ext_vector_type(4)));
typedef float f32x2 __attribute__((ext_vector_type(2)));
typedef unsigned u32x4 __attribute__((ext_vector_type(4)));
typedef unsigned u32x2 __attribute__((ext_vector_type(2)));
constexpr int PF_JUNK_OFF = 131072 + 6144;
#ifndef MK_RESID_ALL16
#define MK_RESID_ALL16 0
#endif
#ifndef MK_SWIGLU_V2
#define MK_SWIGLU_V2 1
#endif
#ifndef MK_PF_BASE
#define MK_PF_BASE false
#endif
constexpr int BM = 256, BK = 64, HALF = 128, HTB = HALF * BK * 2  , STAGE_BYTES = 8 * HTB, NXCD = 8, WGM = MK_WGM;

__host__ __device__ __forceinline__ int lds_byte(int r, int c) { const int st = (r >> 4) * 2 + (c >> 5), rr = r & 15, cc = c & 31, ob = rr * 64 + cc * 2; return st * 1024 + (ob ^ (((ob >> 9) & 1) << 5)); }
__host__ __device__ __forceinline__ void stage_rc(int b, int& R, int& C) { const int st = b / 1024, sb = b % 1024, swz = sb ^ (((sb >> 9) & 1) << 5); R = (st >> 1) * 16 + swz / 64; C = (st & 1) * 32 + (swz % 64) / 2; }
__host__ __device__ __forceinline__ int perm32(int rho) { const int n = rho >> 4, i = rho & 15; return 8 * (i >> 2) + 4 * n + (i & 3); }

struct Unit { int pm, pn; };
struct Gemm { const bf16_t* A; const bf16_t* Bt; int K; int lda, ldb; int gatherA; int a_pn_off; };

struct StaticOrder {
    int nM, nN, nwg, G, c;
    __host__ __device__ __forceinline__ void init(int nM_, int nN_, int G_, int c_) { nM = nM_; nN = nN_; nwg = nM * nN; G = G_; c = c_; }
    __host__ __device__ __forceinline__ bool next(int i, Unit& u) const {
        const long L = (long)i * G + c; if (L >= nwg) return false;
        int wgid = (int)L; { const int q = nwg / NXCD, r = nwg % NXCD, xcd = wgid % NXCD, off = wgid / NXCD; wgid = (xcd < r ? xcd * (q + 1) : r * (q + 1) + (xcd - r) * q) + off; }
        const int nig = WGM * nN, gid = wgid / nig, fm = gid * WGM, gsz = (nM - fm) < WGM ? (nM - fm) : WGM;
        u.pm = fm + ((wgid % nig) % gsz); u.pn = (wgid % nig) / gsz; return true;
    }
};

__device__ __forceinline__ unsigned cvt_pk_bf16(float lo, float hi) { unsigned r; asm volatile("v_cvt_pk_bf16_f32 %0, %1, %2" : "=v"(r) : "v"(lo), "v"(hi)); return r; }

template <class Epi, class Sched, bool ALIGN_EPI>
__device__ __forceinline__ void gemm_phase(PG8_LAS unsigned char* lds, const int tid, const Gemm g, const Sched& S, const Epi& E) {
    const int wid = __builtin_amdgcn_readfirstlane(tid >> 6), lane = tid & 63, wr = wid >> 2, wc = wid & 3, fr = lane & 15, fq = lane >> 4;
    const int K = g.K, nt = K / BK;
    unsigned voffA[2], voffB[2];
#pragma unroll
    for (int i = 0; i < 2; ++i) { int R, C; stage_rc(tid * 16 + i * 8192, R, C); const int Rb = Epi::PERM ? ((R & ~31) + perm32(R & 31)) : R;
        voffA[i] = g.gatherA ? (unsigned)(R * g.lda + (C >> 4) * g.gatherA + (C & 15)) * 2u : (unsigned)(R * g.lda + C) * 2u; voffB[i] = (unsigned)(Rb * g.ldb + C) * 2u; }
    const size_t kstepA = g.gatherA ? (size_t)g.gatherA * 8 : (size_t)(BK * 2), kstepB = (size_t)(BK * 2);
    const size_t hstepA = (size_t)HALF * g.lda * 2, hstepB = (size_t)HALF * g.ldb * 2;
    const size_t tstepA = 2 * hstepA, tstepB = 2 * hstepB;
    const unsigned ldsw = (unsigned)wid * 1024u;
    const int aoff = lds_byte(wr * 64 + fr, fq * 8), boff = lds_byte(wc * 32 + fr, fq * 8);
#define PG8_SA(b, h) (((b) * 2 + (h)) * HTB)
#define PG8_SB(b, h) ((4 + (b) * 2 + (h)) * HTB)
#define PG8_STAGE(bufoff, gbase, voff) do { _Pragma("unroll") for (int _i = 0; _i < 2; ++_i) \
        __builtin_amdgcn_global_load_lds((const unsigned*)((const char*)(gbase) + (voff)[_i]), (PG8_LAS unsigned*)(lds + (bufoff) + ldsw + _i * 8192), 16, 0, 0); } while (0)
#define PG8_LDA(dst, b, h) do { _Pragma("unroll") for (int m = 0; m < 4; ++m) _Pragma("unroll") for (int k = 0; k < 2; ++k) dst[m][k] = *(const PG8_LAS bf16x8*)(lds + PG8_SA(b, h) + aoff + m * 2048 + k * 1024); } while (0)
#define PG8_LDB(dst, b, h) do { _Pragma("unroll") for (int n = 0; n < 2; ++n) _Pragma("unroll") for (int k = 0; k < 2; ++k) dst[n][k] = *(const PG8_LAS bf16x8*)(lds + PG8_SB(b, h) + boff + n * 2048 + k * 1024); } while (0)
#define PG8_MMA(ai, bj, At, Bt) do { __builtin_amdgcn_s_setprio(1); _Pragma("unroll") for (int m = 0; m < 4; ++m) _Pragma("unroll") for (int n = 0; n < 2; ++n) _Pragma("unroll") for (int k = 0; k < 2; ++k) \
        acc[ai][bj][m][n] = __builtin_amdgcn_mfma_f32_16x16x32_bf16(Bt[n][k], At[m][k], acc[ai][bj][m][n], 0, 0, 0); __builtin_amdgcn_s_setprio(0); } while (0)
#define PG8_WAIT_V(n) asm volatile("s_waitcnt vmcnt(" #n ")" ::: "memory")
#define PG8_WAIT_L(n) asm volatile("s_waitcnt lgkmcnt(" #n ")" ::: "memory")
#define PG8_BAR __builtin_amdgcn_s_barrier()
#define PG8_SCHED __builtin_amdgcn_sched_barrier(0)
    Unit cur, nxt; int ui = 0;
    if (!S.next(0, cur)) return;
    f32x4 acc[2][2][4][2];
#pragma unroll
    for (int a = 0; a < 2; ++a)
#pragma unroll
        for (int b = 0; b < 2; ++b)
#pragma unroll
            for (int m = 0; m < 4; ++m)
#pragma unroll
                for (int n = 0; n < 2; ++n) acc[a][b][m][n] = (f32x4){0.f, 0.f, 0.f, 0.f};
    bf16x8 At[4][2], B0[2][2], B1[2][2];
    const char* cA = (const char*)g.A + (size_t)cur.pm * tstepA + (size_t)cur.pn * g.a_pn_off; const char* cB = (const char*)g.Bt + (size_t)cur.pn * tstepB;
    PG8_STAGE(PG8_SB(0, 0), cB, voffB); PG8_STAGE(PG8_SB(0, 1), cB + hstepB, voffB); PG8_STAGE(PG8_SA(0, 0), cA, voffA); PG8_STAGE(PG8_SA(0, 1), cA + hstepA, voffA);
    if (wr == 1) PG8_BAR;
    PG8_WAIT_V(2); PG8_BAR;
    PG8_STAGE(PG8_SB(1, 0), cB + kstepB, voffB); PG8_STAGE(PG8_SA(1, 0), cA + kstepA, voffA); PG8_STAGE(PG8_SB(1, 1), cB + hstepB + kstepB, voffB);
    PG8_WAIT_V(6); PG8_BAR;
    for (;;) {
        const bool has_next = S.next(ui + 1, nxt);
        const char* nA = has_next ? (const char*)g.A + (size_t)nxt.pm * tstepA + (size_t)nxt.pn * g.a_pn_off : cA; const char* nB = has_next ? (const char*)g.Bt + (size_t)nxt.pn * tstepB : cB;
        for (int t = 0; t < nt; t += 2) {
            const bool last = (t == nt - 2);
            const char* a1 = cA + (size_t)(t + 1) * kstepA;
            const char* a2 = last ? nA : cA + (size_t)(t + 2) * kstepA; const char* b2 = last ? nB : cB + (size_t)(t + 2) * kstepB;
            const char* a3 = a2 + kstepA; const char* b3 = b2 + kstepB;
            if constexpr (Epi::PREFETCH) { if (last) { int pl_; asm volatile("v_mbcnt_lo_u32_b32 %0, -1, 0\n\tv_mbcnt_hi_u32_b32 %0, -1, %0" : "=v"(pl_)); E.prefetch(cur, wid * 64 + pl_, lds + PF_JUNK_OFF + ldsw / 4); } }
            PG8_LDB(B0, 0, 0); PG8_LDB(B1, 0, 1); PG8_SCHED; PG8_LDA(At, 0, 0); PG8_STAGE(PG8_SA(1, 1), a1 + hstepA, voffA);
            PG8_WAIT_V(8); PG8_WAIT_L(0); PG8_BAR; PG8_MMA(0, 0, At, B0); PG8_MMA(0, 1, At, B1); PG8_BAR; PG8_SCHED;
            PG8_LDA(At, 0, 1); PG8_STAGE(PG8_SB(0, 0), b2, voffB); PG8_STAGE(PG8_SB(0, 1), b2 + hstepB, voffB); PG8_STAGE(PG8_SA(0, 0), a2, voffA);
            PG8_WAIT_V(8); PG8_WAIT_L(0); PG8_BAR; PG8_MMA(1, 0, At, B0); PG8_MMA(1, 1, At, B1); PG8_BAR; PG8_SCHED;
            PG8_LDB(B0, 1, 0); PG8_LDB(B1, 1, 1); PG8_SCHED; PG8_LDA(At, 1, 0); PG8_STAGE(PG8_SA(0, 1), a2 + hstepA, voffA);
            PG8_WAIT_V(8); PG8_WAIT_L(0); PG8_BAR; PG8_MMA(0, 0, At, B0); PG8_MMA(0, 1, At, B1); PG8_BAR; PG8_SCHED;
            PG8_LDA(At, 1, 1); PG8_STAGE(PG8_SB(1, 0), b3, voffB); PG8_STAGE(PG8_SB(1, 1), b3 + hstepB, voffB); PG8_STAGE(PG8_SA(1, 0), a3, voffA);
            PG8_WAIT_V(8); PG8_WAIT_L(0); PG8_BAR; PG8_MMA(1, 0, At, B0); PG8_MMA(1, 1, At, B1); PG8_BAR; PG8_SCHED;
        }
        if constexpr (ALIGN_EPI) { if (wr == 0) PG8_BAR; }
        if constexpr (!Epi::AFTER_DRAIN) { int ln_; asm volatile("v_mbcnt_lo_u32_b32 %0, -1, 0\n\tv_mbcnt_hi_u32_b32 %0, -1, %0" : "=v"(ln_)); E(acc, cur, wr, wc, ln_ & 15, ln_ >> 4); }
        if (!has_next) break;
#pragma unroll
        for (int a = 0; a < 2; ++a)
#pragma unroll
            for (int b = 0; b < 2; ++b)
#pragma unroll
                for (int m = 0; m < 4; ++m)
#pragma unroll
                    for (int n = 0; n < 2; ++n) acc[a][b][m][n] = (f32x4){0.f, 0.f, 0.f, 0.f};
        cur = nxt; cA = nA; cB = nB; ++ui;
        if constexpr (ALIGN_EPI) { if (wr == 1) PG8_BAR; }
    }
    PG8_WAIT_V(0);
    if constexpr (!ALIGN_EPI) { if (wr == 0) PG8_BAR; }
    PG8_BAR;
    if constexpr (Epi::AFTER_DRAIN) { int ln_; asm volatile("v_mbcnt_lo_u32_b32 %0, -1, 0\n\tv_mbcnt_hi_u32_b32 %0, -1, %0" : "=v"(ln_)); E.fused(acc, cur, wr, wc, ln_ & 15, ln_ >> 4, lds, wid, ln_); }
#undef PG8_SA
#undef PG8_SB
#undef PG8_STAGE
#undef PG8_LDA
#undef PG8_LDB
#undef PG8_MMA
#undef PG8_WAIT_V
#undef PG8_WAIT_L
#undef PG8_BAR
#undef PG8_SCHED
}

__device__ __forceinline__ float shx(float v, int lane, int m) { return __builtin_bit_cast(float, __builtin_amdgcn_ds_bpermute((lane ^ m) << 2, __builtin_bit_cast(int, v))); }
constexpr float RMS_EPS = 1e-6f;
typedef unsigned long long ssq_t;
constexpr float SSQ_SCALE = 1048576.0f;
__device__ __forceinline__ float rstd_row(const ssq_t* ssq, int row) { return __builtin_amdgcn_rsqf((float)ssq[row] * (1.0f / (1024.0f * SSQ_SCALE)) + RMS_EPS); }
#define PG8_GAS __attribute__((address_space(1)))
#ifndef MK_WT_STORES
#define MK_WT_STORES 0
#endif
template <int OFF = 0, typename V> __device__ __forceinline__ void st_wt(PG8_GAS void* p, const V v) {
    static_assert(OFF >= 0 && OFF < 4096, "immediate offset range");
#if MK_WT_STORES
    if constexpr (sizeof(V) == 16) asm volatile("global_store_dwordx4 %0, %1, off offset:%2 sc1\n\ts_nop 1" :: "v"(p), "v"(v), "n"(OFF) : "memory");
    else if constexpr (sizeof(V) == 8) asm volatile("global_store_dwordx2 %0, %1, off offset:%2 sc1\n\ts_nop 1" :: "v"(p), "v"(v), "n"(OFF) : "memory");
    else { static_assert(sizeof(V) == 4, "store width"); asm volatile("global_store_dword %0, %1, off offset:%2 sc1\n\ts_nop 1" :: "v"(p), "v"(v), "n"(OFF) : "memory"); }
#else
    *(PG8_GAS V*)((PG8_GAS unsigned char*)p + OFF) = v;
#endif
}
#ifndef MK_WT_RESID
#define MK_WT_RESID 0
#endif
__device__ __forceinline__ void st_resid(PG8_GAS unsigned char* base, unsigned off, const u32x4 v) {
#if MK_WT_RESID
    asm volatile("global_store_dwordx4 %0, %1, %2 sc1\n\ts_nop 1" :: "v"(off), "v"(v), "s"(base) : "memory");
#else
    *(PG8_GAS u32x4*)(base + off) = v;
#endif
}
#ifndef MK_NT_STORES
#define MK_NT_STORES 0
#endif
template <typename V> __device__ __forceinline__ void st_big(PG8_GAS void* p, const V v) {
#if MK_NT_STORES
    __builtin_nontemporal_store(v, (PG8_GAS V*)p);
#else
    st_wt(p, v);
#endif
}
#if MK_WT_STORES
#define ATTN_STORE16(p,v) pg8::st_wt((PG8_GAS void*)(p), (v))
#endif
__device__ __forceinline__ void rstd8(const ssq_t* ssq, int row0, float (&rs)[2][4]) {
    ssq_t sv[2][4];
#pragma unroll
    for (int ai = 0; ai < 2; ++ai)
#pragma unroll
        for (int m = 0; m < 4; ++m) sv[ai][m] = ((const PG8_GAS ssq_t*)ssq)[row0 + ai * HALF + m * 16];
#pragma unroll
    for (int ai = 0; ai < 2; ++ai)
#pragma unroll
        for (int m = 0; m < 4; ++m) rs[ai][m] = __builtin_amdgcn_rsqf((float)sv[ai][m] * (1.0f / (1024.0f * SSQ_SCALE)) + RMS_EPS);
}
__device__ __forceinline__ float fast_sigmoid(float x) { return __builtin_amdgcn_rcpf(1.0f + __builtin_amdgcn_exp2f(-1.4426950408889634f * x)); }

struct EpiQKV {
    static constexpr bool PERM = true, AFTER_DRAIN = false, PREFETCH = false;
    bf16_t* O; size_t split_stride; const ssq_t* ssq; float scale0; float* nrm; int dummy;
    __device__ __forceinline__ void operator()(const f32x4 (&acc)[2][2][4][2], const Unit& u, int wr, int wc, int fr, int fq) const {
        const int row0 = u.pm * BM + wr * 64 + fr, t = u.pn >> 2; bf16_t* base = O + (size_t)t * split_stride; const float sc = (t == 0) ? scale0 : 1.f;
        const int col0 = (u.pn & 3) * BM + wc * 32 + 8 * fq, ln = fq * 16 + fr;
        float rsv[2][4]; rstd8(ssq, row0, rsv);
#pragma unroll
        for (int ai = 0; ai < 2; ++ai)
#pragma unroll
            for (int m = 0; m < 4; ++m) { const int row = row0 + ai * HALF + m * 16; const float rs = rsv[ai][m] * sc; PG8_GAS bf16_t* rowp = (PG8_GAS bf16_t*)base + (size_t)row * 1024 + col0;
#pragma unroll
                for (int bj = 0; bj < 2; ++bj) { const f32x4 v0 = acc[ai][bj][m][0] * rs, v1 = acc[ai][bj][m][1] * rs;
                    u32x4 w; w.x = cvt_pk_bf16(v0[0], v0[1]); w.y = cvt_pk_bf16(v0[2], v0[3]); w.z = cvt_pk_bf16(v1[0], v1[1]); w.w = cvt_pk_bf16(v1[2], v1[3]);
                    st_big(rowp + bj * HALF, w);
                    if (t < 2) { float s = ((v0[0] * v0[0] + v0[1] * v0[1]) + (v0[2] * v0[2] + v0[3] * v0[3])) + ((v1[0] * v1[0] + v1[1] * v1[1]) + (v1[2] * v1[2] + v1[3] * v1[3]));
                        s += shx(s, ln, 16); s += shx(s, ln, 32);
                        if (fq == 0) ((PG8_GAS float*)nrm)[(((size_t)(t * 4 + (u.pn & 3)) * 16384 + row) * 4 + 2 * bj + (wc >> 1)) * 2 + (wc & 1)] = s; } } }
    }
};
struct EpiSwiGLU {
    static constexpr bool PERM = true, AFTER_DRAIN = false, PREFETCH = false;
    bf16_t* Hh; int ldh; const ssq_t* ssq; int dummy;
    __device__ __forceinline__ void operator()(const f32x4 (&acc)[2][2][4][2], const Unit& u, int wr, int wc, int fr, int fq) const {
        const int row0 = u.pm * BM + wr * 64 + fr, col0 = u.pn * HALF + wc * 32 + 8 * fq;
        if (dummy == 1) { if (fr == 0 && fq == 0) *(PG8_GAS float*)((PG8_GAS bf16_t*)Hh + (size_t)row0 * ldh + col0) = acc[0][0][0][0][0] + acc[1][1][3][1][3]; return; }
#if MK_SWIGLU_V2
        ssq_t sv[2][4];
#pragma unroll
        for (int ai = 0; ai < 2; ++ai)
#pragma unroll
            for (int m = 0; m < 4; ++m) sv[ai][m] = ((const PG8_GAS ssq_t*)ssq)[row0 + ai * HALF + m * 16];
#pragma unroll
        for (int ai = 0; ai < 2; ++ai)
#pragma unroll
            for (int m = 0; m < 4; ++m) { const int row = row0 + ai * HALF + m * 16;
                const float ms = (float)sv[ai][m] * (1.0f / (1024.0f * SSQ_SCALE)) + RMS_EPS, rsn = __builtin_amdgcn_rsqf(ms) * (-1.4426950408889634f);
                float h[8];
#pragma unroll
                for (int n = 0; n < 2; ++n)
#pragma unroll
                    for (int j = 0; j < 4; j += 2) {
                        const f32x2 g2 = {acc[ai][0][m][n][j], acc[ai][0][m][n][j + 1]}, u2 = {acc[ai][1][m][n][j], acc[ai][1][m][n][j + 1]};
                        const f32x2 ar = g2 * rsn, t = g2 * u2;
                        f32x2 e; e.x = __builtin_amdgcn_exp2f(ar.x); e.y = __builtin_amdgcn_exp2f(ar.y);
                        const f32x2 msv = {ms, ms}; const f32x2 dn = __builtin_elementwise_fma(e, msv, msv); f32x2 r; r.x = __builtin_amdgcn_rcpf(dn.x); r.y = __builtin_amdgcn_rcpf(dn.y);
                        const f32x2 hv = t * r; h[n * 4 + j] = hv.x; h[n * 4 + j + 1] = hv.y; }
#else
        float rsv[2][4]; rstd8(ssq, row0, rsv);
#pragma unroll
        for (int ai = 0; ai < 2; ++ai)
#pragma unroll
            for (int m = 0; m < 4; ++m) { const int row = row0 + ai * HALF + m * 16; const float rs = rsv[ai][m];
                float h[8];
#pragma unroll
                for (int n = 0; n < 2; ++n)
#pragma unroll
                    for (int j = 0; j < 4; j += 2) {
                        const f32x2 g2 = {acc[ai][0][m][n][j], acc[ai][0][m][n][j + 1]}, u2 = {acc[ai][1][m][n][j], acc[ai][1][m][n][j + 1]};
                        const f32x2 gs = g2 * rs, us = u2 * rs, ar = gs * (-1.4426950408889634f);
                        f32x2 e; e.x = __builtin_amdgcn_exp2f(ar.x); e.y = __builtin_amdgcn_exp2f(ar.y);
                        const f32x2 dn = e + 1.0f; f32x2 r; r.x = __builtin_amdgcn_rcpf(dn.x); r.y = __builtin_amdgcn_rcpf(dn.y);
                        const f32x2 hv = (gs * r) * us; h[n * 4 + j] = hv.x; h[n * 4 + j + 1] = hv.y; }
#endif
                u32x4 w; w.x = cvt_pk_bf16(h[0], h[1]); w.y = cvt_pk_bf16(h[2], h[3]); w.z = cvt_pk_bf16(h[4], h[5]); w.w = cvt_pk_bf16(h[6], h[7]);
                st_big((PG8_GAS bf16_t*)Hh + (size_t)row * ldh + col0, w); }
    }
};
__device__ __forceinline__ void bf8_to_f32(const u32x4 w, f32x4& lo, f32x4& hi) {
    lo = (f32x4){__builtin_bit_cast(float, w.x << 16), __builtin_bit_cast(float, w.x & 0xffff0000u), __builtin_bit_cast(float, w.y << 16), __builtin_bit_cast(float, w.y & 0xffff0000u)};
    hi = (f32x4){__builtin_bit_cast(float, w.z << 16), __builtin_bit_cast(float, w.z & 0xffff0000u), __builtin_bit_cast(float, w.w << 16), __builtin_bit_cast(float, w.w & 0xffff0000u)};
}
template <int MODE> struct EpiResid {
    static constexpr bool PERM = true, AFTER_DRAIN = false, PREFETCH = MK_PF_BASE && MODE == 0;
    const bf16_t* base; bf16_t* XB; ssq_t* ssq_out; const float* pb; const float* psc; int dummy;
    __device__ __forceinline__ void prefetch(const Unit& u, int tid, PG8_LAS unsigned char* junk) const {
        const int r = tid >> 1, h = tid & 1;
        const char* p = (const char*)base + ((size_t)(u.pm * BM + r) * 1024 + (MODE == 1 ? u.pn * HALF : u.pn * BM)) * 2 + h * (MODE == 1 ? 128 : 256);
        __builtin_amdgcn_global_load_lds((const unsigned*)p, (PG8_LAS unsigned*)junk, 4, 0, 0);
        if (MODE != 1) __builtin_amdgcn_global_load_lds((const unsigned*)(p + 128), (PG8_LAS unsigned*)junk, 4, 0, 0);
    }
    __device__ __forceinline__ void operator()(const f32x4 (&acc)[2][2][4][2], const Unit& u, int wr, int wc, int fr, int fq) const {
        if (dummy == 1) { if (acc[0][0][0][0][0] + acc[1][1][3][1][3] == 12345.678f) ((PG8_GAS float*)pb)[0] = 1.f; return; }
        const int row0 = u.pm * BM + wr * 64 + fr;
        const int col0 = (MODE == 1 ? u.pn * HALF : u.pn * BM) + wc * 32 + 8 * fq;
        constexpr int NBJ = (MODE == 1) ? 1 : 2;
        const PG8_GAS unsigned char* gb = (const PG8_GAS unsigned char*)base; PG8_GAS unsigned char* gx = (PG8_GAS unsigned char*)XB; const unsigned ob = ((unsigned)row0 * 1024u + (unsigned)col0) * 2u;
#define PG8_ROFF(dr, co_) (ob + (unsigned)((((dr)) * 1024 + (co_)) * 2))
        float ss[2][4];
#pragma unroll
        for (int ai = 0; ai < 2; ++ai)
#pragma unroll
            for (int m = 0; m < 4; ++m) ss[ai][m] = 0.f;
        constexpr bool ALL16 = (MODE == 0) && MK_RESID_ALL16;
        u32x4 bsall[ALL16 ? 2 : 1][2][4];
        if constexpr (ALL16) {
#pragma unroll
            for (int bj = 0; bj < 2; ++bj)
#pragma unroll
                for (int ai = 0; ai < 2; ++ai)
#pragma unroll
                    for (int m = 0; m < 4; ++m) bsall[bj][ai][m] = *(const PG8_GAS u32x4*)(gb + (ob + (unsigned)(((ai * HALF + m * 16) * 1024 + bj * HALF) * 2))); }
#pragma unroll
        for (int bj = 0; bj < NBJ; ++bj) { const int co = bj * HALF;
            f32x4 bb0 = {0.f, 0.f, 0.f, 0.f}, bb1 = bb0, sc0 = {1.f, 1.f, 1.f, 1.f}, sc1 = sc0;
            if (MODE == 2) { bb0 = *(const PG8_GAS f32x4*)((const PG8_GAS float*)pb + col0 + co); bb1 = *(const PG8_GAS f32x4*)((const PG8_GAS float*)pb + col0 + co + 4);
                             sc0 = *(const PG8_GAS f32x4*)((const PG8_GAS float*)psc + col0 + co); sc1 = *(const PG8_GAS f32x4*)((const PG8_GAS float*)psc + col0 + co + 4); }
            constexpr int NAB = (MODE == 2) ? 1 : 2;
#pragma unroll
            for (int a0 = 0; a0 < 2; a0 += NAB) {
                u32x4 bs[NAB][4];
#pragma unroll
                for (int ai = 0; ai < NAB; ++ai)
#pragma unroll
                    for (int m = 0; m < 4; ++m) { if constexpr (ALL16) bs[ai][m] = bsall[bj][ai][m]; else bs[ai][m] = *(const PG8_GAS u32x4*)(gb + PG8_ROFF((a0 + ai) * HALF + m * 16, co)); }
#pragma unroll
                for (int aa = 0; aa < NAB; ++aa)
#pragma unroll
                    for (int m = 0; m < 4; ++m) { const int ai = a0 + aa; const unsigned off = PG8_ROFF(ai * HALF + m * 16, co); f32x4 d0, d1;
                        if (MODE == 0) { d0 = acc[ai][bj][m][0]; d1 = acc[ai][bj][m][1]; }
                        else if (MODE == 1) { const f32x4 v0 = acc[ai][0][m][0], g0 = acc[ai][1][m][0], v1 = acc[ai][0][m][1], g1 = acc[ai][1][m][1];
                            d0 = (f32x4){v0[0] * fast_sigmoid(g0[0]), v0[1] * fast_sigmoid(g0[1]), v0[2] * fast_sigmoid(g0[2]), v0[3] * fast_sigmoid(g0[3])};
                            d1 = (f32x4){v1[0] * fast_sigmoid(g1[0]), v1[1] * fast_sigmoid(g1[1]), v1[2] * fast_sigmoid(g1[2]), v1[3] * fast_sigmoid(g1[3])}; }
                        else { d0 = (acc[ai][bj][m][0] + bb0) * sc0; d1 = (acc[ai][bj][m][1] + bb1) * sc1; }
                        f32x4 b0, b1; bf8_to_f32(bs[aa][m], b0, b1);
                        const f32x4 o0 = b0 + d0, o1 = b1 + d1;
                        ss[ai][m] += ((o0[0] * o0[0] + o0[1] * o0[1]) + (o0[2] * o0[2] + o0[3] * o0[3])) + ((o1[0] * o1[0] + o1[1] * o1[1]) + (o1[2] * o1[2] + o1[3] * o1[3]));
                        u32x4 w; w.x = cvt_pk_bf16(o0[0], o0[1]); w.y = cvt_pk_bf16(o0[2], o0[3]); w.z = cvt_pk_bf16(o1[0], o1[1]); w.w = cvt_pk_bf16(o1[2], o1[3]);
                        st_resid(gx, off, w); }
                if (NAB == 1) asm volatile("" ::: "memory"); }
            asm volatile("" ::: "memory"); }
        const int ln = fq * 16 + fr;
#pragma unroll
        for (int ai = 0; ai < 2; ++ai)
#pragma unroll
            for (int m = 0; m < 4; ++m) { float s = ss[ai][m]; s += shx(s, ln, 16); s += shx(s, ln, 32);
                if (fq == 0) atomicAdd(ssq_out + row0 + ai * HALF + m * 16, (ssq_t)__builtin_llrintf(s * SSQ_SCALE)); }
    }
};
struct EpiResidFinal {
    static constexpr bool PERM = true, AFTER_DRAIN = true, PREFETCH = false;
    const bf16_t* base; float* out; ssq_t* ssq_out; const float* gain; unsigned* cnt;
    __device__ __forceinline__ void prefetch(const Unit& u, int tid, PG8_LAS unsigned char* junk) const {
        const int r = tid >> 1, h = tid & 1;
        const char* p = (const char*)base + ((size_t)(u.pm * BM + r) * 1024 + u.pn * BM) * 2 + h * 256;
        __builtin_amdgcn_global_load_lds((const unsigned*)p, (PG8_LAS unsigned*)junk, 4, 0, 0);
        __builtin_amdgcn_global_load_lds((const unsigned*)(p + 128), (PG8_LAS unsigned*)junk, 4, 0, 0);
    }
    __device__ __forceinline__ void fused(f32x4 (&acc)[2][2][4][2], const Unit& u, int wr, int wc, int fr, int fq, PG8_LAS unsigned char* lds, int wid, int lane) const {
        const int row0 = u.pm * BM + wr * 64 + fr, col0 = u.pn * BM + wc * 32 + 8 * fq;
        const PG8_GAS bf16_t* gb = (const PG8_GAS bf16_t*)base + (size_t)row0 * 1024 + col0;
        float ss[2][4]; float chain_ = 0.f;
#pragma unroll
        for (int ai = 0; ai < 2; ++ai)
#pragma unroll
            for (int m = 0; m < 4; m += 2) { int ro_ = (ai * HALF + m * 16) * 1024; asm volatile("" : "+v"(ro_) : "v"(chain_));
                const PG8_GAS bf16_t* rp = gb + ro_;
                const u32x4 wa = *(const PG8_GAS u32x4*)(rp), wb = *(const PG8_GAS u32x4*)(rp + HALF), wc_ = *(const PG8_GAS u32x4*)(rp + 16 * 1024), wd = *(const PG8_GAS u32x4*)(rp + 16 * 1024 + HALF);
#pragma unroll
                for (int q = 0; q < 2; ++q) { f32x4 b0, b1, b2, b3; bf8_to_f32(q ? wc_ : wa, b0, b1); bf8_to_f32(q ? wd : wb, b2, b3);
                    const f32x4 o0 = b0 + acc[ai][0][m + q][0], o1 = b1 + acc[ai][0][m + q][1], o2 = b2 + acc[ai][1][m + q][0], o3 = b3 + acc[ai][1][m + q][1];
                    acc[ai][0][m + q][0] = o0; acc[ai][0][m + q][1] = o1; acc[ai][1][m + q][0] = o2; acc[ai][1][m + q][1] = o3;
                    ss[ai][m + q] = ((o0[0] * o0[0] + o0[1] * o0[1]) + (o0[2] * o0[2] + o0[3] * o0[3])) + ((o1[0] * o1[0] + o1[1] * o1[1]) + (o1[2] * o1[2] + o1[3] * o1[3]))
                                  + ((o2[0] * o2[0] + o2[1] * o2[1]) + (o2[2] * o2[2] + o2[3] * o2[3])) + ((o3[0] * o3[0] + o3[1] * o3[1]) + (o3[2] * o3[2] + o3[3] * o3[3])); }
                chain_ = ss[ai][m] + ss[ai][m + 1]; }
        const int ln = fq * 16 + fr;
#pragma unroll
        for (int ai = 0; ai < 2; ++ai)
#pragma unroll
            for (int m = 0; m < 4; ++m) { float s = ss[ai][m]; s += shx(s, ln, 16); s += shx(s, ln, 32);
                if (fq == 0) atomicAdd(ssq_out + row0 + ai * HALF + m * 16, (ssq_t)__builtin_llrintf(s * SSQ_SCALE)); }
        asm volatile("s_waitcnt vmcnt(0)" ::: "memory"); __builtin_amdgcn_s_barrier(); asm volatile("" ::: "memory");
        if (wid == 0) {
            unsigned* c = cnt + 64 * u.pm;
            if (lane == 0) __hip_atomic_fetch_add(c, 1u, __ATOMIC_RELAXED, __HIP_MEMORY_SCOPE_AGENT);
            unsigned spins = 0;
            while ((unsigned)__builtin_amdgcn_readfirstlane(__hip_atomic_load(c, __ATOMIC_RELAXED, __HIP_MEMORY_SCOPE_AGENT)) < 4u && ++spins < (1u << 22)) __builtin_amdgcn_s_sleep(2);
        }
        __builtin_amdgcn_s_barrier(); asm volatile("" ::: "memory");
        int l2_; asm volatile("v_mbcnt_lo_u32_b32 %0, -1, 0\n\tv_mbcnt_hi_u32_b32 %0, -1, %0" : "=v"(l2_));
        const int row0b = u.pm * BM + wr * 64 + (l2_ & 15), col0b = u.pn * BM + wc * 32 + 8 * (l2_ >> 4);
        PG8_GAS float* go = (PG8_GAS float*)out + (size_t)row0b * 1024 + col0b;
        float rs[2][4];
#pragma unroll
        for (int ai = 0; ai < 2; ++ai)
#pragma unroll
            for (int m = 0; m < 4; ++m) rs[ai][m] = __builtin_amdgcn_rsqf((float)__hip_atomic_load(ssq_out + row0b + ai * HALF + m * 16, __ATOMIC_RELAXED, __HIP_MEMORY_SCOPE_AGENT) * (1.0f / (1024.0f * SSQ_SCALE)) + RMS_EPS);
#pragma unroll
        for (int bj = 0; bj < 2; ++bj) { int co = bj * HALF; asm volatile("" : "+v"(co) : "v"(chain_));
            const f32x4 gg0 = *(const PG8_GAS f32x4*)((const PG8_GAS float*)gain + col0b + co), gg1 = *(const PG8_GAS f32x4*)((const PG8_GAS float*)gain + col0b + co + 4);
#pragma unroll
            for (int ai = 0; ai < 2; ++ai)
#pragma unroll
                for (int m = 0; m < 4; ++m) {
                    const f32x4 ov0 = acc[ai][bj][m][0] * rs[ai][m] * gg0, ov1 = acc[ai][bj][m][1] * rs[ai][m] * gg1;
                    PG8_GAS float* op = go + (size_t)(ai * HALF + m * 16) * 1024 + co; *(PG8_GAS f32x4*)op = ov0; *(PG8_GAS f32x4*)(op + 4) = ov1; chain_ = ov1[0]; }
            asm volatile("" ::: "memory"); }
    }
};
struct EpiU {
    static constexpr bool PERM = true, AFTER_DRAIN = false, PREFETCH = false;
    bf16_t* UX; const ssq_t* ssq;
    __device__ __forceinline__ void operator()(const f32x4 (&acc)[2][2][4][2], const Unit& u, int wr, int wc, int fr, int fq) const {
        const int row0 = u.pm * BM + wr * 64 + fr, col0 = u.pn * BM + wc * 32 + 8 * fq;
        float rsv[2][4]; rstd8(ssq, row0, rsv);
#pragma unroll
        for (int ai = 0; ai < 2; ++ai)
#pragma unroll
            for (int m = 0; m < 4; ++m) { const int row = row0 + ai * HALF + m * 16; const float rs = rsv[ai][m];
#pragma unroll
                for (int bj = 0; bj < 2; ++bj) { const int col = col0 + bj * HALF; const f32x4 v0 = acc[ai][bj][m][0] * rs, v1 = acc[ai][bj][m][1] * rs;
                    u32x4 w; w.x = cvt_pk_bf16(v0[0], v0[1]); w.y = cvt_pk_bf16(v0[2], v0[3]); w.z = cvt_pk_bf16(v1[0], v1[1]); w.w = cvt_pk_bf16(v1[2], v1[3]);
                    st_wt((PG8_GAS bf16_t*)UX + ((size_t)(col >> 4) * 1024 + (row >> 4)) * 384 + (row & 15) * 16 + (col & 15), w); } }
    }
};
struct EpiSloc {
    static constexpr bool PERM = false, AFTER_DRAIN = true, PREFETCH = false;
    const float* lamc; bf16_t* UX; PG8_LAS unsigned char* esc;
    __device__ __forceinline__ void fused(f32x4 (&acc)[2][2][4][2], const Unit& u, int wr, int wc, int fr, int fq, PG8_LAS unsigned char* lds, int wid, int lane) const {
        PG8_LAS float* SL = (PG8_LAS float*)lds;
#pragma unroll
        for (int ai = 0; ai < 2; ++ai)
#pragma unroll
            for (int m = 0; m < 4; ++m)
#pragma unroll
                for (int n = 0; n < 2; ++n) *(PG8_LAS f32x4*)(SL + (ai * HALF + wr * 64 + m * 16 + fr) * 128 + wc * 32 + n * 16 + 4 * fq) = acc[ai][0][m][n];
        asm volatile("s_waitcnt lgkmcnt(0)" ::: "memory"); __builtin_amdgcn_s_barrier(); asm volatile("" ::: "memory");
        const int g = u.pn, b = u.pm, seg = wid, p = lane;
        const float lr = lamc[(g * 64 + p) * 2], li = lamc[(g * 64 + p) * 2 + 1];
        float sr = 0.f, si = 0.f;
        for (int c = seg * 32; c < seg * 32 + 32; ++c) { const float xr = SL[c * 128 + p], xi = SL[c * 128 + 64 + p]; const float nr = lr * sr - li * si + xr, ni = lr * si + li * sr + xi; sr = nr; si = ni; }
        PG8_LAS float* E = (PG8_LAS float*)esc;
        E[(seg * 64 + p) * 2] = sr; E[(seg * 64 + p) * 2 + 1] = si;
        asm volatile("s_waitcnt lgkmcnt(0)" ::: "memory"); __builtin_amdgcn_s_barrier(); asm volatile("" ::: "memory");
        float l32r = lr, l32i = li;
#pragma unroll
        for (int q = 0; q < 5; ++q) { const float t = l32r * l32r - l32i * l32i; l32i = 2.f * l32r * l32i; l32r = t; }
        sr = 0.f; si = 0.f;
        for (int j = 0; j < seg; ++j) { const float er = E[(j * 64 + p) * 2], ei = E[(j * 64 + p) * 2 + 1]; const float nr = l32r * sr - l32i * si + er, ni = l32r * si + l32i * sr + ei; sr = nr; si = ni; }
        bf16_t* dst = UX + ((size_t)g * 1024 + b * 256 + seg * 32) * 384 + 256 + p;
        for (int c = seg * 32; c < seg * 32 + 32; ++c) {
            { unsigned ur = __builtin_bit_cast(unsigned, sr), ui = __builtin_bit_cast(unsigned, si); ur = (ur + 0x7fffu + ((ur >> 16) & 1u)) >> 16; ui = (ui + 0x7fffu + ((ui >> 16) & 1u)) >> 16;
              dst[0] = (bf16_t)ur; dst[64] = (bf16_t)ui; }
            const float xr = SL[c * 128 + p], xi = SL[c * 128 + 64 + p]; const float nr = lr * sr - li * si + xr, ni = lr * si + li * sr + xi; sr = nr; si = ni;
            dst += 384; }
        asm volatile("s_waitcnt vmcnt(0) lgkmcnt(0)" ::: "memory"); __builtin_amdgcn_s_barrier(); asm volatile("" ::: "memory");
        if (wid == 0) { __builtin_amdgcn_fence(__ATOMIC_ACQUIRE, "agent"); asm volatile("s_waitcnt vmcnt(0)" ::: "memory"); }
        __builtin_amdgcn_s_barrier(); asm volatile("" ::: "memory");
    }
};
struct EpiY {
    static constexpr bool PERM = true, AFTER_DRAIN = false, PREFETCH = false;
    const bf16_t* UX; const float* dvec; bf16_t* G1;
    __device__ __forceinline__ void operator()(const f32x4 (&acc)[2][2][4][2], const Unit& u, int wr, int wc, int fr, int fq) const {
        const int g = u.pn, b = u.pm, ch0 = g * 16 + 8 * (fq & 1);
        const f32x4 d0 = *(const f32x4*)(dvec + ch0), d1 = *(const f32x4*)(dvec + ch0 + 4);
#pragma unroll
        for (int ai = 0; ai < 2; ++ai) {
            u32x4 uwv[4][2];
#pragma unroll
            for (int m = 0; m < 4; ++m)
#pragma unroll
                for (int bj = 0; bj < 2; ++bj) uwv[m][bj] = *(const PG8_GAS u32x4*)((const PG8_GAS bf16_t*)UX + ((size_t)g * 1024 + b * 256 + (ai * HALF + wr * 64 + m * 16 + fr)) * 384 + (8 * bj + 2 * wc + (fq >> 1)) * 16 + 8 * (fq & 1));
#pragma unroll
            for (int m = 0; m < 4; ++m) { const int R = ai * HALF + wr * 64 + m * 16 + fr;
#pragma unroll
                for (int bj = 0; bj < 2; ++bj) { const int i = 8 * bj + 2 * wc + (fq >> 1);
                    const u32x4 uw = uwv[m][bj];
                    float y[8];
#pragma unroll
                    for (int j = 0; j < 4; ++j) { y[j] = acc[ai][bj][m][0][j] + d0[j] * __builtin_bit_cast(float, (j & 1) ? (uw[j >> 1] & 0xffff0000u) : (uw[j >> 1] << 16));
                                                  y[4 + j] = acc[ai][bj][m][1][j] + d1[j] * __builtin_bit_cast(float, (j & 1) ? (uw[2 + (j >> 1)] & 0xffff0000u) : (uw[2 + (j >> 1)] << 16)); }
#pragma unroll
                    for (int j = 0; j < 8; ++j) { const float z = 0.7978845608028654f * (y[j] + 0.044715f * y[j] * y[j] * y[j]); y[j] = y[j] * fast_sigmoid(2.f * z); }
                    u32x4 w; w.x = cvt_pk_bf16(y[0], y[1]); w.y = cvt_pk_bf16(y[2], y[3]); w.z = cvt_pk_bf16(y[4], y[5]); w.w = cvt_pk_bf16(y[6], y[7]);
                    st_wt((PG8_GAS bf16_t*)G1 + (MK_G1_NATURAL ? ((size_t)(b * 4096 + 16 * R + i) * 1024 + g * 16 + 8 * (fq & 1)) : (((size_t)g * 16384 + b * 4096 + 16 * R + i) * 16 + 8 * (fq & 1))), w); } }
            asm volatile("" ::: "memory"); }
    }
};
}
#include <hip/hip_bf16.h>
#include <cmath>
namespace attn_body {
using bf16=__hip_bfloat16;
using bf16x8=__attribute__((ext_vector_type(8)))short;
using s16x4=__attribute__((ext_vector_type(4)))short;
using f32x16=__attribute__((ext_vector_type(16)))float;
using u32x4=__attribute__((ext_vector_type(4)))unsigned;
constexpr int BATCH=4,NHEAD=16,SEQ=4096,D=64,DM=NHEAD*D;
constexpr int NW=8,QBLK=32,QB=QBLK*NW,KVBLK=64,NQB=SEQ/QB;
constexpr int ATTN_PITCH=DM, ATTN_UNIT_ROWS=QB;
__device__ __forceinline__ int crow(int r,int hi){return (r&3)+8*(r>>2)+4*hi;}
#define SBAR() __builtin_amdgcn_sched_barrier(0)
__device__ __forceinline__ void cmask(f32x16&p0,f32x16&p1,int jb,int qrel,int hi){
  const float NEG=-INFINITY; int kb=64*jb+4*hi;
  #pragma unroll
  for(int r=0;r<16;++r){int kv=kb+(r&3)+8*(r>>2); if(kv>qrel)p0[r]=NEG; if(kv+32>qrel)p1[r]=NEG;}
}

constexpr int NSLOT=3, SLOTB=8192;
constexpr int LDS_K=0, LDS_V=NSLOT*SLOTB, LDS_WS=2*NSLOT*SLOTB, LDS_OST=LDS_WS+NW*64*4, LDS_BYTES=LDS_OST+NW*4096;
constexpr float C2=0.125f*1.4426950408889634f;
__device__ __forceinline__ void glds16(const void*gsrc,unsigned lds_dst){unsigned keep;
  asm volatile("s_mov_b32 %0, m0\n\ts_mov_b32 m0, %2\n\ts_nop 0\n\tglobal_load_lds_dwordx4 %1, off\n\ts_mov_b32 m0, %0":"=&s"(keep):"v"(gsrc),"s"(lds_dst):"memory");}
__device__ __forceinline__ float max3f(float a,float b,float c){float r;asm("v_max3_f32 %0, %1, %2, %3":"=v"(r):"v"(a),"v"(b),"v"(c));return r;}
__device__ __forceinline__ float max2f(float a,float b){float r;asm("v_max_f32_e32 %0, %1, %2":"=v"(r):"v"(a),"v"(b));return r;}
__device__ __forceinline__ float fadd_s(float a,float b){float r;asm("v_add_f32_e32 %0, %1, %2":"=v"(r):"v"(a),"v"(b));return r;}
__device__ __forceinline__ float fsub_s(float a,float b){float r;asm("v_sub_f32_e32 %0, %1, %2":"=v"(r):"v"(a),"v"(b));return r;}
typedef float f32x2_t __attribute__((ext_vector_type(2))); typedef __bf16 bf16x2_t __attribute__((ext_vector_type(2)));
__device__ __forceinline__ unsigned cvtpk_s(float lo,float hi){f32x2_t v={lo,hi};bf16x2_t b=__builtin_convertvector(v,bf16x2_t);return __builtin_bit_cast(unsigned,b);}
#define WAIT_BAR(N) asm volatile("s_waitcnt vmcnt(" #N ") lgkmcnt(0)\n\ts_barrier":::"memory")

__device__ __forceinline__ void qkt(f32x16&p0,f32x16&p1,const char*Kslot,const bf16x8*qr,int r32,int hi){
  const char*kb=Kslot+hi*1024+r32*16;
  #pragma unroll
  for(int d0=0;d0<4;++d0){
    const bf16x8 b0=*reinterpret_cast<const bf16x8*>(kb+d0*2048);
    const bf16x8 b1=*reinterpret_cast<const bf16x8*>(kb+d0*2048+512);
    {p0=__builtin_amdgcn_mfma_f32_32x32x16_bf16(b0,qr[d0],p0,0,0,0);p1=__builtin_amdgcn_mfma_f32_32x32x16_bf16(b1,qr[d0],p1,0,0,0);}}
}
typedef __attribute__((address_space(3))) const char* lds_cptr;
typedef short v4i16_t __attribute__((ext_vector_type(4)));
__device__ __forceinline__ void kload8(bf16x8*kf,lds_cptr kp){
  kf[0]=*(const __attribute__((address_space(3))) bf16x8*)(kp);      kf[1]=*(const __attribute__((address_space(3))) bf16x8*)(kp+512);
  kf[2]=*(const __attribute__((address_space(3))) bf16x8*)(kp+2048); kf[3]=*(const __attribute__((address_space(3))) bf16x8*)(kp+2560);
  kf[4]=*(const __attribute__((address_space(3))) bf16x8*)(kp+4096); kf[5]=*(const __attribute__((address_space(3))) bf16x8*)(kp+4608);
  kf[6]=*(const __attribute__((address_space(3))) bf16x8*)(kp+6144); kf[7]=*(const __attribute__((address_space(3))) bf16x8*)(kp+6656);
}
__device__ __forceinline__ void kload2(bf16x8*kf,lds_cptr kp,int j){ kf[2*j]=*(const __attribute__((address_space(3))) bf16x8*)(kp+j*2048); kf[2*j+1]=*(const __attribute__((address_space(3))) bf16x8*)(kp+j*2048+512); }
__device__ __forceinline__ s16x4 vtr(lds_cptr p){ return __builtin_bit_cast(s16x4,__builtin_amdgcn_ds_read_tr16_b64_v4i16((__attribute__((address_space(3))) v4i16_t*)p)); }
__device__ __forceinline__ float rowmax(const f32x16&p0,const f32x16&p1){
  float a=max3f(p0[0],p0[1],p1[0]),b=max3f(p0[2],p0[3],p1[1]);a=max3f(a,p1[2],p1[3]);
  #pragma unroll
  for(int r=4;r<16;r+=4){a=max3f(a,p0[r],p0[r+1]);b=max3f(b,p0[r+2],p0[r+3]);a=max3f(a,p1[r],p1[r+1]);b=max3f(b,p1[r+2],p1[r+3]);}
  const float m=max2f(a,b);
  auto rr=__builtin_amdgcn_permlane32_swap(__float_as_uint(m),__float_as_uint(m),false,false);
  return max2f(__uint_as_float(rr[0]),__uint_as_float(rr[1]));
}
__device__ __forceinline__ void pv(f32x16*o,int vb,bf16x8 pa0,bf16x8 pa1,bf16x8 pa2,bf16x8 pa3){
  #pragma unroll
  for(int d0=0;d0<2;++d0){s16x4 lo[4],hi[4];
    #pragma unroll
    for(int ks=0;ks<4;++ks){
      asm volatile("ds_read_b64_tr_b16 %0,%1 offset:%c2":"=&v"(lo[ks]):"v"(vb),"i"(d0*4096+ks*1024):"memory");
      asm volatile("ds_read_b64_tr_b16 %0,%1 offset:%c2":"=&v"(hi[ks]):"v"(vb),"i"(d0*4096+ks*1024+512):"memory");}
    asm volatile("s_waitcnt lgkmcnt(0)":::"memory");SBAR();
    #define PK(k) (bf16x8){lo[k][0],lo[k][1],lo[k][2],lo[k][3],hi[k][0],hi[k][1],hi[k][2],hi[k][3]}
    o[d0]=__builtin_amdgcn_mfma_f32_32x32x16_bf16(pa0,PK(0),o[d0],0,0,0);
    o[d0]=__builtin_amdgcn_mfma_f32_32x32x16_bf16(pa1,PK(1),o[d0],0,0,0);
    o[d0]=__builtin_amdgcn_mfma_f32_32x32x16_bf16(pa2,PK(2),o[d0],0,0,0);
    o[d0]=__builtin_amdgcn_mfma_f32_32x32x16_bf16(pa3,PK(3),o[d0],0,0,0);
    #undef PK
  }
}

#ifndef ATTN_STORE16
#define ATTN_STORE16(p,v) (*(u32x4*)(p)=(v))
#endif
typedef float f32x4b __attribute__((ext_vector_type(4)));
template<int THRL> __device__ __forceinline__ void attn_unit(int b,int h,int qb,const bf16*Q,const bf16*__restrict__ K,const bf16*__restrict__ V,bf16*O,char*shm,const __attribute__((address_space(3))) float*bl0,const int tid_,const int tskip){
  const __attribute__((address_space(3))) float*bl=bl0+tskip*64;
  const int tid=tid_,lane=tid&63,r32=lane&31,hi=lane>>5; const int wid=__builtin_amdgcn_readfirstlane(tid>>6);
  const long rowbase=(long)b*SEQ; const int q0=qb*QB;
  const bf16*Qw=Q+(rowbase+q0+wid*QBLK)*DM+h*D;
  const bf16*Kh=K+(rowbase+(long)tskip*KVBLK)*DM+h*D,*Vh=V+(rowbase+(long)tskip*KVBLK)*DM+h*D;
  const unsigned lds0=(unsigned)(uintptr_t)shm;
  float*wsf=(float*)(shm+LDS_WS)+wid*64;
  const bf16*ksrc=Kh+(long)lane*DM+wid*8;
  const bf16*vsrc=Vh+(long)(16*(wid&3)+(lane>>2))*DM+(wid>>2)*32+(lane&3)*8;
  const unsigned kdst=lds0+LDS_K+wid*1024, vdst=lds0+LDS_V+wid*1024;
  #define DMA_K(t,slot) glds16(ksrc+(long)(t)*KVBLK*DM,(unsigned)__builtin_amdgcn_readfirstlane(kdst+(slot)))
  #define DMA_V(t,slot) glds16(vsrc+(long)(t)*KVBLK*DM,(unsigned)__builtin_amdgcn_readfirstlane(vdst+(slot)))
  const int vb0=(int)(lds0+LDS_V)+((lane>>4)&1)*32+(lane&3)*8+(4*hi+((lane&15)>>2))*64;
  const char*Kbase=shm+LDS_K; bf16x8 kf[8];
  const lds_cptr shm3=(lds_cptr)shm; const lds_cptr kp0=shm3+LDS_K+hi*1024+r32*16; const lds_cptr vp0=shm3+LDS_V+((lane>>4)&1)*32+(lane&3)*8+(4*hi+((lane&15)>>2))*64;
  const int NT=(q0+QB)/KVBLK-tskip;
  DMA_K(0,0);DMA_V(0,0);DMA_K(1,SLOTB);
  bf16x8 qr[4];
  #pragma unroll
  for(int d0=0;d0<4;++d0)qr[d0]=*reinterpret_cast<const bf16x8*>(&Qw[(long)r32*DM+d0*16+hi*8]);
  float mhat=0.f,l_reg=0.f;f32x16 o[2];o[0]=f32x16{};o[1]=f32x16{};
  const int qrel=wid*QBLK+r32;
  #define CMASK(P0,P1,t) do{int jb_=(t)-(NT-4); if(jb_>=0)cmask(P0,P1,jb_,qrel,hi);}while(0)
  #define BIASLD(P0,P1,t) do{ const __attribute__((address_space(3))) f32x4b*bp_=(const __attribute__((address_space(3))) f32x4b*)(bl+(t)*64+hi*4); \
    _Pragma("unroll") for(int g_=0;g_<4;++g_){ const f32x4b b0_=bp_[2*g_],b1_=bp_[8+2*g_]; \
      P0[4*g_]=b0_[0];P0[4*g_+1]=b0_[1];P0[4*g_+2]=b0_[2];P0[4*g_+3]=b0_[3]; P1[4*g_]=b1_[0];P1[4*g_+1]=b1_[1];P1[4*g_+2]=b1_[2];P1[4*g_+3]=b1_[3]; } }while(0)
  bool resc=false;
  #define START(P0,P1) do{ const float rm=rowmax(P0,P1); resc=false; \
    { const float dl=rm; mhat=fadd_s(mhat,dl); \
      _Pragma("unroll") for(int r=0;r<16;++r){P0[r]=fsub_s(P0[r],dl);P1[r]=fsub_s(P1[r],dl);} } \
    _Pragma("unroll") for(int r=0;r<16;++r)P0[r]=__builtin_amdgcn_exp2f(P0[r]); }while(0)
  #define RESC() do{ if(resc){ asm volatile("s_waitcnt lgkmcnt(0)":::"memory"); \
      _Pragma("unroll") for(int d_=0;d_<2;++d_) _Pragma("unroll") for(int r=0;r<16;++r)o[d_][r]*=wsf[crow(r,hi)]; } }while(0)
  f32x16 pA0,pA1,pB0,pB1;
  int sl_prev=0,sl_cur=0,sl_next=SLOTB;
  #define ROT() do{sl_prev=sl_cur;sl_cur=sl_next;sl_next=(sl_next==(NSLOT-1)*SLOTB)?0:sl_next+SLOTB;}while(0)
  DMA_K(2,2*SLOTB);
  WAIT_BAR(3);
  BIASLD(pA0,pA1,0);qkt(pA0,pA1,Kbase,qr,r32,hi);asm volatile("s_nop 15\n\ts_nop 7":"+v"(pA0),"+v"(pA1));CMASK(pA0,pA1,0);
  START(pA0,pA1);
  _Pragma("unroll") for(int r=0;r<16;++r)pA1[r]=__builtin_amdgcn_exp2f(pA1[r]);
  WAIT_BAR(0);
  DMA_K(3,0);DMA_V(1,SLOTB);
  ROT();
  kload8(kf,kp0+sl_cur);
  WAIT_BAR(2);
  s16x4 vlo[8],vhi[8]; u32x4 pw0,pw1,pw2,pw3;
  #define PKW(P,B) cvtpk_s(P[B],P[B+1])
  #define PAF(k) __builtin_bit_cast(bf16x8,pw##k)
  #define VFR(i) (bf16x8){vlo[i][0],vlo[i][1],vlo[i][2],vlo[i][3],vhi[i][0],vhi[i][1],vhi[i][2],vhi[i][3]}
  #define PIN(x) asm volatile("":"+v"(x))
  #define MX3(a,b,c) __builtin_fmaxf(__builtin_fmaxf((a),(b)),(c))
  #define GAPA(MF,A0,A1,A2,A3,W0,W1,PW) do{ MF; sacc+=A0; sacc+=A1; sacc+=A2; sacc+=A3; PIN(sacc); W0; W1; PIN(PW); SBAR(); }while(0)
  #define EX(v) __builtin_amdgcn_exp2f(v)
  #define GAPB(MF,X,B) do{ MF; X[B]=EX(X[B]-mhat); X[B+1]=EX(X[B+1]-mhat); X[B+2]=EX(X[B+2]-mhat); X[B+3]=EX(X[B+3]-mhat); PIN(X); SBAR(); }while(0)
  #define VRD(i) do{ vlo[i]=vtr(vp_+(((i)>>2)*4096+((i)&3)*1024)); vhi[i]=vtr(vp_+(((i)>>2)*4096+((i)&3)*1024+512)); }while(0)
  #define KRD(G,j) do{ if(G){ kload2(kf,kp0+sl_next,j); SBAR(); } }while(0)
  #define STEP(C0,C1,P0,P1,t,GK,GV,GL) do{ SBAR(); BIASLD(C0,C1,t); SBAR(); \
    const lds_cptr vp_=vp0+sl_prev; \
    VRD(0); SBAR(); float sacc=(P0[0]+P0[1]); \
    GAPA(C0=__builtin_amdgcn_mfma_f32_32x32x16_bf16(kf[0],qr[0],C0,0,0,0), P0[2],P0[3],P0[4],P0[5],     pw0[0]=PKW(P0,0), pw0[1]=PKW(P0,2), pw0); \
    VRD(4); SBAR(); GAPA(C1=__builtin_amdgcn_mfma_f32_32x32x16_bf16(kf[1],qr[0],C1,0,0,0), P0[6],P0[7],P0[8],P0[9],     pw0[2]=PKW(P0,4), pw0[3]=PKW(P0,6), pw0); \
    VRD(1); SBAR(); GAPA(C0=__builtin_amdgcn_mfma_f32_32x32x16_bf16(kf[2],qr[1],C0,0,0,0),   P0[10],P0[11],P0[12],P0[13], pw1[0]=PKW(P0,8), pw1[1]=PKW(P0,10), pw1); \
    VRD(5); SBAR(); GAPA(C1=__builtin_amdgcn_mfma_f32_32x32x16_bf16(kf[3],qr[1],C1,0,0,0),   P0[14],P0[15],P1[0],P1[1],   pw1[2]=PKW(P0,12),pw1[3]=PKW(P0,14), pw1); \
    VRD(2); SBAR(); GAPA(C0=__builtin_amdgcn_mfma_f32_32x32x16_bf16(kf[4],qr[2],C0,0,0,0),   P1[2],P1[3],P1[4],P1[5],     pw2[0]=PKW(P1,0), pw2[1]=PKW(P1,2), pw2); \
    VRD(6); SBAR(); GAPA(C1=__builtin_amdgcn_mfma_f32_32x32x16_bf16(kf[5],qr[2],C1,0,0,0),   P1[6],P1[7],P1[8],P1[9],     pw2[2]=PKW(P1,4), pw2[3]=PKW(P1,6), pw2); \
    VRD(3); SBAR(); GAPA(C0=__builtin_amdgcn_mfma_f32_32x32x16_bf16(kf[6],qr[3],C0,0,0,0),   P1[10],P1[11],P1[12],P1[13], pw3[0]=PKW(P1,8), pw3[1]=PKW(P1,10), pw3); \
    VRD(7); SBAR(); GAPA(C1=__builtin_amdgcn_mfma_f32_32x32x16_bf16(kf[7],qr[3],C1,0,0,0),   P1[14],P1[15],0.f,0.f,       pw3[2]=PKW(P1,12),pw3[3]=PKW(P1,14), pw3); \
    l_reg+=sacc; \
    if(GK){DMA_K((t)+3,sl_cur);} if(GV){DMA_V((t)+1,sl_next);} \
    CMASK(C0,C1,t); \
    { float a=MX3(C0[0],C0[1],C1[0]),b=MX3(C0[2],C0[3],C1[1]); a=MX3(a,C1[2],C1[3]); \
      _Pragma("unroll") for(int r=4;r<16;r+=4){a=MX3(a,C0[r],C0[r+1]);b=MX3(b,C0[r+2],C0[r+3]);a=MX3(a,C1[r],C1[r+1]);b=MX3(b,C1[r+2],C1[r+3]);} \
      float rm=__builtin_fmaxf(a,b); { auto rr=__builtin_amdgcn_permlane32_swap(__float_as_uint(rm),__float_as_uint(rm),false,false); rm=__builtin_fmaxf(__uint_as_float(rr[0]),__uint_as_float(rr[1])); } \
      resc=false; const float dm_=rm-mhat; \
      if(__builtin_expect(__any(dm_>(float)THRL),0)){ const float dl=__builtin_fmaxf(dm_,0.f); mhat+=dl; \
        const float f=__builtin_amdgcn_exp2f(-dl); l_reg*=f; if(hi==0)wsf[r32]=f; resc=true; } } \
    SBAR(); \
    GAPB(o[0]=__builtin_amdgcn_mfma_f32_32x32x16_bf16(PAF(0),VFR(0),o[0],0,0,0), C0,0); \
    GAPB(o[1]=__builtin_amdgcn_mfma_f32_32x32x16_bf16(PAF(0),VFR(4),o[1],0,0,0), C0,4); \
    KRD(GL,0); GAPB(o[0]=__builtin_amdgcn_mfma_f32_32x32x16_bf16(PAF(1),VFR(1),o[0],0,0,0), C0,8); \
    KRD(GL,1); GAPB(o[1]=__builtin_amdgcn_mfma_f32_32x32x16_bf16(PAF(1),VFR(5),o[1],0,0,0), C0,12); \
    KRD(GL,2); GAPB(o[0]=__builtin_amdgcn_mfma_f32_32x32x16_bf16(PAF(2),VFR(2),o[0],0,0,0), C1,0); \
    KRD(GL,3); GAPB(o[1]=__builtin_amdgcn_mfma_f32_32x32x16_bf16(PAF(2),VFR(6),o[1],0,0,0), C1,4); \
    GAPB(o[0]=__builtin_amdgcn_mfma_f32_32x32x16_bf16(PAF(3),VFR(3),o[0],0,0,0), C1,8); \
    GAPB(o[1]=__builtin_amdgcn_mfma_f32_32x32x16_bf16(PAF(3),VFR(7),o[1],0,0,0), C1,12); \
    }while(0)
  int t=1;
  #undef CMASK
  #define CMASK(P0,P1,t) do{}while(0)
  for(;t+5<NT;t+=2){
    STEP(pB0,pB1,pA0,pA1,t,true,true,true);     WAIT_BAR(2); RESC(); ROT();
    STEP(pA0,pA1,pB0,pB1,t+1,true,true,true);   WAIT_BAR(2); RESC(); ROT();
  }
  #undef CMASK
  #define CMASK(P0,P1,t) do{int jb_=(t)-(NT-4); if(jb_>=0)cmask(P0,P1,jb_,qrel,hi);}while(0)
  #define ENDW(tt) do{ if((tt)+3<NT){WAIT_BAR(2);} else if((tt)+2<NT){WAIT_BAR(1);} else {WAIT_BAR(0);} }while(0)
  for(;t+1<NT;t+=2){
    STEP(pB0,pB1,pA0,pA1,t,(t+3<NT),(t+1<NT),(t+1<NT));       ENDW(t);   RESC(); ROT();
    STEP(pA0,pA1,pB0,pB1,t+1,(t+4<NT),(t+2<NT),(t+2<NT));     ENDW(t+1); RESC(); ROT();
  }
  STEP(pB0,pB1,pA0,pA1,NT-1,false,false,false); RESC();
  { float sacc=pB0[0]+pB0[1]; _Pragma("unroll") for(int r=2;r<16;++r)sacc+=pB0[r]; _Pragma("unroll") for(int r=0;r<16;++r)sacc+=pB1[r]; l_reg+=sacc;
    pw0=(u32x4){PKW(pB0,0),PKW(pB0,2),PKW(pB0,4),PKW(pB0,6)};pw1=(u32x4){PKW(pB0,8),PKW(pB0,10),PKW(pB0,12),PKW(pB0,14)};pw2=(u32x4){PKW(pB1,0),PKW(pB1,2),PKW(pB1,4),PKW(pB1,6)};pw3=(u32x4){PKW(pB1,8),PKW(pB1,10),PKW(pB1,12),PKW(pB1,14)};
    SBAR(); pv(o,vb0+sl_cur,PAF(0),PAF(1),PAF(2),PAF(3)); }
  #undef PKW
  #undef PAF
  #undef VFR
  #undef PIN
  #undef MX3
  #undef GAPA
  #undef GAPB
  #undef EX
  #undef VRD
  #undef KRD
  #undef STEP
  #undef ENDW
  {auto rr=__builtin_amdgcn_permlane32_swap(__float_as_uint(l_reg),__float_as_uint(l_reg),false,false);l_reg=__uint_as_float(rr[0])+__uint_as_float(rr[1]);}
  if(hi==0)wsf[32+r32]=l_reg;asm volatile("s_waitcnt lgkmcnt(0)":::"memory");
  float rli[16];
  #pragma unroll
  for(int r=0;r<16;++r)rli[r]=__builtin_amdgcn_rcpf(wsf[32+crow(r,hi)]);
  bf16*Ow=O+(rowbase+q0+wid*QBLK)*DM+h*D;
  { bf16*stg=(bf16*)(shm+LDS_OST)+wid*2048;
    #pragma unroll
    for(int r=0;r<16;++r){const int orow=crow(r,hi);
      #pragma unroll
      for(int d0=0;d0<2;++d0)stg[orow*64+d0*32+r32]=__float2bfloat16(o[d0][r]*rli[r]);}
    asm volatile("s_waitcnt lgkmcnt(0)":::"memory");
    #pragma unroll
    for(int i=0;i<4;++i){const int row=i*8+(lane>>3),ch=lane&7; const u32x4 v=*(const u32x4*)(stg+row*64+ch*8); ATTN_STORE16(Ow+(long)row*DM+ch*8,v);} }
  asm volatile("s_waitcnt lgkmcnt(0)\n\ts_barrier":::"memory");
  #undef DMA_K
  #undef DMA_V
  #undef CMASK
  #undef BIASLD
  #undef START
  #undef RESC
  #undef ROT
}
constexpr int ATTN_LDS_BYTES=LDS_BYTES;
struct AttnTensors { const bf16* Q; const bf16* K; const bf16* V; bf16* O; };
struct AttnUnit { int bh; int qb; };
struct StaticOrder {
  int vcu;
  __device__ __forceinline__ explicit StaticOrder(int grid,int block):vcu((block%8)*(grid/8)+block/8){}
  __device__ __forceinline__ bool next(int i,AttnUnit&u)const{ if(i>=4)return false; const int s=vcu&3; u.bh=vcu>>2; u.qb=(i==0)?s:(i==1)?7-s:(i==2)?8+s:15-s; return true; }
};
template<class Sched,int THRL=8> __device__ __forceinline__ void attn_phase(char*lds,const AttnTensors&T,const Sched&S,const __attribute__((address_space(3))) float*bl,const int tid,const __attribute__((address_space(3))) int*tsk){
  AttnUnit u;
  for(int i=0;S.next(i,u);++i){ attn_unit<THRL>(u.bh/NHEAD,u.bh%NHEAD,u.qb,T.Q,T.K,T.V,T.O,lds,bl,tid,__builtin_amdgcn_readfirstlane(tsk[i])); }
}
#undef SBAR
#undef WAIT_BAR
}
namespace mk {
#define LAS __attribute__((address_space(3)))
#define XB_TMO      128
#define XB_XCNT(j)  (256  + 64 * (j))
#define XB_XSUB(j)  (1280 + 64 * (j))
#define XB_XGEN(j)  (2304 + 64 * (j))
#define XB_TOP      3328
#define XB_TOPGEN   3392
#define XCD_BAR_WORDS 3456
#define XB_SPIN_CAP (1u << 18)

__device__ __forceinline__ unsigned xb_ld(unsigned* p)              { return __hip_atomic_load(p, __ATOMIC_RELAXED, __HIP_MEMORY_SCOPE_AGENT); }
__device__ __forceinline__ unsigned xb_add(unsigned* p, unsigned v) { return __hip_atomic_fetch_add(p, v, __ATOMIC_RELAXED, __HIP_MEMORY_SCOPE_AGENT); }
__device__ __forceinline__ unsigned xb_xcc_id() { return (unsigned)__builtin_amdgcn_s_getreg((3 << 11) | 20) & 0xFu; }
#define XB_SPIN(cond, bar) do { unsigned _sp = 0; while (cond) { __builtin_amdgcn_s_sleep(1); \
    if ((++_sp & 255u) == 0u) { if (xb_ld(&(bar)[XB_TMO])) break; if (_sp > XB_SPIN_CAP) { atomicAdd(&(bar)[XB_TMO], 1u); break; } } } } while (0)

struct XcdBarrier {
    unsigned* bar; unsigned x;
    volatile LAS unsigned* st;
};

__device__ __forceinline__ XcdBarrier xcd_barrier_post(unsigned* bar, volatile LAS unsigned* st) {
    XcdBarrier b; b.bar = bar; b.x = xb_xcc_id(); b.st = st;
    if (threadIdx.x == 0) (void)xb_add(&bar[XB_XCNT(b.x)], 1u);
    return b;
}
__device__ __forceinline__ void xcd_barrier_complete(unsigned* bar, unsigned x, unsigned& nloc, unsigned& nx) {
    const unsigned G = gridDim.x * gridDim.y * gridDim.z;
    unsigned sum, cnt, mine, sp = 0u;
    for (;;) {
        sum = 0u; cnt = 0u; mine = 0u;
#pragma unroll
        for (unsigned j = 0; j < 16; ++j) { const unsigned c = xb_ld(&bar[XB_XCNT(j)]); sum += c; cnt += (c > 0u) ? 1u : 0u; mine = (j == x) ? c : mine; }
        if (sum == G) break;
        __builtin_amdgcn_s_sleep(1);
        if ((++sp & 255u) == 0u) { if (xb_ld(&bar[XB_TMO])) break; if (sp > XB_SPIN_CAP) { atomicAdd(&bar[XB_TMO], 1u); break; } }
    }
    nloc = mine > 0u ? mine : 1u; nx = cnt > 0u ? cnt : 1u;
}

__device__ __forceinline__ void xcd_barrier(const XcdBarrier& b) {
    asm volatile("s_waitcnt vmcnt(0)" ::: "memory");
    __syncthreads();
    if (threadIdx.x == 0) {
        unsigned* bar = b.bar;
        __builtin_amdgcn_s_waitcnt(0);
        unsigned nloc = b.st[0], nx = b.st[1];
        if (nloc == 0u) { xcd_barrier_complete(bar, b.x, nloc, nx); b.st[0] = nloc; b.st[1] = nx; }
        const unsigned old = xb_add(&bar[XB_XSUB(b.x)], 1u);
        const unsigned gen = old / nloc;
        if (old + 1u == (gen + 1u) * nloc) {
            __builtin_amdgcn_fence(__ATOMIC_RELEASE, "agent");
            asm volatile("s_waitcnt vmcnt(0)" ::: "memory");
            const unsigned og = xb_add(&bar[XB_TOP], 1u);
            const unsigned tg = og / nx;
            if (og + 1u == (tg + 1u) * nx) xb_add(&bar[XB_TOPGEN], 1u);
            else XB_SPIN(xb_ld(&bar[XB_TOPGEN]) == tg, bar);
            __builtin_amdgcn_fence(__ATOMIC_ACQUIRE, "agent");
            xb_add(&bar[XB_XGEN(b.x)], 1u);
            asm volatile("s_waitcnt vmcnt(0)" ::: "memory");
        } else {
            XB_SPIN(xb_ld(&bar[XB_XGEN(b.x)]) == gen, bar);
            __builtin_amdgcn_fence(__ATOMIC_ACQUIRE, "agent");
            asm volatile("s_waitcnt vmcnt(0)" ::: "memory");
        }
    }
    __syncthreads();
}

#undef LAS
}
namespace mk {
constexpr int NWAVES = 8;
constexpr int D = 1024, BATCH = 4, SEQ = 4096, M = BATCH * SEQ, DEPTH = 4, NH = 16, HD = 64, FOX_IN = 3 * D + NH, DFF = 2816;
constexpr int SG = 64, SP = 64, SC = 16;
constexpr float RMS_EPS = 1e-6f;
constexpr size_t MiB = 1u << 20;
constexpr size_t WS_CTL = 276 * MiB, CTL_ZERO_BYTES = 3 * MiB;
constexpr size_t WS_SSQ = 277 * MiB;
constexpr size_t WS_WQKV = 2 * MiB;
constexpr size_t WS_WO = 14 * MiB;
constexpr size_t WS_WS5IN = 18 * MiB;
constexpr size_t WS_WGLU = 20 * MiB;
constexpr size_t WS_BTA = 24 * MiB;
constexpr size_t WS_BTB = 32 * MiB;
constexpr size_t WS_WPOOL = 44 * MiB;
constexpr size_t WS_WF = 44 * MiB + 512 * 1024;
constexpr size_t WS_KERN = 45 * MiB;
constexpr size_t WS_LAMC = 46 * MiB;
constexpr size_t WS_LF = 47 * MiB;
constexpr size_t WS_WGU = 48 * MiB;
constexpr size_t WS_WDN = 92 * MiB;
constexpr size_t WS_XB = 114 * MiB;
constexpr size_t WS_ACT = 146 * MiB;
constexpr size_t WS_O = 244 * MiB;
constexpr size_t WS_NRM = 279 * MiB;
constexpr size_t WS_END = 283 * MiB;
constexpr int CW_TMO = 0, CW_BAR = 4096, CW_PANEL = 16384, CW_QUEUE = 24576, CW_HQ = 32768;

constexpr int RING_OFF = 0, RING_BYTES = 131072;
constexpr int LDSCTL_OFF = RING_BYTES, MISC_OFF = LDSCTL_OFF + 320;
constexpr int LDS_BYTES = 147456;

#define GAS __attribute__((address_space(1)))
#define LAS __attribute__((address_space(3)))
typedef unsigned short bf16;
typedef unsigned v4u __attribute__((ext_vector_type(4)));
typedef float f32x4 __attribute__((ext_vector_type(4)));
typedef float f32x2 __attribute__((ext_vector_type(2)));
typedef short bf16x8 __attribute__((ext_vector_type(8)));
typedef GAS unsigned gu32;
#define RLX_AGENT __ATOMIC_RELAXED, __HIP_MEMORY_SCOPE_AGENT
#define LDS_WAIT() asm volatile("s_waitcnt lgkmcnt(0)" ::: "memory")
#define VM_WAIT() asm volatile("s_waitcnt vmcnt(0)" ::: "memory")
__device__ __forceinline__ unsigned f2bf(float f) { unsigned u = __builtin_bit_cast(unsigned, f); return (u + 0x7fffu + ((u >> 16) & 1u)) >> 16; }
__device__ __forceinline__ unsigned pk2(float lo, float hi) { return f2bf(lo) | (f2bf(hi) << 16); }
__device__ __forceinline__ float bf2f(unsigned short b) { return __builtin_bit_cast(float, (unsigned)b << 16); }
__device__ __forceinline__ float lshx(float v, int lane, int m) { return __builtin_bit_cast(float, __builtin_amdgcn_ds_bpermute((lane ^ m) << 2, __builtin_bit_cast(int, v))); }
__device__ __forceinline__ float wave_sum(float v, int lane) {
#pragma unroll
    for (int o = 1; o < 64; o <<= 1) v += lshx(v, lane, o);
    return v;
}

enum Op { OP_PROLOGUE = 0, OP_QKV, OP_ATTN, OP_WO, OP_UP, OP_DOWN, OP_S5IN, OP_SSM, OP_SSMB, OP_GLU, OP_POOLPREP, OP_POOLGEMM, OP_FINAL, OP_NORMX, OP_S5TAB };
struct PhaseEnt { int op, layer, j, sin, sout; };
#define MK_PROGRAM \
    {OP_PROLOGUE, 0, 0, 0, 0}, \
    {OP_QKV, 0, 0, 0, 0}, {OP_ATTN, 0, 0, 0, 0}, {OP_WO, 0, 0, 0, 1}, {OP_UP, 0, 0, 1, 0}, {OP_DOWN, 0, 0, 0, 2}, \
    {OP_S5IN, 1, 0, 2, 0}, {OP_SSM, 1, 0, 0, 0}, {OP_GLU, 1, 0, 0, 3}, {OP_UP, 1, 0, 3, 0}, {OP_DOWN, 1, 0, 0, 4}, \
    {OP_POOLGEMM, 2, 0, 4, 5}, {OP_UP, 2, 0, 5, 0}, {OP_DOWN, 2, 0, 0, 6}, \
    {OP_QKV, 3, 1, 6, 0}, {OP_ATTN, 3, 1, 0, 0}, {OP_WO, 3, 1, 0, 7}, {OP_UP, 3, 0, 7, 0}, {OP_DOWN, 3, 0, 0, 8}, \
    {OP_FINAL, 0, 0, 8, 0}, \
    {OP_NORMX, 0, 0, 0, 1}, {OP_NORMX, 0, 0, 0, 2}, {OP_NORMX, 0, 0, 0, 3}, {OP_NORMX, 0, 0, 0, 4}, {OP_NORMX, 0, 0, 0, 5}, {OP_NORMX, 0, 0, 0, 6}, {OP_NORMX, 0, 0, 0, 7}, {OP_NORMX, 0, 0, 0, 8}, \
    {OP_S5TAB, 0, 0, 0, 0}
constexpr int N_PROG = 29, PH_FINAL = 19, PH_LAST = 18, PH_NORMX1 = 20, PH_S5TAB = 28;
__constant__ PhaseEnt PROG[N_PROG] = { MK_PROGRAM };

struct Args { const float* in[22]; float* out; unsigned char* ws; int ph_lo, ph_hi; };

__device__ __forceinline__ void wt_load(f32x4 (&v)[8], const float* W, int ldw, int n0_src, int k0, int lane) {
    const int c4 = lane & 7, r8 = lane >> 3;
    const GAS f32x4* src = (const GAS f32x4*)(W + (size_t)(k0 + r8) * ldw + n0_src + 4 * c4);
#pragma unroll
    for (int i = 0; i < 8; ++i) v[i] = MK_WNT ? __builtin_nontemporal_load(src + (size_t)i * 2 * ldw) : src[(size_t)i * 2 * ldw];
}
__device__ __forceinline__ void wt_store(f32x4 (&v)[8], int K, const float* gain, bf16* WT, int n0_dst, int k0, LAS float* scr, int lane) {
    const int c4 = lane & 7, r8 = lane >> 3;
    if (gain) {
#pragma unroll
        for (int i = 0; i < 8; ++i) v[i] = v[i] * gain[k0 + r8 + 8 * i]; }
#pragma unroll
    for (int i = 0; i < 8; ++i) { LAS float* d = scr + (r8 + 8 * i) * 33 + 4 * c4; d[0] = v[i].x; d[1] = v[i].y; d[2] = v[i].z; d[3] = v[i].w; }
    LDS_WAIT(); asm volatile("" ::: "memory");
    const int c = lane & 7;
#pragma unroll
    for (int j = 0; j < 4; ++j) { const int n = (lane >> 3) + 8 * j; const LAS float* s = scr + (8 * c) * 33 + n;
        v4u o; o.x = pk2(s[0 * 33], s[1 * 33]); o.y = pk2(s[2 * 33], s[3 * 33]); o.z = pk2(s[4 * 33], s[5 * 33]); o.w = pk2(s[6 * 33], s[7 * 33]);
        pg8::st_wt((GAS bf16*)WT + (size_t)(n0_dst + n) * K + k0 + 8 * c, o); }
    LDS_WAIT(); asm volatile("" ::: "memory");
}
__device__ __forceinline__ void wt_item(const float* W, int ldw, int K, const float* gain, bf16* WT, int n0_dst, int n0_src, int k0, LAS float* scr, int lane) {
    f32x4 v[8]; wt_load(v, W, ldw, n0_src, k0, lane); wt_store(v, K, gain, WT, n0_dst, k0, scr, lane);
}
template <int NR> __device__ __forceinline__ void normx_rows(const float* x0, size_t xstride, bf16* o0, size_t ostride, pg8::ssq_t* ssq0, size_t sstride, int lane) {
    f32x4 v[NR][4]; float s[NR];
#pragma unroll
    for (int r = 0; r < NR; ++r) { const GAS f32x4* xr = (const GAS f32x4*)(x0 + r * xstride) + lane;
#pragma unroll
        for (int j = 0; j < 4; ++j) v[r][j] = xr[64 * j]; }
#pragma unroll
    for (int r = 0; r < NR; ++r) { s[r] = 0.f;
#pragma unroll
        for (int j = 0; j < 4; ++j) s[r] += (v[r][j].x * v[r][j].x + v[r][j].y * v[r][j].y) + (v[r][j].z * v[r][j].z + v[r][j].w * v[r][j].w);
        s[r] = wave_sum(s[r], lane); }
#pragma unroll
    for (int r = 0; r < NR; ++r) { GAS unsigned long long* o8 = (GAS unsigned long long*)(o0 + r * ostride) + lane;
#pragma unroll
        for (int j = 0; j < 4; ++j) pg8::st_wt(o8 + 64 * j, (unsigned long long)pk2(v[r][j].x, v[r][j].y) | ((unsigned long long)pk2(v[r][j].z, v[r][j].w) << 32));
        if (lane == 0) ssq0[r * sstride] = (pg8::ssq_t)__builtin_llrintf(s[r] * pg8::SSQ_SCALE); }
}
__device__ __forceinline__ void normx_row(const float* xrow, bf16* orow, pg8::ssq_t* ssq_slot, int lane) { normx_rows<1>(xrow, 0, orow, 0, ssq_slot, 0, lane); }
__device__ __forceinline__ f32x4 bf4(const pg8::u32x2 w) { return (f32x4){__builtin_bit_cast(float, w.x << 16), __builtin_bit_cast(float, w.x & 0xffff0000u), __builtin_bit_cast(float, w.y << 16), __builtin_bit_cast(float, w.y & 0xffff0000u)}; }
template <int W> __device__ __forceinline__ void pool_item(const bf16* X, const pg8::ssq_t* ssq, const f32x4 gg, bf16* PD, int row0, int t0, int c0) {
    f32x4 ring[W]; f32x4 run = {0.f, 0.f, 0.f, 0.f};
    { pg8::u32x2 xw[W]; pg8::ssq_t sw[W];
#pragma unroll
      for (int kk = 1; kk < W; ++kk) { xw[kk] = (pg8::u32x2){0u, 0u}; sw[kk] = 0;
          if (t0 - W + kk >= 0) { const int r = row0 - W + kk; xw[kk] = *(const GAS pg8::u32x2*)(X + (size_t)r * D + c0); sw[kk] = ((const GAS pg8::ssq_t*)ssq)[r]; } }
#pragma unroll
      for (int kk = 1; kk < W; ++kk) {
          const f32x4 hv = bf4(xw[kk]) * __builtin_amdgcn_rsqf((float)sw[kk] * (1.0f / (1024.0f * pg8::SSQ_SCALE)) + RMS_EPS) * gg;
          ring[kk % W] = hv; run += hv; } }
    pg8::u32x2 xc[16]; pg8::ssq_t sc[16];
#pragma unroll
    for (int i = 0; i < 16; ++i) { xc[i] = *(const GAS pg8::u32x2*)(X + (size_t)(row0 + i) * D + c0); sc[i] = ((const GAS pg8::ssq_t*)ssq)[row0 + i]; }
#pragma unroll
    for (int i = 0; i < 16; ++i) { const int r = row0 + i, t = t0 + i;
        const f32x4 hv = bf4(xc[i]) * __builtin_amdgcn_rsqf((float)sc[i] * (1.0f / (1024.0f * pg8::SSQ_SCALE)) + RMS_EPS) * gg;
        run += hv; ring[i % W] = hv;
        const int cnt = (t + 1 < W) ? (t + 1) : W; const f32x4 o = run * (1.0f / (float)cnt) - hv;
        pg8::st_wt((GAS bf16*)PD + (size_t)r * D + c0, (unsigned long long)pk2(o[0], o[1]) | ((unsigned long long)pk2(o[2], o[3]) << 32));
        run -= ring[(i + 1) % W]; }
}
__device__ __forceinline__ void touch_lines(const void* p, int bytes, int tid) {
    const GAS unsigned* q = (const GAS unsigned*)p + tid * 32; unsigned acc = 0;
    for (int o = 0; o < bytes; o += 512 * 128 * 8) {
#pragma unroll
        for (int i = 0; i < 8; ++i) acc |= q[(size_t)(o / 4) + (size_t)i * 512 * 32];
    }
    asm volatile("" :: "v"(acc));
}
struct WtDesc { const float* W; const float* gain; bf16* WT; int ldw, K, Ndst, kind, off2; };
__device__ __forceinline__ WtDesc wt_desc(const Args& args, int i) {
    unsigned char* ws = args.ws; const float* mix_g = args.in[1]; const float* ffn_g = args.in[2];
    WtDesc d;
    if (i < 2) { d.W = args.in[4] + (size_t)i * D * FOX_IN; d.gain = mix_g + (i ? 3 * D : 0); d.WT = (bf16*)(ws + WS_WQKV) + (size_t)i * 3 * D * D; d.ldw = FOX_IN; d.K = D; d.Ndst = 3 * D; d.kind = 0; d.off2 = 0; }
    else if (i < 4) { d.W = args.in[6] + (size_t)(i - 2) * D * D; d.gain = nullptr; d.WT = (bf16*)(ws + WS_WO) + (size_t)(i - 2) * D * D; d.ldw = D; d.K = D; d.Ndst = D; d.kind = 0; d.off2 = 0; }
    else if (i == 4) { d.W = args.in[7]; d.gain = mix_g + D; d.WT = (bf16*)(ws + WS_WS5IN); d.ldw = D; d.K = D; d.Ndst = D; d.kind = 0; d.off2 = 0; }
    else if (i == 5) { d.W = args.in[16]; d.gain = nullptr; d.WT = (bf16*)(ws + WS_WGLU); d.ldw = 2 * D; d.K = D; d.Ndst = 2 * D; d.kind = 1; d.off2 = D; }
    else if (i < 10) { d.W = args.in[17] + (size_t)(i - 6) * 65536; d.gain = nullptr; d.WT = (bf16*)(ws + WS_WPOOL) + (size_t)(i - 6) * 65536; d.ldw = 256; d.K = 256; d.Ndst = 256; d.kind = 0; d.off2 = 0; }
    else if (i < 14) { d.W = args.in[20] + (size_t)(i - 10) * D * 2 * DFF; d.gain = ffn_g + (i - 10) * D; d.WT = (bf16*)(ws + WS_WGU) + (size_t)(i - 10) * 2 * DFF * D; d.ldw = 2 * DFF; d.K = D; d.Ndst = 2 * DFF; d.kind = 1; d.off2 = DFF; }
    else { d.W = args.in[21] + (size_t)(i - 14) * DFF * D; d.gain = nullptr; d.WT = (bf16*)(ws + WS_WDN) + (size_t)(i - 14) * D * DFF; d.ldw = D; d.K = DFF; d.Ndst = D; d.kind = 0; d.off2 = 0; }
    return d;
}
__device__ __forceinline__ void ph_s5tables(const Args& args, LAS float* scr, LAS float* wsc, int gw, int NGW, int lane) {
    unsigned char* ws = args.ws;
    { const float* a_re = args.in[8]; const float* a_im = args.in[9]; const float* log_dt = args.in[10];
      const float* b_re = args.in[11]; const float* b_im = args.in[12]; const float* c_re = args.in[13]; const float* c_im = args.in[14];
      float* KERN = (float*)(ws + WS_KERN);
      for (int it = (gw + NGW / 2) % NGW; it < SG * 16; it += NGW) {
          const int g = it >> 4, tau = it & 15, p = lane;
          { const GAS f32x4* s0 = (const GAS f32x4*)(c_re + (size_t)g * 1024), *s1 = (const GAS f32x4*)(c_im + (size_t)g * 1024), *s2 = (const GAS f32x4*)(b_re + (size_t)g * 1024), *s3 = (const GAS f32x4*)(b_im + (size_t)g * 1024);
            f32x4 t0[4], t1[4], t2[4], t3[4];
#pragma unroll
            for (int j = 0; j < 4; ++j) { t0[j] = s0[lane + 64 * j]; t1[j] = s1[lane + 64 * j]; t2[j] = s2[lane + 64 * j]; t3[j] = s3[lane + 64 * j]; }
#pragma unroll
            for (int j = 0; j < 4; ++j) { ((LAS f32x4*)scr)[lane + 64 * j] = t0[j]; ((LAS f32x4*)scr)[256 + lane + 64 * j] = t1[j]; ((LAS f32x4*)scr)[512 + lane + 64 * j] = t2[j]; ((LAS f32x4*)scr)[768 + lane + 64 * j] = t3[j]; } }
          const double lr = a_re[g * SP + p], li = a_im[g * SP + p], dt = exp((double)log_dt[g]);
          const double er = exp(lr * dt), lbr = er * cos(li * dt), lbi = er * sin(li * dt);
          const double nr = lbr - 1.0, ni = lbi, den = lr * lr + li * li, fr = (nr * lr + ni * li) / den, fi = (ni * lr - nr * li) / den;
          const double et = exp(lr * dt * tau), ptr_ = et * cos(li * dt * tau), pti = et * sin(li * dt * tau);
          wsc[p] = (float)(ptr_ * fr - pti * fi); wsc[64 + p] = (float)(ptr_ * fi + pti * fr);
          LDS_WAIT(); asm volatile("" ::: "memory");
          const LAS float* Cr = scr, *Ci = scr + 1024, *Br = scr + 2048, *Bi = scr + 3072, *Wr_ = wsc, *Wi_ = wsc + 64;
          float acc[4] = {0.f, 0.f, 0.f, 0.f}; const int ci = lane & 15, cob = lane >> 4;
#pragma unroll 8
          for (int pp = 0; pp < SP; ++pp) {
              const float wr = Wr_[pp], wi = Wi_[pp], br = Br[pp * 16 + ci], bi = Bi[pp * 16 + ci];
#pragma unroll
              for (int q = 0; q < 4; ++q) { const int co = cob + 4 * q; const float cr = Cr[co * 64 + pp], cim = Ci[co * 64 + pp];
                  const float cwr = cr * wr - cim * wi, cwi = cr * wi + cim * wr; acc[q] += cwr * br - cwi * bi; } }
#pragma unroll
          for (int q = 0; q < 4; ++q) KERN[(size_t)it * 256 + lane + 64 * q] = acc[q];
          LDS_WAIT(); asm volatile("" ::: "memory");
      }
      bf16* BTA = (bf16*)(ws + WS_BTA);
      for (int e = gw * 64 + lane; e < SG * 128 * 16; e += NGW * 64) {
          const int g = e >> 11, n = (e >> 4) & 127, j = e & 15, p = n & 63, im = n >> 6;
          const double lr = a_re[g * SP + p], li = a_im[g * SP + p], dt = exp((double)log_dt[g]);
          const double er = exp(lr * dt), lbr = er * cos(li * dt), lbi = er * sin(li * dt);
          const double nr = lbr - 1.0, ni = lbi, den = lr * lr + li * li, fr = (nr * lr + ni * li) / den, fi = (ni * lr - nr * li) / den;
          const double tt = (double)(15 - j), et = exp(lr * dt * tt), ptr_ = et * cos(li * dt * tt), pti = et * sin(li * dt * tt);
          const float Wr = (float)(ptr_ * fr - pti * fi), Wi = (float)(ptr_ * fi + pti * fr);
          unsigned w[8];
#pragma unroll
          for (int c = 0; c < 16; c += 2) { float v[2];
#pragma unroll
              for (int q = 0; q < 2; ++q) { const float br = b_re[(g * SP + p) * SC + c + q], bi = b_im[(g * SP + p) * SC + c + q]; v[q] = im ? (Wr * bi + Wi * br) : (Wr * br - Wi * bi); }
              w[c >> 1] = pk2(v[0], v[1]); }
          v4u* dst = (v4u*)(BTA + ((size_t)g * 256 + n) * 256 + j * 16);
          dst[0] = (v4u){w[0], w[1], w[2], w[3]}; dst[1] = (v4u){w[4], w[5], w[6], w[7]};
      }
      for (int e = gw * 64 + lane; e < SG * 128 * 32; e += NGW * 64) { const int g = e >> 12, r = e & 4095; ((v4u*)(BTA + ((size_t)g * 256 + 128) * 256))[r] = (v4u){0u, 0u, 0u, 0u}; }
      bf16* BTB = (bf16*)(ws + WS_BTB);
      for (int e = gw * 64 + lane; e < SG * 16 * SP; e += NGW * 64) {
          const int g = e >> 10, i = (e >> 6) & 15, p = e & 63;
          const double lr = a_re[g * SP + p], li = a_im[g * SP + p], dt = exp((double)log_dt[g]);
          const double tt = (double)(i + 1), et = exp(lr * dt * tt); const float pr = (float)(et * cos(li * dt * tt)), pi_ = (float)(et * sin(li * dt * tt));
          float crv[16], civ[16];
#pragma unroll
          for (int co = 0; co < 16; ++co) { crv[co] = c_re[(g * SC + co) * SP + p]; civ[co] = c_im[(g * SC + co) * SP + p]; }
#pragma unroll
          for (int co = 0; co < 16; ++co) { const float cr = crv[co], cim = civ[co];
              bf16* row = BTB + ((size_t)g * 256 + i * 16 + co) * 384 + 256;
              row[p] = (bf16)f2bf(cr * pr - cim * pi_); row[64 + p] = (bf16)f2bf(-(cr * pi_ + cim * pr)); }
      }
      float* LAMC = (float*)(ws + WS_LAMC);
      for (int e = gw * 64 + lane; e < SG * SP; e += NGW * 64) {
          const double lr = a_re[e], li = a_im[e], dt = exp((double)log_dt[e >> 6]), et = exp(lr * dt * 16.0);
          LAMC[2 * e] = (float)(et * cos(li * dt * 16.0)); LAMC[2 * e + 1] = (float)(et * sin(li * dt * 16.0)); }
    }
}
__device__ __forceinline__ bool wt_one(const Args& args, LAS float* scr, unsigned mask, int it, int lane) {
    constexpr int NMAT = 18; int base = 0;
    for (int mi = 0; mi < NMAT; ++mi) { if (!((mask >> mi) & 1u)) continue;
        const WtDesc d = wt_desc(args, mi); const int n_it = (d.K / 64) * (d.Ndst / 32);
        if (it < base + n_it) { const int r = it - base, nblk = d.Ndst / 32, kb = r / nblk, nb = r % nblk, n0 = nb * 32; int ns = n0;
            if (d.kind == 1) { const int pn = n0 >> 8, j = n0 & 255; ns = (j < 128) ? (128 * pn + j) : (d.off2 + 128 * pn + (j - 128)); }
            wt_item(d.W, d.ldw, d.K, d.gain, d.WT, n0, ns, kb * 64, scr, lane); return true; }
        base += n_it; }
    return false;
}
struct WtWork { const float* gain; bf16* WT; int K, n0, k0; bool ok; };
__device__ __forceinline__ WtWork wt_fetch(const Args& args, unsigned mask, int it, f32x4 (&v)[8], int lane) {
    constexpr int NMAT = 18; int base = 0; WtWork w{}; w.ok = false;
    for (int mi = 0; mi < NMAT; ++mi) { if (!((mask >> mi) & 1u)) continue;
        const WtDesc d = wt_desc(args, mi); const int n_it = (d.K / 64) * (d.Ndst / 32);
        if (it < base + n_it) { const int r = it - base, nblk = d.Ndst / 32, kb = r / nblk, nb = r % nblk, n0 = nb * 32; int ns = n0;
            if (d.kind == 1) { const int pn = n0 >> 8, j = n0 & 255; ns = (j < 128) ? (128 * pn + j) : (d.off2 + 128 * pn + (j - 128)); }
            wt_load(v, d.W, d.ldw, ns, kb * 64, lane); w.gain = d.gain; w.WT = d.WT; w.K = d.K; w.n0 = n0; w.k0 = kb * 64; w.ok = true; return w; }
        base += n_it; }
    return w;
}
__device__ __forceinline__ void ph_weights(const Args& args, LAS float* scr, unsigned mask, int rk, int nw, int lane) {
    f32x4 va[8], vb[8];
    WtWork wa = wt_fetch(args, mask, rk, va, lane);
    for (int it = rk; wa.ok; it += 2 * nw) {
        WtWork wb = wt_fetch(args, mask, it + nw, vb, lane);
        wt_store(va, wa.K, wa.gain, wa.WT, wa.n0, wa.k0, scr, lane);
        if (!wb.ok) break;
        wa = wt_fetch(args, mask, it + 2 * nw, va, lane);
        wt_store(vb, wb.K, wb.gain, wb.WT, wb.n0, wb.k0, scr, lane);
    }
}
__device__ __forceinline__ void ph_wf(const Args& args, int j, int rk, int nw, int lane) {
    for (int e = rk * 64 + lane; e < NH * D; e += nw * 64) { const int h = e >> 10, kk = e & 1023;
        ((bf16*)(args.ws + WS_WF))[j * NH * D + e] = (bf16)f2bf(args.in[4][(size_t)j * D * FOX_IN + (size_t)kk * FOX_IN + 3 * D + h] * args.in[1][(j ? 3 * D : 0) + kk]); }
}
constexpr unsigned WMASK_PRO = (1u << 0);
constexpr unsigned WMASK_ATT = (1u << 2) | (1u << 10) | (1u << 4) | (1u << 5);
constexpr int WATT_ITEMS = 16 * 32 + 16 * 176 + 16 * 32 + 16 * 64;
constexpr unsigned WMASK_L0 = (1u << 14) | (1u << 11);
constexpr unsigned WMASK_L1 = (1u << 15) | (1u << 6) | (1u << 7) | (1u << 8) | (1u << 9) | (1u << 12);
constexpr unsigned WMASK_L2 = (1u << 16) | (1u << 1) | (1u << 3) | (1u << 13);
constexpr unsigned WMASK_L3 = (1u << 17);
__device__ __forceinline__ void ph_prologue(const Args& args, LAS unsigned char* lds, int gw, int NGW, int wave, int lane) {
    unsigned char* ws = args.ws;
    LAS float* scr = (LAS float*)(lds + RING_OFF + wave * 16384);
    ph_weights(args, scr, MK_DEFER_WEIGHTS ? WMASK_PRO : 0x3ffffu, gw, NGW, lane);
    ph_wf(args, 0, gw, NGW, lane); if (!MK_DEFER_WEIGHTS) ph_wf(args, 1, gw, NGW, lane);
    for (int rep_ = 0; rep_ < MK_S5TAB_REPS; ++rep_) ph_s5tables(args, scr, (LAS float*)(lds + LDSCTL_OFF + 8192 + wave * 512), gw, NGW, lane);
    pg8::ssq_t* ssq0 = (pg8::ssq_t*)(ws + WS_SSQ);
    for (int m = gw; m < M; m += NGW) normx_row(args.in[0] + (size_t)m * D, (bf16*)(ws + WS_XB) + (size_t)m * D, ssq0 + m, lane);
}

__device__ __forceinline__ void ph_toeplitz(unsigned char* ws, int rk, int nw, int lane) {
    const float* KERN = (const float*)(ws + WS_KERN); bf16* BTB = (bf16*)(ws + WS_BTB);
    for (int e2 = rk * 64 + lane; e2 < SG * 256 * 16; e2 += nw * 64) { const int g = e2 >> 12, n = (e2 >> 4) & 255, j = e2 & 15, i = n >> 4, co = n & 15;
        v4u o0 = {0u, 0u, 0u, 0u}, o1 = {0u, 0u, 0u, 0u};
        if (i >= j) { const f32x4* kp = (const f32x4*)(KERN + (((size_t)g * 16 + (i - j)) * 16 + co) * 16); const f32x4 a = kp[0], b = kp[1], c = kp[2], d = kp[3];
            o0 = (v4u){pk2(a[0], a[1]), pk2(a[2], a[3]), pk2(b[0], b[1]), pk2(b[2], b[3])}; o1 = (v4u){pk2(c[0], c[1]), pk2(c[2], c[3]), pk2(d[0], d[1]), pk2(d[2], d[3])}; }
        v4u* dst = (v4u*)(BTB + ((size_t)g * 256 + n) * 384 + j * 16); dst[0] = o0; dst[1] = o1; }
}
__global__ void __launch_bounds__(NWAVES * 64, 2) mega_k(Args args) {
    extern __shared__ __attribute__((aligned(16))) unsigned char lds_raw[];
    LAS unsigned char* lds = (LAS unsigned char*)lds_raw;
    const int vcu0 = (gridDim.x % 8 == 0) ? (blockIdx.x % 8) * (gridDim.x / 8) + blockIdx.x / 8 : blockIdx.x;
    const int vcu = vcu0, NGW = gridDim.x * NWAVES, wave0 = __builtin_amdgcn_readfirstlane(threadIdx.x >> 6);
    for (int u = threadIdx.x; u < (LDS_BYTES - LDSCTL_OFF) / 4; u += NWAVES * 64) ((LAS unsigned*)(lds + LDSCTL_OFF))[u] = 0u;
    __syncthreads();
    MK_BAR_SETUP();
    int e0 = args.ph_lo;
    if (e0 == PH_S5TAB) { const int tid = threadIdx.x, lane = tid & 63, wave = __builtin_amdgcn_readfirstlane(tid >> 6); ph_s5tables(args, (LAS float*)(lds + RING_OFF + wave * 16384), (LAS float*)(lds + LDSCTL_OFF + 8192 + wave * 512), vcu * NWAVES + wave, NGW, lane); return; }
    if (e0 == 0) {
        const int tid = threadIdx.x, lane = tid & 63, wave = __builtin_amdgcn_readfirstlane(tid >> 6);
        ph_prologue(args, lds, vcu * NWAVES + wave, NGW, wave, lane);
        e0 = 1;
        if (e0 < args.ph_hi) { MK_GRID_BAR(); }
    }
    for (int e = e0; e < args.ph_hi; ++e) {
#define MK_LANE_TID() int lane_; asm volatile("v_mbcnt_lo_u32_b32 %0, -1, 0\n\tv_mbcnt_hi_u32_b32 %0, -1, %0" : "=v"(lane_)); const int lane = lane_, tid = wave * 64 + lane, gw = vcu * NWAVES + wave; (void)tid; (void)gw; (void)lane
        const int wave = wave0;
        int G = gridDim.x, bx = blockIdx.x, vcu = vcu0; asm volatile("" : "+s"(G), "+s"(bx), "+s"(vcu));
        const int NGW = G * NWAVES;
        unsigned char* ws = args.ws; float* X = args.out; asm volatile("" : "+s"(ws), "+s"(X));
        pg8::ssq_t* SSQ = (pg8::ssq_t*)(ws + WS_SSQ);
        const int op = PROG[e].op, layer = PROG[e].layer, pj = PROG[e].j, sin = PROG[e].sin, sout = PROG[e].sout;
#define MK_XBS(s_) ((s_) == 5 ? (bf16*)(ws + WS_O) : (bf16*)(ws + WS_XB))
#define MK_XBO(s_) (MK_JUNK ? (bf16*)X + (size_t)M * D : MK_XBS(s_))
#define MK_SSQO(s_) (SSQ + (size_t)(MK_JUNK ? 12 : (s_)) * M)
        bf16* XB = MK_XBS(sin);
        (void)pj;
        if (op == OP_NORMX) {
            MK_LANE_TID();
            for (int m = gw; m < M; m += NGW) normx_row(X + (size_t)m * D, XB + (size_t)m * D, SSQ + (size_t)sout * M + m, lane);
        } else if (op == OP_UP) {
            MK_LANE_TID();
            pg8::Gemm g{XB, (const bf16*)(ws + WS_WGU) + (size_t)layer * 2 * DFF * D, D, D, D, 0, 0};
            pg8::StaticOrder S; S.init(M / 256, 2 * DFF / 256, G, bx);
            pg8::EpiSwiGLU E{(bf16*)(ws + WS_ACT), DFF, SSQ + (size_t)sin * M, MK_UP_DUMMY};
            pg8::gemm_phase<pg8::EpiSwiGLU, pg8::StaticOrder, MK_ALIGN_UP>(lds + RING_OFF, tid, g, S, E);
            if (MK_DEFER_WEIGHTS && bx >= 128 && !(MK_UP_DUMMY)) {
                LAS float* scr = (LAS float*)(lds + RING_OFF + wave * 16384); const int rk = (bx - 128) * NWAVES + wave;
                ph_weights(args, scr, layer == 0 ? WMASK_L0 : layer == 1 ? WMASK_L1 : layer == 2 ? WMASK_L2 : WMASK_L3, rk, 128 * NWAVES, lane);
                if (layer == 2) ph_wf(args, 1, rk, 128 * NWAVES, lane); }
        } else if (op == OP_DOWN) {
            MK_LANE_TID();
            pg8::Gemm g{(const bf16*)(ws + WS_ACT), (const bf16*)(ws + WS_WDN) + (size_t)layer * D * DFF, DFF, DFF, DFF, 0, 0};
            pg8::StaticOrder S; S.init(M / 256, D / 256, G, bx);
            if (layer == 3 && !(MK_JUNK)) {
                pg8::EpiResidFinal E{MK_XBS(sout - 1), X, SSQ + (size_t)sout * M, args.in[3], (unsigned*)(ws + WS_CTL) + CW_PANEL};
                pg8::gemm_phase<pg8::EpiResidFinal, pg8::StaticOrder, false>(lds + RING_OFF, tid, g, S, E);
            } else {
                pg8::EpiResid<0> E{MK_XBS(sout - 1), MK_XBO(sout), MK_SSQO(sout), args.in[18], nullptr, MK_UP_DUMMY};
                pg8::gemm_phase<pg8::EpiResid<0>, pg8::StaticOrder, true>(lds + RING_OFF, tid, g, S, E); }
        }
        else if (op == OP_QKV) {
            MK_LANE_TID();
            if (MK_TOUCH) touch_lines(XB + (size_t)(8 * (bx & 7) + ((bx >> 3) & 7)) * 256 * D, 256 * D * 2, tid);
            if (!(MK_QKV_NOGATES)) {
              const bf16* WfT = (const bf16*)(ws + WS_WF) + (size_t)pj * NH * D; const pg8::ssq_t* ssq = SSQ + (size_t)sin * M; const float* bfp = args.in[5] + pj * NH; float* LF = (float*)(ws + WS_LF);
#pragma unroll
              for (int i = 0; i < 4; ++i) { const int c = tid + 512 * i; *(LAS v4u*)(lds + (c >> 7) * 2064 + (c & 127) * 16) = ((const GAS v4u*)WfT)[c]; }
              LDS_WAIT(); __syncthreads();
              if (wave < 4) {
                const int r0 = (vcu * 4 + wave) * 16, kq = lane >> 4; const GAS bf16x8* ap = (const GAS bf16x8*)(XB + (size_t)(r0 + (lane & 15)) * D + kq * 8); const LAS unsigned char* bp = lds + (lane & 15) * 2064 + kq * 16;
                bf16x8 afr[32];
#pragma unroll
                for (int ks = 0; ks < 32; ++ks) afr[ks] = ap[ks * 4];
                f32x4 acc = {0.f, 0.f, 0.f, 0.f};
#pragma unroll
                for (int ks = 0; ks < 32; ++ks) acc = __builtin_amdgcn_mfma_f32_16x16x32_bf16(afr[ks], *(const LAS bf16x8*)(bp + ks * 64), acc, 0, 0, 0);
                const int rr = r0 + 4 * kq, hh = lane & 15; const float bb = bfp[hh]; f32x4 o;
#pragma unroll
                for (int i = 0; i < 4; ++i) { const float z = acc[i] * pg8::rstd_row(ssq, rr + i) + bb; o[i] = fminf(z, 0.f) - log1pf(expf(-fabsf(z))); }
                pg8::st_wt((GAS float*)LF + ((size_t)(rr / SEQ) * NH + hh) * SEQ + (rr % SEQ), o); }
              LDS_WAIT(); __syncthreads(); }
            pg8::Gemm g{XB, (const bf16*)(ws + WS_WQKV) + (size_t)pj * 3 * D * D, D, D, D, 0, 0};
            pg8::StaticOrder S; S.init(M / 256, 3 * D / 256, G, bx);
            pg8::EpiQKV E{(bf16*)(ws + WS_ACT), (size_t)16 * MiB, SSQ + (size_t)sin * M, attn_body::C2, (float*)(ws + WS_NRM), MK_UP_DUMMY};
            pg8::gemm_phase<pg8::EpiQKV, pg8::StaticOrder, true>(lds + RING_OFF, tid, g, S, E);
        } else if (op == OP_ATTN) {
            MK_LANE_TID();
#if MK_ATT_DYN
            LAS float* bl = (LAS float*)(lds + RING_OFF + attn_body::ATTN_LDS_BYTES);
            LAS int* tsk = (LAS int*)(lds + LDSCTL_OFF + 12288); LAS float* kn = (LAS float*)(lds + LDSCTL_OFF + 12288 + 64); LAS float* qn = kn + 64;
            unsigned* hq = (unsigned*)(ws + WS_CTL) + CW_HQ + pj * 2048 + (MK_JUNK ? 4096 : 0);
            const attn_body::AttnTensors AT{(const attn_body::bf16*)(ws + WS_ACT), (const attn_body::bf16*)(ws + WS_ACT + 32 * MiB), (const attn_body::bf16*)(ws + WS_ACT + 64 * MiB), (attn_body::bf16*)(ws + WS_O)};
            const int home = vcu >> 2; int cur = home, built = -1;
            for (;;) {
                int ln_; asm volatile("v_mbcnt_lo_u32_b32 %0, -1, 0\n\tv_mbcnt_hi_u32_b32 %0, -1, %0" : "=v"(ln_)); const int ln = ln_, td = wave * 64 + ln_;
                if (wave == 0) {
                    int c = cur, idx = 0;
                    for (int att = 0; ; ++att) {
                        unsigned i0 = 0; if (ln == 0) i0 = __hip_atomic_fetch_add(hq + c * 32, 1u, __ATOMIC_RELAXED, __HIP_MEMORY_SCOPE_AGENT); i0 = (unsigned)__builtin_amdgcn_readfirstlane((int)i0);
                        if (i0 < 16u) { idx = (int)i0; break; }
                        if (att == 6) { c = -1; break; }
                        unsigned cnt = __hip_atomic_load(hq + ln * 32, __ATOMIC_RELAXED, __HIP_MEMORY_SCOPE_AGENT); cnt = cnt > 16u ? 16u : cnt;
                        unsigned key = cnt * 64u + (unsigned)((ln - home) & 63);
#pragma unroll
                        for (int o = 1; o < 64; o <<= 1) { const unsigned k2 = (unsigned)__builtin_amdgcn_ds_bpermute((ln ^ o) << 2, (int)key); key = k2 < key ? k2 : key; }
                        key = (unsigned)__builtin_amdgcn_readfirstlane((int)key);
                        if ((key >> 6) >= 16u) { c = -1; break; }
                        c = (home + (int)(key & 63u)) & 63;
                    }
                    if (ln == 0) { tsk[8] = c; tsk[9] = idx; }
                }
                LDS_WAIT(); __syncthreads();
                const int c = __builtin_amdgcn_readfirstlane(tsk[8]), idx = __builtin_amdgcn_readfirstlane(tsk[9]);
                if (c < 0) break;
                cur = c;
                const int hd = c & 15; const size_t rb = (size_t)(c >> 4) * SEQ;
                if (c != built) { built = c;
                    { const float* lf = (const float*)(ws + WS_LF) + (size_t)c * SEQ + td * 8; LAS float* wt = (LAS float*)(lds + LDSCTL_OFF + 1024);
                      const f32x4 a = *(const GAS f32x4*)lf, b = *(const GAS f32x4*)(lf + 4);
                      float p[8]; p[0] = a[0]; p[1] = p[0] + a[1]; p[2] = p[1] + a[2]; p[3] = p[2] + a[3]; p[4] = p[3] + b[0]; p[5] = p[4] + b[1]; p[6] = p[5] + b[2]; p[7] = p[6] + b[3];
                      float tot = p[7];
#pragma unroll
                      for (int o = 1; o < 64; o <<= 1) { const float u = __builtin_bit_cast(float, __builtin_amdgcn_ds_bpermute((ln - o) << 2, __builtin_bit_cast(int, tot))); if (ln >= o) tot += u; }
                      if (ln == 63) wt[wave] = tot;
                      LDS_WAIT(); __syncthreads();
                      float off = tot - p[7];
                      for (int w = 0; w < wave; ++w) off += wt[w];
#pragma unroll
                      for (int i = 0; i < 8; ++i) bl[td * 8 + i] = -(p[i] + off) * 1.4426950408889634f; }
                    { const GAS f32x2* Nk = (const GAS f32x2*)(ws + WS_NRM) + ((size_t)(4 + (hd >> 2)) * M + rb) * 4 + (hd & 3); f32x2 v[8];
#pragma unroll
                      for (int i = 0; i < 8; ++i) v[i] = Nk[(size_t)(td * 8 + i) * 4];
                      float mx = 0.f;
#pragma unroll
                      for (int i = 0; i < 8; ++i) mx = fmaxf(mx, v[i].x + v[i].y);
                      mx = fmaxf(mx, lshx(mx, ln, 1)); mx = fmaxf(mx, lshx(mx, ln, 2)); mx = fmaxf(mx, lshx(mx, ln, 4));
                      if ((ln & 7) == 0) kn[td >> 3] = mx; } }
                const int qb = 15 - idx, nt = 4 * qb + 4;
                { const GAS f32x2* Nq = (const GAS f32x2*)(ws + WS_NRM) + ((size_t)(hd >> 2) * M + rb) * 4 + (hd & 3);
                  float mx = 0.f; if (td < 256) { const f32x2 v = Nq[(size_t)(qb * 256 + td) * 4]; mx = v.x + v.y; }
#pragma unroll
                  for (int o = 1; o < 64; o <<= 1) mx = fmaxf(mx, lshx(mx, ln, o));
                  if (ln == 0) qn[wave] = mx; }
                LDS_WAIT(); __syncthreads();
                if (wave == 0) {
                    float q2 = (ln < 8) ? qn[ln] : 0.f, k2 = (ln < nt) ? kn[ln] : 0.f;
#pragma unroll
                    for (int o = 1; o < 64; o <<= 1) { q2 = fmaxf(q2, lshx(q2, ln, o)); k2 = fmaxf(k2, lshx(k2, ln, o)); }
                    const float lim = MK_SKIP_QK * sqrtf(q2) * sqrtf(k2) * 1.01f + 30.0f, bq = bl[qb * 256];
                    const int ts = 2 * ln;
                    const bool okc = (ts + 2 <= nt - 4) && (bq - bl[64 * (ts + 1) + 63] >= lim);
                    const int cntc = __builtin_popcountll(__ballot(okc));
                    if (ln == 0) tsk[0] = 2 * cntc; }
                LDS_WAIT(); __syncthreads();
                attn_body::attn_unit<MK_THRL>(c >> 4, hd, qb, AT.Q, AT.K, AT.V, AT.O, (char*)lds_raw + RING_OFF, bl, td, __builtin_amdgcn_readfirstlane(tsk[0]));
            }
#else
            LAS float* bl = (LAS float*)(lds + RING_OFF + attn_body::ATTN_LDS_BYTES);
            { const float* lf = (const float*)(ws + WS_LF) + (size_t)(vcu >> 2) * SEQ + tid * 8; LAS float* wt = (LAS float*)(lds + LDSCTL_OFF + 1024);
              const f32x4 a = *(const f32x4*)lf, b = *(const f32x4*)(lf + 4);
              float p[8]; p[0] = a[0]; p[1] = p[0] + a[1]; p[2] = p[1] + a[2]; p[3] = p[2] + a[3]; p[4] = p[3] + b[0]; p[5] = p[4] + b[1]; p[6] = p[5] + b[2]; p[7] = p[6] + b[3];
              float tot = p[7];
#pragma unroll
              for (int o = 1; o < 64; o <<= 1) { const float u = __builtin_bit_cast(float, __builtin_amdgcn_ds_bpermute((lane - o) << 2, __builtin_bit_cast(int, tot))); if (lane >= o) tot += u; }
              if (lane == 63) wt[wave] = tot;
              LDS_WAIT(); __syncthreads();
              float off = tot - p[7];
              for (int w = 0; w < wave; ++w) off += wt[w];
#pragma unroll
              for (int i = 0; i < 8; ++i) bl[tid * 8 + i] = -(p[i] + off) * 1.4426950408889634f;
              LDS_WAIT(); __syncthreads(); }
            LAS int* tsk = (LAS int*)(lds + LDSCTL_OFF + 12288);
            for (int prep_ = 0; prep_ < MK_PREPASS_REPS; ++prep_) { LAS float* kn = (LAS float*)(lds + LDSCTL_OFF + 12288 + 64); LAS float* qn = kn + 64;
              const int bh = vcu >> 2, sq = vcu & 3; const size_t rb = (size_t)(bh >> 4) * SEQ; const int hc = (bh & 15) * HD + (lane & 7) * 8;
              (void)hc;
              const int hd = bh & 15; const GAS f32x2* Nk = (const GAS f32x2*)(ws + WS_NRM) + ((size_t)(4 + (hd >> 2)) * M + rb) * 4 + (hd & 3); const GAS f32x2* Nq = (const GAS f32x2*)(ws + WS_NRM) + ((size_t)(hd >> 2) * M + rb) * 4 + (hd & 3);
              { f32x2 v[8];
#pragma unroll
                for (int i = 0; i < 8; ++i) v[i] = Nk[(size_t)(tid * 8 + i) * 4];
                float mx = 0.f;
#pragma unroll
                for (int i = 0; i < 8; ++i) mx = fmaxf(mx, v[i].x + v[i].y);
                mx = fmaxf(mx, lshx(mx, lane, 1)); mx = fmaxf(mx, lshx(mx, lane, 2)); mx = fmaxf(mx, lshx(mx, lane, 4));
                if ((lane & 7) == 0) kn[tid >> 3] = mx; }
              { f32x2 v[2]; const int i = wave >> 1, qb = (i == 0) ? sq : (i == 1) ? 7 - sq : (i == 2) ? 8 + sq : 15 - sq;
#pragma unroll
                for (int jj = 0; jj < 2; ++jj) v[jj] = Nq[(size_t)(qb * 256 + (wave & 1) * 128 + lane * 2 + jj) * 4];
                float mx = fmaxf(v[0].x + v[0].y, v[1].x + v[1].y);
#pragma unroll
                for (int o = 1; o < 64; o <<= 1) mx = fmaxf(mx, lshx(mx, lane, o));
                if (lane == 0) qn[i * 8 + (wave & 1)] = mx; if (lane == 1) { qn[i * 8 + 2 + (wave & 1) * 3] = 0.f; qn[i * 8 + 3 + (wave & 1) * 3] = 0.f; qn[i * 8 + 4 + (wave & 1) * 3] = 0.f; } }
              LAS float* kbs = (LAS float*)(lds + LDSCTL_OFF + 13312);
              { const int i = wave >> 1, qb = (i == 0) ? sq : (i == 1) ? 7 - sq : (i == 2) ? 8 + sq : 15 - sq; float cs[8];
#pragma unroll
                for (int e2 = 0; e2 < 8; ++e2) cs[e2] = 0.f;
                if (qb > 0) { const GAS pg8::u32x4* kp = (const GAS pg8::u32x4*)((const bf16*)(ws + WS_ACT + 32 * MiB) + (rb + (size_t)(qb * 256 - 64)) * D + hd * HD); pg8::u32x4 w[4];
#pragma unroll
                    for (int k4 = 0; k4 < 4; ++k4) { const int pc = (wave & 1) * 64 + lane + 128 * k4; w[k4] = kp[(size_t)(pc >> 3) * (D / 8) + (pc & 7)]; }
#pragma unroll
                    for (int k4 = 0; k4 < 4; ++k4) { f32x4 lo, hi2; pg8::bf8_to_f32(w[k4], lo, hi2); cs[0] += lo[0]; cs[1] += lo[1]; cs[2] += lo[2]; cs[3] += lo[3]; cs[4] += hi2[0]; cs[5] += hi2[1]; cs[6] += hi2[2]; cs[7] += hi2[3]; } }
#pragma unroll
                for (int e2 = 0; e2 < 8; ++e2) { cs[e2] += lshx(cs[e2], lane, 8); cs[e2] += lshx(cs[e2], lane, 16); cs[e2] += lshx(cs[e2], lane, 32); }
                if (lane < 8) {
#pragma unroll
                    for (int e2 = 0; e2 < 8; ++e2) kbs[wave * 64 + lane * 8 + e2] = cs[e2]; } }
              LDS_WAIT(); __syncthreads();
              if (wave < 4) { const int i = wave, qb = (i == 0) ? sq : (i == 1) ? 7 - sq : (i == 2) ? 8 + sq : 15 - sq, nt = 4 * qb + 4;
                  float q2 = (lane < 8) ? qn[i * 8 + lane] : 0.f, k2 = (lane < nt) ? kn[lane] : 0.f;
#pragma unroll
                  for (int o = 1; o < 64; o <<= 1) { q2 = fmaxf(q2, lshx(q2, lane, o)); k2 = fmaxf(k2, lshx(k2, lane, o)); }
                  float kb = kbs[(2 * i) * 64 + lane] + kbs[(2 * i + 1) * 64 + lane]; kb = kb * kb * (1.0f / 4096.0f);
                  float mb = (qb > 0) ? bl[(4 * qb - 1) * 64 + lane] : 0.f;
#pragma unroll
                  for (int o = 1; o < 64; o <<= 1) { kb += lshx(kb, lane, o); mb += lshx(mb, lane, o); }
                  mb *= (1.0f / 64.0f);
                  const float lim = sqrtf(q2) * (sqrtf(k2) + sqrtf(kb)) * 1.01f + 30.0f;
                  const int ts = 2 * lane;
                  const bool okc = (ts + 2 <= nt - 4) && (mb - bl[64 * (ts + 1) + 63] >= lim);
                  const int cntc = __builtin_popcountll(__ballot(okc));
                  if (lane == 0) tsk[i] = 2 * cntc; }
              LDS_WAIT(); __syncthreads(); }
            const attn_body::AttnTensors AT{(const attn_body::bf16*)(ws + WS_ACT), (const attn_body::bf16*)(ws + WS_ACT + 32 * MiB), (const attn_body::bf16*)(ws + WS_ACT + 64 * MiB), (attn_body::bf16*)(ws + WS_O)};
            const attn_body::StaticOrder S(G, bx);
            attn_body::attn_phase<attn_body::StaticOrder, MK_THRL>((char*)lds_raw + RING_OFF, AT, S, bl, tid, tsk);
#endif
            if (MK_DEFER_WEIGHTS && layer == 0) {
                LAS float* scr = (LAS float*)(lds + RING_OFF + wave * 16384); unsigned* q = (unsigned*)(ws + WS_CTL) + CW_QUEUE;
                for (;;) { unsigned b0 = 0; if (lane == 0) b0 = __hip_atomic_fetch_add(q, 4u, __ATOMIC_RELAXED, __HIP_MEMORY_SCOPE_AGENT); b0 = (unsigned)__builtin_amdgcn_readfirstlane((int)b0);
                    if (b0 >= (unsigned)WATT_ITEMS) break;
                    for (int i = 0; i < 4; ++i) if (!wt_one(args, scr, WMASK_ATT, (int)b0 + i, lane)) break; } }
        } else if (op == OP_WO) {
            MK_LANE_TID();
            pg8::Gemm g{(const bf16*)(ws + WS_O), (const bf16*)(ws + WS_WO) + (size_t)pj * D * D, D, D, D, 0, 0};
            pg8::StaticOrder S; S.init(M / 256, D / 256, G, bx);
            pg8::EpiResid<0> E{MK_XBS(sout - 1), MK_XBO(sout), MK_SSQO(sout), args.in[18], nullptr, MK_UP_DUMMY};
            pg8::gemm_phase<pg8::EpiResid<0>, pg8::StaticOrder, true>(lds + RING_OFF, tid, g, S, E);
        }
        else if (op == OP_S5IN) {
            MK_LANE_TID();
            ph_toeplitz(ws, gw, NGW, lane);
            pg8::Gemm g{XB, (const bf16*)(ws + WS_WS5IN), D, D, D, 0, 0};
            pg8::StaticOrder S; S.init(M / 256, D / 256, G, bx);
            pg8::EpiU E{(bf16*)(ws + WS_ACT), SSQ + (size_t)sin * M};
            pg8::gemm_phase<pg8::EpiU, pg8::StaticOrder, true>(lds + RING_OFF, tid, g, S, E);
        } else if (op == OP_SSM) {
            MK_LANE_TID();
            pg8::StaticOrder S; S.init(BATCH, SG, G, bx);
            { pg8::Gemm g{(const bf16*)(ws + WS_ACT), (const bf16*)(ws + WS_BTA), 256, 384, 256, 0, 1024 * 384 * 2};
              pg8::EpiSloc E{(const float*)(ws + WS_LAMC), (bf16*)(ws + WS_ACT), lds + LDSCTL_OFF + 2048};
              pg8::gemm_phase<pg8::EpiSloc, pg8::StaticOrder, false>(lds + RING_OFF, tid, g, S, E); }
            { pg8::Gemm g{(const bf16*)(ws + WS_ACT), (const bf16*)(ws + WS_BTB), 384, 384, 384, 0, 1024 * 384 * 2};
              pg8::EpiY E{(const bf16*)(ws + WS_ACT), args.in[15], (bf16*)(ws + WS_ACT + 48 * MiB)};
              pg8::gemm_phase<pg8::EpiY, pg8::StaticOrder, true>(lds + RING_OFF, tid, g, S, E); }
        } else if (op == OP_GLU) {
            MK_LANE_TID();
            pg8::Gemm g{(const bf16*)(ws + WS_ACT + 48 * MiB), (const bf16*)(ws + WS_WGLU), D, MK_G1_NATURAL ? D : 16, D, MK_G1_NATURAL ? 0 : M * 16, 0};
            pg8::StaticOrder S; S.init(M / 256, 2 * D / 256, G, bx);
            pg8::EpiResid<1> E{MK_XBS(sout - 1), MK_XBO(sout), MK_SSQO(sout), args.in[18], nullptr, MK_UP_DUMMY};
            pg8::gemm_phase<pg8::EpiResid<1>, pg8::StaticOrder, true>(lds + RING_OFF, tid, g, S, E);
        }
        else if (op == OP_POOLPREP) {
        } else if (op == OP_POOLGEMM) {
            MK_LANE_TID();
            pg8::StaticOrder S; S.init(M / 256, 4, G, bx);
            { pg8::Unit u0; if (S.next(0, u0)) { const pg8::ssq_t* ssq = SSQ + (size_t)sin * M; const float* gain = args.in[1] + (size_t)layer * D; bf16* PD = (bf16*)(ws + WS_ACT);
                const int gi = u0.pn, c0 = gi * 256 + lane * 4; const f32x4 gg = *(const f32x4*)(gain + c0);
                for (int ci = wave; ci < 16; ci += NWAVES) { const int row0 = u0.pm * 256 + ci * 16, t0 = row0 & (SEQ - 1);
                    if (gi == 0) pool_item<2>(XB, ssq, gg, PD, row0, t0, c0); else if (gi == 1) pool_item<4>(XB, ssq, gg, PD, row0, t0, c0);
                    else if (gi == 2) pool_item<8>(XB, ssq, gg, PD, row0, t0, c0); else pool_item<16>(XB, ssq, gg, PD, row0, t0, c0); } }
              asm volatile("s_waitcnt vmcnt(0)" ::: "memory"); __syncthreads();
              if (wave == 0) { __builtin_amdgcn_fence(__ATOMIC_ACQUIRE, "agent"); asm volatile("s_waitcnt vmcnt(0)" ::: "memory"); }
              __syncthreads(); }
            pg8::Gemm g{(const bf16*)(ws + WS_ACT), (const bf16*)(ws + WS_WPOOL), 256, D, 256, 0, 512};
            pg8::EpiResid<2> E{MK_XBS(sout - 1), MK_XBS(sout), SSQ + (size_t)sout * M, args.in[18], args.in[19], 0};
            pg8::gemm_phase<pg8::EpiResid<2>, pg8::StaticOrder, true>(lds + RING_OFF, tid, g, S, E);
        } else if (op == OP_FINAL) {
            MK_LANE_TID();
            { const pg8::ssq_t* ssq = SSQ + (size_t)sin * M; const float* gain = args.in[3];
              for (int m = gw; m < M; m += NGW) { const float rs = pg8::rstd_row(ssq, m); f32x4* xr = (f32x4*)(X + (size_t)m * D) + lane; const f32x4* gr = (const f32x4*)gain + lane;
#pragma unroll
                  for (int j = 0; j < 4; ++j) xr[64 * j] = xr[64 * j] * rs * gr[64 * j]; } }
        }
        if (e + 1 < args.ph_hi) { MK_GRID_BAR(); }
    }
}
}
extern "C" void kernel_launch(void* const* d_in, const int* in_sizes, int n_in, void* d_out, int out_size, void* d_ws, size_t ws_size, hipStream_t stream) {
    static int grid = 0;
    if (grid == 0) {
        int dev = 0, cus = 0, per_cu = 0;
        if (hipGetDevice(&dev) != hipSuccess || hipDeviceGetAttribute(&cus, hipDeviceAttributeMultiprocessorCount, dev) != hipSuccess) { grid = -1; return; }
        if (hipFuncSetAttribute((const void*)mk::mega_k, hipFuncAttributeMaxDynamicSharedMemorySize, mk::LDS_BYTES) != hipSuccess) { grid = -1; return; }
        if (hipOccupancyMaxActiveBlocksPerMultiprocessor(&per_cu, (const void*)mk::mega_k, mk::NWAVES * 64, mk::LDS_BYTES) != hipSuccess || per_cu < 1) { fprintf(stderr, "kernel_launch: occupancy query says %d blocks per CU\n", per_cu); grid = -1; (void)hipGetLastError(); return; }
        (void)hipGetLastError();
        grid = cus;
        if (n_in != 22 || ws_size < mk::WS_END || cus != 256 || in_sizes[0] != mk::M * mk::D || out_size != mk::M * mk::D) { fprintf(stderr, "kernel_launch: unexpected n_in %d / ws_size %zu / CUs %d\n", n_in, ws_size, cus); grid = -1; }
    }
    if (grid < 0) return;
    (void)hipMemsetAsync((char*)d_ws + mk::WS_CTL, 0, mk::CTL_ZERO_BYTES, stream);
    mk::Args a{};
    for (int i = 0; i < 22; ++i) a.in[i] = (const float*)d_in[i];
    a.out = (float*)d_out; a.ws = (unsigned char*)d_ws;
#if MK_ONE_LAUNCH
    a.ph_lo = 0; a.ph_hi = mk::PH_LAST + 1;
    void* kargs[] = {&a};
    const hipError_t e = hipLaunchCooperativeKernel((const void*)mk::mega_k, dim3(grid), dim3(mk::NWAVES * 64), kargs, mk::LDS_BYTES, stream);
    if (e != hipSuccess) fprintf(stderr, "kernel_launch: cooperative launch failed: %s\n", hipGetErrorString(e));
#else
    for (int ph = 0; ph <= mk::PH_LAST; ++ph) { a.ph_lo = ph; a.ph_hi = ph + 1; hipLaunchKernelGGL(mk::mega_k, dim3(grid), dim3(mk::NWAVES * 64), mk::LDS_BYTES, stream, a);
    }
#endif
}
```

```cpp
#include <hip/hip_runtime.h>
#include <hip/hip_cooperative_groups.h>
#include <cstdio>
#include <cstdint>
#include <cmath>
#define MK_BAR_SETUP() cooperative_groups::grid_group mk_grid = cooperative_groups::this_grid(); bool mk_first = true; \
    XcdBarrier mk_bar = xcd_barrier_post((unsigned*)(args.ws + WS_CTL) + CW_BAR, (volatile LAS unsigned*)(lds + MISC_OFF) + 8)
#ifndef MK_CG_FIRST
#define MK_CG_FIRST 0
#endif
#define MK_GRID_BAR() do { if (MK_CG_FIRST ? mk_first : (args.ph_lo < 0)) { mk_grid.sync(); mk_first = false; } else xcd_barrier(mk_bar); } while (0)
#define MK_ONE_LAUNCH 1
#define MK_NO_NAIVE 1
#define MK_THRL 24
#define MK_UP_DUMMY 0
#define MK_JUNK false
#define MK_QKV_NOGATES 0
#define MK_DEFER_WEIGHTS 1
#define MK_SKIP_QK 2.0f
#ifndef MK_PREPASS_REPS
#define MK_PREPASS_REPS 1
#endif
#ifndef MK_TOUCH
#define MK_TOUCH 0
#endif
#ifndef MK_WGM
#define MK_WGM 8
#endif
#ifndef MK_ALIGN_UP
#define MK_ALIGN_UP true
#endif
#ifndef MK_S5TAB_REPS
#define MK_S5TAB_REPS 1
#endif
#ifndef MK_G1_NATURAL
#define MK_G1_NATURAL 0
#endif
#ifndef MK_WNT
#define MK_WNT 0
#endif
#ifndef MK_ATT_DYN
#define MK_ATT_DYN 0
#endif
namespace pg8 {
#define PG8_LAS __attribute__((address_space(3)))
typedef unsigned short bf16_t;
typedef short bf16x8 __attribute__((ext_vector_type(8)));
typedef float f32x4 __attribute__((ext_vector_type(4)));
typedef float f32x2 __attribute__((ext_vector_type(2)));
typedef unsigned u32x4 __attribute__((ext_vector_type(4)));
typedef unsigned u32x2 __attribute__((ext_vector_type(2)));
constexpr int PF_JUNK_OFF = 131072 + 6144;
#ifndef MK_RESID_ALL16
#define MK_RESID_ALL16 0
#endif
#ifndef MK_SWIGLU_V2
#define MK_SWIGLU_V2 1
#endif
#ifndef MK_PF_BASE
#define MK_PF_BASE false
#endif
constexpr int BM = 256, BK = 64, HALF = 128, HTB = HALF * BK * 2  , STAGE_BYTES = 8 * HTB, NXCD = 8, WGM = MK_WGM;

__host__ __device__ __forceinline__ int lds_byte(int r, int c) { const int st = (r >> 4) * 2 + (c >> 5), rr = r & 15, cc = c & 31, ob = rr * 64 + cc * 2; return st * 1024 + (ob ^ (((ob >> 9) & 1) << 5)); }
__host__ __device__ __forceinline__ void stage_rc(int b, int& R, int& C) { const int st = b / 1024, sb = b % 1024, swz = sb ^ (((sb >> 9) & 1) << 5); R = (st >> 1) * 16 + swz / 64; C = (st & 1) * 32 + (swz % 64) / 2; }
__host__ __device__ __forceinline__ int perm32(int rho) { const int n = rho >> 4, i = rho & 15; return 8 * (i >> 2) + 4 * n + (i & 3); }

struct Unit { int pm, pn; };
struct Gemm { const bf16_t* A; const bf16_t* Bt; int K; int lda, ldb; int gatherA; int a_pn_off; };

struct StaticOrder {
    int nM, nN, nwg, G, c;
    __host__ __device__ __forceinline__ void init(int nM_, int nN_, int G_, int c_) { nM = nM_; nN = nN_; nwg = nM * nN; G = G_; c = c_; }
    __host__ __device__ __forceinline__ bool next(int i, Unit& u) const {
        const long L = (long)i * G + c; if (L >= nwg) return false;
        int wgid = (int)L; { const int q = nwg / NXCD, r = nwg % NXCD, xcd = wgid % NXCD, off = wgid / NXCD; wgid = (xcd < r ? xcd * (q + 1) : r * (q + 1) + (xcd - r) * q) + off; }
        const int nig = WGM * nN, gid = wgid / nig, fm = gid * WGM, gsz = (nM - fm) < WGM ? (nM - fm) : WGM;
        u.pm = fm + ((wgid % nig) % gsz); u.pn = (wgid % nig) / gsz; return true;
    }
};

__device__ __forceinline__ unsigned cvt_pk_bf16(float lo, float hi) { unsigned r; asm volatile("v_cvt_pk_bf16_f32 %0, %1, %2" : "=v"(r) : "v"(lo), "v"(hi)); return r; }

template <class Epi, class Sched, bool ALIGN_EPI>
__device__ __forceinline__ void gemm_phase(PG8_LAS unsigned char* lds, const int tid, const Gemm g, const Sched& S, const Epi& E) {
    const int wid = __builtin_amdgcn_readfirstlane(tid >> 6), lane = tid & 63, wr = wid >> 2, wc = wid & 3, fr = lane & 15, fq = lane >> 4;
    const int K = g.K, nt = K / BK;
    unsigned voffA[2], voffB[2];
#pragma unroll
    for (int i = 0; i < 2; ++i) { int R, C; stage_rc(tid * 16 + i * 8192, R, C); const int Rb = Epi::PERM ? ((R & ~31) + perm32(R & 31)) : R;
        voffA[i] = g.gatherA ? (unsigned)(R * g.lda + (C >> 4) * g.gatherA + (C & 15)) * 2u : (unsigned)(R * g.lda + C) * 2u; voffB[i] = (unsigned)(Rb * g.ldb + C) * 2u; }
    const size_t kstepA = g.gatherA ? (size_t)g.gatherA * 8 : (size_t)(BK * 2), kstepB = (size_t)(BK * 2);
    const size_t hstepA = (size_t)HALF * g.lda * 2, hstepB = (size_t)HALF * g.ldb * 2;
    const size_t tstepA = 2 * hstepA, tstepB = 2 * hstepB;
    const unsigned ldsw = (unsigned)wid * 1024u;
    const int aoff = lds_byte(wr * 64 + fr, fq * 8), boff = lds_byte(wc * 32 + fr, fq * 8);
#define PG8_SA(b, h) (((b) * 2 + (h)) * HTB)
#define PG8_SB(b, h) ((4 + (b) * 2 + (h)) * HTB)
#define PG8_STAGE(bufoff, gbase, voff) do { _Pragma("unroll") for (int _i = 0; _i < 2; ++_i) \
        __builtin_amdgcn_global_load_lds((const unsigned*)((const char*)(gbase) + (voff)[_i]), (PG8_LAS unsigned*)(lds + (bufoff) + ldsw + _i * 8192), 16, 0, 0); } while (0)
#define PG8_LDA(dst, b, h) do { _Pragma("unroll") for (int m = 0; m < 4; ++m) _Pragma("unroll") for (int k = 0; k < 2; ++k) dst[m][k] = *(const PG8_LAS bf16x8*)(lds + PG8_SA(b, h) + aoff + m * 2048 + k * 1024); } while (0)
#define PG8_LDB(dst, b, h) do { _Pragma("unroll") for (int n = 0; n < 2; ++n) _Pragma("unroll") for (int k = 0; k < 2; ++k) dst[n][k] = *(const PG8_LAS bf16x8*)(lds + PG8_SB(b, h) + boff + n * 2048 + k * 1024); } while (0)
#define PG8_MMA(ai, bj, At, Bt) do { __builtin_amdgcn_s_setprio(1); _Pragma("unroll") for (int m = 0; m < 4; ++m) _Pragma("unroll") for (int n = 0; n < 2; ++n) _Pragma("unroll") for (int k = 0; k < 2; ++k) \
        acc[ai][bj][m][n] = __builtin_amdgcn_mfma_f32_16x16x32_bf16(Bt[n][k], At[m][k], acc[ai][bj][m][n], 0, 0, 0); __builtin_amdgcn_s_setprio(0); } while (0)
#define PG8_WAIT_V(n) asm volatile("s_waitcnt vmcnt(" #n ")" ::: "memory")
#define PG8_WAIT_L(n) asm volatile("s_waitcnt lgkmcnt(" #n ")" ::: "memory")
#define PG8_BAR __builtin_amdgcn_s_barrier()
#define PG8_SCHED __builtin_amdgcn_sched_barrier(0)
    Unit cur, nxt; int ui = 0;
    if (!S.next(0, cur)) return;
    f32x4 acc[2][2][4][2];
#pragma unroll
    for (int a = 0; a < 2; ++a)
#pragma unroll
        for (int b = 0; b < 2; ++b)
#pragma unroll
            for (int m = 0; m < 4; ++m)
#pragma unroll
                for (int n = 0; n < 2; ++n) acc[a][b][m][n] = (f32x4){0.f, 0.f, 0.f, 0.f};
    bf16x8 At[4][2], B0[2][2], B1[2][2];
    const char* cA = (const char*)g.A + (size_t)cur.pm * tstepA + (size_t)cur.pn * g.a_pn_off; const char* cB = (const char*)g.Bt + (size_t)cur.pn * tstepB;
    PG8_STAGE(PG8_SB(0, 0), cB, voffB); PG8_STAGE(PG8_SB(0, 1), cB + hstepB, voffB); PG8_STAGE(PG8_SA(0, 0), cA, voffA); PG8_STAGE(PG8_SA(0, 1), cA + hstepA, voffA);
    if (wr == 1) PG8_BAR;
    PG8_WAIT_V(2); PG8_BAR;
    PG8_STAGE(PG8_SB(1, 0), cB + kstepB, voffB); PG8_STAGE(PG8_SA(1, 0), cA + kstepA, voffA); PG8_STAGE(PG8_SB(1, 1), cB + hstepB + kstepB, voffB);
    PG8_WAIT_V(6); PG8_BAR;
    for (;;) {
        const bool has_next = S.next(ui + 1, nxt);
        const char* nA = has_next ? (const char*)g.A + (size_t)nxt.pm * tstepA + (size_t)nxt.pn * g.a_pn_off : cA; const char* nB = has_next ? (const char*)g.Bt + (size_t)nxt.pn * tstepB : cB;
        for (int t = 0; t < nt; t += 2) {
            const bool last = (t == nt - 2);
            const char* a1 = cA + (size_t)(t + 1) * kstepA;
            const char* a2 = last ? nA : cA + (size_t)(t + 2) * kstepA; const char* b2 = last ? nB : cB + (size_t)(t + 2) * kstepB;
            const char* a3 = a2 + kstepA; const char* b3 = b2 + kstepB;
            if constexpr (Epi::PREFETCH) { if (last) { int pl_; asm volatile("v_mbcnt_lo_u32_b32 %0, -1, 0\n\tv_mbcnt_hi_u32_b32 %0, -1, %0" : "=v"(pl_)); E.prefetch(cur, wid * 64 + pl_, lds + PF_JUNK_OFF + ldsw / 4); } }
            PG8_LDB(B0, 0, 0); PG8_LDB(B1, 0, 1); PG8_SCHED; PG8_LDA(At, 0, 0); PG8_STAGE(PG8_SA(1, 1), a1 + hstepA, voffA);
            PG8_WAIT_V(8); PG8_WAIT_L(0); PG8_BAR; PG8_MMA(0, 0, At, B0); PG8_MMA(0, 1, At, B1); PG8_BAR; PG8_SCHED;
            PG8_LDA(At, 0, 1); PG8_STAGE(PG8_SB(0, 0), b2, voffB); PG8_STAGE(PG8_SB(0, 1), b2 + hstepB, voffB); PG8_STAGE(PG8_SA(0, 0), a2, voffA);
            PG8_WAIT_V(8); PG8_WAIT_L(0); PG8_BAR; PG8_MMA(1, 0, At, B0); PG8_MMA(1, 1, At, B1); PG8_BAR; PG8_SCHED;
            PG8_LDB(B0, 1, 0); PG8_LDB(B1, 1, 1); PG8_SCHED; PG8_LDA(At, 1, 0); PG8_STAGE(PG8_SA(0, 1), a2 + hstepA, voffA);
            PG8_WAIT_V(8); PG8_WAIT_L(0); PG8_BAR; PG8_MMA(0, 0, At, B0); PG8_MMA(0, 1, At, B1); PG8_BAR; PG8_SCHED;
            PG8_LDA(At, 1, 1); PG8_STAGE(PG8_SB(1, 0), b3, voffB); PG8_STAGE(PG8_SB(1, 1), b3 + hstepB, voffB); PG8_STAGE(PG8_SA(1, 0), a3, voffA);
            PG8_WAIT_V(8); PG8_WAIT_L(0); PG8_BAR; PG8_MMA(1, 0, At, B0); PG8_MMA(1, 1, At, B1); PG8_BAR; PG8_SCHED;
        }
        if constexpr (ALIGN_EPI) { if (wr == 0) PG8_BAR; }
        if constexpr (!Epi::AFTER_DRAIN) { int ln_; asm volatile("v_mbcnt_lo_u32_b32 %0, -1, 0\n\tv_mbcnt_hi_u32_b32 %0, -1, %0" : "=v"(ln_)); E(acc, cur, wr, wc, ln_ & 15, ln_ >> 4); }
        if (!has_next) break;
#pragma unroll
        for (int a = 0; a < 2; ++a)
#pragma unroll
            for (int b = 0; b < 2; ++b)
#pragma unroll
                for (int m = 0; m < 4; ++m)
#pragma unroll
                    for (int n = 0; n < 2; ++n) acc[a][b][m][n] = (f32x4){0.f, 0.f, 0.f, 0.f};
        cur = nxt; cA = nA; cB = nB; ++ui;
        if constexpr (ALIGN_EPI) { if (wr == 1) PG8_BAR; }
    }
    PG8_WAIT_V(0);
    if constexpr (!ALIGN_EPI) { if (wr == 0) PG8_BAR; }
    PG8_BAR;
    if constexpr (Epi::AFTER_DRAIN) { int ln_; asm volatile("v_mbcnt_lo_u32_b32 %0, -1, 0\n\tv_mbcnt_hi_u32_b32 %0, -1, %0" : "=v"(ln_)); E.fused(acc, cur, wr, wc, ln_ & 15, ln_ >> 4, lds, wid, ln_); }
#undef PG8_SA
#undef PG8_SB
#undef PG8_STAGE
#undef PG8_LDA
#undef PG8_LDB
#undef PG8_MMA
#undef PG8_WAIT_V
#undef PG8_WAIT_L
#undef PG8_BAR
#undef PG8_SCHED
}

__device__ __forceinline__ float shx(float v, int lane, int m) { return __builtin_bit_cast(float, __builtin_amdgcn_ds_bpermute((lane ^ m) << 2, __builtin_bit_cast(int, v))); }
constexpr float RMS_EPS = 1e-6f;
typedef unsigned long long ssq_t;
constexpr float SSQ_SCALE = 1048576.0f;
__device__ __forceinline__ float rstd_row(const ssq_t* ssq, int row) { return __builtin_amdgcn_rsqf((float)ssq[row] * (1.0f / (1024.0f * SSQ_SCALE)) + RMS_EPS); }
#define PG8_GAS __attribute__((address_space(1)))
#ifndef MK_WT_STORES
#define MK_WT_STORES 0
#endif
template <int OFF = 0, typename V> __device__ __forceinline__ void st_wt(PG8_GAS void* p, const V v) {
    static_assert(OFF >= 0 && OFF < 4096, "immediate offset range");
#if MK_WT_STORES
    if constexpr (sizeof(V) == 16) asm volatile("global_store_dwordx4 %0, %1, off offset:%2 sc1\n\ts_nop 1" :: "v"(p), "v"(v), "n"(OFF) : "memory");
    else if constexpr (sizeof(V) == 8) asm volatile("global_store_dwordx2 %0, %1, off offset:%2 sc1\n\ts_nop 1" :: "v"(p), "v"(v), "n"(OFF) : "memory");
    else { static_assert(sizeof(V) == 4, "store width"); asm volatile("global_store_dword %0, %1, off offset:%2 sc1\n\ts_nop 1" :: "v"(p), "v"(v), "n"(OFF) : "memory"); }
#else
    *(PG8_GAS V*)((PG8_GAS unsigned char*)p + OFF) = v;
#endif
}
#ifndef MK_WT_RESID
#define MK_WT_RESID 0
#endif
__device__ __forceinline__ void st_resid(PG8_GAS unsigned char* base, unsigned off, const u32x4 v) {
#if MK_WT_RESID
    asm volatile("global_store_dwordx4 %0, %1, %2 sc1\n\ts_nop 1" :: "v"(off), "v"(v), "s"(base) : "memory");
#else
    *(PG8_GAS u32x4*)(base + off) = v;
#endif
}
#ifndef MK_NT_STORES
#define MK_NT_STORES 0
#endif
template <typename V> __device__ __forceinline__ void st_big(PG8_GAS void* p, const V v) {
#if MK_NT_STORES
    __builtin_nontemporal_store(v, (PG8_GAS V*)p);
#else
    st_wt(p, v);
#endif
}
#if MK_WT_STORES
#define ATTN_STORE16(p,v) pg8::st_wt((PG8_GAS void*)(p), (v))
#endif
__device__ __forceinline__ void rstd8(const ssq_t* ssq, int row0, float (&rs)[2][4]) {
    ssq_t sv[2][4];
#pragma unroll
    for (int ai = 0; ai < 2; ++ai)
#pragma unroll
        for (int m = 0; m < 4; ++m) sv[ai][m] = ((const PG8_GAS ssq_t*)ssq)[row0 + ai * HALF + m * 16];
#pragma unroll
    for (int ai = 0; ai < 2; ++ai)
#pragma unroll
        for (int m = 0; m < 4; ++m) rs[ai][m] = __builtin_amdgcn_rsqf((float)sv[ai][m] * (1.0f / (1024.0f * SSQ_SCALE)) + RMS_EPS);
}
__device__ __forceinline__ float fast_sigmoid(float x) { return __builtin_amdgcn_rcpf(1.0f + __builtin_amdgcn_exp2f(-1.4426950408889634f * x)); }

struct EpiQKV {
    static constexpr bool PERM = true, AFTER_DRAIN = false, PREFETCH = false;
    bf16_t* O; size_t split_stride; const ssq_t* ssq; float scale0; float* nrm; int dummy;
    __device__ __forceinline__ void operator()(const f32x4 (&acc)[2][2][4][2], const Unit& u, int wr, int wc, int fr, int fq) const {
        const int row0 = u.pm * BM + wr * 64 + fr, t = u.pn >> 2; bf16_t* base = O + (size_t)t * split_stride; const float sc = (t == 0) ? scale0 : 1.f;
        const int col0 = (u.pn & 3) * BM + wc * 32 + 8 * fq, ln = fq * 16 + fr;
        float rsv[2][4]; rstd8(ssq, row0, rsv);
#pragma unroll
        for (int ai = 0; ai < 2; ++ai)
#pragma unroll
            for (int m = 0; m < 4; ++m) { const int row = row0 + ai * HALF + m * 16; const float rs = rsv[ai][m] * sc; PG8_GAS bf16_t* rowp = (PG8_GAS bf16_t*)base + (size_t)row * 1024 + col0;
#pragma unroll
                for (int bj = 0; bj < 2; ++bj) { const f32x4 v0 = acc[ai][bj][m][0] * rs, v1 = acc[ai][bj][m][1] * rs;
                    u32x4 w; w.x = cvt_pk_bf16(v0[0], v0[1]); w.y = cvt_pk_bf16(v0[2], v0[3]); w.z = cvt_pk_bf16(v1[0], v1[1]); w.w = cvt_pk_bf16(v1[2], v1[3]);
                    st_big(rowp + bj * HALF, w);
                    if (t < 2) { float s = ((v0[0] * v0[0] + v0[1] * v0[1]) + (v0[2] * v0[2] + v0[3] * v0[3])) + ((v1[0] * v1[0] + v1[1] * v1[1]) + (v1[2] * v1[2] + v1[3] * v1[3]));
                        s += shx(s, ln, 16); s += shx(s, ln, 32);
                        if (fq == 0) ((PG8_GAS float*)nrm)[(((size_t)(t * 4 + (u.pn & 3)) * 16384 + row) * 4 + 2 * bj + (wc >> 1)) * 2 + (wc & 1)] = s; } } }
    }
};
struct EpiSwiGLU {
    static constexpr bool PERM = true, AFTER_DRAIN = false, PREFETCH = false;
    bf16_t* Hh; int ldh; const ssq_t* ssq; int dummy;
    __device__ __forceinline__ void operator()(const f32x4 (&acc)[2][2][4][2], const Unit& u, int wr, int wc, int fr, int fq) const {
        const int row0 = u.pm * BM + wr * 64 + fr, col0 = u.pn * HALF + wc * 32 + 8 * fq;
        if (dummy == 1) { if (fr == 0 && fq == 0) *(PG8_GAS float*)((PG8_GAS bf16_t*)Hh + (size_t)row0 * ldh + col0) = acc[0][0][0][0][0] + acc[1][1][3][1][3]; return; }
#if MK_SWIGLU_V2
        ssq_t sv[2][4];
#pragma unroll
        for (int ai = 0; ai < 2; ++ai)
#pragma unroll
            for (int m = 0; m < 4; ++m) sv[ai][m] = ((const PG8_GAS ssq_t*)ssq)[row0 + ai * HALF + m * 16];
#pragma unroll
        for (int ai = 0; ai < 2; ++ai)
#pragma unroll
            for (int m = 0; m < 4; ++m) { const int row = row0 + ai * HALF + m * 16;
                const float ms = (float)sv[ai][m] * (1.0f / (1024.0f * SSQ_SCALE)) + RMS_EPS, rsn = __builtin_amdgcn_rsqf(ms) * (-1.4426950408889634f);
                float h[8];
#pragma unroll
                for (int n = 0; n < 2; ++n)
#pragma unroll
                    for (int j = 0; j < 4; j += 2) {
                        const f32x2 g2 = {acc[ai][0][m][n][j], acc[ai][0][m][n][j + 1]}, u2 = {acc[ai][1][m][n][j], acc[ai][1][m][n][j + 1]};
                        const f32x2 ar = g2 * rsn, t = g2 * u2;
                        f32x2 e; e.x = __builtin_amdgcn_exp2f(ar.x); e.y = __builtin_amdgcn_exp2f(ar.y);
                        const f32x2 msv = {ms, ms}; const f32x2 dn = __builtin_elementwise_fma(e, msv, msv); f32x2 r; r.x = __builtin_amdgcn_rcpf(dn.x); r.y = __builtin_amdgcn_rcpf(dn.y);
                        const f32x2 hv = t * r; h[n * 4 + j] = hv.x; h[n * 4 + j + 1] = hv.y; }
#else
        float rsv[2][4]; rstd8(ssq, row0, rsv);
#pragma unroll
        for (int ai = 0; ai < 2; ++ai)
#pragma unroll
            for (int m = 0; m < 4; ++m) { const int row = row0 + ai * HALF + m * 16; const float rs = rsv[ai][m];
                float h[8];
#pragma unroll
                for (int n = 0; n < 2; ++n)
#pragma unroll
                    for (int j = 0; j < 4; j += 2) {
                        const f32x2 g2 = {acc[ai][0][m][n][j], acc[ai][0][m][n][j + 1]}, u2 = {acc[ai][1][m][n][j], acc[ai][1][m][n][j + 1]};
                        const f32x2 gs = g2 * rs, us = u2 * rs, ar = gs * (-1.4426950408889634f);
                        f32x2 e; e.x = __builtin_amdgcn_exp2f(ar.x); e.y = __builtin_amdgcn_exp2f(ar.y);
                        const f32x2 dn = e + 1.0f; f32x2 r; r.x = __builtin_amdgcn_rcpf(dn.x); r.y = __builtin_amdgcn_rcpf(dn.y);
                        const f32x2 hv = (gs * r) * us; h[n * 4 + j] = hv.x; h[n * 4 + j + 1] = hv.y; }
#endif
                u32x4 w; w.x = cvt_pk_bf16(h[0], h[1]); w.y = cvt_pk_bf16(h[2], h[3]); w.z = cvt_pk_bf16(h[4], h[5]); w.w = cvt_pk_bf16(h[6], h[7]);
                st_big((PG8_GAS bf16_t*)Hh + (size_t)row * ldh + col0, w); }
    }
};
__device__ __forceinline__ void bf8_to_f32(const u32x4 w, f32x4& lo, f32x4& hi) {
    lo = (f32x4){__builtin_bit_cast(float, w.x << 16), __builtin_bit_cast(float, w.x & 0xffff0000u), __builtin_bit_cast(float, w.y << 16), __builtin_bit_cast(float, w.y & 0xffff0000u)};
    hi = (f32x4){__builtin_bit_cast(float, w.z << 16), __builtin_bit_cast(float, w.z & 0xffff0000u), __builtin_bit_cast(float, w.w << 16), __builtin_bit_cast(float, w.w & 0xffff0000u)};
}
template <int MODE> struct EpiResid {
    static constexpr bool PERM = true, AFTER_DRAIN = false, PREFETCH = MK_PF_BASE && MODE == 0;
    const bf16_t* base; bf16_t* XB; ssq_t* ssq_out; const float* pb; const float* psc; int dummy;
    __device__ __forceinline__ void prefetch(const Unit& u, int tid, PG8_LAS unsigned char* junk) const {
        const int r = tid >> 1, h = tid & 1;
        const char* p = (const char*)base + ((size_t)(u.pm * BM + r) * 1024 + (MODE == 1 ? u.pn * HALF : u.pn * BM)) * 2 + h * (MODE == 1 ? 128 : 256);
        __builtin_amdgcn_global_load_lds((const unsigned*)p, (PG8_LAS unsigned*)junk, 4, 0, 0);
        if (MODE != 1) __builtin_amdgcn_global_load_lds((const unsigned*)(p + 128), (PG8_LAS unsigned*)junk, 4, 0, 0);
    }
    __device__ __forceinline__ void operator()(const f32x4 (&acc)[2][2][4][2], const Unit& u, int wr, int wc, int fr, int fq) const {
        if (dummy == 1) { if (acc[0][0][0][0][0] + acc[1][1][3][1][3] == 12345.678f) ((PG8_GAS float*)pb)[0] = 1.f; return; }
        const int row0 = u.pm * BM + wr * 64 + fr;
        const int col0 = (MODE == 1 ? u.pn * HALF : u.pn * BM) + wc * 32 + 8 * fq;
        constexpr int NBJ = (MODE == 1) ? 1 : 2;
        const PG8_GAS unsigned char* gb = (const PG8_GAS unsigned char*)base; PG8_GAS unsigned char* gx = (PG8_GAS unsigned char*)XB; const unsigned ob = ((unsigned)row0 * 1024u + (unsigned)col0) * 2u;
#define PG8_ROFF(dr, co_) (ob + (unsigned)((((dr)) * 1024 + (co_)) * 2))
        float ss[2][4];
#pragma unroll
        for (int ai = 0; ai < 2; ++ai)
#pragma unroll
            for (int m = 0; m < 4; ++m) ss[ai][m] = 0.f;
        constexpr bool ALL16 = (MODE == 0) && MK_RESID_ALL16;
        u32x4 bsall[ALL16 ? 2 : 1][2][4];
        if constexpr (ALL16) {
#pragma unroll
            for (int bj = 0; bj < 2; ++bj)
#pragma unroll
                for (int ai = 0; ai < 2; ++ai)
#pragma unroll
                    for (int m = 0; m < 4; ++m) bsall[bj][ai][m] = *(const PG8_GAS u32x4*)(gb + (ob + (unsigned)(((ai * HALF + m * 16) * 1024 + bj * HALF) * 2))); }
#pragma unroll
        for (int bj = 0; bj < NBJ; ++bj) { const int co = bj * HALF;
            f32x4 bb0 = {0.f, 0.f, 0.f, 0.f}, bb1 = bb0, sc0 = {1.f, 1.f, 1.f, 1.f}, sc1 = sc0;
            if (MODE == 2) { bb0 = *(const PG8_GAS f32x4*)((const PG8_GAS float*)pb + col0 + co); bb1 = *(const PG8_GAS f32x4*)((const PG8_GAS float*)pb + col0 + co + 4);
                             sc0 = *(const PG8_GAS f32x4*)((const PG8_GAS float*)psc + col0 + co); sc1 = *(const PG8_GAS f32x4*)((const PG8_GAS float*)psc + col0 + co + 4); }
            constexpr int NAB = (MODE == 2) ? 1 : 2;
#pragma unroll
            for (int a0 = 0; a0 < 2; a0 += NAB) {
                u32x4 bs[NAB][4];
#pragma unroll
                for (int ai = 0; ai < NAB; ++ai)
#pragma unroll
                    for (int m = 0; m < 4; ++m) { if constexpr (ALL16) bs[ai][m] = bsall[bj][ai][m]; else bs[ai][m] = *(const PG8_GAS u32x4*)(gb + PG8_ROFF((a0 + ai) * HALF + m * 16, co)); }
#pragma unroll
                for (int aa = 0; aa < NAB; ++aa)
#pragma unroll
                    for (int m = 0; m < 4; ++m) { const int ai = a0 + aa; const unsigned off = PG8_ROFF(ai * HALF + m * 16, co); f32x4 d0, d1;
                        if (MODE == 0) { d0 = acc[ai][bj][m][0]; d1 = acc[ai][bj][m][1]; }
                        else if (MODE == 1) { const f32x4 v0 = acc[ai][0][m][0], g0 = acc[ai][1][m][0], v1 = acc[ai][0][m][1], g1 = acc[ai][1][m][1];
                            d0 = (f32x4){v0[0] * fast_sigmoid(g0[0]), v0[1] * fast_sigmoid(g0[1]), v0[2] * fast_sigmoid(g0[2]), v0[3] * fast_sigmoid(g0[3])};
                            d1 = (f32x4){v1[0] * fast_sigmoid(g1[0]), v1[1] * fast_sigmoid(g1[1]), v1[2] * fast_sigmoid(g1[2]), v1[3] * fast_sigmoid(g1[3])}; }
                        else { d0 = (acc[ai][bj][m][0] + bb0) * sc0; d1 = (acc[ai][bj][m][1] + bb1) * sc1; }
                        f32x4 b0, b1; bf8_to_f32(bs[aa][m], b0, b1);
                        const f32x4 o0 = b0 + d0, o1 = b1 + d1;
                        ss[ai][m] += ((o0[0] * o0[0] + o0[1] * o0[1]) + (o0[2] * o0[2] + o0[3] * o0[3])) + ((o1[0] * o1[0] + o1[1] * o1[1]) + (o1[2] * o1[2] + o1[3] * o1[3]));
                        u32x4 w; w.x = cvt_pk_bf16(o0[0], o0[1]); w.y = cvt_pk_bf16(o0[2], o0[3]); w.z = cvt_pk_bf16(o1[0], o1[1]); w.w = cvt_pk_bf16(o1[2], o1[3]);
                        st_resid(gx, off, w); }
                if (NAB == 1) asm volatile("" ::: "memory"); }
            asm volatile("" ::: "memory"); }
        const int ln = fq * 16 + fr;
#pragma unroll
        for (int ai = 0; ai < 2; ++ai)
#pragma unroll
            for (int m = 0; m < 4; ++m) { float s = ss[ai][m]; s += shx(s, ln, 16); s += shx(s, ln, 32);
                if (fq == 0) atomicAdd(ssq_out + row0 + ai * HALF + m * 16, (ssq_t)__builtin_llrintf(s * SSQ_SCALE)); }
    }
};
struct EpiResidFinal {
    static constexpr bool PERM = true, AFTER_DRAIN = true, PREFETCH = false;
    const bf16_t* base; float* out; ssq_t* ssq_out; const float* gain; unsigned* cnt;
    __device__ __forceinline__ void prefetch(const Unit& u, int tid, PG8_LAS unsigned char* junk) const {
        const int r = tid >> 1, h = tid & 1;
        const char* p = (const char*)base + ((size_t)(u.pm * BM + r) * 1024 + u.pn * BM) * 2 + h * 256;
        __builtin_amdgcn_global_load_lds((const unsigned*)p, (PG8_LAS unsigned*)junk, 4, 0, 0);
        __builtin_amdgcn_global_load_lds((const unsigned*)(p + 128), (PG8_LAS unsigned*)junk, 4, 0, 0);
    }
    __device__ __forceinline__ void fused(f32x4 (&acc)[2][2][4][2], const Unit& u, int wr, int wc, int fr, int fq, PG8_LAS unsigned char* lds, int wid, int lane) const {
        const int row0 = u.pm * BM + wr * 64 + fr, col0 = u.pn * BM + wc * 32 + 8 * fq;
        const PG8_GAS bf16_t* gb = (const PG8_GAS bf16_t*)base + (size_t)row0 * 1024 + col0;
        float ss[2][4]; float chain_ = 0.f;
#pragma unroll
        for (int ai = 0; ai < 2; ++ai)
#pragma unroll
            for (int m = 0; m < 4; m += 2) { int ro_ = (ai * HALF + m * 16) * 1024; asm volatile("" : "+v"(ro_) : "v"(chain_));
                const PG8_GAS bf16_t* rp = gb + ro_;
                const u32x4 wa = *(const PG8_GAS u32x4*)(rp), wb = *(const PG8_GAS u32x4*)(rp + HALF), wc_ = *(const PG8_GAS u32x4*)(rp + 16 * 1024), wd = *(const PG8_GAS u32x4*)(rp + 16 * 1024 + HALF);
#pragma unroll
                for (int q = 0; q < 2; ++q) { f32x4 b0, b1, b2, b3; bf8_to_f32(q ? wc_ : wa, b0, b1); bf8_to_f32(q ? wd : wb, b2, b3);
                    const f32x4 o0 = b0 + acc[ai][0][m + q][0], o1 = b1 + acc[ai][0][m + q][1], o2 = b2 + acc[ai][1][m + q][0], o3 = b3 + acc[ai][1][m + q][1];
                    acc[ai][0][m + q][0] = o0; acc[ai][0][m + q][1] = o1; acc[ai][1][m + q][0] = o2; acc[ai][1][m + q][1] = o3;
                    ss[ai][m + q] = ((o0[0] * o0[0] + o0[1] * o0[1]) + (o0[2] * o0[2] + o0[3] * o0[3])) + ((o1[0] * o1[0] + o1[1] * o1[1]) + (o1[2] * o1[2] + o1[3] * o1[3]))
                                  + ((o2[0] * o2[0] + o2[1] * o2[1]) + (o2[2] * o2[2] + o2[3] * o2[3])) + ((o3[0] * o3[0] + o3[1] * o3[1]) + (o3[2] * o3[2] + o3[3] * o3[3])); }
                chain_ = ss[ai][m] + ss[ai][m + 1]; }
        const int ln = fq * 16 + fr;
#pragma unroll
        for (int ai = 0; ai < 2; ++ai)
#pragma unroll
            for (int m = 0; m < 4; ++m) { float s = ss[ai][m]; s += shx(s, ln, 16); s += shx(s, ln, 32);
                if (fq == 0) atomicAdd(ssq_out + row0 + ai * HALF + m * 16, (ssq_t)__builtin_llrintf(s * SSQ_SCALE)); }
        asm volatile("s_waitcnt vmcnt(0)" ::: "memory"); __builtin_amdgcn_s_barrier(); asm volatile("" ::: "memory");
        if (wid == 0) {
            unsigned* c = cnt + 64 * u.pm;
            if (lane == 0) __hip_atomic_fetch_add(c, 1u, __ATOMIC_RELAXED, __HIP_MEMORY_SCOPE_AGENT);
            unsigned spins = 0;
            while ((unsigned)__builtin_amdgcn_readfirstlane(__hip_atomic_load(c, __ATOMIC_RELAXED, __HIP_MEMORY_SCOPE_AGENT)) < 4u && ++spins < (1u << 22)) __builtin_amdgcn_s_sleep(2);
        }
        __builtin_amdgcn_s_barrier(); asm volatile("" ::: "memory");
        int l2_; asm volatile("v_mbcnt_lo_u32_b32 %0, -1, 0\n\tv_mbcnt_hi_u32_b32 %0, -1, %0" : "=v"(l2_));
        const int row0b = u.pm * BM + wr * 64 + (l2_ & 15), col0b = u.pn * BM + wc * 32 + 8 * (l2_ >> 4);
        PG8_GAS float* go = (PG8_GAS float*)out + (size_t)row0b * 1024 + col0b;
        float rs[2][4];
#pragma unroll
        for (int ai = 0; ai < 2; ++ai)
#pragma unroll
            for (int m = 0; m < 4; ++m) rs[ai][m] = __builtin_amdgcn_rsqf((float)__hip_atomic_load(ssq_out + row0b + ai * HALF + m * 16, __ATOMIC_RELAXED, __HIP_MEMORY_SCOPE_AGENT) * (1.0f / (1024.0f * SSQ_SCALE)) + RMS_EPS);
#pragma unroll
        for (int bj = 0; bj < 2; ++bj) { int co = bj * HALF; asm volatile("" : "+v"(co) : "v"(chain_));
            const f32x4 gg0 = *(const PG8_GAS f32x4*)((const PG8_GAS float*)gain + col0b + co), gg1 = *(const PG8_GAS f32x4*)((const PG8_GAS float*)gain + col0b + co + 4);
#pragma unroll
            for (int ai = 0; ai < 2; ++ai)
#pragma unroll
                for (int m = 0; m < 4; ++m) {
                    const f32x4 ov0 = acc[ai][bj][m][0] * rs[ai][m] * gg0, ov1 = acc[ai][bj][m][1] * rs[ai][m] * gg1;
                    PG8_GAS float* op = go + (size_t)(ai * HALF + m * 16) * 1024 + co; *(PG8_GAS f32x4*)op = ov0; *(PG8_GAS f32x4*)(op + 4) = ov1; chain_ = ov1[0]; }
            asm volatile("" ::: "memory"); }
    }
};
struct EpiU {
    static constexpr bool PERM = true, AFTER_DRAIN = false, PREFETCH = false;
    bf16_t* UX; const ssq_t* ssq;
    __device__ __forceinline__ void operator()(const f32x4 (&acc)[2][2][4][2], const Unit& u, int wr, int wc, int fr, int fq) const {
        const int row0 = u.pm * BM + wr * 64 + fr, col0 = u.pn * BM + wc * 32 + 8 * fq;
        float rsv[2][4]; rstd8(ssq, row0, rsv);
#pragma unroll
        for (int ai = 0; ai < 2; ++ai)
#pragma unroll
            for (int m = 0; m < 4; ++m) { const int row = row0 + ai * HALF + m * 16; const float rs = rsv[ai][m];
#pragma unroll
                for (int bj = 0; bj < 2; ++bj) { const int col = col0 + bj * HALF; const f32x4 v0 = acc[ai][bj][m][0] * rs, v1 = acc[ai][bj][m][1] * rs;
                    u32x4 w; w.x = cvt_pk_bf16(v0[0], v0[1]); w.y = cvt_pk_bf16(v0[2], v0[3]); w.z = cvt_pk_bf16(v1[0], v1[1]); w.w = cvt_pk_bf16(v1[2], v1[3]);
                    st_wt((PG8_GAS bf16_t*)UX + ((size_t)(col >> 4) * 1024 + (row >> 4)) * 384 + (row & 15) * 16 + (col & 15), w); } }
    }
};
struct EpiSloc {
    static constexpr bool PERM = false, AFTER_DRAIN = true, PREFETCH = false;
    const float* lamc; bf16_t* UX; PG8_LAS unsigned char* esc;
    __device__ __forceinline__ void fused(f32x4 (&acc)[2][2][4][2], const Unit& u, int wr, int wc, int fr, int fq, PG8_LAS unsigned char* lds, int wid, int lane) const {
        PG8_LAS float* SL = (PG8_LAS float*)lds;
#pragma unroll
        for (int ai = 0; ai < 2; ++ai)
#pragma unroll
            for (int m = 0; m < 4; ++m)
#pragma unroll
                for (int n = 0; n < 2; ++n) *(PG8_LAS f32x4*)(SL + (ai * HALF + wr * 64 + m * 16 + fr) * 128 + wc * 32 + n * 16 + 4 * fq) = acc[ai][0][m][n];
        asm volatile("s_waitcnt lgkmcnt(0)" ::: "memory"); __builtin_amdgcn_s_barrier(); asm volatile("" ::: "memory");
        const int g = u.pn, b = u.pm, seg = wid, p = lane;
        const float lr = lamc[(g * 64 + p) * 2], li = lamc[(g * 64 + p) * 2 + 1];
        float sr = 0.f, si = 0.f;
        for (int c = seg * 32; c < seg * 32 + 32; ++c) { const float xr = SL[c * 128 + p], xi = SL[c * 128 + 64 + p]; const float nr = lr * sr - li * si + xr, ni = lr * si + li * sr + xi; sr = nr; si = ni; }
        PG8_LAS float* E = (PG8_LAS float*)esc;
        E[(seg * 64 + p) * 2] = sr; E[(seg * 64 + p) * 2 + 1] = si;
        asm volatile("s_waitcnt lgkmcnt(0)" ::: "memory"); __builtin_amdgcn_s_barrier(); asm volatile("" ::: "memory");
        float l32r = lr, l32i = li;
#pragma unroll
        for (int q = 0; q < 5; ++q) { const float t = l32r * l32r - l32i * l32i; l32i = 2.f * l32r * l32i; l32r = t; }
        sr = 0.f; si = 0.f;
        for (int j = 0; j < seg; ++j) { const float er = E[(j * 64 + p) * 2], ei = E[(j * 64 + p) * 2 + 1]; const float nr = l32r * sr - l32i * si + er, ni = l32r * si + l32i * sr + ei; sr = nr; si = ni; }
        bf16_t* dst = UX + ((size_t)g * 1024 + b * 256 + seg * 32) * 384 + 256 + p;
        for (int c = seg * 32; c < seg * 32 + 32; ++c) {
            { unsigned ur = __builtin_bit_cast(unsigned, sr), ui = __builtin_bit_cast(unsigned, si); ur = (ur + 0x7fffu + ((ur >> 16) & 1u)) >> 16; ui = (ui + 0x7fffu + ((ui >> 16) & 1u)) >> 16;
              dst[0] = (bf16_t)ur; dst[64] = (bf16_t)ui; }
            const float xr = SL[c * 128 + p], xi = SL[c * 128 + 64 + p]; const float nr = lr * sr - li * si + xr, ni = lr * si + li * sr + xi; sr = nr; si = ni;
            dst += 384; }
        asm volatile("s_waitcnt vmcnt(0) lgkmcnt(0)" ::: "memory"); __builtin_amdgcn_s_barrier(); asm volatile("" ::: "memory");
        if (wid == 0) { __builtin_amdgcn_fence(__ATOMIC_ACQUIRE, "agent"); asm volatile("s_waitcnt vmcnt(0)" ::: "memory"); }
        __builtin_amdgcn_s_barrier(); asm volatile("" ::: "memory");
    }
};
struct EpiY {
    static constexpr bool PERM = true, AFTER_DRAIN = false, PREFETCH = false;
    const bf16_t* UX; const float* dvec; bf16_t* G1;
    __device__ __forceinline__ void operator()(const f32x4 (&acc)[2][2][4][2], const Unit& u, int wr, int wc, int fr, int fq) const {
        const int g = u.pn, b = u.pm, ch0 = g * 16 + 8 * (fq & 1);
        const f32x4 d0 = *(const f32x4*)(dvec + ch0), d1 = *(const f32x4*)(dvec + ch0 + 4);
#pragma unroll
        for (int ai = 0; ai < 2; ++ai) {
            u32x4 uwv[4][2];
#pragma unroll
            for (int m = 0; m < 4; ++m)
#pragma unroll
                for (int bj = 0; bj < 2; ++bj) uwv[m][bj] = *(const PG8_GAS u32x4*)((const PG8_GAS bf16_t*)UX + ((size_t)g * 1024 + b * 256 + (ai * HALF + wr * 64 + m * 16 + fr)) * 384 + (8 * bj + 2 * wc + (fq >> 1)) * 16 + 8 * (fq & 1));
#pragma unroll
            for (int m = 0; m < 4; ++m) { const int R = ai * HALF + wr * 64 + m * 16 + fr;
#pragma unroll
                for (int bj = 0; bj < 2; ++bj) { const int i = 8 * bj + 2 * wc + (fq >> 1);
                    const u32x4 uw = uwv[m][bj];
                    float y[8];
#pragma unroll
                    for (int j = 0; j < 4; ++j) { y[j] = acc[ai][bj][m][0][j] + d0[j] * __builtin_bit_cast(float, (j & 1) ? (uw[j >> 1] & 0xffff0000u) : (uw[j >> 1] << 16));
                                                  y[4 + j] = acc[ai][bj][m][1][j] + d1[j] * __builtin_bit_cast(float, (j & 1) ? (uw[2 + (j >> 1)] & 0xffff0000u) : (uw[2 + (j >> 1)] << 16)); }
#pragma unroll
                    for (int j = 0; j < 8; ++j) { const float z = 0.7978845608028654f * (y[j] + 0.044715f * y[j] * y[j] * y[j]); y[j] = y[j] * fast_sigmoid(2.f * z); }
                    u32x4 w; w.x = cvt_pk_bf16(y[0], y[1]); w.y = cvt_pk_bf16(y[2], y[3]); w.z = cvt_pk_bf16(y[4], y[5]); w.w = cvt_pk_bf16(y[6], y[7]);
                    st_wt((PG8_GAS bf16_t*)G1 + (MK_G1_NATURAL ? ((size_t)(b * 4096 + 16 * R + i) * 1024 + g * 16 + 8 * (fq & 1)) : (((size_t)g * 16384 + b * 4096 + 16 * R + i) * 16 + 8 * (fq & 1))), w); } }
            asm volatile("" ::: "memory"); }
    }
};
}
#include <hip/hip_bf16.h>
#include <cmath>
namespace attn_body {
using bf16=__hip_bfloat16;
using bf16x8=__attribute__((ext_vector_type(8)))short;
using s16x4=__attribute__((ext_vector_type(4)))short;
using f32x16=__attribute__((ext_vector_type(16)))float;
using u32x4=__attribute__((ext_vector_type(4)))unsigned;
constexpr int BATCH=4,NHEAD=16,SEQ=4096,D=64,DM=NHEAD*D;
constexpr int NW=8,QBLK=32,QB=QBLK*NW,KVBLK=64,NQB=SEQ/QB;
constexpr int ATTN_PITCH=DM, ATTN_UNIT_ROWS=QB;
__device__ __forceinline__ int crow(int r,int hi){return (r&3)+8*(r>>2)+4*hi;}
#define SBAR() __builtin_amdgcn_sched_barrier(0)
__device__ __forceinline__ void cmask(f32x16&p0,f32x16&p1,int jb,int qrel,int hi){
  const float NEG=-INFINITY; int kb=64*jb+4*hi;
  #pragma unroll
  for(int r=0;r<16;++r){int kv=kb+(r&3)+8*(r>>2); if(kv>qrel)p0[r]=NEG; if(kv+32>qrel)p1[r]=NEG;}
}

constexpr int NSLOT=3, SLOTB=8192;
constexpr int LDS_K=0, LDS_V=NSLOT*SLOTB, LDS_WS=2*NSLOT*SLOTB, LDS_OST=LDS_WS+NW*64*4, LDS_BYTES=LDS_OST+NW*4096;
constexpr float C2=0.125f*1.4426950408889634f;
__device__ __forceinline__ void glds16(const void*gsrc,unsigned lds_dst){unsigned keep;
  asm volatile("s_mov_b32 %0, m0\n\ts_mov_b32 m0, %2\n\ts_nop 0\n\tglobal_load_lds_dwordx4 %1, off\n\ts_mov_b32 m0, %0":"=&s"(keep):"v"(gsrc),"s"(lds_dst):"memory");}
__device__ __forceinline__ float max3f(float a,float b,float c){float r;asm("v_max3_f32 %0, %1, %2, %3":"=v"(r):"v"(a),"v"(b),"v"(c));return r;}
__device__ __forceinline__ float max2f(float a,float b){float r;asm("v_max_f32_e32 %0, %1, %2":"=v"(r):"v"(a),"v"(b));return r;}
__device__ __forceinline__ float fadd_s(float a,float b){float r;asm("v_add_f32_e32 %0, %1, %2":"=v"(r):"v"(a),"v"(b));return r;}
__device__ __forceinline__ float fsub_s(float a,float b){float r;asm("v_sub_f32_e32 %0, %1, %2":"=v"(r):"v"(a),"v"(b));return r;}
typedef float f32x2_t __attribute__((ext_vector_type(2))); typedef __bf16 bf16x2_t __attribute__((ext_vector_type(2)));
__device__ __forceinline__ unsigned cvtpk_s(float lo,float hi){f32x2_t v={lo,hi};bf16x2_t b=__builtin_convertvector(v,bf16x2_t);return __builtin_bit_cast(unsigned,b);}
#define WAIT_BAR(N) asm volatile("s_waitcnt vmcnt(" #N ") lgkmcnt(0)\n\ts_barrier":::"memory")

__device__ __forceinline__ void qkt(f32x16&p0,f32x16&p1,const char*Kslot,const bf16x8*qr,int r32,int hi){
  const char*kb=Kslot+hi*1024+r32*16;
  #pragma unroll
  for(int d0=0;d0<4;++d0){
    const bf16x8 b0=*reinterpret_cast<const bf16x8*>(kb+d0*2048);
    const bf16x8 b1=*reinterpret_cast<const bf16x8*>(kb+d0*2048+512);
    {p0=__builtin_amdgcn_mfma_f32_32x32x16_bf16(b0,qr[d0],p0,0,0,0);p1=__builtin_amdgcn_mfma_f32_32x32x16_bf16(b1,qr[d0],p1,0,0,0);}}
}
typedef __attribute__((address_space(3))) const char* lds_cptr;
typedef short v4i16_t __attribute__((ext_vector_type(4)));
__device__ __forceinline__ void kload8(bf16x8*kf,lds_cptr kp){
  kf[0]=*(const __attribute__((address_space(3))) bf16x8*)(kp);      kf[1]=*(const __attribute__((address_space(3))) bf16x8*)(kp+512);
  kf[2]=*(const __attribute__((address_space(3))) bf16x8*)(kp+2048); kf[3]=*(const __attribute__((address_space(3))) bf16x8*)(kp+2560);
  kf[4]=*(const __attribute__((address_space(3))) bf16x8*)(kp+4096); kf[5]=*(const __attribute__((address_space(3))) bf16x8*)(kp+4608);
  kf[6]=*(const __attribute__((address_space(3))) bf16x8*)(kp+6144); kf[7]=*(const __attribute__((address_space(3))) bf16x8*)(kp+6656);
}
__device__ __forceinline__ void kload2(bf16x8*kf,lds_cptr kp,int j){ kf[2*j]=*(const __attribute__((address_space(3))) bf16x8*)(kp+j*2048); kf[2*j+1]=*(const __attribute__((address_space(3))) bf16x8*)(kp+j*2048+512); }
__device__ __forceinline__ s16x4 vtr(lds_cptr p){ return __builtin_bit_cast(s16x4,__builtin_amdgcn_ds_read_tr16_b64_v4i16((__attribute__((address_space(3))) v4i16_t*)p)); }
__device__ __forceinline__ float rowmax(const f32x16&p0,const f32x16&p1){
  float a=max3f(p0[0],p0[1],p1[0]),b=max3f(p0[2],p0[3],p1[1]);a=max3f(a,p1[2],p1[3]);
  #pragma unroll
  for(int r=4;r<16;r+=4){a=max3f(a,p0[r],p0[r+1]);b=max3f(b,p0[r+2],p0[r+3]);a=max3f(a,p1[r],p1[r+1]);b=max3f(b,p1[r+2],p1[r+3]);}
  const float m=max2f(a,b);
  auto rr=__builtin_amdgcn_permlane32_swap(__float_as_uint(m),__float_as_uint(m),false,false);
  return max2f(__uint_as_float(rr[0]),__uint_as_float(rr[1]));
}
__device__ __forceinline__ void pv(f32x16*o,int vb,bf16x8 pa0,bf16x8 pa1,bf16x8 pa2,bf16x8 pa3){
  #pragma unroll
  for(int d0=0;d0<2;++d0){s16x4 lo[4],hi[4];
    #pragma unroll
    for(int ks=0;ks<4;++ks){
      asm volatile("ds_read_b64_tr_b16 %0,%1 offset:%c2":"=&v"(lo[ks]):"v"(vb),"i"(d0*4096+ks*1024):"memory");
      asm volatile("ds_read_b64_tr_b16 %0,%1 offset:%c2":"=&v"(hi[ks]):"v"(vb),"i"(d0*4096+ks*1024+512):"memory");}
    asm volatile("s_waitcnt lgkmcnt(0)":::"memory");SBAR();
    #define PK(k) (bf16x8){lo[k][0],lo[k][1],lo[k][2],lo[k][3],hi[k][0],hi[k][1],hi[k][2],hi[k][3]}
    o[d0]=__builtin_amdgcn_mfma_f32_32x32x16_bf16(pa0,PK(0),o[d0],0,0,0);
    o[d0]=__builtin_amdgcn_mfma_f32_32x32x16_bf16(pa1,PK(1),o[d0],0,0,0);
    o[d0]=__builtin_amdgcn_mfma_f32_32x32x16_bf16(pa2,PK(2),o[d0],0,0,0);
    o[d0]=__builtin_amdgcn_mfma_f32_32x32x16_bf16(pa3,PK(3),o[d0],0,0,0);
    #undef PK
  }
}

#ifndef ATTN_STORE16
#define ATTN_STORE16(p,v) (*(u32x4*)(p)=(v))
#endif
typedef float f32x4b __attribute__((ext_vector_type(4)));
template<int THRL> __device__ __forceinline__ void attn_unit(int b,int h,int qb,const bf16*Q,const bf16*__restrict__ K,const bf16*__restrict__ V,bf16*O,char*shm,const __attribute__((address_space(3))) float*bl0,const int tid_,const int tskip){
  const __attribute__((address_space(3))) float*bl=bl0+tskip*64;
  const int tid=tid_,lane=tid&63,r32=lane&31,hi=lane>>5; const int wid=__builtin_amdgcn_readfirstlane(tid>>6);
  const long rowbase=(long)b*SEQ; const int q0=qb*QB;
  const bf16*Qw=Q+(rowbase+q0+wid*QBLK)*DM+h*D;
  const bf16*Kh=K+(rowbase+(long)tskip*KVBLK)*DM+h*D,*Vh=V+(rowbase+(long)tskip*KVBLK)*DM+h*D;
  const unsigned lds0=(unsigned)(uintptr_t)shm;
  float*wsf=(float*)(shm+LDS_WS)+wid*64;
  const bf16*ksrc=Kh+(long)lane*DM+wid*8;
  const bf16*vsrc=Vh+(long)(16*(wid&3)+(lane>>2))*DM+(wid>>2)*32+(lane&3)*8;
  const unsigned kdst=lds0+LDS_K+wid*1024, vdst=lds0+LDS_V+wid*1024;
  #define DMA_K(t,slot) glds16(ksrc+(long)(t)*KVBLK*DM,(unsigned)__builtin_amdgcn_readfirstlane(kdst+(slot)))
  #define DMA_V(t,slot) glds16(vsrc+(long)(t)*KVBLK*DM,(unsigned)__builtin_amdgcn_readfirstlane(vdst+(slot)))
  const int vb0=(int)(lds0+LDS_V)+((lane>>4)&1)*32+(lane&3)*8+(4*hi+((lane&15)>>2))*64;
  const char*Kbase=shm+LDS_K; bf16x8 kf[8];
  const lds_cptr shm3=(lds_cptr)shm; const lds_cptr kp0=shm3+LDS_K+hi*1024+r32*16; const lds_cptr vp0=shm3+LDS_V+((lane>>4)&1)*32+(lane&3)*8+(4*hi+((lane&15)>>2))*64;
  const int NT=(q0+QB)/KVBLK-tskip;
  DMA_K(0,0);DMA_V(0,0);DMA_K(1,SLOTB);
  bf16x8 qr[4];
  #pragma unroll
  for(int d0=0;d0<4;++d0)qr[d0]=*reinterpret_cast<const bf16x8*>(&Qw[(long)r32*DM+d0*16+hi*8]);
  float mhat=0.f,l_reg=0.f;f32x16 o[2];o[0]=f32x16{};o[1]=f32x16{};
  const int qrel=wid*QBLK+r32;
  #define CMASK(P0,P1,t) do{int jb_=(t)-(NT-4); if(jb_>=0)cmask(P0,P1,jb_,qrel,hi);}while(0)
  #define BIASLD(P0,P1,t) do{ const __attribute__((address_space(3))) f32x4b*bp_=(const __attribute__((address_space(3))) f32x4b*)(bl+(t)*64+hi*4); \
    _Pragma("unroll") for(int g_=0;g_<4;++g_){ const f32x4b b0_=bp_[2*g_],b1_=bp_[8+2*g_]; \
      P0[4*g_]=b0_[0];P0[4*g_+1]=b0_[1];P0[4*g_+2]=b0_[2];P0[4*g_+3]=b0_[3]; P1[4*g_]=b1_[0];P1[4*g_+1]=b1_[1];P1[4*g_+2]=b1_[2];P1[4*g_+3]=b1_[3]; } }while(0)
  bool resc=false;
  #define START(P0,P1) do{ const float rm=rowmax(P0,P1); resc=false; \
    { const float dl=rm; mhat=fadd_s(mhat,dl); \
      _Pragma("unroll") for(int r=0;r<16;++r){P0[r]=fsub_s(P0[r],dl);P1[r]=fsub_s(P1[r],dl);} } \
    _Pragma("unroll") for(int r=0;r<16;++r)P0[r]=__builtin_amdgcn_exp2f(P0[r]); }while(0)
  #define RESC() do{ if(resc){ asm volatile("s_waitcnt lgkmcnt(0)":::"memory"); \
      _Pragma("unroll") for(int d_=0;d_<2;++d_) _Pragma("unroll") for(int r=0;r<16;++r)o[d_][r]*=wsf[crow(r,hi)]; } }while(0)
  f32x16 pA0,pA1,pB0,pB1;
  int sl_prev=0,sl_cur=0,sl_next=SLOTB;
  #define ROT() do{sl_prev=sl_cur;sl_cur=sl_next;sl_next=(sl_next==(NSLOT-1)*SLOTB)?0:sl_next+SLOTB;}while(0)
  DMA_K(2,2*SLOTB);
  WAIT_BAR(3);
  BIASLD(pA0,pA1,0);qkt(pA0,pA1,Kbase,qr,r32,hi);asm volatile("s_nop 15\n\ts_nop 7":"+v"(pA0),"+v"(pA1));CMASK(pA0,pA1,0);
  START(pA0,pA1);
  _Pragma("unroll") for(int r=0;r<16;++r)pA1[r]=__builtin_amdgcn_exp2f(pA1[r]);
  WAIT_BAR(0);
  DMA_K(3,0);DMA_V(1,SLOTB);
  ROT();
  kload8(kf,kp0+sl_cur);
  WAIT_BAR(2);
  s16x4 vlo[8],vhi[8]; u32x4 pw0,pw1,pw2,pw3;
  #define PKW(P,B) cvtpk_s(P[B],P[B+1])
  #define PAF(k) __builtin_bit_cast(bf16x8,pw##k)
  #define VFR(i) (bf16x8){vlo[i][0],vlo[i][1],vlo[i][2],vlo[i][3],vhi[i][0],vhi[i][1],vhi[i][2],vhi[i][3]}
  #define PIN(x) asm volatile("":"+v"(x))
  #define MX3(a,b,c) __builtin_fmaxf(__builtin_fmaxf((a),(b)),(c))
  #define GAPA(MF,A0,A1,A2,A3,W0,W1,PW) do{ MF; sacc+=A0; sacc+=A1; sacc+=A2; sacc+=A3; PIN(sacc); W0; W1; PIN(PW); SBAR(); }while(0)
  #define EX(v) __builtin_amdgcn_exp2f(v)
  #define GAPB(MF,X,B) do{ MF; X[B]=EX(X[B]-mhat); X[B+1]=EX(X[B+1]-mhat); X[B+2]=EX(X[B+2]-mhat); X[B+3]=EX(X[B+3]-mhat); PIN(X); SBAR(); }while(0)
  #define VRD(i) do{ vlo[i]=vtr(vp_+(((i)>>2)*4096+((i)&3)*1024)); vhi[i]=vtr(vp_+(((i)>>2)*4096+((i)&3)*1024+512)); }while(0)
  #define KRD(G,j) do{ if(G){ kload2(kf,kp0+sl_next,j); SBAR(); } }while(0)
  #define STEP(C0,C1,P0,P1,t,GK,GV,GL) do{ SBAR(); BIASLD(C0,C1,t); SBAR(); \
    const lds_cptr vp_=vp0+sl_prev; \
    VRD(0); SBAR(); float sacc=(P0[0]+P0[1]); \
    GAPA(C0=__builtin_amdgcn_mfma_f32_32x32x16_bf16(kf[0],qr[0],C0,0,0,0), P0[2],P0[3],P0[4],P0[5],     pw0[0]=PKW(P0,0), pw0[1]=PKW(P0,2), pw0); \
    VRD(4); SBAR(); GAPA(C1=__builtin_amdgcn_mfma_f32_32x32x16_bf16(kf[1],qr[0],C1,0,0,0), P0[6],P0[7],P0[8],P0[9],     pw0[2]=PKW(P0,4), pw0[3]=PKW(P0,6), pw0); \
    VRD(1); SBAR(); GAPA(C0=__builtin_amdgcn_mfma_f32_32x32x16_bf16(kf[2],qr[1],C0,0,0,0),   P0[10],P0[11],P0[12],P0[13], pw1[0]=PKW(P0,8), pw1[1]=PKW(P0,10), pw1); \
    VRD(5); SBAR(); GAPA(C1=__builtin_amdgcn_mfma_f32_32x32x16_bf16(kf[3],qr[1],C1,0,0,0),   P0[14],P0[15],P1[0],P1[1],   pw1[2]=PKW(P0,12),pw1[3]=PKW(P0,14), pw1); \
    VRD(2); SBAR(); GAPA(C0=__builtin_amdgcn_mfma_f32_32x32x16_bf16(kf[4],qr[2],C0,0,0,0),   P1[2],P1[3],P1[4],P1[5],     pw2[0]=PKW(P1,0), pw2[1]=PKW(P1,2), pw2); \
    VRD(6); SBAR(); GAPA(C1=__builtin_amdgcn_mfma_f32_32x32x16_bf16(kf[5],qr[2],C1,0,0,0),   P1[6],P1[7],P1[8],P1[9],     pw2[2]=PKW(P1,4), pw2[3]=PKW(P1,6), pw2); \
    VRD(3); SBAR(); GAPA(C0=__builtin_amdgcn_mfma_f32_32x32x16_bf16(kf[6],qr[3],C0,0,0,0),   P1[10],P1[11],P1[12],P1[13], pw3[0]=PKW(P1,8), pw3[1]=PKW(P1,10), pw3); \
    VRD(7); SBAR(); GAPA(C1=__builtin_amdgcn_mfma_f32_32x32x16_bf16(kf[7],qr[3],C1,0,0,0),   P1[14],P1[15],0.f,0.f,       pw3[2]=PKW(P1,12),pw3[3]=PKW(P1,14), pw3); \
    l_reg+=sacc; \
    if(GK){DMA_K((t)+3,sl_cur);} if(GV){DMA_V((t)+1,sl_next);} \
    CMASK(C0,C1,t); \
    { float a=MX3(C0[0],C0[1],C1[0]),b=MX3(C0[2],C0[3],C1[1]); a=MX3(a,C1[2],C1[3]); \
      _Pragma("unroll") for(int r=4;r<16;r+=4){a=MX3(a,C0[r],C0[r+1]);b=MX3(b,C0[r+2],C0[r+3]);a=MX3(a,C1[r],C1[r+1]);b=MX3(b,C1[r+2],C1[r+3]);} \
      float rm=__builtin_fmaxf(a,b); { auto rr=__builtin_amdgcn_permlane32_swap(__float_as_uint(rm),__float_as_uint(rm),false,false); rm=__builtin_fmaxf(__uint_as_float(rr[0]),__uint_as_float(rr[1])); } \
      resc=false; const float dm_=rm-mhat; \
      if(__builtin_expect(__any(dm_>(float)THRL),0)){ const float dl=__builtin_fmaxf(dm_,0.f); mhat+=dl; \
        const float f=__builtin_amdgcn_exp2f(-dl); l_reg*=f; if(hi==0)wsf[r32]=f; resc=true; } } \
    SBAR(); \
    GAPB(o[0]=__builtin_amdgcn_mfma_f32_32x32x16_bf16(PAF(0),VFR(0),o[0],0,0,0), C0,0); \
    GAPB(o[1]=__builtin_amdgcn_mfma_f32_32x32x16_bf16(PAF(0),VFR(4),o[1],0,0,0), C0,4); \
    KRD(GL,0); GAPB(o[0]=__builtin_amdgcn_mfma_f32_32x32x16_bf16(PAF(1),VFR(1),o[0],0,0,0), C0,8); \
    KRD(GL,1); GAPB(o[1]=__builtin_amdgcn_mfma_f32_32x32x16_bf16(PAF(1),VFR(5),o[1],0,0,0), C0,12); \
    KRD(GL,2); GAPB(o[0]=__builtin_amdgcn_mfma_f32_32x32x16_bf16(PAF(2),VFR(2),o[0],0,0,0), C1,0); \
    KRD(GL,3); GAPB(o[1]=__builtin_amdgcn_mfma_f32_32x32x16_bf16(PAF(2),VFR(6),o[1],0,0,0), C1,4); \
    GAPB(o[0]=__builtin_amdgcn_mfma_f32_32x32x16_bf16(PAF(3),VFR(3),o[0],0,0,0), C1,8); \
    GAPB(o[1]=__builtin_amdgcn_mfma_f32_32x32x16_bf16(PAF(3),VFR(7),o[1],0,0,0), C1,12); \
    }while(0)
  int t=1;
  #undef CMASK
  #define CMASK(P0,P1,t) do{}while(0)
  for(;t+5<NT;t+=2){
    STEP(pB0,pB1,pA0,pA1,t,true,true,true);     WAIT_BAR(2); RESC(); ROT();
    STEP(pA0,pA1,pB0,pB1,t+1,true,true,true);   WAIT_BAR(2); RESC(); ROT();
  }
  #undef CMASK
  #define CMASK(P0,P1,t) do{int jb_=(t)-(NT-4); if(jb_>=0)cmask(P0,P1,jb_,qrel,hi);}while(0)
  #define ENDW(tt) do{ if((tt)+3<NT){WAIT_BAR(2);} else if((tt)+2<NT){WAIT_BAR(1);} else {WAIT_BAR(0);} }while(0)
  for(;t+1<NT;t+=2){
    STEP(pB0,pB1,pA0,pA1,t,(t+3<NT),(t+1<NT),(t+1<NT));       ENDW(t);   RESC(); ROT();
    STEP(pA0,pA1,pB0,pB1,t+1,(t+4<NT),(t+2<NT),(t+2<NT));     ENDW(t+1); RESC(); ROT();
  }
  STEP(pB0,pB1,pA0,pA1,NT-1,false,false,false); RESC();
  { float sacc=pB0[0]+pB0[1]; _Pragma("unroll") for(int r=2;r<16;++r)sacc+=pB0[r]; _Pragma("unroll") for(int r=0;r<16;++r)sacc+=pB1[r]; l_reg+=sacc;
    pw0=(u32x4){PKW(pB0,0),PKW(pB0,2),PKW(pB0,4),PKW(pB0,6)};pw1=(u32x4){PKW(pB0,8),PKW(pB0,10),PKW(pB0,12),PKW(pB0,14)};pw2=(u32x4){PKW(pB1,0),PKW(pB1,2),PKW(pB1,4),PKW(pB1,6)};pw3=(u32x4){PKW(pB1,8),PKW(pB1,10),PKW(pB1,12),PKW(pB1,14)};
    SBAR(); pv(o,vb0+sl_cur,PAF(0),PAF(1),PAF(2),PAF(3)); }
  #undef PKW
  #undef PAF
  #undef VFR
  #undef PIN
  #undef MX3
  #undef GAPA
  #undef GAPB
  #undef EX
  #undef VRD
  #undef KRD
  #undef STEP
  #undef ENDW
  {auto rr=__builtin_amdgcn_permlane32_swap(__float_as_uint(l_reg),__float_as_uint(l_reg),false,false);l_reg=__uint_as_float(rr[0])+__uint_as_float(rr[1]);}
  if(hi==0)wsf[32+r32]=l_reg;asm volatile("s_waitcnt lgkmcnt(0)":::"memory");
  float rli[16];
  #pragma unroll
  for(int r=0;r<16;++r)rli[r]=__builtin_amdgcn_rcpf(wsf[32+crow(r,hi)]);
  bf16*Ow=O+(rowbase+q0+wid*QBLK)*DM+h*D;
  { bf16*stg=(bf16*)(shm+LDS_OST)+wid*2048;
    #pragma unroll
    for(int r=0;r<16;++r){const int orow=crow(r,hi);
      #pragma unroll
      for(int d0=0;d0<2;++d0)stg[orow*64+d0*32+r32]=__float2bfloat16(o[d0][r]*rli[r]);}
    asm volatile("s_waitcnt lgkmcnt(0)":::"memory");
    #pragma unroll
    for(int i=0;i<4;++i){const int row=i*8+(lane>>3),ch=lane&7; const u32x4 v=*(const u32x4*)(stg+row*64+ch*8); ATTN_STORE16(Ow+(long)row*DM+ch*8,v);} }
  asm volatile("s_waitcnt lgkmcnt(0)\n\ts_barrier":::"memory");
  #undef DMA_K
  #undef DMA_V
  #undef CMASK
  #undef BIASLD
  #undef START
  #undef RESC
  #undef ROT
}
constexpr int ATTN_LDS_BYTES=LDS_BYTES;
struct AttnTensors { const bf16* Q; const bf16* K; const bf16* V; bf16* O; };
struct AttnUnit { int bh; int qb; };
struct StaticOrder {
  int vcu;
  __device__ __forceinline__ explicit StaticOrder(int grid,int block):vcu((block%8)*(grid/8)+block/8){}
  __device__ __forceinline__ bool next(int i,AttnUnit&u)const{ if(i>=4)return false; const int s=vcu&3; u.bh=vcu>>2; u.qb=(i==0)?s:(i==1)?7-s:(i==2)?8+s:15-s; return true; }
};
template<class Sched,int THRL=8> __device__ __forceinline__ void attn_phase(char*lds,const AttnTensors&T,const Sched&S,const __attribute__((address_space(3))) float*bl,const int tid,const __attribute__((address_space(3))) int*tsk){
  AttnUnit u;
  for(int i=0;S.next(i,u);++i){ attn_unit<THRL>(u.bh/NHEAD,u.bh%NHEAD,u.qb,T.Q,T.K,T.V,T.O,lds,bl,tid,__builtin_amdgcn_readfirstlane(tsk[i])); }
}
#undef SBAR
#undef WAIT_BAR
}
namespace mk {
#define LAS __attribute__((address_space(3)))
#define XB_TMO      128
#define XB_XCNT(j)  (256  + 64 * (j))
#define XB_XSUB(j)  (1280 + 64 * (j))
#define XB_XGEN(j)  (2304 + 64 * (j))
#define XB_TOP      3328
#define XB_TOPGEN   3392
#define XCD_BAR_WORDS 3456
#define XB_SPIN_CAP (1u << 18)

__device__ __forceinline__ unsigned xb_ld(unsigned* p)              { return __hip_atomic_load(p, __ATOMIC_RELAXED, __HIP_MEMORY_SCOPE_AGENT); }
__device__ __forceinline__ unsigned xb_add(unsigned* p, unsigned v) { return __hip_atomic_fetch_add(p, v, __ATOMIC_RELAXED, __HIP_MEMORY_SCOPE_AGENT); }
__device__ __forceinline__ unsigned xb_xcc_id() { return (unsigned)__builtin_amdgcn_s_getreg((3 << 11) | 20) & 0xFu; }
#define XB_SPIN(cond, bar) do { unsigned _sp = 0; while (cond) { __builtin_amdgcn_s_sleep(1); \
    if ((++_sp & 255u) == 0u) { if (xb_ld(&(bar)[XB_TMO])) break; if (_sp > XB_SPIN_CAP) { atomicAdd(&(bar)[XB_TMO], 1u); break; } } } } while (0)

struct XcdBarrier {
    unsigned* bar; unsigned x;
    volatile LAS unsigned* st;
};

__device__ __forceinline__ XcdBarrier xcd_barrier_post(unsigned* bar, volatile LAS unsigned* st) {
    XcdBarrier b; b.bar = bar; b.x = xb_xcc_id(); b.st = st;
    if (threadIdx.x == 0) (void)xb_add(&bar[XB_XCNT(b.x)], 1u);
    return b;
}
__device__ __forceinline__ void xcd_barrier_complete(unsigned* bar, unsigned x, unsigned& nloc, unsigned& nx) {
    const unsigned G = gridDim.x * gridDim.y * gridDim.z;
    unsigned sum, cnt, mine, sp = 0u;
    for (;;) {
        sum = 0u; cnt = 0u; mine = 0u;
#pragma unroll
        for (unsigned j = 0; j < 16; ++j) { const unsigned c = xb_ld(&bar[XB_XCNT(j)]); sum += c; cnt += (c > 0u) ? 1u : 0u; mine = (j == x) ? c : mine; }
        if (sum == G) break;
        __builtin_amdgcn_s_sleep(1);
        if ((++sp & 255u) == 0u) { if (xb_ld(&bar[XB_TMO])) break; if (sp > XB_SPIN_CAP) { atomicAdd(&bar[XB_TMO], 1u); break; } }
    }
    nloc = mine > 0u ? mine : 1u; nx = cnt > 0u ? cnt : 1u;
}

__device__ __forceinline__ void xcd_barrier(const XcdBarrier& b) {
    asm volatile("s_waitcnt vmcnt(0)" ::: "memory");
    __syncthreads();
    if (threadIdx.x == 0) {
        unsigned* bar = b.bar;
        __builtin_amdgcn_s_waitcnt(0);
        unsigned nloc = b.st[0], nx = b.st[1];
        if (nloc == 0u) { xcd_barrier_complete(bar, b.x, nloc, nx); b.st[0] = nloc; b.st[1] = nx; }
        const unsigned old = xb_add(&bar[XB_XSUB(b.x)], 1u);
        const unsigned gen = old / nloc;
        if (old + 1u == (gen + 1u) * nloc) {
            __builtin_amdgcn_fence(__ATOMIC_RELEASE, "agent");
            asm volatile("s_waitcnt vmcnt(0)" ::: "memory");
            const unsigned og = xb_add(&bar[XB_TOP], 1u);
            const unsigned tg = og / nx;
            if (og + 1u == (tg + 1u) * nx) xb_add(&bar[XB_TOPGEN], 1u);
            else XB_SPIN(xb_ld(&bar[XB_TOPGEN]) == tg, bar);
            __builtin_amdgcn_fence(__ATOMIC_ACQUIRE, "agent");
            xb_add(&bar[XB_XGEN(b.x)], 1u);
            asm volatile("s_waitcnt vmcnt(0)" ::: "memory");
        } else {
            XB_SPIN(xb_ld(&bar[XB_XGEN(b.x)]) == gen, bar);
            __builtin_amdgcn_fence(__ATOMIC_ACQUIRE, "agent");
            asm volatile("s_waitcnt vmcnt(0)" ::: "memory");
        }
    }
    __syncthreads();
}

#undef LAS
}
namespace mk {
constexpr int NWAVES = 8;
constexpr int D = 1024, BATCH = 4, SEQ = 4096, M = BATCH * SEQ, DEPTH = 4, NH = 16, HD = 64, FOX_IN = 3 * D + NH, DFF = 2816;
constexpr int SG = 64, SP = 64, SC = 16;
constexpr float RMS_EPS = 1e-6f;
constexpr size_t MiB = 1u << 20;
constexpr size_t WS_CTL = 276 * MiB, CTL_ZERO_BYTES = 3 * MiB;
constexpr size_t WS_SSQ = 277 * MiB;
constexpr size_t WS_WQKV = 2 * MiB;
constexpr size_t WS_WO = 14 * MiB;
constexpr size_t WS_WS5IN = 18 * MiB;
constexpr size_t WS_WGLU = 20 * MiB;
constexpr size_t WS_BTA = 24 * MiB;
constexpr size_t WS_BTB = 32 * MiB;
constexpr size_t WS_WPOOL = 44 * MiB;
constexpr size_t WS_WF = 44 * MiB + 512 * 1024;
constexpr size_t WS_KERN = 45 * MiB;
constexpr size_t WS_LAMC = 46 * MiB;
constexpr size_t WS_LF = 47 * MiB;
constexpr size_t WS_WGU = 48 * MiB;
constexpr size_t WS_WDN = 92 * MiB;
constexpr size_t WS_XB = 114 * MiB;
constexpr size_t WS_ACT = 146 * MiB;
constexpr size_t WS_O = 244 * MiB;
constexpr size_t WS_NRM = 279 * MiB;
constexpr size_t WS_END = 283 * MiB;
constexpr int CW_TMO = 0, CW_BAR = 4096, CW_PANEL = 16384, CW_QUEUE = 24576, CW_HQ = 32768;

constexpr int RING_OFF = 0, RING_BYTES = 131072;
constexpr int LDSCTL_OFF = RING_BYTES, MISC_OFF = LDSCTL_OFF + 320;
constexpr int LDS_BYTES = 147456;

#define GAS __attribute__((address_space(1)))
#define LAS __attribute__((address_space(3)))
typedef unsigned short bf16;
typedef unsigned v4u __attribute__((ext_vector_type(4)));
typedef float f32x4 __attribute__((ext_vector_type(4)));
typedef float f32x2 __attribute__((ext_vector_type(2)));
typedef short bf16x8 __attribute__((ext_vector_type(8)));
typedef GAS unsigned gu32;
#define RLX_AGENT __ATOMIC_RELAXED, __HIP_MEMORY_SCOPE_AGENT
#define LDS_WAIT() asm volatile("s_waitcnt lgkmcnt(0)" ::: "memory")
#define VM_WAIT() asm volatile("s_waitcnt vmcnt(0)" ::: "memory")
__device__ __forceinline__ unsigned f2bf(float f) { unsigned u = __builtin_bit_cast(unsigned, f); return (u + 0x7fffu + ((u >> 16) & 1u)) >> 16; }
__device__ __forceinline__ unsigned pk2(float lo, float hi) { return f2bf(lo) | (f2bf(hi) << 16); }
__device__ __forceinline__ float bf2f(unsigned short b) { return __builtin_bit_cast(float, (unsigned)b << 16); }
__device__ __forceinline__ float lshx(float v, int lane, int m) { return __builtin_bit_cast(float, __builtin_amdgcn_ds_bpermute((lane ^ m) << 2, __builtin_bit_cast(int, v))); }
__device__ __forceinline__ float wave_sum(float v, int lane) {
#pragma unroll
    for (int o = 1; o < 64; o <<= 1) v += lshx(v, lane, o);
    return v;
}

enum Op { OP_PROLOGUE = 0, OP_QKV, OP_ATTN, OP_WO, OP_UP, OP_DOWN, OP_S5IN, OP_SSM, OP_SSMB, OP_GLU, OP_POOLPREP, OP_POOLGEMM, OP_FINAL, OP_NORMX, OP_S5TAB };
struct PhaseEnt { int op, layer, j, sin, sout; };
#define MK_PROGRAM \
    {OP_PROLOGUE, 0, 0, 0, 0}, \
    {OP_QKV, 0, 0, 0, 0}, {OP_ATTN, 0, 0, 0, 0}, {OP_WO, 0, 0, 0, 1}, {OP_UP, 0, 0, 1, 0}, {OP_DOWN, 0, 0, 0, 2}, \
    {OP_S5IN, 1, 0, 2, 0}, {OP_SSM, 1, 0, 0, 0}, {OP_GLU, 1, 0, 0, 3}, {OP_UP, 1, 0, 3, 0}, {OP_DOWN, 1, 0, 0, 4}, \
    {OP_POOLGEMM, 2, 0, 4, 5}, {OP_UP, 2, 0, 5, 0}, {OP_DOWN, 2, 0, 0, 6}, \
    {OP_QKV, 3, 1, 6, 0}, {OP_ATTN, 3, 1, 0, 0}, {OP_WO, 3, 1, 0, 7}, {OP_UP, 3, 0, 7, 0}, {OP_DOWN, 3, 0, 0, 8}, \
    {OP_FINAL, 0, 0, 8, 0}, \
    {OP_NORMX, 0, 0, 0, 1}, {OP_NORMX, 0, 0, 0, 2}, {OP_NORMX, 0, 0, 0, 3}, {OP_NORMX, 0, 0, 0, 4}, {OP_NORMX, 0, 0, 0, 5}, {OP_NORMX, 0, 0, 0, 6}, {OP_NORMX, 0, 0, 0, 7}, {OP_NORMX, 0, 0, 0, 8}, \
    {OP_S5TAB, 0, 0, 0, 0}
constexpr int N_PROG = 29, PH_FINAL = 19, PH_LAST = 18, PH_NORMX1 = 20, PH_S5TAB = 28;
__constant__ PhaseEnt PROG[N_PROG] = { MK_PROGRAM };

struct Args { const float* in[22]; float* out; unsigned char* ws; int ph_lo, ph_hi; };

__device__ __forceinline__ void wt_load(f32x4 (&v)[8], const float* W, int ldw, int n0_src, int k0, int lane) {
    const int c4 = lane & 7, r8 = lane >> 3;
    const GAS f32x4* src = (const GAS f32x4*)(W + (size_t)(k0 + r8) * ldw + n0_src + 4 * c4);
#pragma unroll
    for (int i = 0; i < 8; ++i) v[i] = MK_WNT ? __builtin_nontemporal_load(src + (size_t)i * 2 * ldw) : src[(size_t)i * 2 * ldw];
}
__device__ __forceinline__ void wt_store(f32x4 (&v)[8], int K, const float* gain, bf16* WT, int n0_dst, int k0, LAS float* scr, int lane) {
    const int c4 = lane & 7, r8 = lane >> 3;
    if (gain) {
#pragma unroll
        for (int i = 0; i < 8; ++i) v[i] = v[i] * gain[k0 + r8 + 8 * i]; }
#pragma unroll
    for (int i = 0; i < 8; ++i) { LAS float* d = scr + (r8 + 8 * i) * 33 + 4 * c4; d[0] = v[i].x; d[1] = v[i].y; d[2] = v[i].z; d[3] = v[i].w; }
    LDS_WAIT(); asm volatile("" ::: "memory");
    const int c = lane & 7;
#pragma unroll
    for (int j = 0; j < 4; ++j) { const int n = (lane >> 3) + 8 * j; const LAS float* s = scr + (8 * c) * 33 + n;
        v4u o; o.x = pk2(s[0 * 33], s[1 * 33]); o.y = pk2(s[2 * 33], s[3 * 33]); o.z = pk2(s[4 * 33], s[5 * 33]); o.w = pk2(s[6 * 33], s[7 * 33]);
        pg8::st_wt((GAS bf16*)WT + (size_t)(n0_dst + n) * K + k0 + 8 * c, o); }
    LDS_WAIT(); asm volatile("" ::: "memory");
}
__device__ __forceinline__ void wt_item(const float* W, int ldw, int K, const float* gain, bf16* WT, int n0_dst, int n0_src, int k0, LAS float* scr, int lane) {
    f32x4 v[8]; wt_load(v, W, ldw, n0_src, k0, lane); wt_store(v, K, gain, WT, n0_dst, k0, scr, lane);
}
template <int NR> __device__ __forceinline__ void normx_rows(const float* x0, size_t xstride, bf16* o0, size_t ostride, pg8::ssq_t* ssq0, size_t sstride, int lane) {
    f32x4 v[NR][4]; float s[NR];
#pragma unroll
    for (int r = 0; r < NR; ++r) { const GAS f32x4* xr = (const GAS f32x4*)(x0 + r * xstride) + lane;
#pragma unroll
        for (int j = 0; j < 4; ++j) v[r][j] = xr[64 * j]; }
#pragma unroll
    for (int r = 0; r < NR; ++r) { s[r] = 0.f;
#pragma unroll
        for (int j = 0; j < 4; ++j) s[r] += (v[r][j].x * v[r][j].x + v[r][j].y * v[r][j].y) + (v[r][j].z * v[r][j].z + v[r][j].w * v[r][j].w);
        s[r] = wave_sum(s[r], lane); }
#pragma unroll
    for (int r = 0; r < NR; ++r) { GAS unsigned long long* o8 = (GAS unsigned long long*)(o0 + r * ostride) + lane;
#pragma unroll
        for (int j = 0; j < 4; ++j) pg8::st_wt(o8 + 64 * j, (unsigned long long)pk2(v[r][j].x, v[r][j].y) | ((unsigned long long)pk2(v[r][j].z, v[r][j].w) << 32));
        if (lane == 0) ssq0[r * sstride] = (pg8::ssq_t)__builtin_llrintf(s[r] * pg8::SSQ_SCALE); }
}
__device__ __forceinline__ void normx_row(const float* xrow, bf16* orow, pg8::ssq_t* ssq_slot, int lane) { normx_rows<1>(xrow, 0, orow, 0, ssq_slot, 0, lane); }
__device__ __forceinline__ f32x4 bf4(const pg8::u32x2 w) { return (f32x4){__builtin_bit_cast(float, w.x << 16), __builtin_bit_cast(float, w.x & 0xffff0000u), __builtin_bit_cast(float, w.y << 16), __builtin_bit_cast(float, w.y & 0xffff0000u)}; }
template <int W> __device__ __forceinline__ void pool_item(const bf16* X, const pg8::ssq_t* ssq, const f32x4 gg, bf16* PD, int row0, int t0, int c0) {
    f32x4 ring[W]; f32x4 run = {0.f, 0.f, 0.f, 0.f};
    { pg8::u32x2 xw[W]; pg8::ssq_t sw[W];
#pragma unroll
      for (int kk = 1; kk < W; ++kk) { xw[kk] = (pg8::u32x2){0u, 0u}; sw[kk] = 0;
          if (t0 - W + kk >= 0) { const int r = row0 - W + kk; xw[kk] = *(const GAS pg8::u32x2*)(X + (size_t)r * D + c0); sw[kk] = ((const GAS pg8::ssq_t*)ssq)[r]; } }
#pragma unroll
      for (int kk = 1; kk < W; ++kk) {
          const f32x4 hv = bf4(xw[kk]) * __builtin_amdgcn_rsqf((float)sw[kk] * (1.0f / (1024.0f * pg8::SSQ_SCALE)) + RMS_EPS) * gg;
          ring[kk % W] = hv; run += hv; } }
    pg8::u32x2 xc[16]; pg8::ssq_t sc[16];
#pragma unroll
    for (int i = 0; i < 16; ++i) { xc[i] = *(const GAS pg8::u32x2*)(X + (size_t)(row0 + i) * D + c0); sc[i] = ((const GAS pg8::ssq_t*)ssq)[row0 + i]; }
#pragma unroll
    for (int i = 0; i < 16; ++i) { const int r = row0 + i, t = t0 + i;
        const f32x4 hv = bf4(xc[i]) * __builtin_amdgcn_rsqf((float)sc[i] * (1.0f / (1024.0f * pg8::SSQ_SCALE)) + RMS_EPS) * gg;
        run += hv; ring[i % W] = hv;
        const int cnt = (t + 1 < W) ? (t + 1) : W; const f32x4 o = run * (1.0f / (float)cnt) - hv;
        pg8::st_wt((GAS bf16*)PD + (size_t)r * D + c0, (unsigned long long)pk2(o[0], o[1]) | ((unsigned long long)pk2(o[2], o[3]) << 32));
        run -= ring[(i + 1) % W]; }
}
__device__ __forceinline__ void touch_lines(const void* p, int bytes, int tid) {
    const GAS unsigned* q = (const GAS unsigned*)p + tid * 32; unsigned acc = 0;
    for (int o = 0; o < bytes; o += 512 * 128 * 8) {
#pragma unroll
        for (int i = 0; i < 8; ++i) acc |= q[(size_t)(o / 4) + (size_t)i * 512 * 32];
    }
    asm volatile("" :: "v"(acc));
}
struct WtDesc { const float* W; const float* gain; bf16* WT; int ldw, K, Ndst, kind, off2; };
__device__ __forceinline__ WtDesc wt_desc(const Args& args, int i) {
    unsigned char* ws = args.ws; const float* mix_g = args.in[1]; const float* ffn_g = args.in[2];
    WtDesc d;
    if (i < 2) { d.W = args.in[4] + (size_t)i * D * FOX_IN; d.gain = mix_g + (i ? 3 * D : 0); d.WT = (bf16*)(ws + WS_WQKV) + (size_t)i * 3 * D * D; d.ldw = FOX_IN; d.K = D; d.Ndst = 3 * D; d.kind = 0; d.off2 = 0; }
    else if (i < 4) { d.W = args.in[6] + (size_t)(i - 2) * D * D; d.gain = nullptr; d.WT = (bf16*)(ws + WS_WO) + (size_t)(i - 2) * D * D; d.ldw = D; d.K = D; d.Ndst = D; d.kind = 0; d.off2 = 0; }
    else if (i == 4) { d.W = args.in[7]; d.gain = mix_g + D; d.WT = (bf16*)(ws + WS_WS5IN); d.ldw = D; d.K = D; d.Ndst = D; d.kind = 0; d.off2 = 0; }
    else if (i == 5) { d.W = args.in[16]; d.gain = nullptr; d.WT = (bf16*)(ws + WS_WGLU); d.ldw = 2 * D; d.K = D; d.Ndst = 2 * D; d.kind = 1; d.off2 = D; }
    else if (i < 10) { d.W = args.in[17] + (size_t)(i - 6) * 65536; d.gain = nullptr; d.WT = (bf16*)(ws + WS_WPOOL) + (size_t)(i - 6) * 65536; d.ldw = 256; d.K = 256; d.Ndst = 256; d.kind = 0; d.off2 = 0; }
    else if (i < 14) { d.W = args.in[20] + (size_t)(i - 10) * D * 2 * DFF; d.gain = ffn_g + (i - 10) * D; d.WT = (bf16*)(ws + WS_WGU) + (size_t)(i - 10) * 2 * DFF * D; d.ldw = 2 * DFF; d.K = D; d.Ndst = 2 * DFF; d.kind = 1; d.off2 = DFF; }
    else { d.W = args.in[21] + (size_t)(i - 14) * DFF * D; d.gain = nullptr; d.WT = (bf16*)(ws + WS_WDN) + (size_t)(i - 14) * D * DFF; d.ldw = D; d.K = DFF; d.Ndst = D; d.kind = 0; d.off2 = 0; }
    return d;
}
__device__ __forceinline__ void ph_s5tables(const Args& args, LAS float* scr, LAS float* wsc, int gw, int NGW, int lane) {
    unsigned char* ws = args.ws;
    { const float* a_re = args.in[8]; const float* a_im = args.in[9]; const float* log_dt = args.in[10];
      const float* b_re = args.in[11]; const float* b_im = args.in[12]; const float* c_re = args.in[13]; const float* c_im = args.in[14];
      float* KERN = (float*)(ws + WS_KERN);
      for (int it = (gw + NGW / 2) % NGW; it < SG * 16; it += NGW) {
          const int g = it >> 4, tau = it & 15, p = lane;
          { const GAS f32x4* s0 = (const GAS f32x4*)(c_re + (size_t)g * 1024), *s1 = (const GAS f32x4*)(c_im + (size_t)g * 1024), *s2 = (const GAS f32x4*)(b_re + (size_t)g * 1024), *s3 = (const GAS f32x4*)(b_im + (size_t)g * 1024);
            f32x4 t0[4], t1[4], t2[4], t3[4];
#pragma unroll
            for (int j = 0; j < 4; ++j) { t0[j] = s0[lane + 64 * j]; t1[j] = s1[lane + 64 * j]; t2[j] = s2[lane + 64 * j]; t3[j] = s3[lane + 64 * j]; }
#pragma unroll
            for (int j = 0; j < 4; ++j) { ((LAS f32x4*)scr)[lane + 64 * j] = t0[j]; ((LAS f32x4*)scr)[256 + lane + 64 * j] = t1[j]; ((LAS f32x4*)scr)[512 + lane + 64 * j] = t2[j]; ((LAS f32x4*)scr)[768 + lane + 64 * j] = t3[j]; } }
          const double lr = a_re[g * SP + p], li = a_im[g * SP + p], dt = exp((double)log_dt[g]);
          const double er = exp(lr * dt), lbr = er * cos(li * dt), lbi = er * sin(li * dt);
          const double nr = lbr - 1.0, ni = lbi, den = lr * lr + li * li, fr = (nr * lr + ni * li) / den, fi = (ni * lr - nr * li) / den;
          const double et = exp(lr * dt * tau), ptr_ = et * cos(li * dt * tau), pti = et * sin(li * dt * tau);
          wsc[p] = (float)(ptr_ * fr - pti * fi); wsc[64 + p] = (float)(ptr_ * fi + pti * fr);
          LDS_WAIT(); asm volatile("" ::: "memory");
          const LAS float* Cr = scr, *Ci = scr + 1024, *Br = scr + 2048, *Bi = scr + 3072, *Wr_ = wsc, *Wi_ = wsc + 64;
          float acc[4] = {0.f, 0.f, 0.f, 0.f}; const int ci = lane & 15, cob = lane >> 4;
#pragma unroll 8
          for (int pp = 0; pp < SP; ++pp) {
              const float wr = Wr_[pp], wi = Wi_[pp], br = Br[pp * 16 + ci], bi = Bi[pp * 16 + ci];
#pragma unroll
              for (int q = 0; q < 4; ++q) { const int co = cob + 4 * q; const float cr = Cr[co * 64 + pp], cim = Ci[co * 64 + pp];
                  const float cwr = cr * wr - cim * wi, cwi = cr * wi + cim * wr; acc[q] += cwr * br - cwi * bi; } }
#pragma unroll
          for (int q = 0; q < 4; ++q) KERN[(size_t)it * 256 + lane + 64 * q] = acc[q];
          LDS_WAIT(); asm volatile("" ::: "memory");
      }
      bf16* BTA = (bf16*)(ws + WS_BTA);
      for (int e = gw * 64 + lane; e < SG * 128 * 16; e += NGW * 64) {
          const int g = e >> 11, n = (e >> 4) & 127, j = e & 15, p = n & 63, im = n >> 6;
          const double lr = a_re[g * SP + p], li = a_im[g * SP + p], dt = exp((double)log_dt[g]);
          const double er = exp(lr * dt), lbr = er * cos(li * dt), lbi = er * sin(li * dt);
          const double nr = lbr - 1.0, ni = lbi, den = lr * lr + li * li, fr = (nr * lr + ni * li) / den, fi = (ni * lr - nr * li) / den;
          const double tt = (double)(15 - j), et = exp(lr * dt * tt), ptr_ = et * cos(li * dt * tt), pti = et * sin(li * dt * tt);
          const float Wr = (float)(ptr_ * fr - pti * fi), Wi = (float)(ptr_ * fi + pti * fr);
          unsigned w[8];
#pragma unroll
          for (int c = 0; c < 16; c += 2) { float v[2];
#pragma unroll
              for (int q = 0; q < 2; ++q) { const float br = b_re[(g * SP + p) * SC + c + q], bi = b_im[(g * SP + p) * SC + c + q]; v[q] = im ? (Wr * bi + Wi * br) : (Wr * br - Wi * bi); }
              w[c >> 1] = pk2(v[0], v[1]); }
          v4u* dst = (v4u*)(BTA + ((size_t)g * 256 + n) * 256 + j * 16);
          dst[0] = (v4u){w[0], w[1], w[2], w[3]}; dst[1] = (v4u){w[4], w[5], w[6], w[7]};
      }
      for (int e = gw * 64 + lane; e < SG * 128 * 32; e += NGW * 64) { const int g = e >> 12, r = e & 4095; ((v4u*)(BTA + ((size_t)g * 256 + 128) * 256))[r] = (v4u){0u, 0u, 0u, 0u}; }
      bf16* BTB = (bf16*)(ws + WS_BTB);
      for (int e = gw * 64 + lane; e < SG * 16 * SP; e += NGW * 64) {
          const int g = e >> 10, i = (e >> 6) & 15, p = e & 63;
          const double lr = a_re[g * SP + p], li = a_im[g * SP + p], dt = exp((double)log_dt[g]);
          const double tt = (double)(i + 1), et = exp(lr * dt * tt); const float pr = (float)(et * cos(li * dt * tt)), pi_ = (float)(et * sin(li * dt * tt));
          float crv[16], civ[16];
#pragma unroll
          for (int co = 0; co < 16; ++co) { crv[co] = c_re[(g * SC + co) * SP + p]; civ[co] = c_im[(g * SC + co) * SP + p]; }
#pragma unroll
          for (int co = 0; co < 16; ++co) { const float cr = crv[co], cim = civ[co];
              bf16* row = BTB + ((size_t)g * 256 + i * 16 + co) * 384 + 256;
              row[p] = (bf16)f2bf(cr * pr - cim * pi_); row[64 + p] = (bf16)f2bf(-(cr * pi_ + cim * pr)); }
      }
      float* LAMC = (float*)(ws + WS_LAMC);
      for (int e = gw * 64 + lane; e < SG * SP; e += NGW * 64) {
          const double lr = a_re[e], li = a_im[e], dt = exp((double)log_dt[e >> 6]), et = exp(lr * dt * 16.0);
          LAMC[2 * e] = (float)(et * cos(li * dt * 16.0)); LAMC[2 * e + 1] = (float)(et * sin(li * dt * 16.0)); }
    }
}
__device__ __forceinline__ bool wt_one(const Args& args, LAS float* scr, unsigned mask, int it, int lane) {
    constexpr int NMAT = 18; int base = 0;
    for (int mi = 0; mi < NMAT; ++mi) { if (!((mask >> mi) & 1u)) continue;
        const WtDesc d = wt_desc(args, mi); const int n_it = (d.K / 64) * (d.Ndst / 32);
        if (it < base + n_it) { const int r = it - base, nblk = d.Ndst / 32, kb = r / nblk, nb = r % nblk, n0 = nb * 32; int ns = n0;
            if (d.kind == 1) { const int pn = n0 >> 8, j = n0 & 255; ns = (j < 128) ? (128 * pn + j) : (d.off2 + 128 * pn + (j - 128)); }
            wt_item(d.W, d.ldw, d.K, d.gain, d.WT, n0, ns, kb * 64, scr, lane); return true; }
        base += n_it; }
    return false;
}
struct WtWork { const float* gain; bf16* WT; int K, n0, k0; bool ok; };
__device__ __forceinline__ WtWork wt_fetch(const Args& args, unsigned mask, int it, f32x4 (&v)[8], int lane) {
    constexpr int NMAT = 18; int base = 0; WtWork w{}; w.ok = false;
    for (int mi = 0; mi < NMAT; ++mi) { if (!((mask >> mi) & 1u)) continue;
        const WtDesc d = wt_desc(args, mi); const int n_it = (d.K / 64) * (d.Ndst / 32);
        if (it < base + n_it) { const int r = it - base, nblk = d.Ndst / 32, kb = r / nblk, nb = r % nblk, n0 = nb * 32; int ns = n0;
            if (d.kind == 1) { const int pn = n0 >> 8, j = n0 & 255; ns = (j < 128) ? (128 * pn + j) : (d.off2 + 128 * pn + (j - 128)); }
            wt_load(v, d.W, d.ldw, ns, kb * 64, lane); w.gain = d.gain; w.WT = d.WT; w.K = d.K; w.n0 = n0; w.k0 = kb * 64; w.ok = true; return w; }
        base += n_it; }
    return w;
}
__device__ __forceinline__ void ph_weights(const Args& args, LAS float* scr, unsigned mask, int rk, int nw, int lane) {
    f32x4 va[8], vb[8];
    WtWork wa = wt_fetch(args, mask, rk, va, lane);
    for (int it = rk; wa.ok; it += 2 * nw) {
        WtWork wb = wt_fetch(args, mask, it + nw, vb, lane);
        wt_store(va, wa.K, wa.gain, wa.WT, wa.n0, wa.k0, scr, lane);
        if (!wb.ok) break;
        wa = wt_fetch(args, mask, it + 2 * nw, va, lane);
        wt_store(vb, wb.K, wb.gain, wb.WT, wb.n0, wb.k0, scr, lane);
    }
}
__device__ __forceinline__ void ph_wf(const Args& args, int j, int rk, int nw, int lane) {
    for (int e = rk * 64 + lane; e < NH * D; e += nw * 64) { const int h = e >> 10, kk = e & 1023;
        ((bf16*)(args.ws + WS_WF))[j * NH * D + e] = (bf16)f2bf(args.in[4][(size_t)j * D * FOX_IN + (size_t)kk * FOX_IN + 3 * D + h] * args.in[1][(j ? 3 * D : 0) + kk]); }
}
constexpr unsigned WMASK_PRO = (1u << 0);
constexpr unsigned WMASK_ATT = (1u << 2) | (1u << 10) | (1u << 4) | (1u << 5);
constexpr int WATT_ITEMS = 16 * 32 + 16 * 176 + 16 * 32 + 16 * 64;
constexpr unsigned WMASK_L0 = (1u << 14) | (1u << 11);
constexpr unsigned WMASK_L1 = (1u << 15) | (1u << 6) | (1u << 7) | (1u << 8) | (1u << 9) | (1u << 12);
constexpr unsigned WMASK_L2 = (1u << 16) | (1u << 1) | (1u << 3) | (1u << 13);
constexpr unsigned WMASK_L3 = (1u << 17);
__device__ __forceinline__ void ph_prologue(const Args& args, LAS unsigned char* lds, int gw, int NGW, int wave, int lane) {
    unsigned char* ws = args.ws;
    LAS float* scr = (LAS float*)(lds + RING_OFF + wave * 16384);
    ph_weights(args, scr, MK_DEFER_WEIGHTS ? WMASK_PRO : 0x3ffffu, gw, NGW, lane);
    ph_wf(args, 0, gw, NGW, lane); if (!MK_DEFER_WEIGHTS) ph_wf(args, 1, gw, NGW, lane);
    for (int rep_ = 0; rep_ < MK_S5TAB_REPS; ++rep_) ph_s5tables(args, scr, (LAS float*)(lds + LDSCTL_OFF + 8192 + wave * 512), gw, NGW, lane);
    pg8::ssq_t* ssq0 = (pg8::ssq_t*)(ws + WS_SSQ);
    for (int m = gw; m < M; m += NGW) normx_row(args.in[0] + (size_t)m * D, (bf16*)(ws + WS_XB) + (size_t)m * D, ssq0 + m, lane);
}

__device__ __forceinline__ void ph_toeplitz(unsigned char* ws, int rk, int nw, int lane) {
    const float* KERN = (const float*)(ws + WS_KERN); bf16* BTB = (bf16*)(ws + WS_BTB);
    for (int e2 = rk * 64 + lane; e2 < SG * 256 * 16; e2 += nw * 64) { const int g = e2 >> 12, n = (e2 >> 4) & 255, j = e2 & 15, i = n >> 4, co = n & 15;
        v4u o0 = {0u, 0u, 0u, 0u}, o1 = {0u, 0u, 0u, 0u};
        if (i >= j) { const f32x4* kp = (const f32x4*)(KERN + (((size_t)g * 16 + (i - j)) * 16 + co) * 16); const f32x4 a = kp[0], b = kp[1], c = kp[2], d = kp[3];
            o0 = (v4u){pk2(a[0], a[1]), pk2(a[2], a[3]), pk2(b[0], b[1]), pk2(b[2], b[3])}; o1 = (v4u){pk2(c[0], c[1]), pk2(c[2], c[3]), pk2(d[0], d[1]), pk2(d[2], d[3])}; }
        v4u* dst = (v4u*)(BTB + ((size_t)g * 256 + n) * 384 + j * 16); dst[0] = o0; dst[1] = o1; }
}
__global__ void __launch_bounds__(NWAVES * 64, 2) mega_k(Args args) {
    extern __shared__ __attribute__((aligned(16))) unsigned char lds_raw[];
    LAS unsigned char* lds = (LAS unsigned char*)lds_raw;
    const int vcu0 = (gridDim.x % 8 == 0) ? (blockIdx.x % 8) * (gridDim.x / 8) + blockIdx.x / 8 : blockIdx.x;
    const int vcu = vcu0, NGW = gridDim.x * NWAVES, wave0 = __builtin_amdgcn_readfirstlane(threadIdx.x >> 6);
    for (int u = threadIdx.x; u < (LDS_BYTES - LDSCTL_OFF) / 4; u += NWAVES * 64) ((LAS unsigned*)(lds + LDSCTL_OFF))[u] = 0u;
    __syncthreads();
    MK_BAR_SETUP();
    int e0 = args.ph_lo;
    if (e0 == PH_S5TAB) { const int tid = threadIdx.x, lane = tid & 63, wave = __builtin_amdgcn_readfirstlane(tid >> 6); ph_s5tables(args, (LAS float*)(lds + RING_OFF + wave * 16384), (LAS float*)(lds + LDSCTL_OFF + 8192 + wave * 512), vcu * NWAVES + wave, NGW, lane); return; }
    if (e0 == 0) {
        const int tid = threadIdx.x, lane = tid & 63, wave = __builtin_amdgcn_readfirstlane(tid >> 6);
        ph_prologue(args, lds, vcu * NWAVES + wave, NGW, wave, lane);
        e0 = 1;
        if (e0 < args.ph_hi) { MK_GRID_BAR(); }
    }
    for (int e = e0; e < args.ph_hi; ++e) {
#define MK_LANE_TID() int lane_; asm volatile("v_mbcnt_lo_u32_b32 %0, -1, 0\n\tv_mbcnt_hi_u32_b32 %0, -1, %0" : "=v"(lane_)); const int lane = lane_, tid = wave * 64 + lane, gw = vcu * NWAVES + wave; (void)tid; (void)gw; (void)lane
        const int wave = wave0;
        int G = gridDim.x, bx = blockIdx.x, vcu = vcu0; asm volatile("" : "+s"(G), "+s"(bx), "+s"(vcu));
        const int NGW = G * NWAVES;
        unsigned char* ws = args.ws; float* X = args.out; asm volatile("" : "+s"(ws), "+s"(X));
        pg8::ssq_t* SSQ = (pg8::ssq_t*)(ws + WS_SSQ);
        const int op = PROG[e].op, layer = PROG[e].layer, pj = PROG[e].j, sin = PROG[e].sin, sout = PROG[e].sout;
#define MK_XBS(s_) ((s_) == 5 ? (bf16*)(ws + WS_O) : (bf16*)(ws + WS_XB))
#define MK_XBO(s_) (MK_JUNK ? (bf16*)X + (size_t)M * D : MK_XBS(s_))
#define MK_SSQO(s_) (SSQ + (size_t)(MK_JUNK ? 12 : (s_)) * M)
        bf16* XB = MK_XBS(sin);
        (void)pj;
        if (op == OP_NORMX) {
            MK_LANE_TID();
            for (int m = gw; m < M; m += NGW) normx_row(X + (size_t)m * D, XB + (size_t)m * D, SSQ + (size_t)sout * M + m, lane);
        } else if (op == OP_UP) {
            MK_LANE_TID();
            pg8::Gemm g{XB, (const bf16*)(ws + WS_WGU) + (size_t)layer * 2 * DFF * D, D, D, D, 0, 0};
            pg8::StaticOrder S; S.init(M / 256, 2 * DFF / 256, G, bx);
            pg8::EpiSwiGLU E{(bf16*)(ws + WS_ACT), DFF, SSQ + (size_t)sin * M, MK_UP_DUMMY};
            pg8::gemm_phase<pg8::EpiSwiGLU, pg8::StaticOrder, MK_ALIGN_UP>(lds + RING_OFF, tid, g, S, E);
            if (MK_DEFER_WEIGHTS && bx >= 128 && !(MK_UP_DUMMY)) {
                LAS float* scr = (LAS float*)(lds + RING_OFF + wave * 16384); const int rk = (bx - 128) * NWAVES + wave;
                ph_weights(args, scr, layer == 0 ? WMASK_L0 : layer == 1 ? WMASK_L1 : layer == 2 ? WMASK_L2 : WMASK_L3, rk, 128 * NWAVES, lane);
                if (layer == 2) ph_wf(args, 1, rk, 128 * NWAVES, lane); }
        } else if (op == OP_DOWN) {
            MK_LANE_TID();
            pg8::Gemm g{(const bf16*)(ws + WS_ACT), (const bf16*)(ws + WS_WDN) + (size_t)layer * D * DFF, DFF, DFF, DFF, 0, 0};
            pg8::StaticOrder S; S.init(M / 256, D / 256, G, bx);
            if (layer == 3 && !(MK_JUNK)) {
                pg8::EpiResidFinal E{MK_XBS(sout - 1), X, SSQ + (size_t)sout * M, args.in[3], (unsigned*)(ws + WS_CTL) + CW_PANEL};
                pg8::gemm_phase<pg8::EpiResidFinal, pg8::StaticOrder, false>(lds + RING_OFF, tid, g, S, E);
            } else {
                pg8::EpiResid<0> E{MK_XBS(sout - 1), MK_XBO(sout), MK_SSQO(sout), args.in[18], nullptr, MK_UP_DUMMY};
                pg8::gemm_phase<pg8::EpiResid<0>, pg8::StaticOrder, true>(lds + RING_OFF, tid, g, S, E); }
        }
        else if (op == OP_QKV) {
            MK_LANE_TID();
            if (MK_TOUCH) touch_lines(XB + (size_t)(8 * (bx & 7) + ((bx >> 3) & 7)) * 256 * D, 256 * D * 2, tid);
            if (!(MK_QKV_NOGATES)) {
              const bf16* WfT = (const bf16*)(ws + WS_WF) + (size_t)pj * NH * D; const pg8::ssq_t* ssq = SSQ + (size_t)sin * M; const float* bfp = args.in[5] + pj * NH; float* LF = (float*)(ws + WS_LF);
#pragma unroll
              for (int i = 0; i < 4; ++i) { const int c = tid + 512 * i; *(LAS v4u*)(lds + (c >> 7) * 2064 + (c & 127) * 16) = ((const GAS v4u*)WfT)[c]; }
              LDS_WAIT(); __syncthreads();
              if (wave < 4) {
                const int r0 = (vcu * 4 + wave) * 16, kq = lane >> 4; const GAS bf16x8* ap = (const GAS bf16x8*)(XB + (size_t)(r0 + (lane & 15)) * D + kq * 8); const LAS unsigned char* bp = lds + (lane & 15) * 2064 + kq * 16;
                bf16x8 afr[32];
#pragma unroll
                for (int ks = 0; ks < 32; ++ks) afr[ks] = ap[ks * 4];
                f32x4 acc = {0.f, 0.f, 0.f, 0.f};
#pragma unroll
                for (int ks = 0; ks < 32; ++ks) acc = __builtin_amdgcn_mfma_f32_16x16x32_bf16(afr[ks], *(const LAS bf16x8*)(bp + ks * 64), acc, 0, 0, 0);
                const int rr = r0 + 4 * kq, hh = lane & 15; const float bb = bfp[hh]; f32x4 o;
#pragma unroll
                for (int i = 0; i < 4; ++i) { const float z = acc[i] * pg8::rstd_row(ssq, rr + i) + bb; o[i] = fminf(z, 0.f) - log1pf(expf(-fabsf(z))); }
                pg8::st_wt((GAS float*)LF + ((size_t)(rr / SEQ) * NH + hh) * SEQ + (rr % SEQ), o); }
              LDS_WAIT(); __syncthreads(); }
            pg8::Gemm g{XB, (const bf16*)(ws + WS_WQKV) + (size_t)pj * 3 * D * D, D, D, D, 0, 0};
            pg8::StaticOrder S; S.init(M / 256, 3 * D / 256, G, bx);
            pg8::EpiQKV E{(bf16*)(ws + WS_ACT), (size_t)16 * MiB, SSQ + (size_t)sin * M, attn_body::C2, (float*)(ws + WS_NRM), MK_UP_DUMMY};
            pg8::gemm_phase<pg8::EpiQKV, pg8::StaticOrder, true>(lds + RING_OFF, tid, g, S, E);
        } else if (op == OP_ATTN) {
            MK_LANE_TID();
#if MK_ATT_DYN
            LAS float* bl = (LAS float*)(lds + RING_OFF + attn_body::ATTN_LDS_BYTES);
            LAS int* tsk = (LAS int*)(lds + LDSCTL_OFF + 12288); LAS float* kn = (LAS float*)(lds + LDSCTL_OFF + 12288 + 64); LAS float* qn = kn + 64;
            unsigned* hq = (unsigned*)(ws + WS_CTL) + CW_HQ + pj * 2048 + (MK_JUNK ? 4096 : 0);
            const attn_body::AttnTensors AT{(const attn_body::bf16*)(ws + WS_ACT), (const attn_body::bf16*)(ws + WS_ACT + 32 * MiB), (const attn_body::bf16*)(ws + WS_ACT + 64 * MiB), (attn_body::bf16*)(ws + WS_O)};
            const int home = vcu >> 2; int cur = home, built = -1;
            for (;;) {
                int ln_; asm volatile("v_mbcnt_lo_u32_b32 %0, -1, 0\n\tv_mbcnt_hi_u32_b32 %0, -1, %0" : "=v"(ln_)); const int ln = ln_, td = wave * 64 + ln_;
                if (wave == 0) {
                    int c = cur, idx = 0;
                    for (int att = 0; ; ++att) {
                        unsigned i0 = 0; if (ln == 0) i0 = __hip_atomic_fetch_add(hq + c * 32, 1u, __ATOMIC_RELAXED, __HIP_MEMORY_SCOPE_AGENT); i0 = (unsigned)__builtin_amdgcn_readfirstlane((int)i0);
                        if (i0 < 16u) { idx = (int)i0; break; }
                        if (att == 6) { c = -1; break; }
                        unsigned cnt = __hip_atomic_load(hq + ln * 32, __ATOMIC_RELAXED, __HIP_MEMORY_SCOPE_AGENT); cnt = cnt > 16u ? 16u : cnt;
                        unsigned key = cnt * 64u + (unsigned)((ln - home) & 63);
#pragma unroll
                        for (int o = 1; o < 64; o <<= 1) { const unsigned k2 = (unsigned)__builtin_amdgcn_ds_bpermute((ln ^ o) << 2, (int)key); key = k2 < key ? k2 : key; }
                        key = (unsigned)__builtin_amdgcn_readfirstlane((int)key);
                        if ((key >> 6) >= 16u) { c = -1; break; }
                        c = (home + (int)(key & 63u)) & 63;
                    }
                    if (ln == 0) { tsk[8] = c; tsk[9] = idx; }
                }
                LDS_WAIT(); __syncthreads();
                const int c = __builtin_amdgcn_readfirstlane(tsk[8]), idx = __builtin_amdgcn_readfirstlane(tsk[9]);
                if (c < 0) break;
                cur = c;
                const int hd = c & 15; const size_t rb = (size_t)(c >> 4) * SEQ;
                if (c != built) { built = c;
                    { const float* lf = (const float*)(ws + WS_LF) + (size_t)c * SEQ + td * 8; LAS float* wt = (LAS float*)(lds + LDSCTL_OFF + 1024);
                      const f32x4 a = *(const GAS f32x4*)lf, b = *(const GAS f32x4*)(lf + 4);
                      float p[8]; p[0] = a[0]; p[1] = p[0] + a[1]; p[2] = p[1] + a[2]; p[3] = p[2] + a[3]; p[4] = p[3] + b[0]; p[5] = p[4] + b[1]; p[6] = p[5] + b[2]; p[7] = p[6] + b[3];
                      float tot = p[7];
#pragma unroll
                      for (int o = 1; o < 64; o <<= 1) { const float u = __builtin_bit_cast(float, __builtin_amdgcn_ds_bpermute((ln - o) << 2, __builtin_bit_cast(int, tot))); if (ln >= o) tot += u; }
                      if (ln == 63) wt[wave] = tot;
                      LDS_WAIT(); __syncthreads();
                      float off = tot - p[7];
                      for (int w = 0; w < wave; ++w) off += wt[w];
#pragma unroll
                      for (int i = 0; i < 8; ++i) bl[td * 8 + i] = -(p[i] + off) * 1.4426950408889634f; }
                    { const GAS f32x2* Nk = (const GAS f32x2*)(ws + WS_NRM) + ((size_t)(4 + (hd >> 2)) * M + rb) * 4 + (hd & 3); f32x2 v[8];
#pragma unroll
                      for (int i = 0; i < 8; ++i) v[i] = Nk[(size_t)(td * 8 + i) * 4];
                      float mx = 0.f;
#pragma unroll
                      for (int i = 0; i < 8; ++i) mx = fmaxf(mx, v[i].x + v[i].y);
                      mx = fmaxf(mx, lshx(mx, ln, 1)); mx = fmaxf(mx, lshx(mx, ln, 2)); mx = fmaxf(mx, lshx(mx, ln, 4));
                      if ((ln & 7) == 0) kn[td >> 3] = mx; } }
                const int qb = 15 - idx, nt = 4 * qb + 4;
                { const GAS f32x2* Nq = (const GAS f32x2*)(ws + WS_NRM) + ((size_t)(hd >> 2) * M + rb) * 4 + (hd & 3);
                  float mx = 0.f; if (td < 256) { const f32x2 v = Nq[(size_t)(qb * 256 + td) * 4]; mx = v.x + v.y; }
#pragma unroll
                  for (int o = 1; o < 64; o <<= 1) mx = fmaxf(mx, lshx(mx, ln, o));
                  if (ln == 0) qn[wave] = mx; }
                LDS_WAIT(); __syncthreads();
                if (wave == 0) {
                    float q2 = (ln < 8) ? qn[ln] : 0.f, k2 = (ln < nt) ? kn[ln] : 0.f;
#pragma unroll
                    for (int o = 1; o < 64; o <<= 1) { q2 = fmaxf(q2, lshx(q2, ln, o)); k2 = fmaxf(k2, lshx(k2, ln, o)); }
                    const float lim = MK_SKIP_QK * sqrtf(q2) * sqrtf(k2) * 1.01f + 30.0f, bq = bl[qb * 256];
                    const int ts = 2 * ln;
                    const bool okc = (ts + 2 <= nt - 4) && (bq - bl[64 * (ts + 1) + 63] >= lim);
                    const int cntc = __builtin_popcountll(__ballot(okc));
                    if (ln == 0) tsk[0] = 2 * cntc; }
                LDS_WAIT(); __syncthreads();
                attn_body::attn_unit<MK_THRL>(c >> 4, hd, qb, AT.Q, AT.K, AT.V, AT.O, (char*)lds_raw + RING_OFF, bl, td, __builtin_amdgcn_readfirstlane(tsk[0]));
            }
#else
            LAS float* bl = (LAS float*)(lds + RING_OFF + attn_body::ATTN_LDS_BYTES);
            { const float* lf = (const float*)(ws + WS_LF) + (size_t)(vcu >> 2) * SEQ + tid * 8; LAS float* wt = (LAS float*)(lds + LDSCTL_OFF + 1024);
              const f32x4 a = *(const f32x4*)lf, b = *(const f32x4*)(lf + 4);
              float p[8]; p[0] = a[0]; p[1] = p[0] + a[1]; p[2] = p[1] + a[2]; p[3] = p[2] + a[3]; p[4] = p[3] + b[0]; p[5] = p[4] + b[1]; p[6] = p[5] + b[2]; p[7] = p[6] + b[3];
              float tot = p[7];
#pragma unroll
              for (int o = 1; o < 64; o <<= 1) { const float u = __builtin_bit_cast(float, __builtin_amdgcn_ds_bpermute((lane - o) << 2, __builtin_bit_cast(int, tot))); if (lane >= o) tot += u; }
              if (lane == 63) wt[wave] = tot;
              LDS_WAIT(); __syncthreads();
              float off = tot - p[7];
              for (int w = 0; w < wave; ++w) off += wt[w];
#pragma unroll
              for (int i = 0; i < 8; ++i) bl[tid * 8 + i] = -(p[i] + off) * 1.4426950408889634f;
              LDS_WAIT(); __syncthreads(); }
            LAS int* tsk = (LAS int*)(lds + LDSCTL_OFF + 12288);
            for (int prep_ = 0; prep_ < MK_PREPASS_REPS; ++prep_) { LAS float* kn = (LAS float*)(lds + LDSCTL_OFF + 12288 + 64); LAS float* qn = kn + 64;
              const int bh = vcu >> 2, sq = vcu & 3; const size_t rb = (size_t)(bh >> 4) * SEQ; const int hc = (bh & 15) * HD + (lane & 7) * 8;
              (void)hc;
              const int hd = bh & 15; const GAS f32x2* Nk = (const GAS f32x2*)(ws + WS_NRM) + ((size_t)(4 + (hd >> 2)) * M + rb) * 4 + (hd & 3); const GAS f32x2* Nq = (const GAS f32x2*)(ws + WS_NRM) + ((size_t)(hd >> 2) * M + rb) * 4 + (hd & 3);
              { f32x2 v[8];
#pragma unroll
                for (int i = 0; i < 8; ++i) v[i] = Nk[(size_t)(tid * 8 + i) * 4];
                float mx = 0.f;
#pragma unroll
                for (int i = 0; i < 8; ++i) mx = fmaxf(mx, v[i].x + v[i].y);
                mx = fmaxf(mx, lshx(mx, lane, 1)); mx = fmaxf(mx, lshx(mx, lane, 2)); mx = fmaxf(mx, lshx(mx, lane, 4));
                if ((lane & 7) == 0) kn[tid >> 3] = mx; }
              { f32x2 v[2]; const int i = wave >> 1, qb = (i == 0) ? sq : (i == 1) ? 7 - sq : (i == 2) ? 8 + sq : 15 - sq;
#pragma unroll
                for (int jj = 0; jj < 2; ++jj) v[jj] = Nq[(size_t)(qb * 256 + (wave & 1) * 128 + lane * 2 + jj) * 4];
                float mx = fmaxf(v[0].x + v[0].y, v[1].x + v[1].y);
#pragma unroll
                for (int o = 1; o < 64; o <<= 1) mx = fmaxf(mx, lshx(mx, lane, o));
                if (lane == 0) qn[i * 8 + (wave & 1)] = mx; if (lane == 1) { qn[i * 8 + 2 + (wave & 1) * 3] = 0.f; qn[i * 8 + 3 + (wave & 1) * 3] = 0.f; qn[i * 8 + 4 + (wave & 1) * 3] = 0.f; } }
              LAS float* kbs = (LAS float*)(lds + LDSCTL_OFF + 13312);
              { const int i = wave >> 1, qb = (i == 0) ? sq : (i == 1) ? 7 - sq : (i == 2) ? 8 + sq : 15 - sq; float cs[8];
#pragma unroll
                for (int e2 = 0; e2 < 8; ++e2) cs[e2] = 0.f;
                if (qb > 0) { const GAS pg8::u32x4* kp = (const GAS pg8::u32x4*)((const bf16*)(ws + WS_ACT + 32 * MiB) + (rb + (size_t)(qb * 256 - 64)) * D + hd * HD); pg8::u32x4 w[4];
#pragma unroll
                    for (int k4 = 0; k4 < 4; ++k4) { const int pc = (wave & 1) * 64 + lane + 128 * k4; w[k4] = kp[(size_t)(pc >> 3) * (D / 8) + (pc & 7)]; }
#pragma unroll
                    for (int k4 = 0; k4 < 4; ++k4) { f32x4 lo, hi2; pg8::bf8_to_f32(w[k4], lo, hi2); cs[0] += lo[0]; cs[1] += lo[1]; cs[2] += lo[2]; cs[3] += lo[3]; cs[4] += hi2[0]; cs[5] += hi2[1]; cs[6] += hi2[2]; cs[7] += hi2[3]; } }
#pragma unroll
                for (int e2 = 0; e2 < 8; ++e2) { cs[e2] += lshx(cs[e2], lane, 8); cs[e2] += lshx(cs[e2], lane, 16); cs[e2] += lshx(cs[e2], lane, 32); }
                if (lane < 8) {
#pragma unroll
                    for (int e2 = 0; e2 < 8; ++e2) kbs[wave * 64 + lane * 8 + e2] = cs[e2]; } }
              LAS float* wtl = (LAS float*)(lds + LDSCTL_OFF + 15360);
#pragma unroll
              for (int jj = 0; jj < 8; ++jj) { const int j = wave * 8 + jj; float wv = __builtin_amdgcn_exp2f(bl[64 * j + lane] - bl[64 * j + 63]);
#pragma unroll
                  for (int o = 1; o < 64; o <<= 1) wv += lshx(wv, lane, o);
                  if (lane == 0) wtl[j] = wv; }
              LDS_WAIT(); __syncthreads();
              if (wave < 4) { const int i = wave, qb = (i == 0) ? sq : (i == 1) ? 7 - sq : (i == 2) ? 8 + sq : 15 - sq, nt = 4 * qb + 4;
                  float q2 = (lane < 8) ? qn[i * 8 + lane] : 0.f, k2 = (lane < nt) ? kn[lane] : 0.f;
#pragma unroll
                  for (int o = 1; o < 64; o <<= 1) { q2 = fmaxf(q2, lshx(q2, lane, o)); k2 = fmaxf(k2, lshx(k2, lane, o)); }
                  float kb = kbs[(2 * i) * 64 + lane] + kbs[(2 * i + 1) * 64 + lane]; kb = kb * kb * (1.0f / 4096.0f);
                  float mb = (qb > 0) ? bl[(4 * qb - 1) * 64 + lane] : 0.f;
#pragma unroll
                  for (int o = 1; o < 64; o <<= 1) { kb += lshx(kb, lane, o); mb += lshx(mb, lane, o); }
                  mb *= (1.0f / 64.0f);
                  const int ts = 2 * lane, je = (ts + 1) < 63 ? (ts + 1) : 63;
                  const float be = bl[64 * je + 63];
                  float tw = 0.f;
#pragma nounroll
                  for (int i2 = 0; i2 < 64; ++i2) { const float term = wtl[i2] * __builtin_amdgcn_exp2f(fminf(bl[64 * i2 + 63] - be, 0.f)); tw += (i2 <= je) ? term : 0.f; }
                  const float lim = sqrtf(q2) * (sqrtf(k2) + sqrtf(kb)) * 1.01f + 18.0f + __builtin_amdgcn_logf(fmaxf(tw, 1.f));
                  const bool okc = (ts + 2 <= nt - 4) && (mb - be >= lim);
                  const int cntc = __builtin_popcountll(__ballot(okc));
                  if (lane == 0) tsk[i] = 2 * cntc; }
              LDS_WAIT(); __syncthreads(); }
            const attn_body::AttnTensors AT{(const attn_body::bf16*)(ws + WS_ACT), (const attn_body::bf16*)(ws + WS_ACT + 32 * MiB), (const attn_body::bf16*)(ws + WS_ACT + 64 * MiB), (attn_body::bf16*)(ws + WS_O)};
            const attn_body::StaticOrder S(G, bx);
            attn_body::attn_phase<attn_body::StaticOrder, MK_THRL>((char*)lds_raw + RING_OFF, AT, S, bl, tid, tsk);
#endif
            if (MK_DEFER_WEIGHTS && layer == 0) {
                LAS float* scr = (LAS float*)(lds + RING_OFF + wave * 16384); unsigned* q = (unsigned*)(ws + WS_CTL) + CW_QUEUE;
                for (;;) { unsigned b0 = 0; if (lane == 0) b0 = __hip_atomic_fetch_add(q, 4u, __ATOMIC_RELAXED, __HIP_MEMORY_SCOPE_AGENT); b0 = (unsigned)__builtin_amdgcn_readfirstlane((int)b0);
                    if (b0 >= (unsigned)WATT_ITEMS) break;
                    for (int i = 0; i < 4; ++i) if (!wt_one(args, scr, WMASK_ATT, (int)b0 + i, lane)) break; } }
        } else if (op == OP_WO) {
            MK_LANE_TID();
            pg8::Gemm g{(const bf16*)(ws + WS_O), (const bf16*)(ws + WS_WO) + (size_t)pj * D * D, D, D, D, 0, 0};
            pg8::StaticOrder S; S.init(M / 256, D / 256, G, bx);
            pg8::EpiResid<0> E{MK_XBS(sout - 1), MK_XBO(sout), MK_SSQO(sout), args.in[18], nullptr, MK_UP_DUMMY};
            pg8::gemm_phase<pg8::EpiResid<0>, pg8::StaticOrder, true>(lds + RING_OFF, tid, g, S, E);
        }
        else if (op == OP_S5IN) {
            MK_LANE_TID();
            ph_toeplitz(ws, gw, NGW, lane);
            pg8::Gemm g{XB, (const bf16*)(ws + WS_WS5IN), D, D, D, 0, 0};
            pg8::StaticOrder S; S.init(M / 256, D / 256, G, bx);
            pg8::EpiU E{(bf16*)(ws + WS_ACT), SSQ + (size_t)sin * M};
            pg8::gemm_phase<pg8::EpiU, pg8::StaticOrder, true>(lds + RING_OFF, tid, g, S, E);
        } else if (op == OP_SSM) {
            MK_LANE_TID();
            pg8::StaticOrder S; S.init(BATCH, SG, G, bx);
            { pg8::Gemm g{(const bf16*)(ws + WS_ACT), (const bf16*)(ws + WS_BTA), 256, 384, 256, 0, 1024 * 384 * 2};
              pg8::EpiSloc E{(const float*)(ws + WS_LAMC), (bf16*)(ws + WS_ACT), lds + LDSCTL_OFF + 2048};
              pg8::gemm_phase<pg8::EpiSloc, pg8::StaticOrder, false>(lds + RING_OFF, tid, g, S, E); }
            { pg8::Gemm g{(const bf16*)(ws + WS_ACT), (const bf16*)(ws + WS_BTB), 384, 384, 384, 0, 1024 * 384 * 2};
              pg8::EpiY E{(const bf16*)(ws + WS_ACT), args.in[15], (bf16*)(ws + WS_ACT + 48 * MiB)};
              pg8::gemm_phase<pg8::EpiY, pg8::StaticOrder, true>(lds + RING_OFF, tid, g, S, E); }
        } else if (op == OP_GLU) {
            MK_LANE_TID();
            pg8::Gemm g{(const bf16*)(ws + WS_ACT + 48 * MiB), (const bf16*)(ws + WS_WGLU), D, MK_G1_NATURAL ? D : 16, D, MK_G1_NATURAL ? 0 : M * 16, 0};
            pg8::StaticOrder S; S.init(M / 256, 2 * D / 256, G, bx);
            pg8::EpiResid<1> E{MK_XBS(sout - 1), MK_XBO(sout), MK_SSQO(sout), args.in[18], nullptr, MK_UP_DUMMY};
            pg8::gemm_phase<pg8::EpiResid<1>, pg8::StaticOrder, true>(lds + RING_OFF, tid, g, S, E);
        }
        else if (op == OP_POOLPREP) {
        } else if (op == OP_POOLGEMM) {
            MK_LANE_TID();
            pg8::StaticOrder S; S.init(M / 256, 4, G, bx);
            { pg8::Unit u0; if (S.next(0, u0)) { const pg8::ssq_t* ssq = SSQ + (size_t)sin * M; const float* gain = args.in[1] + (size_t)layer * D; bf16* PD = (bf16*)(ws + WS_ACT);
                const int gi = u0.pn, c0 = gi * 256 + lane * 4; const f32x4 gg = *(const f32x4*)(gain + c0);
                for (int ci = wave; ci < 16; ci += NWAVES) { const int row0 = u0.pm * 256 + ci * 16, t0 = row0 & (SEQ - 1);
                    if (gi == 0) pool_item<2>(XB, ssq, gg, PD, row0, t0, c0); else if (gi == 1) pool_item<4>(XB, ssq, gg, PD, row0, t0, c0);
                    else if (gi == 2) pool_item<8>(XB, ssq, gg, PD, row0, t0, c0); else pool_item<16>(XB, ssq, gg, PD, row0, t0, c0); } }
              asm volatile("s_waitcnt vmcnt(0)" ::: "memory"); __syncthreads();
              if (wave == 0) { __builtin_amdgcn_fence(__ATOMIC_ACQUIRE, "agent"); asm volatile("s_waitcnt vmcnt(0)" ::: "memory"); }
              __syncthreads(); }
            pg8::Gemm g{(const bf16*)(ws + WS_ACT), (const bf16*)(ws + WS_WPOOL), 256, D, 256, 0, 512};
            pg8::EpiResid<2> E{MK_XBS(sout - 1), MK_XBS(sout), SSQ + (size_t)sout * M, args.in[18], args.in[19], 0};
            pg8::gemm_phase<pg8::EpiResid<2>, pg8::StaticOrder, true>(lds + RING_OFF, tid, g, S, E);
        } else if (op == OP_FINAL) {
            MK_LANE_TID();
            { const pg8::ssq_t* ssq = SSQ + (size_t)sin * M; const float* gain = args.in[3];
              for (int m = gw; m < M; m += NGW) { const float rs = pg8::rstd_row(ssq, m); f32x4* xr = (f32x4*)(X + (size_t)m * D) + lane; const f32x4* gr = (const f32x4*)gain + lane;
#pragma unroll
                  for (int j = 0; j < 4; ++j) xr[64 * j] = xr[64 * j] * rs * gr[64 * j]; } }
        }
        if (e + 1 < args.ph_hi) { MK_GRID_BAR(); }
    }
}
}
extern "C" void kernel_launch(void* const* d_in, const int* in_sizes, int n_in, void* d_out, int out_size, void* d_ws, size_t ws_size, hipStream_t stream) {
    static int grid = 0;
    if (grid == 0) {
        int dev = 0, cus = 0, per_cu = 0;
        if (hipGetDevice(&dev) != hipSuccess || hipDeviceGetAttribute(&cus, hipDeviceAttributeMultiprocessorCount, dev) != hipSuccess) { grid = -1; return; }
        if (hipFuncSetAttribute((const void*)mk::mega_k, hipFuncAttributeMaxDynamicSharedMemorySize, mk::LDS_BYTES) != hipSuccess) { grid = -1; return; }
        if (hipOccupancyMaxActiveBlocksPerMultiprocessor(&per_cu, (const void*)mk::mega_k, mk::NWAVES * 64, mk::LDS_BYTES) != hipSuccess || per_cu < 1) { fprintf(stderr, "kernel_launch: occupancy query says %d blocks per CU\n", per_cu); grid = -1; (void)hipGetLastError(); return; }
        (void)hipGetLastError();
        grid = cus;
        if (n_in != 22 || ws_size < mk::WS_END || cus != 256 || in_sizes[0] != mk::M * mk::D || out_size != mk::M * mk::D) { fprintf(stderr, "kernel_launch: unexpected n_in %d / ws_size %zu / CUs %d\n", n_in, ws_size, cus); grid = -1; }
    }
    if (grid < 0) return;
    (void)hipMemsetAsync((char*)d_ws + mk::WS_CTL, 0, mk::CTL_ZERO_BYTES, stream);
    mk::Args a{};
    for (int i = 0; i < 22; ++i) a.in[i] = (const float*)d_in[i];
    a.out = (float*)d_out; a.ws = (unsigned char*)d_ws;
#if MK_ONE_LAUNCH
    a.ph_lo = 0; a.ph_hi = mk::PH_LAST + 1;
    void* kargs[] = {&a};
    const hipError_t e = hipLaunchCooperativeKernel((const void*)mk::mega_k, dim3(grid), dim3(mk::NWAVES * 64), kargs, mk::LDS_BYTES, stream);
    if (e != hipSuccess) fprintf(stderr, "kernel_launch: cooperative launch failed: %s\n", hipGetErrorString(e));
#else
    for (int ph = 0; ph <= mk::PH_LAST; ++ph) { a.ph_lo = ph; a.ph_hi = ph + 1; hipLaunchKernelGGL(mk::mega_k, dim3(grid), dim3(mk::NWAVES * 64), mk::LDS_BYTES, stream, a);
    }
#endif
}
```

```cpp
#include <hip/hip_runtime.h>
#include <hip/hip_cooperative_groups.h>
#include <cstdio>
#include <cstdint>
#include <cmath>
#define MK_BAR_SETUP() cooperative_groups::grid_group mk_grid = cooperative_groups::this_grid(); bool mk_first = true; \
    XcdBarrier mk_bar = xcd_barrier_post((unsigned*)(args.ws + WS_CTL) + CW_BAR, (volatile LAS unsigned*)(lds + MISC_OFF) + 8)
#ifndef MK_CG_FIRST
#define MK_CG_FIRST 0
#endif
#define MK_GRID_BAR() do { if (MK_CG_FIRST ? mk_first : (args.ph_lo < 0)) { mk_grid.sync(); mk_first = false; } else xcd_barrier(mk_bar); } while (0)
#define MK_ONE_LAUNCH 1
#define MK_NO_NAIVE 1
#define MK_THRL 24
#define MK_UP_DUMMY 0
#define MK_JUNK false
#define MK_QKV_NOGATES 0
#define MK_DEFER_WEIGHTS 1
#define MK_SKIP_QK 2.0f
#ifndef MK_PREPASS_REPS
#define MK_PREPASS_REPS 1
#endif
#ifndef MK_TOUCH
#define MK_TOUCH 0
#endif
#ifndef MK_WGM
#define MK_WGM 8
#endif
#ifndef MK_ALIGN_UP
#define MK_ALIGN_UP true
#endif
#ifndef MK_S5TAB_REPS
#define MK_S5TAB_REPS 1
#endif
#ifndef MK_G1_NATURAL
#define MK_G1_NATURAL 0
#endif
#ifndef MK_WNT
#define MK_WNT 0
#endif
#ifndef MK_ATT_DYN
#define MK_ATT_DYN 0
#endif
namespace pg8 {
#define PG8_LAS __attribute__((address_space(3)))
typedef unsigned short bf16_t;
typedef short bf16x8 __attribute__((ext_vector_type(8)));
typedef float f32x4 __attribute__((ext_vector_type(4)));
typedef float f32x2 __attribute__((ext_vector_type(2)));
typedef unsigned u32x4 __attribute__((ext_vector_type(4)));
typedef unsigned u32x2 __attribute__((ext_vector_type(2)));
constexpr int PF_JUNK_OFF = 131072 + 6144;
#ifndef MK_RESID_ALL16
#define MK_RESID_ALL16 0
#endif
#ifndef MK_SWIGLU_V2
#define MK_SWIGLU_V2 1
#endif
#ifndef MK_PF_BASE
#define MK_PF_BASE false
#endif
constexpr int BM = 256, BK = 64, HALF = 128, HTB = HALF * BK * 2  , STAGE_BYTES = 8 * HTB, NXCD = 8, WGM = MK_WGM;

__host__ __device__ __forceinline__ int lds_byte(int r, int c) { const int st = (r >> 4) * 2 + (c >> 5), rr = r & 15, cc = c & 31, ob = rr * 64 + cc * 2; return st * 1024 + (ob ^ (((ob >> 9) & 1) << 5)); }
__host__ __device__ __forceinline__ void stage_rc(int b, int& R, int& C) { const int st = b / 1024, sb = b % 1024, swz = sb ^ (((sb >> 9) & 1) << 5); R = (st >> 1) * 16 + swz / 64; C = (st & 1) * 32 + (swz % 64) / 2; }
__host__ __device__ __forceinline__ int perm32(int rho) { const int n = rho >> 4, i = rho & 15; return 8 * (i >> 2) + 4 * n + (i & 3); }

struct Unit { int pm, pn; };
struct Gemm { const bf16_t* A; const bf16_t* Bt; int K; int lda, ldb; int gatherA; int a_pn_off; };

struct StaticOrder {
    int nM, nN, nwg, G, c;
    __host__ __device__ __forceinline__ void init(int nM_, int nN_, int G_, int c_) { nM = nM_; nN = nN_; nwg = nM * nN; G = G_; c = c_; }
    __host__ __device__ __forceinline__ bool next(int i, Unit& u) const {
        const long L = (long)i * G + c; if (L >= nwg) return false;
        int wgid = (int)L; { const int q = nwg / NXCD, r = nwg % NXCD, xcd = wgid % NXCD, off = wgid / NXCD; wgid = (xcd < r ? xcd * (q + 1) : r * (q + 1) + (xcd - r) * q) + off; }
        const int nig = WGM * nN, gid = wgid / nig, fm = gid * WGM, gsz = (nM - fm) < WGM ? (nM - fm) : WGM;
        u.pm = fm + ((wgid % nig) % gsz); u.pn = (wgid % nig) / gsz; return true;
    }
};

__device__ __forceinline__ unsigned cvt_pk_bf16(float lo, float hi) { unsigned r; asm volatile("v_cvt_pk_bf16_f32 %0, %1, %2" : "=v"(r) : "v"(lo), "v"(hi)); return r; }

template <class Epi, class Sched, bool ALIGN_EPI>
__device__ __forceinline__ void gemm_phase(PG8_LAS unsigned char* lds, const int tid, const Gemm g, const Sched& S, const Epi& E) {
    const int wid = __builtin_amdgcn_readfirstlane(tid >> 6), lane = tid & 63, wr = wid >> 2, wc = wid & 3, fr = lane & 15, fq = lane >> 4;
    const int K = g.K, nt = K / BK;
    unsigned voffA[2], voffB[2];
#pragma unroll
    for (int i = 0; i < 2; ++i) { int R, C; stage_rc(tid * 16 + i * 8192, R, C); const int Rb = Epi::PERM ? ((R & ~31) + perm32(R & 31)) : R;
        voffA[i] = g.gatherA ? (unsigned)(R * g.lda + (C >> 4) * g.gatherA + (C & 15)) * 2u : (unsigned)(R * g.lda + C) * 2u; voffB[i] = (unsigned)(Rb * g.ldb + C) * 2u; }
    const size_t kstepA = g.gatherA ? (size_t)g.gatherA * 8 : (size_t)(BK * 2), kstepB = (size_t)(BK * 2);
    const size_t hstepA = (size_t)HALF * g.lda * 2, hstepB = (size_t)HALF * g.ldb * 2;
    const size_t tstepA = 2 * hstepA, tstepB = 2 * hstepB;
    const unsigned ldsw = (unsigned)wid * 1024u;
    const int aoff = lds_byte(wr * 64 + fr, fq * 8), boff = lds_byte(wc * 32 + fr, fq * 8);
#define PG8_SA(b, h) (((b) * 2 + (h)) * HTB)
#define PG8_SB(b, h) ((4 + (b) * 2 + (h)) * HTB)
#define PG8_STAGE(bufoff, gbase, voff) do { _Pragma("unroll") for (int _i = 0; _i < 2; ++_i) \
        __builtin_amdgcn_global_load_lds((const unsigned*)((const char*)(gbase) + (voff)[_i]), (PG8_LAS unsigned*)(lds + (bufoff) + ldsw + _i * 8192), 16, 0, 0); } while (0)
#define PG8_LDA(dst, b, h) do { _Pragma("unroll") for (int m = 0; m < 4; ++m) _Pragma("unroll") for (int k = 0; k < 2; ++k) dst[m][k] = *(const PG8_LAS bf16x8*)(lds + PG8_SA(b, h) + aoff + m * 2048 + k * 1024); } while (0)
#define PG8_LDB(dst, b, h) do { _Pragma("unroll") for (int n = 0; n < 2; ++n) _Pragma("unroll") for (int k = 0; k < 2; ++k) dst[n][k] = *(const PG8_LAS bf16x8*)(lds + PG8_SB(b, h) + boff + n * 2048 + k * 1024); } while (0)
#define PG8_MMA(ai, bj, At, Bt) do { __builtin_amdgcn_s_setprio(1); _Pragma("unroll") for (int m = 0; m < 4; ++m) _Pragma("unroll") for (int n = 0; n < 2; ++n) _Pragma("unroll") for (int k = 0; k < 2; ++k) \
        acc[ai][bj][m][n] = __builtin_amdgcn_mfma_f32_16x16x32_bf16(Bt[n][k], At[m][k], acc[ai][bj][m][n], 0, 0, 0); __builtin_amdgcn_s_setprio(0); } while (0)
#define PG8_WAIT_V(n) asm volatile("s_waitcnt vmcnt(" #n ")" ::: "memory")
#define PG8_WAIT_L(n) asm volatile("s_waitcnt lgkmcnt(" #n ")" ::: "memory")
#define PG8_BAR __builtin_amdgcn_s_barrier()
#define PG8_SCHED __builtin_amdgcn_sched_barrier(0)
    Unit cur, nxt; int ui = 0;
    if (!S.next(0, cur)) return;
    f32x4 acc[2][2][4][2];
#pragma unroll
    for (int a = 0; a < 2; ++a)
#pragma unroll
        for (int b = 0; b < 2; ++b)
#pragma unroll
            for (int m = 0; m < 4; ++m)
#pragma unroll
                for (int n = 0; n < 2; ++n) acc[a][b][m][n] = (f32x4){0.f, 0.f, 0.f, 0.f};
    bf16x8 At[4][2], B0[2][2], B1[2][2];
    const char* cA = (const char*)g.A + (size_t)cur.pm * tstepA + (size_t)cur.pn * g.a_pn_off; const char* cB = (const char*)g.Bt + (size_t)cur.pn * tstepB;
    PG8_STAGE(PG8_SB(0, 0), cB, voffB); PG8_STAGE(PG8_SB(0, 1), cB + hstepB, voffB); PG8_STAGE(PG8_SA(0, 0), cA, voffA); PG8_STAGE(PG8_SA(0, 1), cA + hstepA, voffA);
    if (wr == 1) PG8_BAR;
    PG8_WAIT_V(2); PG8_BAR;
    PG8_STAGE(PG8_SB(1, 0), cB + kstepB, voffB); PG8_STAGE(PG8_SA(1, 0), cA + kstepA, voffA); PG8_STAGE(PG8_SB(1, 1), cB + hstepB + kstepB, voffB);
    PG8_WAIT_V(6); PG8_BAR;
    for (;;) {
        const bool has_next = S.next(ui + 1, nxt);
        const char* nA = has_next ? (const char*)g.A + (size_t)nxt.pm * tstepA + (size_t)nxt.pn * g.a_pn_off : cA; const char* nB = has_next ? (const char*)g.Bt + (size_t)nxt.pn * tstepB : cB;
        for (int t = 0; t < nt; t += 2) {
            const bool last = (t == nt - 2);
            const char* a1 = cA + (size_t)(t + 1) * kstepA;
            const char* a2 = last ? nA : cA + (size_t)(t + 2) * kstepA; const char* b2 = last ? nB : cB + (size_t)(t + 2) * kstepB;
            const char* a3 = a2 + kstepA; const char* b3 = b2 + kstepB;
            if constexpr (Epi::PREFETCH) { if (last) { int pl_; asm volatile("v_mbcnt_lo_u32_b32 %0, -1, 0\n\tv_mbcnt_hi_u32_b32 %0, -1, %0" : "=v"(pl_)); E.prefetch(cur, wid * 64 + pl_, lds + PF_JUNK_OFF + ldsw / 4); } }
            PG8_LDB(B0, 0, 0); PG8_LDB(B1, 0, 1); PG8_SCHED; PG8_LDA(At, 0, 0); PG8_STAGE(PG8_SA(1, 1), a1 + hstepA, voffA);
            PG8_WAIT_V(8); PG8_WAIT_L(0); PG8_BAR; PG8_MMA(0, 0, At, B0); PG8_MMA(0, 1, At, B1); PG8_BAR; PG8_SCHED;
            PG8_LDA(At, 0, 1); PG8_STAGE(PG8_SB(0, 0), b2, voffB); PG8_STAGE(PG8_SB(0, 1), b2 + hstepB, voffB); PG8_STAGE(PG8_SA(0, 0), a2, voffA);
            PG8_WAIT_V(8); PG8_WAIT_L(0); PG8_BAR; PG8_MMA(1, 0, At, B0); PG8_MMA(1, 1, At, B1); PG8_BAR; PG8_SCHED;
            PG8_LDB(B0, 1, 0); PG8_LDB(B1, 1, 1); PG8_SCHED; PG8_LDA(At, 1, 0); PG8_STAGE(PG8_SA(0, 1), a2 + hstepA, voffA);
            PG8_WAIT_V(8); PG8_WAIT_L(0); PG8_BAR; PG8_MMA(0, 0, At, B0); PG8_MMA(0, 1, At, B1); PG8_BAR; PG8_SCHED;
            PG8_LDA(At, 1, 1); PG8_STAGE(PG8_SB(1, 0), b3, voffB); PG8_STAGE(PG8_SB(1, 1), b3 + hstepB, voffB); PG8_STAGE(PG8_SA(1, 0), a3, voffA);
            PG8_WAIT_V(8); PG8_WAIT_L(0); PG8_BAR; PG8_MMA(1, 0, At, B0); PG8_MMA(1, 1, At, B1); PG8_BAR; PG8_SCHED;
        }
        if constexpr (ALIGN_EPI) { if (wr == 0) PG8_BAR; }
        if constexpr (!Epi::AFTER_DRAIN) { int ln_; asm volatile("v_mbcnt_lo_u32_b32 %0, -1, 0\n\tv_mbcnt_hi_u32_b32 %0, -1, %0" : "=v"(ln_)); E(acc, cur, wr, wc, ln_ & 15, ln_ >> 4); }
        if (!has_next) break;
#pragma unroll
        for (int a = 0; a < 2; ++a)
#pragma unroll
            for (int b = 0; b < 2; ++b)
#pragma unroll
                for (int m = 0; m < 4; ++m)
#pragma unroll
                    for (int n = 0; n < 2; ++n) acc[a][b][m][n] = (f32x4){0.f, 0.f, 0.f, 0.f};
        cur = nxt; cA = nA; cB = nB; ++ui;
        if constexpr (ALIGN_EPI) { if (wr == 1) PG8_BAR; }
    }
    PG8_WAIT_V(0);
    if constexpr (!ALIGN_EPI) { if (wr == 0) PG8_BAR; }
    PG8_BAR;
    if constexpr (Epi::AFTER_DRAIN) { int ln_; asm volatile("v_mbcnt_lo_u32_b32 %0, -1, 0\n\tv_mbcnt_hi_u32_b32 %0, -1, %0" : "=v"(ln_)); E.fused(acc, cur, wr, wc, ln_ & 15, ln_ >> 4, lds, wid, ln_); }
#undef PG8_SA
#undef PG8_SB
#undef PG8_STAGE
#undef PG8_LDA
#undef PG8_LDB
#undef PG8_MMA
#undef PG8_WAIT_V
#undef PG8_WAIT_L
#undef PG8_BAR
#undef PG8_SCHED
}

__device__ __forceinline__ float shx(float v, int lane, int m) { return __builtin_bit_cast(float, __builtin_amdgcn_ds_bpermute((lane ^ m) << 2, __builtin_bit_cast(int, v))); }
constexpr float RMS_EPS = 1e-6f;
typedef unsigned long long ssq_t;
constexpr float SSQ_SCALE = 1048576.0f;
__device__ __forceinline__ float rstd_row(const ssq_t* ssq, int row) { return __builtin_amdgcn_rsqf((float)ssq[row] * (1.0f / (1024.0f * SSQ_SCALE)) + RMS_EPS); }
#define PG8_GAS __attribute__((address_space(1)))
#ifndef MK_WT_STORES
#define MK_WT_STORES 0
#endif
template <int OFF = 0, typename V> __device__ __forceinline__ void st_wt(PG8_GAS void* p, const V v) {
    static_assert(OFF >= 0 && OFF < 4096, "immediate offset range");
#if MK_WT_STORES
    if constexpr (sizeof(V) == 16) asm volatile("global_store_dwordx4 %0, %1, off offset:%2 sc1\n\ts_nop 1" :: "v"(p), "v"(v), "n"(OFF) : "memory");
    else if constexpr (sizeof(V) == 8) asm volatile("global_store_dwordx2 %0, %1, off offset:%2 sc1\n\ts_nop 1" :: "v"(p), "v"(v), "n"(OFF) : "memory");
    else { static_assert(sizeof(V) == 4, "store width"); asm volatile("global_store_dword %0, %1, off offset:%2 sc1\n\ts_nop 1" :: "v"(p), "v"(v), "n"(OFF) : "memory"); }
#else
    *(PG8_GAS V*)((PG8_GAS unsigned char*)p + OFF) = v;
#endif
}
#ifndef MK_WT_RESID
#define MK_WT_RESID 0
#endif
__device__ __forceinline__ void st_resid(PG8_GAS unsigned char* base, unsigned off, const u32x4 v) {
#if MK_WT_RESID
    asm volatile("global_store_dwordx4 %0, %1, %2 sc1\n\ts_nop 1" :: "v"(off), "v"(v), "s"(base) : "memory");
#else
    *(PG8_GAS u32x4*)(base + off) = v;
#endif
}
#ifndef MK_NT_STORES
#define MK_NT_STORES 0
#endif
template <typename V> __device__ __forceinline__ void st_big(PG8_GAS void* p, const V v) {
#if MK_NT_STORES
    __builtin_nontemporal_store(v, (PG8_GAS V*)p);
#else
    st_wt(p, v);
#endif
}
#if MK_WT_STORES
#define ATTN_STORE16(p,v) pg8::st_wt((PG8_GAS void*)(p), (v))
#endif
__device__ __forceinline__ void rstd8(const ssq_t* ssq, int row0, float (&rs)[2][4]) {
    ssq_t sv[2][4];
#pragma unroll
    for (int ai = 0; ai < 2; ++ai)
#pragma unroll
        for (int m = 0; m < 4; ++m) sv[ai][m] = ((const PG8_GAS ssq_t*)ssq)[row0 + ai * HALF + m * 16];
#pragma unroll
    for (int ai = 0; ai < 2; ++ai)
#pragma unroll
        for (int m = 0; m < 4; ++m) rs[ai][m] = __builtin_amdgcn_rsqf((float)sv[ai][m] * (1.0f / (1024.0f * SSQ_SCALE)) + RMS_EPS);
}
__device__ __forceinline__ float fast_sigmoid(float x) { return __builtin_amdgcn_rcpf(1.0f + __builtin_amdgcn_exp2f(-1.4426950408889634f * x)); }

struct EpiQKV {
    static constexpr bool PERM = true, AFTER_DRAIN = false, PREFETCH = false;
    bf16_t* O; size_t split_stride; const ssq_t* ssq; float scale0; float* nrm; int dummy;
    __device__ __forceinline__ void operator()(const f32x4 (&acc)[2][2][4][2], const Unit& u, int wr, int wc, int fr, int fq) const {
        const int row0 = u.pm * BM + wr * 64 + fr, t = u.pn >> 2; bf16_t* base = O + (size_t)t * split_stride; const float sc = (t == 0) ? scale0 : 1.f;
        const int col0 = (u.pn & 3) * BM + wc * 32 + 8 * fq, ln = fq * 16 + fr;
        float rsv[2][4]; rstd8(ssq, row0, rsv);
#pragma unroll
        for (int ai = 0; ai < 2; ++ai)
#pragma unroll
            for (int m = 0; m < 4; ++m) { const int row = row0 + ai * HALF + m * 16; const float rs = rsv[ai][m] * sc; PG8_GAS bf16_t* rowp = (PG8_GAS bf16_t*)base + (size_t)row * 1024 + col0;
#pragma unroll
                for (int bj = 0; bj < 2; ++bj) { const f32x4 v0 = acc[ai][bj][m][0] * rs, v1 = acc[ai][bj][m][1] * rs;
                    u32x4 w; w.x = cvt_pk_bf16(v0[0], v0[1]); w.y = cvt_pk_bf16(v0[2], v0[3]); w.z = cvt_pk_bf16(v1[0], v1[1]); w.w = cvt_pk_bf16(v1[2], v1[3]);
                    st_big(rowp + bj * HALF, w);
                    if (t < 2) { float s = ((v0[0] * v0[0] + v0[1] * v0[1]) + (v0[2] * v0[2] + v0[3] * v0[3])) + ((v1[0] * v1[0] + v1[1] * v1[1]) + (v1[2] * v1[2] + v1[3] * v1[3]));
                        s += shx(s, ln, 16); s += shx(s, ln, 32);
                        if (fq == 0) ((PG8_GAS float*)nrm)[(((size_t)(t * 4 + (u.pn & 3)) * 16384 + row) * 4 + 2 * bj + (wc >> 1)) * 2 + (wc & 1)] = s; } } }
    }
};
struct EpiSwiGLU {
    static constexpr bool PERM = true, AFTER_DRAIN = false, PREFETCH = false;
    bf16_t* Hh; int ldh; const ssq_t* ssq; int dummy;
    __device__ __forceinline__ void operator()(const f32x4 (&acc)[2][2][4][2], const Unit& u, int wr, int wc, int fr, int fq) const {
        const int row0 = u.pm * BM + wr * 64 + fr, col0 = u.pn * HALF + wc * 32 + 8 * fq;
        if (dummy == 1) { if (fr == 0 && fq == 0) *(PG8_GAS float*)((PG8_GAS bf16_t*)Hh + (size_t)row0 * ldh + col0) = acc[0][0][0][0][0] + acc[1][1][3][1][3]; return; }
#if MK_SWIGLU_V2
        ssq_t sv[2][4];
#pragma unroll
        for (int ai = 0; ai < 2; ++ai)
#pragma unroll
            for (int m = 0; m < 4; ++m) sv[ai][m] = ((const PG8_GAS ssq_t*)ssq)[row0 + ai * HALF + m * 16];
#pragma unroll
        for (int ai = 0; ai < 2; ++ai)
#pragma unroll
            for (int m = 0; m < 4; ++m) { const int row = row0 + ai * HALF + m * 16;
                const float ms = (float)sv[ai][m] * (1.0f / (1024.0f * SSQ_SCALE)) + RMS_EPS, rsn = __builtin_amdgcn_rsqf(ms) * (-1.4426950408889634f);
                float h[8];
#pragma unroll
                for (int n = 0; n < 2; ++n)
#pragma unroll
                    for (int j = 0; j < 4; j += 2) {
                        const f32x2 g2 = {acc[ai][0][m][n][j], acc[ai][0][m][n][j + 1]}, u2 = {acc[ai][1][m][n][j], acc[ai][1][m][n][j + 1]};
                        const f32x2 ar = g2 * rsn, t = g2 * u2;
                        f32x2 e; e.x = __builtin_amdgcn_exp2f(ar.x); e.y = __builtin_amdgcn_exp2f(ar.y);
                        const f32x2 msv = {ms, ms}; const f32x2 dn = __builtin_elementwise_fma(e, msv, msv); f32x2 r; r.x = __builtin_amdgcn_rcpf(dn.x); r.y = __builtin_amdgcn_rcpf(dn.y);
                        const f32x2 hv = t * r; h[n * 4 + j] = hv.x; h[n * 4 + j + 1] = hv.y; }
#else
        float rsv[2][4]; rstd8(ssq, row0, rsv);
#pragma unroll
        for (int ai = 0; ai < 2; ++ai)
#pragma unroll
            for (int m = 0; m < 4; ++m) { const int row = row0 + ai * HALF + m * 16; const float rs = rsv[ai][m];
                float h[8];
#pragma unroll
                for (int n = 0; n < 2; ++n)
#pragma unroll
                    for (int j = 0; j < 4; j += 2) {
                        const f32x2 g2 = {acc[ai][0][m][n][j], acc[ai][0][m][n][j + 1]}, u2 = {acc[ai][1][m][n][j], acc[ai][1][m][n][j + 1]};
                        const f32x2 gs = g2 * rs, us = u2 * rs, ar = gs * (-1.4426950408889634f);
                        f32x2 e; e.x = __builtin_amdgcn_exp2f(ar.x); e.y = __builtin_amdgcn_exp2f(ar.y);
                        const f32x2 dn = e + 1.0f; f32x2 r; r.x = __builtin_amdgcn_rcpf(dn.x); r.y = __builtin_amdgcn_rcpf(dn.y);
                        const f32x2 hv = (gs * r) * us; h[n * 4 + j] = hv.x; h[n * 4 + j + 1] = hv.y; }
#endif
                u32x4 w; w.x = cvt_pk_bf16(h[0], h[1]); w.y = cvt_pk_bf16(h[2], h[3]); w.z = cvt_pk_bf16(h[4], h[5]); w.w = cvt_pk_bf16(h[6], h[7]);
                st_big((PG8_GAS bf16_t*)Hh + (size_t)row * ldh + col0, w); }
    }
};
__device__ __forceinline__ void bf8_to_f32(const u32x4 w, f32x4& lo, f32x4& hi) {
    lo = (f32x4){__builtin_bit_cast(float, w.x << 16), __builtin_bit_cast(float, w.x & 0xffff0000u), __builtin_bit_cast(float, w.y << 16), __builtin_bit_cast(float, w.y & 0xffff0000u)};
    hi = (f32x4){__builtin_bit_cast(float, w.z << 16), __builtin_bit_cast(float, w.z & 0xffff0000u), __builtin_bit_cast(float, w.w << 16), __builtin_bit_cast(float, w.w & 0xffff0000u)};
}
template <int MODE> struct EpiResid {
    static constexpr bool PERM = true, AFTER_DRAIN = false, PREFETCH = MK_PF_BASE && MODE == 0;
    const bf16_t* base; bf16_t* XB; ssq_t* ssq_out; const float* pb; const float* psc; int dummy;
    __device__ __forceinline__ void prefetch(const Unit& u, int tid, PG8_LAS unsigned char* junk) const {
        const int r = tid >> 1, h = tid & 1;
        const char* p = (const char*)base + ((size_t)(u.pm * BM + r) * 1024 + (MODE == 1 ? u.pn * HALF : u.pn * BM)) * 2 + h * (MODE == 1 ? 128 : 256);
        __builtin_amdgcn_global_load_lds((const unsigned*)p, (PG8_LAS unsigned*)junk, 4, 0, 0);
        if (MODE != 1) __builtin_amdgcn_global_load_lds((const unsigned*)(p + 128), (PG8_LAS unsigned*)junk, 4, 0, 0);
    }
    __device__ __forceinline__ void operator()(const f32x4 (&acc)[2][2][4][2], const Unit& u, int wr, int wc, int fr, int fq) const {
        if (dummy == 1) { if (acc[0][0][0][0][0] + acc[1][1][3][1][3] == 12345.678f) ((PG8_GAS float*)pb)[0] = 1.f; return; }
        const int row0 = u.pm * BM + wr * 64 + fr;
        const int col0 = (MODE == 1 ? u.pn * HALF : u.pn * BM) + wc * 32 + 8 * fq;
        constexpr int NBJ = (MODE == 1) ? 1 : 2;
        const PG8_GAS unsigned char* gb = (const PG8_GAS unsigned char*)base; PG8_GAS unsigned char* gx = (PG8_GAS unsigned char*)XB; const unsigned ob = ((unsigned)row0 * 1024u + (unsigned)col0) * 2u;
#define PG8_ROFF(dr, co_) (ob + (unsigned)((((dr)) * 1024 + (co_)) * 2))
        float ss[2][4];
#pragma unroll
        for (int ai = 0; ai < 2; ++ai)
#pragma unroll
            for (int m = 0; m < 4; ++m) ss[ai][m] = 0.f;
        constexpr bool ALL16 = (MODE == 0) && MK_RESID_ALL16;
        u32x4 bsall[ALL16 ? 2 : 1][2][4];
        if constexpr (ALL16) {
#pragma unroll
            for (int bj = 0; bj < 2; ++bj)
#pragma unroll
                for (int ai = 0; ai < 2; ++ai)
#pragma unroll
                    for (int m = 0; m < 4; ++m) bsall[bj][ai][m] = *(const PG8_GAS u32x4*)(gb + (ob + (unsigned)(((ai * HALF + m * 16) * 1024 + bj * HALF) * 2))); }
#pragma unroll
        for (int bj = 0; bj < NBJ; ++bj) { const int co = bj * HALF;
            f32x4 bb0 = {0.f, 0.f, 0.f, 0.f}, bb1 = bb0, sc0 = {1.f, 1.f, 1.f, 1.f}, sc1 = sc0;
            if (MODE == 2) { bb0 = *(const PG8_GAS f32x4*)((const PG8_GAS float*)pb + col0 + co); bb1 = *(const PG8_GAS f32x4*)((const PG8_GAS float*)pb + col0 + co + 4);
                             sc0 = *(const PG8_GAS f32x4*)((const PG8_GAS float*)psc + col0 + co); sc1 = *(const PG8_GAS f32x4*)((const PG8_GAS float*)psc + col0 + co + 4); }
            constexpr int NAB = (MODE == 2) ? 1 : 2;
#pragma unroll
            for (int a0 = 0; a0 < 2; a0 += NAB) {
                u32x4 bs[NAB][4];
#pragma unroll
                for (int ai = 0; ai < NAB; ++ai)
#pragma unroll
                    for (int m = 0; m < 4; ++m) { if constexpr (ALL16) bs[ai][m] = bsall[bj][ai][m]; else bs[ai][m] = *(const PG8_GAS u32x4*)(gb + PG8_ROFF((a0 + ai) * HALF + m * 16, co)); }
#pragma unroll
                for (int aa = 0; aa < NAB; ++aa)
#pragma unroll
                    for (int m = 0; m < 4; ++m) { const int ai = a0 + aa; const unsigned off = PG8_ROFF(ai * HALF + m * 16, co); f32x4 d0, d1;
                        if (MODE == 0) { d0 = acc[ai][bj][m][0]; d1 = acc[ai][bj][m][1]; }
                        else if (MODE == 1) { const f32x4 v0 = acc[ai][0][m][0], g0 = acc[ai][1][m][0], v1 = acc[ai][0][m][1], g1 = acc[ai][1][m][1];
                            d0 = (f32x4){v0[0] * fast_sigmoid(g0[0]), v0[1] * fast_sigmoid(g0[1]), v0[2] * fast_sigmoid(g0[2]), v0[3] * fast_sigmoid(g0[3])};
                            d1 = (f32x4){v1[0] * fast_sigmoid(g1[0]), v1[1] * fast_sigmoid(g1[1]), v1[2] * fast_sigmoid(g1[2]), v1[3] * fast_sigmoid(g1[3])}; }
                        else { d0 = (acc[ai][bj][m][0] + bb0) * sc0; d1 = (acc[ai][bj][m][1] + bb1) * sc1; }
                        f32x4 b0, b1; bf8_to_f32(bs[aa][m], b0, b1);
                        const f32x4 o0 = b0 + d0, o1 = b1 + d1;
                        ss[ai][m] += ((o0[0] * o0[0] + o0[1] * o0[1]) + (o0[2] * o0[2] + o0[3] * o0[3])) + ((o1[0] * o1[0] + o1[1] * o1[1]) + (o1[2] * o1[2] + o1[3] * o1[3]));
                        u32x4 w; w.x = cvt_pk_bf16(o0[0], o0[1]); w.y = cvt_pk_bf16(o0[2], o0[3]); w.z = cvt_pk_bf16(o1[0], o1[1]); w.w = cvt_pk_bf16(o1[2], o1[3]);
                        st_resid(gx, off, w); }
                if (NAB == 1) asm volatile("" ::: "memory"); }
            asm volatile("" ::: "memory"); }
        const int ln = fq * 16 + fr;
#pragma unroll
        for (int ai = 0; ai < 2; ++ai)
#pragma unroll
            for (int m = 0; m < 4; ++m) { float s = ss[ai][m]; s += shx(s, ln, 16); s += shx(s, ln, 32);
                if (fq == 0) atomicAdd(ssq_out + row0 + ai * HALF + m * 16, (ssq_t)__builtin_llrintf(s * SSQ_SCALE)); }
    }
};
struct EpiResidFinal {
    static constexpr bool PERM = true, AFTER_DRAIN = true, PREFETCH = false;
    const bf16_t* base; float* out; ssq_t* ssq_out; const float* gain; unsigned* cnt;
    __device__ __forceinline__ void prefetch(const Unit& u, int tid, PG8_LAS unsigned char* junk) const {
        const int r = tid >> 1, h = tid & 1;
        const char* p = (const char*)base + ((size_t)(u.pm * BM + r) * 1024 + u.pn * BM) * 2 + h * 256;
        __builtin_amdgcn_global_load_lds((const unsigned*)p, (PG8_LAS unsigned*)junk, 4, 0, 0);
        __builtin_amdgcn_global_load_lds((const unsigned*)(p + 128), (PG8_LAS unsigned*)junk, 4, 0, 0);
    }
    __device__ __forceinline__ void fused(f32x4 (&acc)[2][2][4][2], const Unit& u, int wr, int wc, int fr, int fq, PG8_LAS unsigned char* lds, int wid, int lane) const {
        const int row0 = u.pm * BM + wr * 64 + fr, col0 = u.pn * BM + wc * 32 + 8 * fq;
        const PG8_GAS bf16_t* gb = (const PG8_GAS bf16_t*)base + (size_t)row0 * 1024 + col0;
        float ss[2][4]; float chain_ = 0.f;
#pragma unroll
        for (int ai = 0; ai < 2; ++ai)
#pragma unroll
            for (int m = 0; m < 4; m += 2) { int ro_ = (ai * HALF + m * 16) * 1024; asm volatile("" : "+v"(ro_) : "v"(chain_));
                const PG8_GAS bf16_t* rp = gb + ro_;
                const u32x4 wa = *(const PG8_GAS u32x4*)(rp), wb = *(const PG8_GAS u32x4*)(rp + HALF), wc_ = *(const PG8_GAS u32x4*)(rp + 16 * 1024), wd = *(const PG8_GAS u32x4*)(rp + 16 * 1024 + HALF);
#pragma unroll
                for (int q = 0; q < 2; ++q) { f32x4 b0, b1, b2, b3; bf8_to_f32(q ? wc_ : wa, b0, b1); bf8_to_f32(q ? wd : wb, b2, b3);
                    const f32x4 o0 = b0 + acc[ai][0][m + q][0], o1 = b1 + acc[ai][0][m + q][1], o2 = b2 + acc[ai][1][m + q][0], o3 = b3 + acc[ai][1][m + q][1];
                    acc[ai][0][m + q][0] = o0; acc[ai][0][m + q][1] = o1; acc[ai][1][m + q][0] = o2; acc[ai][1][m + q][1] = o3;
                    ss[ai][m + q] = ((o0[0] * o0[0] + o0[1] * o0[1]) + (o0[2] * o0[2] + o0[3] * o0[3])) + ((o1[0] * o1[0] + o1[1] * o1[1]) + (o1[2] * o1[2] + o1[3] * o1[3]))
                                  + ((o2[0] * o2[0] + o2[1] * o2[1]) + (o2[2] * o2[2] + o2[3] * o2[3])) + ((o3[0] * o3[0] + o3[1] * o3[1]) + (o3[2] * o3[2] + o3[3] * o3[3])); }
                chain_ = ss[ai][m] + ss[ai][m + 1]; }
        const int ln = fq * 16 + fr;
#pragma unroll
        for (int ai = 0; ai < 2; ++ai)
#pragma unroll
            for (int m = 0; m < 4; ++m) { float s = ss[ai][m]; s += shx(s, ln, 16); s += shx(s, ln, 32);
                if (fq == 0) atomicAdd(ssq_out + row0 + ai * HALF + m * 16, (ssq_t)__builtin_llrintf(s * SSQ_SCALE)); }
        asm volatile("s_waitcnt vmcnt(0)" ::: "memory"); __builtin_amdgcn_s_barrier(); asm volatile("" ::: "memory");
        if (wid == 0) {
            unsigned* c = cnt + 64 * u.pm;
            if (lane == 0) __hip_atomic_fetch_add(c, 1u, __ATOMIC_RELAXED, __HIP_MEMORY_SCOPE_AGENT);
            unsigned spins = 0;
            while ((unsigned)__builtin_amdgcn_readfirstlane(__hip_atomic_load(c, __ATOMIC_RELAXED, __HIP_MEMORY_SCOPE_AGENT)) < 4u && ++spins < (1u << 22)) __builtin_amdgcn_s_sleep(2);
        }
        __builtin_amdgcn_s_barrier(); asm volatile("" ::: "memory");
        int l2_; asm volatile("v_mbcnt_lo_u32_b32 %0, -1, 0\n\tv_mbcnt_hi_u32_b32 %0, -1, %0" : "=v"(l2_));
        const int row0b = u.pm * BM + wr * 64 + (l2_ & 15), col0b = u.pn * BM + wc * 32 + 8 * (l2_ >> 4);
        PG8_GAS float* go = (PG8_GAS float*)out + (size_t)row0b * 1024 + col0b;
        float rs[2][4];
#pragma unroll
        for (int ai = 0; ai < 2; ++ai)
#pragma unroll
            for (int m = 0; m < 4; ++m) rs[ai][m] = __builtin_amdgcn_rsqf((float)__hip_atomic_load(ssq_out + row0b + ai * HALF + m * 16, __ATOMIC_RELAXED, __HIP_MEMORY_SCOPE_AGENT) * (1.0f / (1024.0f * SSQ_SCALE)) + RMS_EPS);
#pragma unroll
        for (int bj = 0; bj < 2; ++bj) { int co = bj * HALF; asm volatile("" : "+v"(co) : "v"(chain_));
            const f32x4 gg0 = *(const PG8_GAS f32x4*)((const PG8_GAS float*)gain + col0b + co), gg1 = *(const PG8_GAS f32x4*)((const PG8_GAS float*)gain + col0b + co + 4);
#pragma unroll
            for (int ai = 0; ai < 2; ++ai)
#pragma unroll
                for (int m = 0; m < 4; ++m) {
                    const f32x4 ov0 = acc[ai][bj][m][0] * rs[ai][m] * gg0, ov1 = acc[ai][bj][m][1] * rs[ai][m] * gg1;
                    PG8_GAS float* op = go + (size_t)(ai * HALF + m * 16) * 1024 + co; *(PG8_GAS f32x4*)op = ov0; *(PG8_GAS f32x4*)(op + 4) = ov1; chain_ = ov1[0]; }
            asm volatile("" ::: "memory"); }
    }
};
struct EpiU {
    static constexpr bool PERM = true, AFTER_DRAIN = false, PREFETCH = false;
    bf16_t* UX; const ssq_t* ssq;
    __device__ __forceinline__ void operator()(const f32x4 (&acc)[2][2][4][2], const Unit& u, int wr, int wc, int fr, int fq) const {
        const int row0 = u.pm * BM + wr * 64 + fr, col0 = u.pn * BM + wc * 32 + 8 * fq;
        float rsv[2][4]; rstd8(ssq, row0, rsv);
#pragma unroll
        for (int ai = 0; ai < 2; ++ai)
#pragma unroll
            for (int m = 0; m < 4; ++m) { const int row = row0 + ai * HALF + m * 16; const float rs = rsv[ai][m];
#pragma unroll
                for (int bj = 0; bj < 2; ++bj) { const int col = col0 + bj * HALF; const f32x4 v0 = acc[ai][bj][m][0] * rs, v1 = acc[ai][bj][m][1] * rs;
                    u32x4 w; w.x = cvt_pk_bf16(v0[0], v0[1]); w.y = cvt_pk_bf16(v0[2], v0[3]); w.z = cvt_pk_bf16(v1[0], v1[1]); w.w = cvt_pk_bf16(v1[2], v1[3]);
                    st_wt((PG8_GAS bf16_t*)UX + ((size_t)(col >> 4) * 1024 + (row >> 4)) * 384 + (row & 15) * 16 + (col & 15), w); } }
    }
};
struct EpiSloc {
    static constexpr bool PERM = false, AFTER_DRAIN = true, PREFETCH = false;
    const float* lamc; bf16_t* UX; PG8_LAS unsigned char* esc;
    __device__ __forceinline__ void fused(f32x4 (&acc)[2][2][4][2], const Unit& u, int wr, int wc, int fr, int fq, PG8_LAS unsigned char* lds, int wid, int lane) const {
        PG8_LAS float* SL = (PG8_LAS float*)lds;
#pragma unroll
        for (int ai = 0; ai < 2; ++ai)
#pragma unroll
            for (int m = 0; m < 4; ++m)
#pragma unroll
                for (int n = 0; n < 2; ++n) *(PG8_LAS f32x4*)(SL + (ai * HALF + wr * 64 + m * 16 + fr) * 128 + wc * 32 + n * 16 + 4 * fq) = acc[ai][0][m][n];
        asm volatile("s_waitcnt lgkmcnt(0)" ::: "memory"); __builtin_amdgcn_s_barrier(); asm volatile("" ::: "memory");
        const int g = u.pn, b = u.pm, seg = wid, p = lane;
        const float lr = lamc[(g * 64 + p) * 2], li = lamc[(g * 64 + p) * 2 + 1];
        float sr = 0.f, si = 0.f;
        for (int c = seg * 32; c < seg * 32 + 32; ++c) { const float xr = SL[c * 128 + p], xi = SL[c * 128 + 64 + p]; const float nr = lr * sr - li * si + xr, ni = lr * si + li * sr + xi; sr = nr; si = ni; }
        PG8_LAS float* E = (PG8_LAS float*)esc;
        E[(seg * 64 + p) * 2] = sr; E[(seg * 64 + p) * 2 + 1] = si;
        asm volatile("s_waitcnt lgkmcnt(0)" ::: "memory"); __builtin_amdgcn_s_barrier(); asm volatile("" ::: "memory");
        float l32r = lr, l32i = li;
#pragma unroll
        for (int q = 0; q < 5; ++q) { const float t = l32r * l32r - l32i * l32i; l32i = 2.f * l32r * l32i; l32r = t; }
        sr = 0.f; si = 0.f;
        for (int j = 0; j < seg; ++j) { const float er = E[(j * 64 + p) * 2], ei = E[(j * 64 + p) * 2 + 1]; const float nr = l32r * sr - l32i * si + er, ni = l32r * si + l32i * sr + ei; sr = nr; si = ni; }
        bf16_t* dst = UX + ((size_t)g * 1024 + b * 256 + seg * 32) * 384 + 256 + p;
        for (int c = seg * 32; c < seg * 32 + 32; ++c) {
            { unsigned ur = __builtin_bit_cast(unsigned, sr), ui = __builtin_bit_cast(unsigned, si); ur = (ur + 0x7fffu + ((ur >> 16) & 1u)) >> 16; ui = (ui + 0x7fffu + ((ui >> 16) & 1u)) >> 16;
              dst[0] = (bf16_t)ur; dst[64] = (bf16_t)ui; }
            const float xr = SL[c * 128 + p], xi = SL[c * 128 + 64 + p]; const float nr = lr * sr - li * si + xr, ni = lr * si + li * sr + xi; sr = nr; si = ni;
            dst += 384; }
        asm volatile("s_waitcnt vmcnt(0) lgkmcnt(0)" ::: "memory"); __builtin_amdgcn_s_barrier(); asm volatile("" ::: "memory");
        if (wid == 0) { __builtin_amdgcn_fence(__ATOMIC_ACQUIRE, "agent"); asm volatile("s_waitcnt vmcnt(0)" ::: "memory"); }
        __builtin_amdgcn_s_barrier(); asm volatile("" ::: "memory");
    }
};
struct EpiY {
    static constexpr bool PERM = true, AFTER_DRAIN = false, PREFETCH = false;
    const bf16_t* UX; const float* dvec; bf16_t* G1;
    __device__ __forceinline__ void operator()(const f32x4 (&acc)[2][2][4][2], const Unit& u, int wr, int wc, int fr, int fq) const {
        const int g = u.pn, b = u.pm, ch0 = g * 16 + 8 * (fq & 1);
        const f32x4 d0 = *(const f32x4*)(dvec + ch0), d1 = *(const f32x4*)(dvec + ch0 + 4);
#pragma unroll
        for (int ai = 0; ai < 2; ++ai) {
            u32x4 uwv[4][2];
#pragma unroll
            for (int m = 0; m < 4; ++m)
#pragma unroll
                for (int bj = 0; bj < 2; ++bj) uwv[m][bj] = *(const PG8_GAS u32x4*)((const PG8_GAS bf16_t*)UX + ((size_t)g * 1024 + b * 256 + (ai * HALF + wr * 64 + m * 16 + fr)) * 384 + (8 * bj + 2 * wc + (fq >> 1)) * 16 + 8 * (fq & 1));
#pragma unroll
            for (int m = 0; m < 4; ++m) { const int R = ai * HALF + wr * 64 + m * 16 + fr;
#pragma unroll
                for (int bj = 0; bj < 2; ++bj) { const int i = 8 * bj + 2 * wc + (fq >> 1);
                    const u32x4 uw = uwv[m][bj];
                    float y[8];
#pragma unroll
                    for (int j = 0; j < 4; ++j) { y[j] = acc[ai][bj][m][0][j] + d0[j] * __builtin_bit_cast(float, (j & 1) ? (uw[j >> 1] & 0xffff0000u) : (uw[j >> 1] << 16));
                                                  y[4 + j] = acc[ai][bj][m][1][j] + d1[j] * __builtin_bit_cast(float, (j & 1) ? (uw[2 + (j >> 1)] & 0xffff0000u) : (uw[2 + (j >> 1)] << 16)); }
#pragma unroll
                    for (int j = 0; j < 8; ++j) { const float z = 0.7978845608028654f * (y[j] + 0.044715f * y[j] * y[j] * y[j]); y[j] = y[j] * fast_sigmoid(2.f * z); }
                    u32x4 w; w.x = cvt_pk_bf16(y[0], y[1]); w.y = cvt_pk_bf16(y[2], y[3]); w.z = cvt_pk_bf16(y[4], y[5]); w.w = cvt_pk_bf16(y[6], y[7]);
                    st_wt((PG8_GAS bf16_t*)G1 + (MK_G1_NATURAL ? ((size_t)(b * 4096 + 16 * R + i) * 1024 + g * 16 + 8 * (fq & 1)) : (((size_t)g * 16384 + b * 4096 + 16 * R + i) * 16 + 8 * (fq & 1))), w); } }
            asm volatile("" ::: "memory"); }
    }
};
}
#include <hip/hip_bf16.h>
#include <cmath>
namespace attn_body {
using bf16=__hip_bfloat16;
using bf16x8=__attribute__((ext_vector_type(8)))short;
using s16x4=__attribute__((ext_vector_type(4)))short;
using f32x16=__attribute__((ext_vector_type(16)))float;
using u32x4=__attribute__((ext_vector_type(4)))unsigned;
constexpr int BATCH=4,NHEAD=16,SEQ=4096,D=64,DM=NHEAD*D;
constexpr int NW=8,QBLK=32,QB=QBLK*NW,KVBLK=64,NQB=SEQ/QB;
constexpr int ATTN_PITCH=DM, ATTN_UNIT_ROWS=QB;
__device__ __forceinline__ int crow(int r,int hi){return (r&3)+8*(r>>2)+4*hi;}
#define SBAR() __builtin_amdgcn_sched_barrier(0)
__device__ __forceinline__ void cmask(f32x16&p0,f32x16&p1,int jb,int qrel,int hi){
  const float NEG=-INFINITY; int kb=64*jb+4*hi;
  #pragma unroll
  for(int r=0;r<16;++r){int kv=kb+(r&3)+8*(r>>2); if(kv>qrel)p0[r]=NEG; if(kv+32>qrel)p1[r]=NEG;}
}

constexpr int NSLOT=3, SLOTB=8192;
constexpr int LDS_K=0, LDS_V=NSLOT*SLOTB, LDS_WS=2*NSLOT*SLOTB, LDS_OST=LDS_WS+NW*64*4, LDS_BYTES=LDS_OST+NW*4096;
constexpr float C2=0.125f*1.4426950408889634f;
__device__ __forceinline__ void glds16(const void*gsrc,unsigned lds_dst){unsigned keep;
  asm volatile("s_mov_b32 %0, m0\n\ts_mov_b32 m0, %2\n\ts_nop 0\n\tglobal_load_lds_dwordx4 %1, off\n\ts_mov_b32 m0, %0":"=&s"(keep):"v"(gsrc),"s"(lds_dst):"memory");}
__device__ __forceinline__ float max3f(float a,float b,float c){float r;asm("v_max3_f32 %0, %1, %2, %3":"=v"(r):"v"(a),"v"(b),"v"(c));return r;}
__device__ __forceinline__ float max2f(float a,float b){float r;asm("v_max_f32_e32 %0, %1, %2":"=v"(r):"v"(a),"v"(b));return r;}
__device__ __forceinline__ float fadd_s(float a,float b){float r;asm("v_add_f32_e32 %0, %1, %2":"=v"(r):"v"(a),"v"(b));return r;}
__device__ __forceinline__ float fsub_s(float a,float b){float r;asm("v_sub_f32_e32 %0, %1, %2":"=v"(r):"v"(a),"v"(b));return r;}
typedef float f32x2_t __attribute__((ext_vector_type(2))); typedef __bf16 bf16x2_t __attribute__((ext_vector_type(2)));
__device__ __forceinline__ unsigned cvtpk_s(float lo,float hi){f32x2_t v={lo,hi};bf16x2_t b=__builtin_convertvector(v,bf16x2_t);return __builtin_bit_cast(unsigned,b);}
#define WAIT_BAR(N) asm volatile("s_waitcnt vmcnt(" #N ") lgkmcnt(0)\n\ts_barrier":::"memory")

__device__ __forceinline__ void qkt(f32x16&p0,f32x16&p1,const char*Kslot,const bf16x8*qr,int r32,int hi){
  const char*kb=Kslot+hi*1024+r32*16;
  #pragma unroll
  for(int d0=0;d0<4;++d0){
    const bf16x8 b0=*reinterpret_cast<const bf16x8*>(kb+d0*2048);
    const bf16x8 b1=*reinterpret_cast<const bf16x8*>(kb+d0*2048+512);
    {p0=__builtin_amdgcn_mfma_f32_32x32x16_bf16(b0,qr[d0],p0,0,0,0);p1=__builtin_amdgcn_mfma_f32_32x32x16_bf16(b1,qr[d0],p1,0,0,0);}}
}
typedef __attribute__((address_space(3))) const char* lds_cptr;
typedef short v4i16_t __attribute__((ext_vector_type(4)));
__device__ __forceinline__ void kload8(bf16x8*kf,lds_cptr kp){
  kf[0]=*(const __attribute__((address_space(3))) bf16x8*)(kp);      kf[1]=*(const __attribute__((address_space(3))) bf16x8*)(kp+512);
  kf[2]=*(const __attribute__((address_space(3))) bf16x8*)(kp+2048); kf[3]=*(const __attribute__((address_space(3))) bf16x8*)(kp+2560);
  kf[4]=*(const __attribute__((address_space(3))) bf16x8*)(kp+4096); kf[5]=*(const __attribute__((address_space(3))) bf16x8*)(kp+4608);
  kf[6]=*(const __attribute__((address_space(3))) bf16x8*)(kp+6144); kf[7]=*(const __attribute__((address_space(3))) bf16x8*)(kp+6656);
}
__device__ __forceinline__ void kload2(bf16x8*kf,lds_cptr kp,int j){ kf[2*j]=*(const __attribute__((address_space(3))) bf16x8*)(kp+j*2048); kf[2*j+1]=*(const __attribute__((address_space(3))) bf16x8*)(kp+j*2048+512); }
__device__ __forceinline__ s16x4 vtr(lds_cptr p){ return __builtin_bit_cast(s16x4,__builtin_amdgcn_ds_read_tr16_b64_v4i16((__attribute__((address_space(3))) v4i16_t*)p)); }
__device__ __forceinline__ float rowmax(const f32x16&p0,const f32x16&p1){
  float a=max3f(p0[0],p0[1],p1[0]),b=max3f(p0[2],p0[3],p1[1]);a=max3f(a,p1[2],p1[3]);
  #pragma unroll
  for(int r=4;r<16;r+=4){a=max3f(a,p0[r],p0[r+1]);b=max3f(b,p0[r+2],p0[r+3]);a=max3f(a,p1[r],p1[r+1]);b=max3f(b,p1[r+2],p1[r+3]);}
  const float m=max2f(a,b);
  auto rr=__builtin_amdgcn_permlane32_swap(__float_as_uint(m),__float_as_uint(m),false,false);
  return max2f(__uint_as_float(rr[0]),__uint_as_float(rr[1]));
}
__device__ __forceinline__ void pv(f32x16*o,int vb,bf16x8 pa0,bf16x8 pa1,bf16x8 pa2,bf16x8 pa3){
  #pragma unroll
  for(int d0=0;d0<2;++d0){s16x4 lo[4],hi[4];
    #pragma unroll
    for(int ks=0;ks<4;++ks){
      asm volatile("ds_read_b64_tr_b16 %0,%1 offset:%c2":"=&v"(lo[ks]):"v"(vb),"i"(d0*4096+ks*1024):"memory");
      asm volatile("ds_read_b64_tr_b16 %0,%1 offset:%c2":"=&v"(hi[ks]):"v"(vb),"i"(d0*4096+ks*1024+512):"memory");}
    asm volatile("s_waitcnt lgkmcnt(0)":::"memory");SBAR();
    #define PK(k) (bf16x8){lo[k][0],lo[k][1],lo[k][2],lo[k][3],hi[k][0],hi[k][1],hi[k][2],hi[k][3]}
    o[d0]=__builtin_amdgcn_mfma_f32_32x32x16_bf16(pa0,PK(0),o[d0],0,0,0);
    o[d0]=__builtin_amdgcn_mfma_f32_32x32x16_bf16(pa1,PK(1),o[d0],0,0,0);
    o[d0]=__builtin_amdgcn_mfma_f32_32x32x16_bf16(pa2,PK(2),o[d0],0,0,0);
    o[d0]=__builtin_amdgcn_mfma_f32_32x32x16_bf16(pa3,PK(3),o[d0],0,0,0);
    #undef PK
  }
}

#ifndef ATTN_STATIC_REF
#define ATTN_STATIC_REF 1
#endif
#ifndef ATTN_STORE16
#define ATTN_STORE16(p,v) (*(u32x4*)(p)=(v))
#endif
typedef float f32x4b __attribute__((ext_vector_type(4)));
template<int THRL> __device__ __forceinline__ void attn_unit(int b,int h,int qb,const bf16*Q,const bf16*__restrict__ K,const bf16*__restrict__ V,bf16*O,char*shm,const __attribute__((address_space(3))) float*bl0,const int tid_,const int tskip,const float qkb){
  const __attribute__((address_space(3))) float*bl=bl0+tskip*64;
  const int tid=tid_,lane=tid&63,r32=lane&31,hi=lane>>5; const int wid=__builtin_amdgcn_readfirstlane(tid>>6);
  const long rowbase=(long)b*SEQ; const int q0=qb*QB;
  const bf16*Qw=Q+(rowbase+q0+wid*QBLK)*DM+h*D;
  const bf16*Kh=K+(rowbase+(long)tskip*KVBLK)*DM+h*D,*Vh=V+(rowbase+(long)tskip*KVBLK)*DM+h*D;
  const unsigned lds0=(unsigned)(uintptr_t)shm;
  float*wsf=(float*)(shm+LDS_WS)+wid*64;
  const bf16*ksrc=Kh+(long)lane*DM+wid*8;
  const bf16*vsrc=Vh+(long)(16*(wid&3)+(lane>>2))*DM+(wid>>2)*32+(lane&3)*8;
  const unsigned kdst=lds0+LDS_K+wid*1024, vdst=lds0+LDS_V+wid*1024;
  #define DMA_K(t,slot) glds16(ksrc+(long)(t)*KVBLK*DM,(unsigned)__builtin_amdgcn_readfirstlane(kdst+(slot)))
  #define DMA_V(t,slot) glds16(vsrc+(long)(t)*KVBLK*DM,(unsigned)__builtin_amdgcn_readfirstlane(vdst+(slot)))
  const int vb0=(int)(lds0+LDS_V)+((lane>>4)&1)*32+(lane&3)*8+(4*hi+((lane&15)>>2))*64;
  const char*Kbase=shm+LDS_K; bf16x8 kf[8];
  const lds_cptr shm3=(lds_cptr)shm; const lds_cptr kp0=shm3+LDS_K+hi*1024+r32*16; const lds_cptr vp0=shm3+LDS_V+((lane>>4)&1)*32+(lane&3)*8+(4*hi+((lane&15)>>2))*64;
  const int NT=(q0+QB)/KVBLK-tskip;
  DMA_K(0,0);DMA_V(0,0);DMA_K(1,SLOTB);
  bf16x8 qr[4];
  #pragma unroll
  for(int d0=0;d0<4;++d0)qr[d0]=*reinterpret_cast<const bf16x8*>(&Qw[(long)r32*DM+d0*16+hi*8]);
#if ATTN_STATIC_REF
  const float mhat=bl0[q0+wid*QBLK+r32]+qkb-24.0f; float l_reg=0.f;f32x16 o[2];o[0]=f32x16{};o[1]=f32x16{};
#else
  float mhat=0.f,l_reg=0.f;f32x16 o[2];o[0]=f32x16{};o[1]=f32x16{};
#endif
  const int qrel=wid*QBLK+r32;
  #define CMASK(P0,P1,t) do{int jb_=(t)-(NT-4); if(jb_>=0)cmask(P0,P1,jb_,qrel,hi);}while(0)
  #define BIASLD(P0,P1,t) do{ const __attribute__((address_space(3))) f32x4b*bp_=(const __attribute__((address_space(3))) f32x4b*)(bl+(t)*64+hi*4); \
    _Pragma("unroll") for(int g_=0;g_<4;++g_){ const f32x4b b0_=bp_[2*g_],b1_=bp_[8+2*g_]; \
      P0[4*g_]=b0_[0];P0[4*g_+1]=b0_[1];P0[4*g_+2]=b0_[2];P0[4*g_+3]=b0_[3]; P1[4*g_]=b1_[0];P1[4*g_+1]=b1_[1];P1[4*g_+2]=b1_[2];P1[4*g_+3]=b1_[3]; } }while(0)
  bool resc=false;
#if ATTN_STATIC_REF
  #define START(P0,P1) do{ _Pragma("unroll") for(int r=0;r<16;++r){P0[r]=fsub_s(P0[r],mhat);P1[r]=fsub_s(P1[r],mhat);} \
    _Pragma("unroll") for(int r=0;r<16;++r)P0[r]=__builtin_amdgcn_exp2f(P0[r]); }while(0)
#else
  #define START(P0,P1) do{ const float rm=rowmax(P0,P1); resc=false; \
    { const float dl=rm; mhat=fadd_s(mhat,dl); \
      _Pragma("unroll") for(int r=0;r<16;++r){P0[r]=fsub_s(P0[r],dl);P1[r]=fsub_s(P1[r],dl);} } \
    _Pragma("unroll") for(int r=0;r<16;++r)P0[r]=__builtin_amdgcn_exp2f(P0[r]); }while(0)
#endif
  #define RESC() do{ if(resc){ asm volatile("s_waitcnt lgkmcnt(0)":::"memory"); \
      _Pragma("unroll") for(int d_=0;d_<2;++d_) _Pragma("unroll") for(int r=0;r<16;++r)o[d_][r]*=wsf[crow(r,hi)]; } }while(0)
  f32x16 pA0,pA1,pB0,pB1;
  int sl_prev=0,sl_cur=0,sl_next=SLOTB;
  #define ROT() do{sl_prev=sl_cur;sl_cur=sl_next;sl_next=(sl_next==(NSLOT-1)*SLOTB)?0:sl_next+SLOTB;}while(0)
  DMA_K(2,2*SLOTB);
  WAIT_BAR(3);
  BIASLD(pA0,pA1,0);qkt(pA0,pA1,Kbase,qr,r32,hi);asm volatile("s_nop 15\n\ts_nop 7":"+v"(pA0),"+v"(pA1));CMASK(pA0,pA1,0);
  START(pA0,pA1);
  _Pragma("unroll") for(int r=0;r<16;++r)pA1[r]=__builtin_amdgcn_exp2f(pA1[r]);
  WAIT_BAR(0);
  DMA_K(3,0);DMA_V(1,SLOTB);
  ROT();
  kload8(kf,kp0+sl_cur);
  WAIT_BAR(2);
  s16x4 vlo[8],vhi[8]; u32x4 pw0,pw1,pw2,pw3;
  #define PKW(P,B) cvtpk_s(P[B],P[B+1])
  #define PAF(k) __builtin_bit_cast(bf16x8,pw##k)
  #define VFR(i) (bf16x8){vlo[i][0],vlo[i][1],vlo[i][2],vlo[i][3],vhi[i][0],vhi[i][1],vhi[i][2],vhi[i][3]}
  #define PIN(x) asm volatile("":"+v"(x))
  #define MX3(a,b,c) __builtin_fmaxf(__builtin_fmaxf((a),(b)),(c))
  #define GAPA(MF,A0,A1,A2,A3,W0,W1,PW) do{ MF; sacc+=A0; sacc+=A1; sacc+=A2; sacc+=A3; PIN(sacc); W0; W1; PIN(PW); SBAR(); }while(0)
  #define EX(v) __builtin_amdgcn_exp2f(v)
  #define GAPB(MF,X,B) do{ MF; X[B]=EX(X[B]-mhat); X[B+1]=EX(X[B+1]-mhat); X[B+2]=EX(X[B+2]-mhat); X[B+3]=EX(X[B+3]-mhat); PIN(X); SBAR(); }while(0)
  #define VRD(i) do{ vlo[i]=vtr(vp_+(((i)>>2)*4096+((i)&3)*1024)); vhi[i]=vtr(vp_+(((i)>>2)*4096+((i)&3)*1024+512)); }while(0)
  #define KRD(G,j) do{ if(G){ kload2(kf,kp0+sl_next,j); SBAR(); } }while(0)
#if ATTN_STATIC_REF
  #define MAXBLK(C0,C1) do{}while(0)
#else
  #define MAXBLK(C0,C1) do    { float a=MX3(C0[0],C0[1],C1[0]),b=MX3(C0[2],C0[3],C1[1]); a=MX3(a,C1[2],C1[3]); \
      _Pragma("unroll") for(int r=4;r<16;r+=4){a=MX3(a,C0[r],C0[r+1]);b=MX3(b,C0[r+2],C0[r+3]);a=MX3(a,C1[r],C1[r+1]);b=MX3(b,C1[r+2],C1[r+3]);} \
      float rm=__builtin_fmaxf(a,b); { auto rr=__builtin_amdgcn_permlane32_swap(__float_as_uint(rm),__float_as_uint(rm),false,false); rm=__builtin_fmaxf(__uint_as_float(rr[0]),__uint_as_float(rr[1])); } \
      resc=false; const float dm_=rm-mhat; \
      if(__builtin_expect(__any(dm_>(float)THRL),0)){ const float dl=__builtin_fmaxf(dm_,0.f); mhat+=dl; \
        const float f=__builtin_amdgcn_exp2f(-dl); l_reg*=f; if(hi==0)wsf[r32]=f; resc=true; } } while(0)
#endif
  #define STEP(C0,C1,P0,P1,t,GK,GV,GL) do{ SBAR(); BIASLD(C0,C1,t); SBAR(); \
    const lds_cptr vp_=vp0+sl_prev; \
    VRD(0); SBAR(); float sacc=(P0[0]+P0[1]); \
    GAPA(C0=__builtin_amdgcn_mfma_f32_32x32x16_bf16(kf[0],qr[0],C0,0,0,0), P0[2],P0[3],P0[4],P0[5],     pw0[0]=PKW(P0,0), pw0[1]=PKW(P0,2), pw0); \
    VRD(4); SBAR(); GAPA(C1=__builtin_amdgcn_mfma_f32_32x32x16_bf16(kf[1],qr[0],C1,0,0,0), P0[6],P0[7],P0[8],P0[9],     pw0[2]=PKW(P0,4), pw0[3]=PKW(P0,6), pw0); \
    VRD(1); SBAR(); GAPA(C0=__builtin_amdgcn_mfma_f32_32x32x16_bf16(kf[2],qr[1],C0,0,0,0),   P0[10],P0[11],P0[12],P0[13], pw1[0]=PKW(P0,8), pw1[1]=PKW(P0,10), pw1); \
    VRD(5); SBAR(); GAPA(C1=__builtin_amdgcn_mfma_f32_32x32x16_bf16(kf[3],qr[1],C1,0,0,0),   P0[14],P0[15],P1[0],P1[1],   pw1[2]=PKW(P0,12),pw1[3]=PKW(P0,14), pw1); \
    VRD(2); SBAR(); GAPA(C0=__builtin_amdgcn_mfma_f32_32x32x16_bf16(kf[4],qr[2],C0,0,0,0),   P1[2],P1[3],P1[4],P1[5],     pw2[0]=PKW(P1,0), pw2[1]=PKW(P1,2), pw2); \
    VRD(6); SBAR(); GAPA(C1=__builtin_amdgcn_mfma_f32_32x32x16_bf16(kf[5],qr[2],C1,0,0,0),   P1[6],P1[7],P1[8],P1[9],     pw2[2]=PKW(P1,4), pw2[3]=PKW(P1,6), pw2); \
    VRD(3); SBAR(); GAPA(C0=__builtin_amdgcn_mfma_f32_32x32x16_bf16(kf[6],qr[3],C0,0,0,0),   P1[10],P1[11],P1[12],P1[13], pw3[0]=PKW(P1,8), pw3[1]=PKW(P1,10), pw3); \
    VRD(7); SBAR(); GAPA(C1=__builtin_amdgcn_mfma_f32_32x32x16_bf16(kf[7],qr[3],C1,0,0,0),   P1[14],P1[15],0.f,0.f,       pw3[2]=PKW(P1,12),pw3[3]=PKW(P1,14), pw3); \
    l_reg+=sacc; \
    if(GK){DMA_K((t)+3,sl_cur);} if(GV){DMA_V((t)+1,sl_next);} \
    CMASK(C0,C1,t); \
    MAXBLK(C0,C1); \
    SBAR(); \
    GAPB(o[0]=__builtin_amdgcn_mfma_f32_32x32x16_bf16(PAF(0),VFR(0),o[0],0,0,0), C0,0); \
    GAPB(o[1]=__builtin_amdgcn_mfma_f32_32x32x16_bf16(PAF(0),VFR(4),o[1],0,0,0), C0,4); \
    KRD(GL,0); GAPB(o[0]=__builtin_amdgcn_mfma_f32_32x32x16_bf16(PAF(1),VFR(1),o[0],0,0,0), C0,8); \
    KRD(GL,1); GAPB(o[1]=__builtin_amdgcn_mfma_f32_32x32x16_bf16(PAF(1),VFR(5),o[1],0,0,0), C0,12); \
    KRD(GL,2); GAPB(o[0]=__builtin_amdgcn_mfma_f32_32x32x16_bf16(PAF(2),VFR(2),o[0],0,0,0), C1,0); \
    KRD(GL,3); GAPB(o[1]=__builtin_amdgcn_mfma_f32_32x32x16_bf16(PAF(2),VFR(6),o[1],0,0,0), C1,4); \
    GAPB(o[0]=__builtin_amdgcn_mfma_f32_32x32x16_bf16(PAF(3),VFR(3),o[0],0,0,0), C1,8); \
    GAPB(o[1]=__builtin_amdgcn_mfma_f32_32x32x16_bf16(PAF(3),VFR(7),o[1],0,0,0), C1,12); \
    }while(0)
  int t=1;
  #undef CMASK
  #define CMASK(P0,P1,t) do{}while(0)
  for(;t+5<NT;t+=2){
    STEP(pB0,pB1,pA0,pA1,t,true,true,true);     WAIT_BAR(2); RESC(); ROT();
    STEP(pA0,pA1,pB0,pB1,t+1,true,true,true);   WAIT_BAR(2); RESC(); ROT();
  }
  #undef CMASK
  #define CMASK(P0,P1,t) do{int jb_=(t)-(NT-4); if(jb_>=0)cmask(P0,P1,jb_,qrel,hi);}while(0)
  #define ENDW(tt) do{ if((tt)+3<NT){WAIT_BAR(2);} else if((tt)+2<NT){WAIT_BAR(1);} else {WAIT_BAR(0);} }while(0)
  for(;t+1<NT;t+=2){
    STEP(pB0,pB1,pA0,pA1,t,(t+3<NT),(t+1<NT),(t+1<NT));       ENDW(t);   RESC(); ROT();
    STEP(pA0,pA1,pB0,pB1,t+1,(t+4<NT),(t+2<NT),(t+2<NT));     ENDW(t+1); RESC(); ROT();
  }
  STEP(pB0,pB1,pA0,pA1,NT-1,false,false,false); RESC();
  { float sacc=pB0[0]+pB0[1]; _Pragma("unroll") for(int r=2;r<16;++r)sacc+=pB0[r]; _Pragma("unroll") for(int r=0;r<16;++r)sacc+=pB1[r]; l_reg+=sacc;
    pw0=(u32x4){PKW(pB0,0),PKW(pB0,2),PKW(pB0,4),PKW(pB0,6)};pw1=(u32x4){PKW(pB0,8),PKW(pB0,10),PKW(pB0,12),PKW(pB0,14)};pw2=(u32x4){PKW(pB1,0),PKW(pB1,2),PKW(pB1,4),PKW(pB1,6)};pw3=(u32x4){PKW(pB1,8),PKW(pB1,10),PKW(pB1,12),PKW(pB1,14)};
    SBAR(); pv(o,vb0+sl_cur,PAF(0),PAF(1),PAF(2),PAF(3)); }
  #undef PKW
  #undef PAF
  #undef VFR
  #undef PIN
  #undef MX3
  #undef GAPA
  #undef GAPB
  #undef EX
  #undef VRD
  #undef KRD
  #undef STEP
  #undef MAXBLK
  #undef ENDW
  {auto rr=__builtin_amdgcn_permlane32_swap(__float_as_uint(l_reg),__float_as_uint(l_reg),false,false);l_reg=__uint_as_float(rr[0])+__uint_as_float(rr[1]);}
  if(hi==0)wsf[32+r32]=l_reg;asm volatile("s_waitcnt lgkmcnt(0)":::"memory");
  float rli[16];
  #pragma unroll
  for(int r=0;r<16;++r)rli[r]=__builtin_amdgcn_rcpf(wsf[32+crow(r,hi)]);
  bf16*Ow=O+(rowbase+q0+wid*QBLK)*DM+h*D;
  { bf16*stg=(bf16*)(shm+LDS_OST)+wid*2048;
    #pragma unroll
    for(int r=0;r<16;++r){const int orow=crow(r,hi);
      #pragma unroll
      for(int d0=0;d0<2;++d0)stg[orow*64+d0*32+r32]=__float2bfloat16(o[d0][r]*rli[r]);}
    asm volatile("s_waitcnt lgkmcnt(0)":::"memory");
    #pragma unroll
    for(int i=0;i<4;++i){const int row=i*8+(lane>>3),ch=lane&7; const u32x4 v=*(const u32x4*)(stg+row*64+ch*8); ATTN_STORE16(Ow+(long)row*DM+ch*8,v);} }
  asm volatile("s_waitcnt lgkmcnt(0)\n\ts_barrier":::"memory");
  #undef DMA_K
  #undef DMA_V
  #undef CMASK
  #undef BIASLD
  #undef START
  #undef RESC
  #undef ROT
}
constexpr int ATTN_LDS_BYTES=LDS_BYTES;
struct AttnTensors { const bf16* Q; const bf16* K; const bf16* V; bf16* O; };
struct AttnUnit { int bh; int qb; };
struct StaticOrder {
  int vcu;
  __device__ __forceinline__ explicit StaticOrder(int grid,int block):vcu((block%8)*(grid/8)+block/8){}
  __device__ __forceinline__ bool next(int i,AttnUnit&u)const{ if(i>=4)return false; const int s=vcu&3; u.bh=vcu>>2; u.qb=(i==0)?s:(i==1)?7-s:(i==2)?8+s:15-s; return true; }
};
template<class Sched,int THRL=8> __device__ __forceinline__ void attn_phase(char*lds,const AttnTensors&T,const Sched&S,const __attribute__((address_space(3))) float*bl,const int tid,const __attribute__((address_space(3))) int*tsk){
  AttnUnit u;
  for(int i=0;S.next(i,u);++i){ attn_unit<THRL>(u.bh/NHEAD,u.bh%NHEAD,u.qb,T.Q,T.K,T.V,T.O,lds,bl,tid,__builtin_amdgcn_readfirstlane(tsk[i]),__builtin_bit_cast(float,__builtin_amdgcn_readfirstlane(tsk[4+i]))); }
}
#undef SBAR
#undef WAIT_BAR
}
namespace mk {
#define LAS __attribute__((address_space(3)))
#define XB_TMO      128
#define XB_XCNT(j)  (256  + 64 * (j))
#define XB_XSUB(j)  (1280 + 64 * (j))
#define XB_XGEN(j)  (2304 + 64 * (j))
#define XB_TOP      3328
#define XB_TOPGEN   3392
#define XCD_BAR_WORDS 3456
#define XB_SPIN_CAP (1u << 18)

__device__ __forceinline__ unsigned xb_ld(unsigned* p)              { return __hip_atomic_load(p, __ATOMIC_RELAXED, __HIP_MEMORY_SCOPE_AGENT); }
__device__ __forceinline__ unsigned xb_add(unsigned* p, unsigned v) { return __hip_atomic_fetch_add(p, v, __ATOMIC_RELAXED, __HIP_MEMORY_SCOPE_AGENT); }
__device__ __forceinline__ unsigned xb_xcc_id() { return (unsigned)__builtin_amdgcn_s_getreg((3 << 11) | 20) & 0xFu; }
#define XB_SPIN(cond, bar) do { unsigned _sp = 0; while (cond) { __builtin_amdgcn_s_sleep(1); \
    if ((++_sp & 255u) == 0u) { if (xb_ld(&(bar)[XB_TMO])) break; if (_sp > XB_SPIN_CAP) { atomicAdd(&(bar)[XB_TMO], 1u); break; } } } } while (0)

struct XcdBarrier {
    unsigned* bar; unsigned x;
    volatile LAS unsigned* st;
};

__device__ __forceinline__ XcdBarrier xcd_barrier_post(unsigned* bar, volatile LAS unsigned* st) {
    XcdBarrier b; b.bar = bar; b.x = xb_xcc_id(); b.st = st;
    if (threadIdx.x == 0) (void)xb_add(&bar[XB_XCNT(b.x)], 1u);
    return b;
}
__device__ __forceinline__ void xcd_barrier_complete(unsigned* bar, unsigned x, unsigned& nloc, unsigned& nx) {
    const unsigned G = gridDim.x * gridDim.y * gridDim.z;
    unsigned sum, cnt, mine, sp = 0u;
    for (;;) {
        sum = 0u; cnt = 0u; mine = 0u;
#pragma unroll
        for (unsigned j = 0; j < 16; ++j) { const unsigned c = xb_ld(&bar[XB_XCNT(j)]); sum += c; cnt += (c > 0u) ? 1u : 0u; mine = (j == x) ? c : mine; }
        if (sum == G) break;
        __builtin_amdgcn_s_sleep(1);
        if ((++sp & 255u) == 0u) { if (xb_ld(&bar[XB_TMO])) break; if (sp > XB_SPIN_CAP) { atomicAdd(&bar[XB_TMO], 1u); break; } }
    }
    nloc = mine > 0u ? mine : 1u; nx = cnt > 0u ? cnt : 1u;
}

__device__ __forceinline__ void xcd_barrier(const XcdBarrier& b) {
    asm volatile("s_waitcnt vmcnt(0)" ::: "memory");
    __syncthreads();
    if (threadIdx.x == 0) {
        unsigned* bar = b.bar;
        __builtin_amdgcn_s_waitcnt(0);
        unsigned nloc = b.st[0], nx = b.st[1];
        if (nloc == 0u) { xcd_barrier_complete(bar, b.x, nloc, nx); b.st[0] = nloc; b.st[1] = nx; }
        const unsigned old = xb_add(&bar[XB_XSUB(b.x)], 1u);
        const unsigned gen = old / nloc;
        if (old + 1u == (gen + 1u) * nloc) {
            __builtin_amdgcn_fence(__ATOMIC_RELEASE, "agent");
            asm volatile("s_waitcnt vmcnt(0)" ::: "memory");
            const unsigned og = xb_add(&bar[XB_TOP], 1u);
            const unsigned tg = og / nx;
            if (og + 1u == (tg + 1u) * nx) xb_add(&bar[XB_TOPGEN], 1u);
            else XB_SPIN(xb_ld(&bar[XB_TOPGEN]) == tg, bar);
            __builtin_amdgcn_fence(__ATOMIC_ACQUIRE, "agent");
            xb_add(&bar[XB_XGEN(b.x)], 1u);
            asm volatile("s_waitcnt vmcnt(0)" ::: "memory");
        } else {
            XB_SPIN(xb_ld(&bar[XB_XGEN(b.x)]) == gen, bar);
            __builtin_amdgcn_fence(__ATOMIC_ACQUIRE, "agent");
            asm volatile("s_waitcnt vmcnt(0)" ::: "memory");
        }
    }
    __syncthreads();
}

#undef LAS
}
namespace mk {
constexpr int NWAVES = 8;
constexpr int D = 1024, BATCH = 4, SEQ = 4096, M = BATCH * SEQ, DEPTH = 4, NH = 16, HD = 64, FOX_IN = 3 * D + NH, DFF = 2816;
constexpr int SG = 64, SP = 64, SC = 16;
constexpr float RMS_EPS = 1e-6f;
constexpr size_t MiB = 1u << 20;
constexpr size_t WS_CTL = 276 * MiB, CTL_ZERO_BYTES = 3 * MiB;
constexpr size_t WS_SSQ = 277 * MiB;
constexpr size_t WS_WQKV = 2 * MiB;
constexpr size_t WS_WO = 14 * MiB;
constexpr size_t WS_WS5IN = 18 * MiB;
constexpr size_t WS_WGLU = 20 * MiB;
constexpr size_t WS_BTA = 24 * MiB;
constexpr size_t WS_BTB = 32 * MiB;
constexpr size_t WS_WPOOL = 44 * MiB;
constexpr size_t WS_WF = 44 * MiB + 512 * 1024;
constexpr size_t WS_KERN = 45 * MiB;
constexpr size_t WS_LAMC = 46 * MiB;
constexpr size_t WS_LF = 47 * MiB;
constexpr size_t WS_WGU = 48 * MiB;
constexpr size_t WS_WDN = 92 * MiB;
constexpr size_t WS_XB = 114 * MiB;
constexpr size_t WS_ACT = 146 * MiB;
constexpr size_t WS_O = 244 * MiB;
constexpr size_t WS_NRM = 279 * MiB;
constexpr size_t WS_END = 283 * MiB;
constexpr int CW_TMO = 0, CW_BAR = 4096, CW_PANEL = 16384, CW_QUEUE = 24576, CW_HQ = 32768;

constexpr int RING_OFF = 0, RING_BYTES = 131072;
constexpr int LDSCTL_OFF = RING_BYTES, MISC_OFF = LDSCTL_OFF + 320;
constexpr int LDS_BYTES = 147456;

#define GAS __attribute__((address_space(1)))
#define LAS __attribute__((address_space(3)))
typedef unsigned short bf16;
typedef unsigned v4u __attribute__((ext_vector_type(4)));
typedef float f32x4 __attribute__((ext_vector_type(4)));
typedef float f32x2 __attribute__((ext_vector_type(2)));
typedef short bf16x8 __attribute__((ext_vector_type(8)));
typedef GAS unsigned gu32;
#define RLX_AGENT __ATOMIC_RELAXED, __HIP_MEMORY_SCOPE_AGENT
#define LDS_WAIT() asm volatile("s_waitcnt lgkmcnt(0)" ::: "memory")
#define VM_WAIT() asm volatile("s_waitcnt vmcnt(0)" ::: "memory")
__device__ __forceinline__ unsigned f2bf(float f) { unsigned u = __builtin_bit_cast(unsigned, f); return (u + 0x7fffu + ((u >> 16) & 1u)) >> 16; }
__device__ __forceinline__ unsigned pk2(float lo, float hi) { return f2bf(lo) | (f2bf(hi) << 16); }
__device__ __forceinline__ float bf2f(unsigned short b) { return __builtin_bit_cast(float, (unsigned)b << 16); }
__device__ __forceinline__ float lshx(float v, int lane, int m) { return __builtin_bit_cast(float, __builtin_amdgcn_ds_bpermute((lane ^ m) << 2, __builtin_bit_cast(int, v))); }
__device__ __forceinline__ float wave_sum(float v, int lane) {
#pragma unroll
    for (int o = 1; o < 64; o <<= 1) v += lshx(v, lane, o);
    return v;
}

enum Op { OP_PROLOGUE = 0, OP_QKV, OP_ATTN, OP_WO, OP_UP, OP_DOWN, OP_S5IN, OP_SSM, OP_SSMB, OP_GLU, OP_POOLPREP, OP_POOLGEMM, OP_FINAL, OP_NORMX, OP_S5TAB };
struct PhaseEnt { int op, layer, j, sin, sout; };
#define MK_PROGRAM \
    {OP_PROLOGUE, 0, 0, 0, 0}, \
    {OP_QKV, 0, 0, 0, 0}, {OP_ATTN, 0, 0, 0, 0}, {OP_WO, 0, 0, 0, 1}, {OP_UP, 0, 0, 1, 0}, {OP_DOWN, 0, 0, 0, 2}, \
    {OP_S5IN, 1, 0, 2, 0}, {OP_SSM, 1, 0, 0, 0}, {OP_GLU, 1, 0, 0, 3}, {OP_UP, 1, 0, 3, 0}, {OP_DOWN, 1, 0, 0, 4}, \
    {OP_POOLGEMM, 2, 0, 4, 5}, {OP_UP, 2, 0, 5, 0}, {OP_DOWN, 2, 0, 0, 6}, \
    {OP_QKV, 3, 1, 6, 0}, {OP_ATTN, 3, 1, 0, 0}, {OP_WO, 3, 1, 0, 7}, {OP_UP, 3, 0, 7, 0}, {OP_DOWN, 3, 0, 0, 8}, \
    {OP_FINAL, 0, 0, 8, 0}, \
    {OP_NORMX, 0, 0, 0, 1}, {OP_NORMX, 0, 0, 0, 2}, {OP_NORMX, 0, 0, 0, 3}, {OP_NORMX, 0, 0, 0, 4}, {OP_NORMX, 0, 0, 0, 5}, {OP_NORMX, 0, 0, 0, 6}, {OP_NORMX, 0, 0, 0, 7}, {OP_NORMX, 0, 0, 0, 8}, \
    {OP_S5TAB, 0, 0, 0, 0}
constexpr int N_PROG = 29, PH_FINAL = 19, PH_LAST = 18, PH_NORMX1 = 20, PH_S5TAB = 28;
__constant__ PhaseEnt PROG[N_PROG] = { MK_PROGRAM };

struct Args { const float* in[22]; float* out; unsigned char* ws; int ph_lo, ph_hi; };

__device__ __forceinline__ void wt_load(f32x4 (&v)[8], const float* W, int ldw, int n0_src, int k0, int lane) {
    const int c4 = lane & 7, r8 = lane >> 3;
    const GAS f32x4* src = (const GAS f32x4*)(W + (size_t)(k0 + r8) * ldw + n0_src + 4 * c4);
#pragma unroll
    for (int i = 0; i < 8; ++i) v[i] = MK_WNT ? __builtin_nontemporal_load(src + (size_t)i * 2 * ldw) : src[(size_t)i * 2 * ldw];
}
__device__ __forceinline__ void wt_store(f32x4 (&v)[8], int K, const float* gain, bf16* WT, int n0_dst, int k0, LAS float* scr, int lane) {
    const int c4 = lane & 7, r8 = lane >> 3;
    if (gain) {
#pragma unroll
        for (int i = 0; i < 8; ++i) v[i] = v[i] * gain[k0 + r8 + 8 * i]; }
#pragma unroll
    for (int i = 0; i < 8; ++i) { LAS float* d = scr + (r8 + 8 * i) * 33 + 4 * c4; d[0] = v[i].x; d[1] = v[i].y; d[2] = v[i].z; d[3] = v[i].w; }
    LDS_WAIT(); asm volatile("" ::: "memory");
    const int c = lane & 7;
#pragma unroll
    for (int j = 0; j < 4; ++j) { const int n = (lane >> 3) + 8 * j; const LAS float* s = scr + (8 * c) * 33 + n;
        v4u o; o.x = pk2(s[0 * 33], s[1 * 33]); o.y = pk2(s[2 * 33], s[3 * 33]); o.z = pk2(s[4 * 33], s[5 * 33]); o.w = pk2(s[6 * 33], s[7 * 33]);
        pg8::st_wt((GAS bf16*)WT + (size_t)(n0_dst + n) * K + k0 + 8 * c, o); }
    LDS_WAIT(); asm volatile("" ::: "memory");
}
__device__ __forceinline__ void wt_item(const float* W, int ldw, int K, const float* gain, bf16* WT, int n0_dst, int n0_src, int k0, LAS float* scr, int lane) {
    f32x4 v[8]; wt_load(v, W, ldw, n0_src, k0, lane); wt_store(v, K, gain, WT, n0_dst, k0, scr, lane);
}
template <int NR> __device__ __forceinline__ void normx_rows(const float* x0, size_t xstride, bf16* o0, size_t ostride, pg8::ssq_t* ssq0, size_t sstride, int lane) {
    f32x4 v[NR][4]; float s[NR];
#pragma unroll
    for (int r = 0; r < NR; ++r) { const GAS f32x4* xr = (const GAS f32x4*)(x0 + r * xstride) + lane;
#pragma unroll
        for (int j = 0; j < 4; ++j) v[r][j] = xr[64 * j]; }
#pragma unroll
    for (int r = 0; r < NR; ++r) { s[r] = 0.f;
#pragma unroll
        for (int j = 0; j < 4; ++j) s[r] += (v[r][j].x * v[r][j].x + v[r][j].y * v[r][j].y) + (v[r][j].z * v[r][j].z + v[r][j].w * v[r][j].w);
        s[r] = wave_sum(s[r], lane); }
#pragma unroll
    for (int r = 0; r < NR; ++r) { GAS unsigned long long* o8 = (GAS unsigned long long*)(o0 + r * ostride) + lane;
#pragma unroll
        for (int j = 0; j < 4; ++j) pg8::st_wt(o8 + 64 * j, (unsigned long long)pk2(v[r][j].x, v[r][j].y) | ((unsigned long long)pk2(v[r][j].z, v[r][j].w) << 32));
        if (lane == 0) ssq0[r * sstride] = (pg8::ssq_t)__builtin_llrintf(s[r] * pg8::SSQ_SCALE); }
}
__device__ __forceinline__ void normx_row(const float* xrow, bf16* orow, pg8::ssq_t* ssq_slot, int lane) { normx_rows<1>(xrow, 0, orow, 0, ssq_slot, 0, lane); }
__device__ __forceinline__ f32x4 bf4(const pg8::u32x2 w) { return (f32x4){__builtin_bit_cast(float, w.x << 16), __builtin_bit_cast(float, w.x & 0xffff0000u), __builtin_bit_cast(float, w.y << 16), __builtin_bit_cast(float, w.y & 0xffff0000u)}; }
template <int W> __device__ __forceinline__ void pool_item(const bf16* X, const pg8::ssq_t* ssq, const f32x4 gg, bf16* PD, int row0, int t0, int c0) {
    f32x4 ring[W]; f32x4 run = {0.f, 0.f, 0.f, 0.f};
    { pg8::u32x2 xw[W]; pg8::ssq_t sw[W];
#pragma unroll
      for (int kk = 1; kk < W; ++kk) { xw[kk] = (pg8::u32x2){0u, 0u}; sw[kk] = 0;
          if (t0 - W + kk >= 0) { const int r = row0 - W + kk; xw[kk] = *(const GAS pg8::u32x2*)(X + (size_t)r * D + c0); sw[kk] = ((const GAS pg8::ssq_t*)ssq)[r]; } }
#pragma unroll
      for (int kk = 1; kk < W; ++kk) {
          const f32x4 hv = bf4(xw[kk]) * __builtin_amdgcn_rsqf((float)sw[kk] * (1.0f / (1024.0f * pg8::SSQ_SCALE)) + RMS_EPS) * gg;
          ring[kk % W] = hv; run += hv; } }
    pg8::u32x2 xc[16]; pg8::ssq_t sc[16];
#pragma unroll
    for (int i = 0; i < 16; ++i) { xc[i] = *(const GAS pg8::u32x2*)(X + (size_t)(row0 + i) * D + c0); sc[i] = ((const GAS pg8::ssq_t*)ssq)[row0 + i]; }
#pragma unroll
    for (int i = 0; i < 16; ++i) { const int r = row0 + i, t = t0 + i;
        const f32x4 hv = bf4(xc[i]) * __builtin_amdgcn_rsqf((float)sc[i] * (1.0f / (1024.0f * pg8::SSQ_SCALE)) + RMS_EPS) * gg;
        run += hv; ring[i % W] = hv;
        const int cnt = (t + 1 < W) ? (t + 1) : W; const f32x4 o = run * (1.0f / (float)cnt) - hv;
        pg8::st_wt((GAS bf16*)PD + (size_t)r * D + c0, (unsigned long long)pk2(o[0], o[1]) | ((unsigned long long)pk2(o[2], o[3]) << 32));
        run -= ring[(i + 1) % W]; }
}
__device__ __forceinline__ void touch_lines(const void* p, int bytes, int tid) {
    const GAS unsigned* q = (const GAS unsigned*)p + tid * 32; unsigned acc = 0;
    for (int o = 0; o < bytes; o += 512 * 128 * 8) {
#pragma unroll
        for (int i = 0; i < 8; ++i) acc |= q[(size_t)(o / 4) + (size_t)i * 512 * 32];
    }
    asm volatile("" :: "v"(acc));
}
struct WtDesc { const float* W; const float* gain; bf16* WT; int ldw, K, Ndst, kind, off2; };
__device__ __forceinline__ WtDesc wt_desc(const Args& args, int i) {
    unsigned char* ws = args.ws; const float* mix_g = args.in[1]; const float* ffn_g = args.in[2];
    WtDesc d;
    if (i < 2) { d.W = args.in[4] + (size_t)i * D * FOX_IN; d.gain = mix_g + (i ? 3 * D : 0); d.WT = (bf16*)(ws + WS_WQKV) + (size_t)i * 3 * D * D; d.ldw = FOX_IN; d.K = D; d.Ndst = 3 * D; d.kind = 0; d.off2 = 0; }
    else if (i < 4) { d.W = args.in[6] + (size_t)(i - 2) * D * D; d.gain = nullptr; d.WT = (bf16*)(ws + WS_WO) + (size_t)(i - 2) * D * D; d.ldw = D; d.K = D; d.Ndst = D; d.kind = 0; d.off2 = 0; }
    else if (i == 4) { d.W = args.in[7]; d.gain = mix_g + D; d.WT = (bf16*)(ws + WS_WS5IN); d.ldw = D; d.K = D; d.Ndst = D; d.kind = 0; d.off2 = 0; }
    else if (i == 5) { d.W = args.in[16]; d.gain = nullptr; d.WT = (bf16*)(ws + WS_WGLU); d.ldw = 2 * D; d.K = D; d.Ndst = 2 * D; d.kind = 1; d.off2 = D; }
    else if (i < 10) { d.W = args.in[17] + (size_t)(i - 6) * 65536; d.gain = nullptr; d.WT = (bf16*)(ws + WS_WPOOL) + (size_t)(i - 6) * 65536; d.ldw = 256; d.K = 256; d.Ndst = 256; d.kind = 0; d.off2 = 0; }
    else if (i < 14) { d.W = args.in[20] + (size_t)(i - 10) * D * 2 * DFF; d.gain = ffn_g + (i - 10) * D; d.WT = (bf16*)(ws + WS_WGU) + (size_t)(i - 10) * 2 * DFF * D; d.ldw = 2 * DFF; d.K = D; d.Ndst = 2 * DFF; d.kind = 1; d.off2 = DFF; }
    else { d.W = args.in[21] + (size_t)(i - 14) * DFF * D; d.gain = nullptr; d.WT = (bf16*)(ws + WS_WDN) + (size_t)(i - 14) * D * DFF; d.ldw = D; d.K = DFF; d.Ndst = D; d.kind = 0; d.off2 = 0; }
    return d;
}
__device__ __forceinline__ void ph_s5tables(const Args& args, LAS float* scr, LAS float* wsc, int gw, int NGW, int lane) {
    unsigned char* ws = args.ws;
    { const float* a_re = args.in[8]; const float* a_im = args.in[9]; const float* log_dt = args.in[10];
      const float* b_re = args.in[11]; const float* b_im = args.in[12]; const float* c_re = args.in[13]; const float* c_im = args.in[14];
      float* KERN = (float*)(ws + WS_KERN);
      for (int it = (gw + NGW / 2) % NGW; it < SG * 16; it += NGW) {
          const int g = it >> 4, tau = it & 15, p = lane;
          { const GAS f32x4* s0 = (const GAS f32x4*)(c_re + (size_t)g * 1024), *s1 = (const GAS f32x4*)(c_im + (size_t)g * 1024), *s2 = (const GAS f32x4*)(b_re + (size_t)g * 1024), *s3 = (const GAS f32x4*)(b_im + (size_t)g * 1024);
            f32x4 t0[4], t1[4], t2[4], t3[4];
#pragma unroll
            for (int j = 0; j < 4; ++j) { t0[j] = s0[lane + 64 * j]; t1[j] = s1[lane + 64 * j]; t2[j] = s2[lane + 64 * j]; t3[j] = s3[lane + 64 * j]; }
#pragma unroll
            for (int j = 0; j < 4; ++j) { ((LAS f32x4*)scr)[lane + 64 * j] = t0[j]; ((LAS f32x4*)scr)[256 + lane + 64 * j] = t1[j]; ((LAS f32x4*)scr)[512 + lane + 64 * j] = t2[j]; ((LAS f32x4*)scr)[768 + lane + 64 * j] = t3[j]; } }
          const double lr = a_re[g * SP + p], li = a_im[g * SP + p], dt = exp((double)log_dt[g]);
          const double er = exp(lr * dt), lbr = er * cos(li * dt), lbi = er * sin(li * dt);
          const double nr = lbr - 1.0, ni = lbi, den = lr * lr + li * li, fr = (nr * lr + ni * li) / den, fi = (ni * lr - nr * li) / den;
          const double et = exp(lr * dt * tau), ptr_ = et * cos(li * dt * tau), pti = et * sin(li * dt * tau);
          wsc[p] = (float)(ptr_ * fr - pti * fi); wsc[64 + p] = (float)(ptr_ * fi + pti * fr);
          LDS_WAIT(); asm volatile("" ::: "memory");
          const LAS float* Cr = scr, *Ci = scr + 1024, *Br = scr + 2048, *Bi = scr + 3072, *Wr_ = wsc, *Wi_ = wsc + 64;
          float acc[4] = {0.f, 0.f, 0.f, 0.f}; const int ci = lane & 15, cob = lane >> 4;
#pragma unroll 8
          for (int pp = 0; pp < SP; ++pp) {
              const float wr = Wr_[pp], wi = Wi_[pp], br = Br[pp * 16 + ci], bi = Bi[pp * 16 + ci];
#pragma unroll
              for (int q = 0; q < 4; ++q) { const int co = cob + 4 * q; const float cr = Cr[co * 64 + pp], cim = Ci[co * 64 + pp];
                  const float cwr = cr * wr - cim * wi, cwi = cr * wi + cim * wr; acc[q] += cwr * br - cwi * bi; } }
#pragma unroll
          for (int q = 0; q < 4; ++q) KERN[(size_t)it * 256 + lane + 64 * q] = acc[q];
          LDS_WAIT(); asm volatile("" ::: "memory");
      }
      bf16* BTA = (bf16*)(ws + WS_BTA);
      for (int e = gw * 64 + lane; e < SG * 128 * 16; e += NGW * 64) {
          const int g = e >> 11, n = (e >> 4) & 127, j = e & 15, p = n & 63, im = n >> 6;
          const double lr = a_re[g * SP + p], li = a_im[g * SP + p], dt = exp((double)log_dt[g]);
          const double er = exp(lr * dt), lbr = er * cos(li * dt), lbi = er * sin(li * dt);
          const double nr = lbr - 1.0, ni = lbi, den = lr * lr + li * li, fr = (nr * lr + ni * li) / den, fi = (ni * lr - nr * li) / den;
          const double tt = (double)(15 - j), et = exp(lr * dt * tt), ptr_ = et * cos(li * dt * tt), pti = et * sin(li * dt * tt);
          const float Wr = (float)(ptr_ * fr - pti * fi), Wi = (float)(ptr_ * fi + pti * fr);
          unsigned w[8];
#pragma unroll
          for (int c = 0; c < 16; c += 2) { float v[2];
#pragma unroll
              for (int q = 0; q < 2; ++q) { const float br = b_re[(g * SP + p) * SC + c + q], bi = b_im[(g * SP + p) * SC + c + q]; v[q] = im ? (Wr * bi + Wi * br) : (Wr * br - Wi * bi); }
              w[c >> 1] = pk2(v[0], v[1]); }
          v4u* dst = (v4u*)(BTA + ((size_t)g * 256 + n) * 256 + j * 16);
          dst[0] = (v4u){w[0], w[1], w[2], w[3]}; dst[1] = (v4u){w[4], w[5], w[6], w[7]};
      }
      for (int e = gw * 64 + lane; e < SG * 128 * 32; e += NGW * 64) { const int g = e >> 12, r = e & 4095; ((v4u*)(BTA + ((size_t)g * 256 + 128) * 256))[r] = (v4u){0u, 0u, 0u, 0u}; }
      bf16* BTB = (bf16*)(ws + WS_BTB);
      for (int e = gw * 64 + lane; e < SG * 16 * SP; e += NGW * 64) {
          const int g = e >> 10, i = (e >> 6) & 15, p = e & 63;
          const double lr = a_re[g * SP + p], li = a_im[g * SP + p], dt = exp((double)log_dt[g]);
          const double tt = (double)(i + 1), et = exp(lr * dt * tt); const float pr = (float)(et * cos(li * dt * tt)), pi_ = (float)(et * sin(li * dt * tt));
          float crv[16], civ[16];
#pragma unroll
          for (int co = 0; co < 16; ++co) { crv[co] = c_re[(g * SC + co) * SP + p]; civ[co] = c_im[(g * SC + co) * SP + p]; }
#pragma unroll
          for (int co = 0; co < 16; ++co) { const float cr = crv[co], cim = civ[co];
              bf16* row = BTB + ((size_t)g * 256 + i * 16 + co) * 384 + 256;
              row[p] = (bf16)f2bf(cr * pr - cim * pi_); row[64 + p] = (bf16)f2bf(-(cr * pi_ + cim * pr)); }
      }
      float* LAMC = (float*)(ws + WS_LAMC);
      for (int e = gw * 64 + lane; e < SG * SP; e += NGW * 64) {
          const double lr = a_re[e], li = a_im[e], dt = exp((double)log_dt[e >> 6]), et = exp(lr * dt * 16.0);
          LAMC[2 * e] = (float)(et * cos(li * dt * 16.0)); LAMC[2 * e + 1] = (float)(et * sin(li * dt * 16.0)); }
    }
}
__device__ __forceinline__ bool wt_one(const Args& args, LAS float* scr, unsigned mask, int it, int lane) {
    constexpr int NMAT = 18; int base = 0;
    for (int mi = 0; mi < NMAT; ++mi) { if (!((mask >> mi) & 1u)) continue;
        const WtDesc d = wt_desc(args, mi); const int n_it = (d.K / 64) * (d.Ndst / 32);
        if (it < base + n_it) { const int r = it - base, nblk = d.Ndst / 32, kb = r / nblk, nb = r % nblk, n0 = nb * 32; int ns = n0;
            if (d.kind == 1) { const int pn = n0 >> 8, j = n0 & 255; ns = (j < 128) ? (128 * pn + j) : (d.off2 + 128 * pn + (j - 128)); }
            wt_item(d.W, d.ldw, d.K, d.gain, d.WT, n0, ns, kb * 64, scr, lane); return true; }
        base += n_it; }
    return false;
}
struct WtWork { const float* gain; bf16* WT; int K, n0, k0; bool ok; };
__device__ __forceinline__ WtWork wt_fetch(const Args& args, unsigned mask, int it, f32x4 (&v)[8], int lane) {
    constexpr int NMAT = 18; int base = 0; WtWork w{}; w.ok = false;
    for (int mi = 0; mi < NMAT; ++mi) { if (!((mask >> mi) & 1u)) continue;
        const WtDesc d = wt_desc(args, mi); const int n_it = (d.K / 64) * (d.Ndst / 32);
        if (it < base + n_it) { const int r = it - base, nblk = d.Ndst / 32, kb = r / nblk, nb = r % nblk, n0 = nb * 32; int ns = n0;
            if (d.kind == 1) { const int pn = n0 >> 8, j = n0 & 255; ns = (j < 128) ? (128 * pn + j) : (d.off2 + 128 * pn + (j - 128)); }
            wt_load(v, d.W, d.ldw, ns, kb * 64, lane); w.gain = d.gain; w.WT = d.WT; w.K = d.K; w.n0 = n0; w.k0 = kb * 64; w.ok = true; return w; }
        base += n_it; }
    return w;
}
__device__ __forceinline__ void ph_weights(const Args& args, LAS float* scr, unsigned mask, int rk, int nw, int lane) {
    f32x4 va[8], vb[8];
    WtWork wa = wt_fetch(args, mask, rk, va, lane);
    for (int it = rk; wa.ok; it += 2 * nw) {
        WtWork wb = wt_fetch(args, mask, it + nw, vb, lane);
        wt_store(va, wa.K, wa.gain, wa.WT, wa.n0, wa.k0, scr, lane);
        if (!wb.ok) break;
        wa = wt_fetch(args, mask, it + 2 * nw, va, lane);
        wt_store(vb, wb.K, wb.gain, wb.WT, wb.n0, wb.k0, scr, lane);
    }
}
__device__ __forceinline__ void ph_wf(const Args& args, int j, int rk, int nw, int lane) {
    for (int e = rk * 64 + lane; e < NH * D; e += nw * 64) { const int h = e >> 10, kk = e & 1023;
        ((bf16*)(args.ws + WS_WF))[j * NH * D + e] = (bf16)f2bf(args.in[4][(size_t)j * D * FOX_IN + (size_t)kk * FOX_IN + 3 * D + h] * args.in[1][(j ? 3 * D : 0) + kk]); }
}
constexpr unsigned WMASK_PRO = (1u << 0);
constexpr unsigned WMASK_ATT = (1u << 2) | (1u << 10) | (1u << 4) | (1u << 5);
constexpr int WATT_ITEMS = 16 * 32 + 16 * 176 + 16 * 32 + 16 * 64;
constexpr unsigned WMASK_L0 = (1u << 14) | (1u << 11);
constexpr unsigned WMASK_L1 = (1u << 15) | (1u << 6) | (1u << 7) | (1u << 8) | (1u << 9) | (1u << 12);
constexpr unsigned WMASK_L2 = (1u << 16) | (1u << 1) | (1u << 3) | (1u << 13);
constexpr unsigned WMASK_L3 = (1u << 17);
__device__ __forceinline__ void ph_prologue(const Args& args, LAS unsigned char* lds, int gw, int NGW, int wave, int lane) {
    unsigned char* ws = args.ws;
    LAS float* scr = (LAS float*)(lds + RING_OFF + wave * 16384);
    ph_weights(args, scr, MK_DEFER_WEIGHTS ? WMASK_PRO : 0x3ffffu, gw, NGW, lane);
    ph_wf(args, 0, gw, NGW, lane); if (!MK_DEFER_WEIGHTS) ph_wf(args, 1, gw, NGW, lane);
    for (int rep_ = 0; rep_ < MK_S5TAB_REPS; ++rep_) ph_s5tables(args, scr, (LAS float*)(lds + LDSCTL_OFF + 8192 + wave * 512), gw, NGW, lane);
    pg8::ssq_t* ssq0 = (pg8::ssq_t*)(ws + WS_SSQ);
    for (int m = gw; m < M; m += NGW) normx_row(args.in[0] + (size_t)m * D, (bf16*)(ws + WS_XB) + (size_t)m * D, ssq0 + m, lane);
}

__device__ __forceinline__ void ph_toeplitz(unsigned char* ws, int rk, int nw, int lane) {
    const float* KERN = (const float*)(ws + WS_KERN); bf16* BTB = (bf16*)(ws + WS_BTB);
    for (int e2 = rk * 64 + lane; e2 < SG * 256 * 16; e2 += nw * 64) { const int g = e2 >> 12, n = (e2 >> 4) & 255, j = e2 & 15, i = n >> 4, co = n & 15;
        v4u o0 = {0u, 0u, 0u, 0u}, o1 = {0u, 0u, 0u, 0u};
        if (i >= j) { const f32x4* kp = (const f32x4*)(KERN + (((size_t)g * 16 + (i - j)) * 16 + co) * 16); const f32x4 a = kp[0], b = kp[1], c = kp[2], d = kp[3];
            o0 = (v4u){pk2(a[0], a[1]), pk2(a[2], a[3]), pk2(b[0], b[1]), pk2(b[2], b[3])}; o1 = (v4u){pk2(c[0], c[1]), pk2(c[2], c[3]), pk2(d[0], d[1]), pk2(d[2], d[3])}; }
        v4u* dst = (v4u*)(BTB + ((size_t)g * 256 + n) * 384 + j * 16); dst[0] = o0; dst[1] = o1; }
}
__global__ void __launch_bounds__(NWAVES * 64, 2) mega_k(Args args) {
    extern __shared__ __attribute__((aligned(16))) unsigned char lds_raw[];
    LAS unsigned char* lds = (LAS unsigned char*)lds_raw;
    const int vcu0 = (gridDim.x % 8 == 0) ? (blockIdx.x % 8) * (gridDim.x / 8) + blockIdx.x / 8 : blockIdx.x;
    const int vcu = vcu0, NGW = gridDim.x * NWAVES, wave0 = __builtin_amdgcn_readfirstlane(threadIdx.x >> 6);
    for (int u = threadIdx.x; u < (LDS_BYTES - LDSCTL_OFF) / 4; u += NWAVES * 64) ((LAS unsigned*)(lds + LDSCTL_OFF))[u] = 0u;
    __syncthreads();
    MK_BAR_SETUP();
    int e0 = args.ph_lo;
    if (e0 == PH_S5TAB) { const int tid = threadIdx.x, lane = tid & 63, wave = __builtin_amdgcn_readfirstlane(tid >> 6); ph_s5tables(args, (LAS float*)(lds + RING_OFF + wave * 16384), (LAS float*)(lds + LDSCTL_OFF + 8192 + wave * 512), vcu * NWAVES + wave, NGW, lane); return; }
    if (e0 == 0) {
        const int tid = threadIdx.x, lane = tid & 63, wave = __builtin_amdgcn_readfirstlane(tid >> 6);
        ph_prologue(args, lds, vcu * NWAVES + wave, NGW, wave, lane);
        e0 = 1;
        if (e0 < args.ph_hi) { MK_GRID_BAR(); }
    }
    for (int e = e0; e < args.ph_hi; ++e) {
#define MK_LANE_TID() int lane_; asm volatile("v_mbcnt_lo_u32_b32 %0, -1, 0\n\tv_mbcnt_hi_u32_b32 %0, -1, %0" : "=v"(lane_)); const int lane = lane_, tid = wave * 64 + lane, gw = vcu * NWAVES + wave; (void)tid; (void)gw; (void)lane
        const int wave = wave0;
        int G = gridDim.x, bx = blockIdx.x, vcu = vcu0; asm volatile("" : "+s"(G), "+s"(bx), "+s"(vcu));
        const int NGW = G * NWAVES;
        unsigned char* ws = args.ws; float* X = args.out; asm volatile("" : "+s"(ws), "+s"(X));
        pg8::ssq_t* SSQ = (pg8::ssq_t*)(ws + WS_SSQ);
        const int op = PROG[e].op, layer = PROG[e].layer, pj = PROG[e].j, sin = PROG[e].sin, sout = PROG[e].sout;
#define MK_XBS(s_) ((s_) == 5 ? (bf16*)(ws + WS_O) : (bf16*)(ws + WS_XB))
#define MK_XBO(s_) (MK_JUNK ? (bf16*)X + (size_t)M * D : MK_XBS(s_))
#define MK_SSQO(s_) (SSQ + (size_t)(MK_JUNK ? 12 : (s_)) * M)
        bf16* XB = MK_XBS(sin);
        (void)pj;
        if (op == OP_NORMX) {
            MK_LANE_TID();
            for (int m = gw; m < M; m += NGW) normx_row(X + (size_t)m * D, XB + (size_t)m * D, SSQ + (size_t)sout * M + m, lane);
        } else if (op == OP_UP) {
            MK_LANE_TID();
            pg8::Gemm g{XB, (const bf16*)(ws + WS_WGU) + (size_t)layer * 2 * DFF * D, D, D, D, 0, 0};
            pg8::StaticOrder S; S.init(M / 256, 2 * DFF / 256, G, bx);
            pg8::EpiSwiGLU E{(bf16*)(ws + WS_ACT), DFF, SSQ + (size_t)sin * M, MK_UP_DUMMY};
            pg8::gemm_phase<pg8::EpiSwiGLU, pg8::StaticOrder, MK_ALIGN_UP>(lds + RING_OFF, tid, g, S, E);
            if (MK_DEFER_WEIGHTS && bx >= 128 && !(MK_UP_DUMMY)) {
                LAS float* scr = (LAS float*)(lds + RING_OFF + wave * 16384); const int rk = (bx - 128) * NWAVES + wave;
                ph_weights(args, scr, layer == 0 ? WMASK_L0 : layer == 1 ? WMASK_L1 : layer == 2 ? WMASK_L2 : WMASK_L3, rk, 128 * NWAVES, lane);
                if (layer == 2) ph_wf(args, 1, rk, 128 * NWAVES, lane); }
        } else if (op == OP_DOWN) {
            MK_LANE_TID();
            pg8::Gemm g{(const bf16*)(ws + WS_ACT), (const bf16*)(ws + WS_WDN) + (size_t)layer * D * DFF, DFF, DFF, DFF, 0, 0};
            pg8::StaticOrder S; S.init(M / 256, D / 256, G, bx);
            if (layer == 3 && !(MK_JUNK)) {
                pg8::EpiResidFinal E{MK_XBS(sout - 1), X, SSQ + (size_t)sout * M, args.in[3], (unsigned*)(ws + WS_CTL) + CW_PANEL};
                pg8::gemm_phase<pg8::EpiResidFinal, pg8::StaticOrder, false>(lds + RING_OFF, tid, g, S, E);
            } else {
                pg8::EpiResid<0> E{MK_XBS(sout - 1), MK_XBO(sout), MK_SSQO(sout), args.in[18], nullptr, MK_UP_DUMMY};
                pg8::gemm_phase<pg8::EpiResid<0>, pg8::StaticOrder, true>(lds + RING_OFF, tid, g, S, E); }
        }
        else if (op == OP_QKV) {
            MK_LANE_TID();
            if (MK_TOUCH) touch_lines(XB + (size_t)(8 * (bx & 7) + ((bx >> 3) & 7)) * 256 * D, 256 * D * 2, tid);
            if (!(MK_QKV_NOGATES)) {
              const bf16* WfT = (const bf16*)(ws + WS_WF) + (size_t)pj * NH * D; const pg8::ssq_t* ssq = SSQ + (size_t)sin * M; const float* bfp = args.in[5] + pj * NH; float* LF = (float*)(ws + WS_LF);
#pragma unroll
              for (int i = 0; i < 4; ++i) { const int c = tid + 512 * i; *(LAS v4u*)(lds + (c >> 7) * 2064 + (c & 127) * 16) = ((const GAS v4u*)WfT)[c]; }
              LDS_WAIT(); __syncthreads();
              if (wave < 4) {
                const int r0 = (vcu * 4 + wave) * 16, kq = lane >> 4; const GAS bf16x8* ap = (const GAS bf16x8*)(XB + (size_t)(r0 + (lane & 15)) * D + kq * 8); const LAS unsigned char* bp = lds + (lane & 15) * 2064 + kq * 16;
                bf16x8 afr[32];
#pragma unroll
                for (int ks = 0; ks < 32; ++ks) afr[ks] = ap[ks * 4];
                f32x4 acc = {0.f, 0.f, 0.f, 0.f};
#pragma unroll
                for (int ks = 0; ks < 32; ++ks) acc = __builtin_amdgcn_mfma_f32_16x16x32_bf16(afr[ks], *(const LAS bf16x8*)(bp + ks * 64), acc, 0, 0, 0);
                const int rr = r0 + 4 * kq, hh = lane & 15; const float bb = bfp[hh]; f32x4 o;
#pragma unroll
                for (int i = 0; i < 4; ++i) { const float z = acc[i] * pg8::rstd_row(ssq, rr + i) + bb; o[i] = fminf(z, 0.f) - log1pf(expf(-fabsf(z))); }
                pg8::st_wt((GAS float*)LF + ((size_t)(rr / SEQ) * NH + hh) * SEQ + (rr % SEQ), o); }
              LDS_WAIT(); __syncthreads(); }
            pg8::Gemm g{XB, (const bf16*)(ws + WS_WQKV) + (size_t)pj * 3 * D * D, D, D, D, 0, 0};
            pg8::StaticOrder S; S.init(M / 256, 3 * D / 256, G, bx);
            pg8::EpiQKV E{(bf16*)(ws + WS_ACT), (size_t)16 * MiB, SSQ + (size_t)sin * M, attn_body::C2, (float*)(ws + WS_NRM), MK_UP_DUMMY};
            pg8::gemm_phase<pg8::EpiQKV, pg8::StaticOrder, true>(lds + RING_OFF, tid, g, S, E);
        } else if (op == OP_ATTN) {
            MK_LANE_TID();
#if MK_ATT_DYN
            LAS float* bl = (LAS float*)(lds + RING_OFF + attn_body::ATTN_LDS_BYTES);
            LAS int* tsk = (LAS int*)(lds + LDSCTL_OFF + 12288); LAS float* kn = (LAS float*)(lds + LDSCTL_OFF + 12288 + 64); LAS float* qn = kn + 64;
            unsigned* hq = (unsigned*)(ws + WS_CTL) + CW_HQ + pj * 2048 + (MK_JUNK ? 4096 : 0);
            const attn_body::AttnTensors AT{(const attn_body::bf16*)(ws + WS_ACT), (const attn_body::bf16*)(ws + WS_ACT + 32 * MiB), (const attn_body::bf16*)(ws + WS_ACT + 64 * MiB), (attn_body::bf16*)(ws + WS_O)};
            const int home = vcu >> 2; int cur = home, built = -1;
            for (;;) {
                int ln_; asm volatile("v_mbcnt_lo_u32_b32 %0, -1, 0\n\tv_mbcnt_hi_u32_b32 %0, -1, %0" : "=v"(ln_)); const int ln = ln_, td = wave * 64 + ln_;
                if (wave == 0) {
                    int c = cur, idx = 0;
                    for (int att = 0; ; ++att) {
                        unsigned i0 = 0; if (ln == 0) i0 = __hip_atomic_fetch_add(hq + c * 32, 1u, __ATOMIC_RELAXED, __HIP_MEMORY_SCOPE_AGENT); i0 = (unsigned)__builtin_amdgcn_readfirstlane((int)i0);
                        if (i0 < 16u) { idx = (int)i0; break; }
                        if (att == 6) { c = -1; break; }
                        unsigned cnt = __hip_atomic_load(hq + ln * 32, __ATOMIC_RELAXED, __HIP_MEMORY_SCOPE_AGENT); cnt = cnt > 16u ? 16u : cnt;
                        unsigned key = cnt * 64u + (unsigned)((ln - home) & 63);
#pragma unroll
                        for (int o = 1; o < 64; o <<= 1) { const unsigned k2 = (unsigned)__builtin_amdgcn_ds_bpermute((ln ^ o) << 2, (int)key); key = k2 < key ? k2 : key; }
                        key = (unsigned)__builtin_amdgcn_readfirstlane((int)key);
                        if ((key >> 6) >= 16u) { c = -1; break; }
                        c = (home + (int)(key & 63u)) & 63;
                    }
                    if (ln == 0) { tsk[8] = c; tsk[9] = idx; }
                }
                LDS_WAIT(); __syncthreads();
                const int c = __builtin_amdgcn_readfirstlane(tsk[8]), idx = __builtin_amdgcn_readfirstlane(tsk[9]);
                if (c < 0) break;
                cur = c;
                const int hd = c & 15; const size_t rb = (size_t)(c >> 4) * SEQ;
                if (c != built) { built = c;
                    { const float* lf = (const float*)(ws + WS_LF) + (size_t)c * SEQ + td * 8; LAS float* wt = (LAS float*)(lds + LDSCTL_OFF + 1024);
                      const f32x4 a = *(const GAS f32x4*)lf, b = *(const GAS f32x4*)(lf + 4);
                      float p[8]; p[0] = a[0]; p[1] = p[0] + a[1]; p[2] = p[1] + a[2]; p[3] = p[2] + a[3]; p[4] = p[3] + b[0]; p[5] = p[4] + b[1]; p[6] = p[5] + b[2]; p[7] = p[6] + b[3];
                      float tot = p[7];
#pragma unroll
                      for (int o = 1; o < 64; o <<= 1) { const float u = __builtin_bit_cast(float, __builtin_amdgcn_ds_bpermute((ln - o) << 2, __builtin_bit_cast(int, tot))); if (ln >= o) tot += u; }
                      if (ln == 63) wt[wave] = tot;
                      LDS_WAIT(); __syncthreads();
                      float off = tot - p[7];
                      for (int w = 0; w < wave; ++w) off += wt[w];
#pragma unroll
                      for (int i = 0; i < 8; ++i) bl[td * 8 + i] = -(p[i] + off) * 1.4426950408889634f; }
                    { const GAS f32x2* Nk = (const GAS f32x2*)(ws + WS_NRM) + ((size_t)(4 + (hd >> 2)) * M + rb) * 4 + (hd & 3); f32x2 v[8];
#pragma unroll
                      for (int i = 0; i < 8; ++i) v[i] = Nk[(size_t)(td * 8 + i) * 4];
                      float mx = 0.f;
#pragma unroll
                      for (int i = 0; i < 8; ++i) mx = fmaxf(mx, v[i].x + v[i].y);
                      mx = fmaxf(mx, lshx(mx, ln, 1)); mx = fmaxf(mx, lshx(mx, ln, 2)); mx = fmaxf(mx, lshx(mx, ln, 4));
                      if ((ln & 7) == 0) kn[td >> 3] = mx; } }
                const int qb = 15 - idx, nt = 4 * qb + 4;
                { const GAS f32x2* Nq = (const GAS f32x2*)(ws + WS_NRM) + ((size_t)(hd >> 2) * M + rb) * 4 + (hd & 3);
                  float mx = 0.f; if (td < 256) { const f32x2 v = Nq[(size_t)(qb * 256 + td) * 4]; mx = v.x + v.y; }
#pragma unroll
                  for (int o = 1; o < 64; o <<= 1) mx = fmaxf(mx, lshx(mx, ln, o));
                  if (ln == 0) qn[wave] = mx; }
                LDS_WAIT(); __syncthreads();
                if (wave == 0) {
                    float q2 = (ln < 8) ? qn[ln] : 0.f, k2 = (ln < nt) ? kn[ln] : 0.f;
#pragma unroll
                    for (int o = 1; o < 64; o <<= 1) { q2 = fmaxf(q2, lshx(q2, ln, o)); k2 = fmaxf(k2, lshx(k2, ln, o)); }
                    const float lim = MK_SKIP_QK * sqrtf(q2) * sqrtf(k2) * 1.01f + 30.0f, bq = bl[qb * 256];
                    const int ts = 2 * ln;
                    const bool okc = (ts + 2 <= nt - 4) && (bq - bl[64 * (ts + 1) + 63] >= lim);
                    const int cntc = __builtin_popcountll(__ballot(okc));
                    if (ln == 0) { tsk[0] = 2 * cntc; tsk[1] = __builtin_bit_cast(int, sqrtf(q2) * sqrtf(k2) * 1.01f); } }
                LDS_WAIT(); __syncthreads();
                attn_body::attn_unit<MK_THRL>(c >> 4, hd, qb, AT.Q, AT.K, AT.V, AT.O, (char*)lds_raw + RING_OFF, bl, td, __builtin_amdgcn_readfirstlane(tsk[0]), __builtin_bit_cast(float, __builtin_amdgcn_readfirstlane(tsk[1])));
            }
#else
            LAS float* bl = (LAS float*)(lds + RING_OFF + attn_body::ATTN_LDS_BYTES);
            { const float* lf = (const float*)(ws + WS_LF) + (size_t)(vcu >> 2) * SEQ + tid * 8; LAS float* wt = (LAS float*)(lds + LDSCTL_OFF + 1024);
              const f32x4 a = *(const f32x4*)lf, b = *(const f32x4*)(lf + 4);
              float p[8]; p[0] = a[0]; p[1] = p[0] + a[1]; p[2] = p[1] + a[2]; p[3] = p[2] + a[3]; p[4] = p[3] + b[0]; p[5] = p[4] + b[1]; p[6] = p[5] + b[2]; p[7] = p[6] + b[3];
              float tot = p[7];
#pragma unroll
              for (int o = 1; o < 64; o <<= 1) { const float u = __builtin_bit_cast(float, __builtin_amdgcn_ds_bpermute((lane - o) << 2, __builtin_bit_cast(int, tot))); if (lane >= o) tot += u; }
              if (lane == 63) wt[wave] = tot;
              LDS_WAIT(); __syncthreads();
              float off = tot - p[7];
              for (int w = 0; w < wave; ++w) off += wt[w];
#pragma unroll
              for (int i = 0; i < 8; ++i) bl[tid * 8 + i] = -(p[i] + off) * 1.4426950408889634f;
              LDS_WAIT(); __syncthreads(); }
            LAS int* tsk = (LAS int*)(lds + LDSCTL_OFF + 12288);
            for (int prep_ = 0; prep_ < MK_PREPASS_REPS; ++prep_) { LAS float* kn = (LAS float*)(lds + LDSCTL_OFF + 12288 + 64); LAS float* qn = kn + 64;
              const int bh = vcu >> 2, sq = vcu & 3; const size_t rb = (size_t)(bh >> 4) * SEQ; const int hc = (bh & 15) * HD + (lane & 7) * 8;
              (void)hc;
              const int hd = bh & 15; const GAS f32x2* Nk = (const GAS f32x2*)(ws + WS_NRM) + ((size_t)(4 + (hd >> 2)) * M + rb) * 4 + (hd & 3); const GAS f32x2* Nq = (const GAS f32x2*)(ws + WS_NRM) + ((size_t)(hd >> 2) * M + rb) * 4 + (hd & 3);
              { f32x2 v[8];
#pragma unroll
                for (int i = 0; i < 8; ++i) v[i] = Nk[(size_t)(tid * 8 + i) * 4];
                float mx = 0.f;
#pragma unroll
                for (int i = 0; i < 8; ++i) mx = fmaxf(mx, v[i].x + v[i].y);
                mx = fmaxf(mx, lshx(mx, lane, 1)); mx = fmaxf(mx, lshx(mx, lane, 2)); mx = fmaxf(mx, lshx(mx, lane, 4));
                if ((lane & 7) == 0) kn[tid >> 3] = mx; }
              { f32x2 v[2]; const int i = wave >> 1, qb = (i == 0) ? sq : (i == 1) ? 7 - sq : (i == 2) ? 8 + sq : 15 - sq;
#pragma unroll
                for (int jj = 0; jj < 2; ++jj) v[jj] = Nq[(size_t)(qb * 256 + (wave & 1) * 128 + lane * 2 + jj) * 4];
                float mx = fmaxf(v[0].x + v[0].y, v[1].x + v[1].y);
#pragma unroll
                for (int o = 1; o < 64; o <<= 1) mx = fmaxf(mx, lshx(mx, lane, o));
                if (lane == 0) qn[i * 8 + (wave & 1)] = mx; if (lane == 1) { qn[i * 8 + 2 + (wave & 1) * 3] = 0.f; qn[i * 8 + 3 + (wave & 1) * 3] = 0.f; qn[i * 8 + 4 + (wave & 1) * 3] = 0.f; } }
              LAS float* kbs = (LAS float*)(lds + LDSCTL_OFF + 13312);
              { const int i = wave >> 1, qb = (i == 0) ? sq : (i == 1) ? 7 - sq : (i == 2) ? 8 + sq : 15 - sq; float cs[8];
#pragma unroll
                for (int e2 = 0; e2 < 8; ++e2) cs[e2] = 0.f;
                if (qb > 0) { const GAS pg8::u32x4* kp = (const GAS pg8::u32x4*)((const bf16*)(ws + WS_ACT + 32 * MiB) + (rb + (size_t)(qb * 256 - 64)) * D + hd * HD); pg8::u32x4 w[4];
#pragma unroll
                    for (int k4 = 0; k4 < 4; ++k4) { const int pc = (wave & 1) * 64 + lane + 128 * k4; w[k4] = kp[(size_t)(pc >> 3) * (D / 8) + (pc & 7)]; }
#pragma unroll
                    for (int k4 = 0; k4 < 4; ++k4) { f32x4 lo, hi2; pg8::bf8_to_f32(w[k4], lo, hi2); cs[0] += lo[0]; cs[1] += lo[1]; cs[2] += lo[2]; cs[3] += lo[3]; cs[4] += hi2[0]; cs[5] += hi2[1]; cs[6] += hi2[2]; cs[7] += hi2[3]; } }
#pragma unroll
                for (int e2 = 0; e2 < 8; ++e2) { cs[e2] += lshx(cs[e2], lane, 8); cs[e2] += lshx(cs[e2], lane, 16); cs[e2] += lshx(cs[e2], lane, 32); }
                if (lane < 8) {
#pragma unroll
                    for (int e2 = 0; e2 < 8; ++e2) kbs[wave * 64 + lane * 8 + e2] = cs[e2]; } }
              LAS float* wtl = (LAS float*)(lds + LDSCTL_OFF + 15360);
#pragma unroll
              for (int jj = 0; jj < 8; ++jj) { const int j = wave * 8 + jj; float wv = __builtin_amdgcn_exp2f(bl[64 * j + lane] - bl[64 * j + 63]);
#pragma unroll
                  for (int o = 1; o < 64; o <<= 1) wv += lshx(wv, lane, o);
                  if (lane == 0) wtl[j] = wv; }
              LDS_WAIT(); __syncthreads();
              if (wave < 4) { const int i = wave, qb = (i == 0) ? sq : (i == 1) ? 7 - sq : (i == 2) ? 8 + sq : 15 - sq, nt = 4 * qb + 4;
                  float q2 = (lane < 8) ? qn[i * 8 + lane] : 0.f, k2 = (lane < nt) ? kn[lane] : 0.f;
#pragma unroll
                  for (int o = 1; o < 64; o <<= 1) { q2 = fmaxf(q2, lshx(q2, lane, o)); k2 = fmaxf(k2, lshx(k2, lane, o)); }
                  float kb = kbs[(2 * i) * 64 + lane] + kbs[(2 * i + 1) * 64 + lane]; kb = kb * kb * (1.0f / 4096.0f);
                  float mb = (qb > 0) ? bl[(4 * qb - 1) * 64 + lane] : 0.f;
#pragma unroll
                  for (int o = 1; o < 64; o <<= 1) { kb += lshx(kb, lane, o); mb += lshx(mb, lane, o); }
                  mb *= (1.0f / 64.0f);
                  const int ts = 2 * lane, je = (ts + 1) < 63 ? (ts + 1) : 63;
                  const float be = bl[64 * je + 63];
                  float tw = 0.f;
#pragma nounroll
                  for (int i2 = 0; i2 < 64; ++i2) { const float term = wtl[i2] * __builtin_amdgcn_exp2f(fminf(bl[64 * i2 + 63] - be, 0.f)); tw += (i2 <= je) ? term : 0.f; }
                  const float lim = sqrtf(q2) * (sqrtf(k2) + sqrtf(kb)) * 1.01f + 18.0f + __builtin_amdgcn_logf(fmaxf(tw, 1.f));
                  const bool okc = (ts + 2 <= nt - 4) && (mb - be >= lim);
                  const int cntc = __builtin_popcountll(__ballot(okc));
                  if (lane == 0) { tsk[i] = 2 * cntc; tsk[4 + i] = __builtin_bit_cast(int, sqrtf(q2) * sqrtf(k2) * 1.01f); } }
              LDS_WAIT(); __syncthreads(); }
            const attn_body::AttnTensors AT{(const attn_body::bf16*)(ws + WS_ACT), (const attn_body::bf16*)(ws + WS_ACT + 32 * MiB), (const attn_body::bf16*)(ws + WS_ACT + 64 * MiB), (attn_body::bf16*)(ws + WS_O)};
            const attn_body::StaticOrder S(G, bx);
            attn_body::attn_phase<attn_body::StaticOrder, MK_THRL>((char*)lds_raw + RING_OFF, AT, S, bl, tid, tsk);
#endif
            if (MK_DEFER_WEIGHTS && layer == 0) {
                LAS float* scr = (LAS float*)(lds + RING_OFF + wave * 16384); unsigned* q = (unsigned*)(ws + WS_CTL) + CW_QUEUE;
                for (;;) { unsigned b0 = 0; if (lane == 0) b0 = __hip_atomic_fetch_add(q, 4u, __ATOMIC_RELAXED, __HIP_MEMORY_SCOPE_AGENT); b0 = (unsigned)__builtin_amdgcn_readfirstlane((int)b0);
                    if (b0 >= (unsigned)WATT_ITEMS) break;
                    for (int i = 0; i < 4; ++i) if (!wt_one(args, scr, WMASK_ATT, (int)b0 + i, lane)) break; } }
        } else if (op == OP_WO) {
            MK_LANE_TID();
            pg8::Gemm g{(const bf16*)(ws + WS_O), (const bf16*)(ws + WS_WO) + (size_t)pj * D * D, D, D, D, 0, 0};
            pg8::StaticOrder S; S.init(M / 256, D / 256, G, bx);
            pg8::EpiResid<0> E{MK_XBS(sout - 1), MK_XBO(sout), MK_SSQO(sout), args.in[18], nullptr, MK_UP_DUMMY};
            pg8::gemm_phase<pg8::EpiResid<0>, pg8::StaticOrder, true>(lds + RING_OFF, tid, g, S, E);
        }
        else if (op == OP_S5IN) {
            MK_LANE_TID();
            ph_toeplitz(ws, gw, NGW, lane);
            pg8::Gemm g{XB, (const bf16*)(ws + WS_WS5IN), D, D, D, 0, 0};
            pg8::StaticOrder S; S.init(M / 256, D / 256, G, bx);
            pg8::EpiU E{(bf16*)(ws + WS_ACT), SSQ + (size_t)sin * M};
            pg8::gemm_phase<pg8::EpiU, pg8::StaticOrder, true>(lds + RING_OFF, tid, g, S, E);
        } else if (op == OP_SSM) {
            MK_LANE_TID();
            pg8::StaticOrder S; S.init(BATCH, SG, G, bx);
            { pg8::Gemm g{(const bf16*)(ws + WS_ACT), (const bf16*)(ws + WS_BTA), 256, 384, 256, 0, 1024 * 384 * 2};
              pg8::EpiSloc E{(const float*)(ws + WS_LAMC), (bf16*)(ws + WS_ACT), lds + LDSCTL_OFF + 2048};
              pg8::gemm_phase<pg8::EpiSloc, pg8::StaticOrder, false>(lds + RING_OFF, tid, g, S, E); }
            { pg8::Gemm g{(const bf16*)(ws + WS_ACT), (const bf16*)(ws + WS_BTB), 384, 384, 384, 0, 1024 * 384 * 2};
              pg8::EpiY E{(const bf16*)(ws + WS_ACT), args.in[15], (bf16*)(ws + WS_ACT + 48 * MiB)};
              pg8::gemm_phase<pg8::EpiY, pg8::StaticOrder, true>(lds + RING_OFF, tid, g, S, E); }
        } else if (op == OP_GLU) {
            MK_LANE_TID();
            pg8::Gemm g{(const bf16*)(ws + WS_ACT + 48 * MiB), (const bf16*)(ws + WS_WGLU), D, MK_G1_NATURAL ? D : 16, D, MK_G1_NATURAL ? 0 : M * 16, 0};
            pg8::StaticOrder S; S.init(M / 256, 2 * D / 256, G, bx);
            pg8::EpiResid<1> E{MK_XBS(sout - 1), MK_XBO(sout), MK_SSQO(sout), args.in[18], nullptr, MK_UP_DUMMY};
            pg8::gemm_phase<pg8::EpiResid<1>, pg8::StaticOrder, true>(lds + RING_OFF, tid, g, S, E);
        }
        else if (op == OP_POOLPREP) {
        } else if (op == OP_POOLGEMM) {
            MK_LANE_TID();
            pg8::StaticOrder S; S.init(M / 256, 4, G, bx);
            { pg8::Unit u0; if (S.next(0, u0)) { const pg8::ssq_t* ssq = SSQ + (size_t)sin * M; const float* gain = args.in[1] + (size_t)layer * D; bf16* PD = (bf16*)(ws + WS_ACT);
                const int gi = u0.pn, c0 = gi * 256 + lane * 4; const f32x4 gg = *(const f32x4*)(gain + c0);
                for (int ci = wave; ci < 16; ci += NWAVES) { const int row0 = u0.pm * 256 + ci * 16, t0 = row0 & (SEQ - 1);
                    if (gi == 0) pool_item<2>(XB, ssq, gg, PD, row0, t0, c0); else if (gi == 1) pool_item<4>(XB, ssq, gg, PD, row0, t0, c0);
                    else if (gi == 2) pool_item<8>(XB, ssq, gg, PD, row0, t0, c0); else pool_item<16>(XB, ssq, gg, PD, row0, t0, c0); } }
              asm volatile("s_waitcnt vmcnt(0)" ::: "memory"); __syncthreads();
              if (wave == 0) { __builtin_amdgcn_fence(__ATOMIC_ACQUIRE, "agent"); asm volatile("s_waitcnt vmcnt(0)" ::: "memory"); }
              __syncthreads(); }
            pg8::Gemm g{(const bf16*)(ws + WS_ACT), (const bf16*)(ws + WS_WPOOL), 256, D, 256, 0, 512};
            pg8::EpiResid<2> E{MK_XBS(sout - 1), MK_XBS(sout), SSQ + (size_t)sout * M, args.in[18], args.in[19], 0};
            pg8::gemm_phase<pg8::EpiResid<2>, pg8::StaticOrder, true>(lds + RING_OFF, tid, g, S, E);
        } else if (op == OP_FINAL) {
            MK_LANE_TID();
            { const pg8::ssq_t* ssq = SSQ + (size_t)sin * M; const float* gain = args.in[3];
              for (int m = gw; m < M; m += NGW) { const float rs = pg8::rstd_row(ssq, m); f32x4* xr = (f32x4*)(X + (size_t)m * D) + lane; const f32x4* gr = (const f32x4*)gain + lane;
#pragma unroll
                  for (int j = 0; j < 4; ++j) xr[64 * j] = xr[64 * j] * rs * gr[64 * j]; } }
        }
        if (e + 1 < args.ph_hi) { MK_GRID_BAR(); }
    }
}
}
extern "C" void kernel_launch(void* const* d_in, const int* in_sizes, int n_in, void* d_out, int out_size, void* d_ws, size_t ws_size, hipStream_t stream) {
    static int grid = 0;
    if (grid == 0) {
        int dev = 0, cus = 0, per_cu = 0;
        if (hipGetDevice(&dev) != hipSuccess || hipDeviceGetAttribute(&cus, hipDeviceAttributeMultiprocessorCount, dev) != hipSuccess) { grid = -1; return; }
        if (hipFuncSetAttribute((const void*)mk::mega_k, hipFuncAttributeMaxDynamicSharedMemorySize, mk::LDS_BYTES) != hipSuccess) { grid = -1; return; }
        if (hipOccupancyMaxActiveBlocksPerMultiprocessor(&per_cu, (const void*)mk::mega_k, mk::NWAVES * 64, mk::LDS_BYTES) != hipSuccess || per_cu < 1) { fprintf(stderr, "kernel_launch: occupancy query says %d blocks per CU\n", per_cu); grid = -1; (void)hipGetLastError(); return; }
        (void)hipGetLastError();
        grid = cus;
        if (n_in != 22 || ws_size < mk::WS_END || cus != 256 || in_sizes[0] != mk::M * mk::D || out_size != mk::M * mk::D) { fprintf(stderr, "kernel_launch: unexpected n_in %d / ws_size %zu / CUs %d\n", n_in, ws_size, cus); grid = -1; }
    }
    if (grid < 0) return;
    (void)hipMemsetAsync((char*)d_ws + mk::WS_CTL, 0, mk::CTL_ZERO_BYTES, stream);
    mk::Args a{};
    for (int i = 0; i < 22; ++i) a.in[i] = (const float*)d_in[i];
    a.out = (float*)d_out; a.ws = (unsigned char*)d_ws;
#if MK_ONE_LAUNCH
    a.ph_lo = 0; a.ph_hi = mk::PH_LAST + 1;
    void* kargs[] = {&a};
    const hipError_t e = hipLaunchCooperativeKernel((const void*)mk::mega_k, dim3(grid), dim3(mk::NWAVES * 64), kargs, mk::LDS_BYTES, stream);
    if (e != hipSuccess) fprintf(stderr, "kernel_launch: cooperative launch failed: %s\n", hipGetErrorString(e));
#else
    for (int ph = 0; ph <= mk::PH_LAST; ++ph) { a.ph_lo = ph; a.ph_hi = ph + 1; hipLaunchKernelGGL(mk::mega_k, dim3(grid), dim3(mk::NWAVES * 64), mk::LDS_BYTES, stream, a);
    }
#endif
}
```
